# Optimizing an MI355X kernel written in HIP

```python
import math
import jax, jax.numpy as jnp
from jax import lax
import numpy as np

D_MODEL = 1024
BATCH = 8
SEQ = 2048
DEPTH = 2
DEC_BATCH = 128
DEC_SEQ = 4
PAST_LEN = 16384
PAGE_SIZE = 128

CHUNK = 64
BR_W = D_MODEL // 2
N_BRANCH = 3
M_HEADS = 4
M_HD = BR_W // M_HEADS
M_W = M_HEADS * M_HD
G_HEADS = 4
G_DK = BR_W // (2 * G_HEADS)
G_DV = BR_W // G_HEADS
G_KW = G_HEADS * G_DK
G_VW = G_HEADS * G_DV
G_RANK = 16
G_TAU = 16.0
S_HD = 64
S_HEADS = BR_W // S_HD
S_W = S_HEADS * S_HD
S_GROUPS = 2
S_HG = S_HEADS // S_GROUPS
S_STATE = 64
S_CONV = 4
S_XBC = S_W + 2 * S_GROUPS * S_STATE
P_HEADS = 8
P_NKEYS = 128
P_EXPERTS = P_NKEYS * P_NKEYS
P_QDIM = 256
P_HALF = P_QDIM // 2
P_TOPK = 16
P_BLOCK = 128
DN_ALPHA = (2.0 * DEPTH) ** 0.25
DN_BETA = (8.0 * DEPTH) ** -0.25
EPS = 1e-5

IN_SIZES = (M_W, M_W, M_W, M_W, M_HEADS, M_HEADS,
            G_KW, G_KW, G_VW, G_VW, G_RANK,
            S_W, S_XBC, S_HEADS,
            N_BRANCH * D_MODEL)
IN_W = sum(IN_SIZES)

kernel_name = 'hybrid_mlstm_gla_ssd_peer_step'


def _split_cols(z):
    out, start = [], 0
    for size in IN_SIZES:
        out.append(z[..., start:start + size])
        start += size
    return out


def _chunk_len(L):
    c = min(CHUNK, L)
    while L % c:
        c -= 1
    return c


def _to_chunks(a, c):
    B, L = a.shape[:2]
    a = a.reshape((B, L // c, c) + a.shape[2:])
    return jnp.moveaxis(a, 1, 0)


def _from_chunks(a):
    a = jnp.moveaxis(a, 0, 1)
    return a.reshape((a.shape[0], a.shape[1] * a.shape[2]) + a.shape[3:])


def _rms(x):
    return x * lax.rsqrt(jnp.mean(jnp.square(x), -1, keepdims=True) + EPS)


def _layernorm(x, g, b):
    xf = x.astype(jnp.float32)
    mu = xf.mean(-1, keepdims=True)
    var = jnp.mean(jnp.square(xf - mu), -1, keepdims=True)
    return (xf - mu) * lax.rsqrt(var + EPS) * g.astype(jnp.float32) + b.astype(jnp.float32)


def _mlstm(q, k, v, log_i, log_f, C0, n0, m0):
    c = _chunk_len(q.shape[1])
    causal = jnp.tril(jnp.ones((c, c), bool))

    def step(carry, xs):
        C, n, m = carry
        qc, kc, vc, lic, lfc = xs
        b = jnp.cumsum(lfc, axis=1)
        a = b + m[:, None, :]
        d = b[:, :, None, :] - b[:, None, :, :] + lic[:, None, :, :]
        d = jnp.where(causal[None, :, :, None], d, -jnp.inf)
        m_t = jnp.maximum(a, jnp.max(d, axis=2))
        s = jnp.einsum('bthd,bshd->btsh', qc, kc) * jnp.exp(d - m_t[:, :, None, :])
        e_in = jnp.exp(a - m_t)
        num = (jnp.einsum('btsh,bshd->bthd', s, vc)
               + e_in[..., None] * jnp.einsum('bhvd,bthd->bthv', C, qc))
        den = jnp.sum(s, axis=2) + e_in * jnp.einsum('bhd,bthd->bth', n, qc)
        h = num / jnp.maximum(jnp.abs(den), jnp.exp(-m_t))[..., None]
        b_last = b[:, -1, :]
        g = b_last[:, None, :] - b + lic
        m_new = jnp.maximum(b_last + m, jnp.max(g, axis=1))
        e_c = jnp.exp(b_last + m - m_new)
        wg = jnp.exp(g - m_new[:, None, :])
        C_new = e_c[..., None, None] * C + jnp.einsum('bsh,bshv,bshd->bhvd', wg, vc, kc)
        n_new = e_c[..., None] * n + jnp.einsum('bsh,bshd->bhd', wg, kc)
        return (C_new, n_new, m_new), h

    xs = tuple(_to_chunks(t, c) for t in (q, k, v, log_i, log_f))
    (C, n, m), h = lax.scan(step, (C0, n0, m0), xs)
    return _from_chunks(h), C, n, m


def _gla(q, k, v, log_a, S0):
    c = _chunk_len(q.shape[1])
    causal = jnp.tril(jnp.ones((c, c), bool))

    def step(S, xs):
        qc, kc, vc, lac = xs
        lam = jnp.cumsum(lac, axis=1)
        diff = lam[:, :, None] - lam[:, None, :]
        decay = jnp.exp(jnp.where(causal[None, :, :, None, None], diff, -jnp.inf))
        att = jnp.einsum('bthk,bshk,btshk->btsh', qc, kc, decay)
        o = (jnp.einsum('btsh,bshv->bthv', att, vc)
             + jnp.einsum('bthk,bhkv->bthv', qc * jnp.exp(lam), S))
        lam_last = lam[:, -1]
        S_new = (jnp.exp(lam_last)[..., None] * S
                 + jnp.einsum('bshk,bshv->bhkv', kc * jnp.exp(lam_last[:, None] - lam), vc))
        return S_new, o

    xs = tuple(_to_chunks(t, c) for t in (q, k, v, log_a))
    S, o = lax.scan(step, S0, xs)
    return _from_chunks(o), S


def _ssd(x, dt, Bm, Cm, A, h0):
    c = _chunk_len(x.shape[1])
    causal = jnp.tril(jnp.ones((c, c), bool))

    def step(h, xs):
        xc, dtc, bc, cc = xs
        lam = jnp.cumsum(dtc * A, axis=1)
        diff = lam[:, :, None] - lam[:, None, :]
        decay = jnp.exp(jnp.where(causal[None, :, :, None, None], diff, -jnp.inf))
        cb = jnp.einsum('btgn,bsgn->btsg', cc, bc)
        w = cb[..., None] * decay * dtc[:, None]
        y = (jnp.einsum('btsgh,bsghp->btghp', w, xc)
             + jnp.einsum('btgn,bghpn->btghp', cc, h) * jnp.exp(lam)[..., None])
        lam_last = lam[:, -1]
        ws = jnp.exp(lam_last[:, None] - lam) * dtc
        h_new = (jnp.exp(lam_last)[..., None, None] * h
                 + jnp.einsum('bsgh,bsghp,bsgn->bghpn', ws, xc, bc))
        return h_new, y

    xs = tuple(_to_chunks(t, c) for t in (x, dt, Bm, Cm))
    h, y = lax.scan(step, h0, xs)
    return _from_chunks(y), h


def _peer(x, p_wq, p_keys, p_u, p_v):
    f32 = jnp.float32
    B, L, D = x.shape
    T = B * L
    xf = x.reshape(T, D)
    q = jnp.matmul(xf, p_wq).astype(f32).reshape(T, P_HEADS, 2, P_HALF)
    sc = jnp.einsum('thjc,hjkc->thjk', q, p_keys.astype(f32))
    s, i = lax.top_k(sc, P_TOPK)
    cand = s[:, :, 0, :, None] + s[:, :, 1, None, :]
    cidx = i[:, :, 0, :, None] * P_NKEYS + i[:, :, 1, None, :]
    top_s, pos = lax.top_k(cand.reshape(T, P_HEADS, P_TOPK * P_TOPK), P_TOPK)
    eidx = jnp.take_along_axis(cidx.reshape(T, P_HEADS, P_TOPK * P_TOPK), pos, axis=-1)
    g = jax.nn.softmax(top_s, axis=-1)
    nb = -(-T // P_BLOCK)
    pad = nb * P_BLOCK - T
    xb = jnp.pad(xf, ((0, pad), (0, 0))).reshape(nb, P_BLOCK, D)
    eb = jnp.pad(eidx.reshape(T, P_HEADS * P_TOPK), ((0, pad), (0, 0))).reshape(nb, P_BLOCK, -1)
    gb = jnp.pad(g.reshape(T, P_HEADS * P_TOPK), ((0, pad), (0, 0))).reshape(nb, P_BLOCK, -1)

    def block(args):
        xt, et, gt = args
        u = jnp.take(p_u, et, axis=0)
        act = jax.nn.gelu(jnp.einsum('tkd,td->tk', u, xt).astype(f32), approximate=False) * gt
        vv = jnp.take(p_v, et, axis=0)
        return jnp.einsum('tk,tkd->td', act, vv.astype(f32))

    out = lax.map(block, (xb, eb, gb))
    return out.reshape(nb * P_BLOCK, D)[:T].reshape(B, L, D)


def _layer(x, C0, n0, m0, S0, h0, buf0,
           w_in, m_i_bias, m_f_bias, m_norm, g_a_up, g_a_bias, g_norm,
           s_conv_w, s_conv_b, s_dt_bias, s_A_log, s_D, s_norm,
           w_branch, w_out, ln1_g, ln1_b, p_wq, p_keys, p_u, p_v, ln2_g, ln2_b):
    f32 = jnp.float32
    B, L, _ = x.shape
    z = jnp.matmul(x, w_in).astype(f32)
    (mq, mk, mv, mo, mi, mf, gq, gk, gv, gr, ga, sz, sxbc, sdt, gate) = _split_cols(z)

    q = mq.reshape(B, L, M_HEADS, M_HD) * (M_HD ** -0.5)
    k = mk.reshape(B, L, M_HEADS, M_HD)
    v = mv.reshape(B, L, M_HEADS, M_HD)
    log_i = mi + m_i_bias.astype(f32)
    log_f = jax.nn.log_sigmoid(mf + m_f_bias.astype(f32))
    hm, C1, n1, m1 = _mlstm(q, k, v, log_i, log_f,
                            C0.astype(f32), n0.astype(f32), m0.astype(f32))
    mu = hm.mean(-1, keepdims=True)
    hm = (hm - mu) * lax.rsqrt(jnp.mean(jnp.square(hm - mu), -1, keepdims=True) + EPS)
    hm = hm.reshape(B, L, M_W) * m_norm.astype(f32) * jax.nn.sigmoid(mo)

    q = gq.reshape(B, L, G_HEADS, G_DK) * (G_DK ** -0.5)
    k = gk.reshape(B, L, G_HEADS, G_DK)
    v = gv.reshape(B, L, G_HEADS, G_DV)
    log_a = jax.nn.log_sigmoid(jnp.matmul(ga, g_a_up.astype(f32)) + g_a_bias.astype(f32)) / G_TAU
    hg, S1 = _gla(q, k, v, log_a.reshape(B, L, G_HEADS, G_DK), S0.astype(f32))
    hg = _rms(hg).reshape(B, L, G_VW) * g_norm.astype(f32) * jax.nn.silu(gr)

    xp = jnp.concatenate([buf0.astype(f32), sxbc], axis=1)
    cw = s_conv_w.astype(f32)
    conv = s_conv_b.astype(f32) + sum(cw[j] * xp[:, j:j + L] for j in range(S_CONV))
    buf1 = xp[:, L:]
    act = jax.nn.silu(conv)
    xs = act[..., :S_W].reshape(B, L, S_GROUPS, S_HG, S_HD)
    Bm = act[..., S_W:S_W + S_GROUPS * S_STATE].reshape(B, L, S_GROUPS, S_STATE)
    Cm = act[..., S_W + S_GROUPS * S_STATE:].reshape(B, L, S_GROUPS, S_STATE)
    dt = jax.nn.softplus(sdt + s_dt_bias.astype(f32)).reshape(B, L, S_GROUPS, S_HG)
    A = -jnp.exp(s_A_log.astype(f32)).reshape(S_GROUPS, S_HG)
    ys, h1 = _ssd(xs, dt, Bm, Cm, A,
                  h0.astype(f32).reshape(B, S_GROUPS, S_HG, S_HD, S_STATE))
    ys = ys + s_D.astype(f32).reshape(S_GROUPS, S_HG, 1) * xs
    ys = ys.reshape(B, L, S_W) * jax.nn.silu(sz)
    hs = _rms(ys.reshape(B, L, S_GROUPS, S_W // S_GROUPS)).reshape(B, L, S_W) * s_norm.astype(f32)
    h1 = h1.reshape(B, S_HEADS, S_HD, S_STATE)

    br = jnp.stack([hm, hg, hs], axis=2)
    proj = jnp.einsum('blnc,ncd->blnd', br, w_branch.astype(f32))
    gates = jax.nn.sigmoid(gate.reshape(B, L, N_BRANCH, D_MODEL))
    mixed = jnp.sum(gates * proj, axis=2)
    y = jnp.matmul(mixed, w_out.astype(f32))
    h = _layernorm(DN_ALPHA * x.astype(f32) + y, ln1_g, ln1_b)

    h = _layernorm(DN_ALPHA * h + _peer(h, p_wq, p_keys, p_u, p_v), ln2_g, ln2_b)
    return (h.astype(x.dtype), C1.astype(C0.dtype), n1.astype(n0.dtype), m1.astype(m0.dtype),
            S1.astype(S0.dtype), h1.astype(h0.dtype), buf1.astype(buf0.dtype))


def _zero_states(b, dtype):
    return (jnp.zeros((b, M_HEADS, M_HD, M_HD), dtype),
            jnp.zeros((b, M_HEADS, M_HD), dtype),
            jnp.zeros((b, M_HEADS), dtype),
            jnp.zeros((b, G_HEADS, G_DK, G_DV), dtype),
            jnp.zeros((b, S_HEADS, S_HD, S_STATE), dtype),
            jnp.zeros((b, S_CONV - 1, S_XBC), dtype))


def setup_inputs(seed: int = 0) -> dict:
    key = jax.random.key(seed)
    ks = iter(jax.random.split(key, 48))
    nrm = lambda shape, s=1.0: jax.random.normal(next(ks), shape, jnp.float32) * s
    uni = lambda shape, lo, hi: jax.random.uniform(next(ks), shape, jnp.float32, lo, hi)
    Dd = DEPTH
    dt0 = jnp.exp(uni((Dd, S_HEADS), math.log(1e-3), math.log(1e-1)))
    return {
        'x_prompt': nrm((BATCH, SEQ, D_MODEL)),
        'x_sample': nrm((DEC_BATCH, DEC_SEQ, D_MODEL)),
        'state_mlstm_C': nrm((Dd, DEC_BATCH, M_HEADS, M_HD, M_HD), 0.1),
        'state_mlstm_n': nrm((Dd, DEC_BATCH, M_HEADS, M_HD), 0.5),
        'state_mlstm_m': uni((Dd, DEC_BATCH, M_HEADS), 0.0, 3.0),
        'state_gla_S': nrm((Dd, DEC_BATCH, G_HEADS, G_DK, G_DV), 0.1),
        'state_ssm_h': nrm((Dd, DEC_BATCH, S_HEADS, S_HD, S_STATE), 0.1),
        'state_conv': nrm((Dd, DEC_BATCH, S_CONV - 1, S_XBC)),
        'w_in': nrm((Dd, D_MODEL, IN_W), D_MODEL ** -0.5),
        'm_i_bias': nrm((Dd, M_HEADS), 0.1),
        'm_f_bias': uni((Dd, M_HEADS), 3.0, 6.0),
        'm_norm': 1.0 + nrm((Dd, M_W), 0.02),
        'g_a_up': nrm((Dd, G_RANK, G_KW), G_RANK ** -0.5),
        'g_a_bias': nrm((Dd, G_KW), 0.1),
        'g_norm': 1.0 + nrm((Dd, G_VW), 0.02),
        's_conv_w': nrm((Dd, S_CONV, S_XBC), S_CONV ** -0.5),
        's_conv_b': nrm((Dd, S_XBC), 0.01),
        's_dt_bias': dt0 + jnp.log(-jnp.expm1(-dt0)),
        's_A_log': jnp.log(uni((Dd, S_HEADS), 1.0, 16.0)),
        's_D': 1.0 + nrm((Dd, S_HEADS), 0.1),
        's_norm': 1.0 + nrm((Dd, S_W), 0.02),
        'w_branch': nrm((Dd, N_BRANCH, BR_W, D_MODEL), DN_BETA * BR_W ** -0.5),
        'w_out': nrm((Dd, D_MODEL, D_MODEL), DN_BETA * D_MODEL ** -0.5),
        'ln1_g': 1.0 + nrm((Dd, D_MODEL), 0.01),
        'ln1_b': nrm((Dd, D_MODEL), 0.01),
        'p_wq': nrm((Dd, D_MODEL, P_HEADS * P_QDIM), D_MODEL ** -0.5),
        'p_keys': nrm((Dd, P_HEADS, 2, P_NKEYS, P_HALF), P_HALF ** -0.5),
        'p_u': nrm((Dd, P_EXPERTS, D_MODEL), D_MODEL ** -0.5),
        'p_v': nrm((Dd, P_EXPERTS, D_MODEL), DN_BETA * (P_HEADS * P_TOPK) ** -0.5),
        'ln2_g': 1.0 + nrm((Dd, D_MODEL), 0.01),
        'ln2_b': nrm((Dd, D_MODEL), 0.01),
    }


def reference(x_prompt, x_sample, state_mlstm_C, state_mlstm_n, state_mlstm_m,
              state_gla_S, state_ssm_h, state_conv,
              w_in, m_i_bias, m_f_bias, m_norm, g_a_up, g_a_bias, g_norm,
              s_conv_w, s_conv_b, s_dt_bias, s_A_log, s_D, s_norm,
              w_branch, w_out, ln1_g, ln1_b, p_wq, p_keys, p_u, p_v, ln2_g, ln2_b):
    hp, hs = x_prompt, x_sample
    new_p = [[] for _ in range(6)]
    new_s = [[] for _ in range(6)]
    for l in range(DEPTH):
        w = (w_in[l], m_i_bias[l], m_f_bias[l], m_norm[l], g_a_up[l], g_a_bias[l], g_norm[l],
             s_conv_w[l], s_conv_b[l], s_dt_bias[l], s_A_log[l], s_D[l], s_norm[l],
             w_branch[l], w_out[l], ln1_g[l], ln1_b[l], p_wq[l], p_keys[l], p_u[l], p_v[l],
             ln2_g[l], ln2_b[l])
        outp = _layer(hp, *_zero_states(hp.shape[0], state_mlstm_C.dtype), *w)
        outs = _layer(hs, state_mlstm_C[l], state_mlstm_n[l], state_mlstm_m[l],
                      state_gla_S[l], state_ssm_h[l], state_conv[l], *w)
        hp, hs = outp[0], outs[0]
        for j in range(6):
            new_p[j].append(outp[j + 1])
            new_s[j].append(outs[j + 1])
    P = [jnp.stack(a, axis=0) for a in new_p]
    S = [jnp.stack(a, axis=0) for a in new_s]
    return (hp, hs, P[0], P[1], P[2], P[3], P[4], P[5], S[0], S[1], S[2], S[3], S[4], S[5])
```

```cpp
#ifndef EMU
#include <hip/hip_runtime.h>
#include <hip/hip_cooperative_groups.h>
#include <cstdio>
#include <cstdint>
namespace cg = cooperative_groups;
namespace pg8 {
#define PG8_LAS __attribute__((address_space(3)))
typedef unsigned short bf16_t;
typedef short bf16x8 __attribute__((ext_vector_type(8)));
typedef float f32x4 __attribute__((ext_vector_type(4)));
typedef unsigned u32x4 __attribute__((ext_vector_type(4)));
constexpr int BM = 256, BK = 64, HALF = 128, HTB = HALF * BK * 2  , STAGE_BYTES = 8 * HTB, NXCD = 8, WGM = 8;

__host__ __device__ __forceinline__ int lds_byte(int r, int c) { const int st = (r >> 4) * 2 + (c >> 5), rr = r & 15, cc = c & 31, ob = rr * 64 + cc * 2; return st * 1024 + (ob ^ (((ob >> 9) & 1) << 5)); }
__host__ __device__ __forceinline__ void stage_rc(int b, int& R, int& C) { const int st = b / 1024, sb = b % 1024, swz = sb ^ (((sb >> 9) & 1) << 5); R = (st >> 1) * 16 + swz / 64; C = (st & 1) * 32 + (swz % 64) / 2; }
__host__ __device__ __forceinline__ int perm32(int rho) { const int n = rho >> 4, i = rho & 15; return 8 * (i >> 2) + 4 * n + (i & 3); }

struct Unit { int pm, pn; };
struct Gemm { const bf16_t* A; const bf16_t* Bt; int M, N, K; };

struct StaticOrder {
    int nM, nN, nwg, G, c;
    __host__ __device__ void init(int M, int N, int G_, int c_) { nM = M / BM; nN = N / BM; nwg = nM * nN; G = G_; c = c_; }
    __host__ __device__ bool next(int i, Unit& u) const {
        const long L = (long)i * G + c; if (L >= nwg) return false;
        int wgid = (int)L; { const int q = nwg / NXCD, r = nwg % NXCD, xcd = wgid % NXCD, off = wgid / NXCD; wgid = (xcd < r ? xcd * (q + 1) : r * (q + 1) + (xcd - r) * q) + off; }
        const int nig = WGM * nN, gid = wgid / nig, fm = gid * WGM, gsz = (nM - fm) < WGM ? (nM - fm) : WGM;
        u.pm = fm + ((wgid % nig) % gsz); u.pn = (wgid % nig) / gsz; return true;
    }
    __device__ __forceinline__ void a_ready(const Unit&) const {}
    __device__ __forceinline__ void done(const Unit&) const {}
};

__device__ __forceinline__ unsigned cvt_pk_bf16(float lo, float hi) { unsigned r; asm volatile("v_cvt_pk_bf16_f32 %0, %1, %2" : "=v"(r) : "v"(lo), "v"(hi)); return r; }
typedef float f32x2 __attribute__((ext_vector_type(2)));
__device__ __forceinline__ f32x2 gelu_pk(f32x2 v) {
    const f32x2 av = __builtin_elementwise_abs(v), d = av * 0.2316418882f + 1.0f;
    f32x2 t; t.x = __builtin_amdgcn_rcpf(d.x); t.y = __builtin_amdgcn_rcpf(d.y);
    f32x2 q = t * 0.5307027145f + (-0.7265760135f); q = q * t + 0.7107068705f; q = q * t + (-0.142248368f); q = q * t + 0.127414796f; q = q * t;
    const f32x2 s = (v * v) * (-0.72134752044f);
    f32x2 e; e.x = __builtin_amdgcn_exp2f(s.x); e.y = __builtin_amdgcn_exp2f(s.y);
    const f32x2 m = v * (q * e), r = v - m;
    f32x2 o; o.x = v.x < 0.f ? m.x : r.x; o.y = v.y < 0.f ? m.y : r.y; return o;
}

template <class Epi, class Sched>
__device__ __forceinline__ void gemm_phase(PG8_LAS unsigned char* lds, const Gemm g, const Sched& S, const Epi& E) {
    int tid_o = threadIdx.x; asm volatile("" : "+v"(tid_o));
    const int tid = tid_o, wid = __builtin_amdgcn_readfirstlane(tid >> 6), lane = tid & 63, wr = wid >> 2, wc = wid & 3, fr = lane & 15, fq = lane >> 4;
    const int K = g.K, nt = K / BK;
    unsigned voffA[2], voffB[2];
#pragma unroll
    for (int i = 0; i < 2; ++i) { int R, C; stage_rc(tid * 16 + i * 8192, R, C); const int Rb = Epi::PERM ? ((R & ~31) + perm32(R & 31)) : R;
        voffA[i] = (unsigned)(R * K + C) * 2u; voffB[i] = (unsigned)(Rb * K + C) * 2u; }
    const size_t kstep = (size_t)(BK * 2);
    const size_t hstep = (size_t)HALF * K * 2;
    const size_t tstep = 2 * hstep;
    const unsigned ldsw = (unsigned)wid * 1024u;
    const int aoff = lds_byte(wr * 64 + fr, fq * 8), boff = lds_byte(wc * 32 + fr, fq * 8);
#define PG8_SA(b, h) (((b) * 2 + (h)) * HTB)
#define PG8_SB(b, h) ((4 + (b) * 2 + (h)) * HTB)
#define PG8_STAGE(bufoff, gbase, voff) do { _Pragma("unroll") for (int _i = 0; _i < 2; ++_i) \
        __builtin_amdgcn_global_load_lds((const unsigned*)((const char*)(gbase) + (voff)[_i]), (PG8_LAS unsigned*)(lds + (bufoff) + ldsw + _i * 8192), 16, 0, 0); } while (0)
#define PG8_LDA(dst, b, h) do { _Pragma("unroll") for (int m = 0; m < 4; ++m) _Pragma("unroll") for (int k = 0; k < 2; ++k) dst[m][k] = *(const PG8_LAS bf16x8*)(lds + PG8_SA(b, h) + aoff + m * 2048 + k * 1024); } while (0)
#define PG8_LDB(dst, b, h) do { _Pragma("unroll") for (int n = 0; n < 2; ++n) _Pragma("unroll") for (int k = 0; k < 2; ++k) dst[n][k] = *(const PG8_LAS bf16x8*)(lds + PG8_SB(b, h) + boff + n * 2048 + k * 1024); } while (0)
#define PG8_MMA(ai, bj, At, Bt) do { __builtin_amdgcn_s_setprio(1); _Pragma("unroll") for (int m = 0; m < 4; ++m) _Pragma("unroll") for (int n = 0; n < 2; ++n) _Pragma("unroll") for (int k = 0; k < 2; ++k) \
        acc[ai][bj][m][n] = __builtin_amdgcn_mfma_f32_16x16x32_bf16(Bt[n][k], At[m][k], acc[ai][bj][m][n], 0, 0, 0); __builtin_amdgcn_s_setprio(0); } while (0)
#define PG8_WAIT_V(n) asm volatile("s_waitcnt vmcnt(" #n ")" ::: "memory")
#define PG8_WAIT_L(n) asm volatile("s_waitcnt lgkmcnt(" #n ")" ::: "memory")
#define PG8_BAR __builtin_amdgcn_s_barrier()
#define PG8_SCHED __builtin_amdgcn_sched_barrier(0)
    Unit cur, nxt; int ui = 0;
    if (!S.next(0, cur)) return;
    f32x4 acc[2][2][4][2];
#pragma unroll
    for (int a = 0; a < 2; ++a)
#pragma unroll
        for (int b = 0; b < 2; ++b)
#pragma unroll
            for (int m = 0; m < 4; ++m)
#pragma unroll
                for (int n = 0; n < 2; ++n) acc[a][b][m][n] = (f32x4){0.f, 0.f, 0.f, 0.f};
    bf16x8 At[4][2], B0[2][2], B1[2][2];
    const char* cA = (const char*)g.A + (size_t)cur.pm * tstep; const char* cB = (const char*)g.Bt + (size_t)cur.pn * tstep;
    S.a_ready(cur);
    PG8_STAGE(PG8_SB(0, 0), cB, voffB); PG8_STAGE(PG8_SA(0, 0), cA, voffA); PG8_STAGE(PG8_SB(0, 1), cB + hstep, voffB); PG8_STAGE(PG8_SA(0, 1), cA + hstep, voffA);
    if (wr == 1) PG8_BAR;
    PG8_WAIT_V(4); PG8_BAR;
    PG8_STAGE(PG8_SB(1, 0), cB + kstep, voffB); PG8_STAGE(PG8_SA(1, 0), cA + kstep, voffA); PG8_STAGE(PG8_SB(1, 1), cB + hstep + kstep, voffB);
    PG8_WAIT_V(6); PG8_BAR;
    for (;;) {
        const bool has_next = S.next(ui + 1, nxt);
        const char* nA = has_next ? (const char*)g.A + (size_t)nxt.pm * tstep : cA; const char* nB = has_next ? (const char*)g.Bt + (size_t)nxt.pn * tstep : cB;
        for (int t = 0; t < nt; t += 2) {
            const bool last = (t == nt - 2);
            const char* a1 = cA + (size_t)(t + 1) * kstep;
            const char* a2 = last ? nA : cA + (size_t)(t + 2) * kstep; const char* b2 = last ? nB : cB + (size_t)(t + 2) * kstep;
            const char* a3 = a2 + kstep; const char* b3 = b2 + kstep;
            if (last && has_next) S.a_ready(nxt);
            PG8_LDB(B0, 0, 0); PG8_SCHED; PG8_LDA(At, 0, 0); PG8_STAGE(PG8_SA(1, 1), a1 + hstep, voffA);
            PG8_WAIT_L(8); PG8_BAR; PG8_WAIT_L(0); PG8_MMA(0, 0, At, B0); PG8_BAR; PG8_SCHED;
            PG8_LDB(B1, 0, 1); PG8_STAGE(PG8_SB(0, 0), b2, voffB);
            PG8_BAR; PG8_WAIT_L(0); PG8_MMA(0, 1, At, B1); PG8_BAR;
            PG8_LDA(At, 0, 1); PG8_STAGE(PG8_SA(0, 0), a2, voffA);
            PG8_BAR; PG8_WAIT_L(0); PG8_MMA(1, 0, At, B0); PG8_BAR; PG8_SCHED;
            PG8_STAGE(PG8_SB(0, 1), b2 + hstep, voffB);
            PG8_WAIT_V(6); PG8_BAR; PG8_MMA(1, 1, At, B1); PG8_BAR;
            PG8_LDB(B0, 1, 0); PG8_SCHED; PG8_LDA(At, 1, 0); PG8_STAGE(PG8_SA(0, 1), a2 + hstep, voffA);
            PG8_WAIT_L(8); PG8_BAR; PG8_WAIT_L(0); PG8_MMA(0, 0, At, B0); PG8_BAR; PG8_SCHED;
            PG8_LDB(B1, 1, 1); PG8_STAGE(PG8_SB(1, 0), b3, voffB);
            PG8_BAR; PG8_WAIT_L(0); PG8_MMA(0, 1, At, B1); PG8_BAR;
            PG8_LDA(At, 1, 1); PG8_STAGE(PG8_SA(1, 0), a3, voffA);
            PG8_BAR; PG8_WAIT_L(0); PG8_MMA(1, 0, At, B0); PG8_BAR; PG8_SCHED;
            PG8_STAGE(PG8_SB(1, 1), b3 + hstep, voffB);
            PG8_WAIT_V(6); PG8_BAR; PG8_MMA(1, 1, At, B1); PG8_BAR;
        }
        if constexpr (!Epi::AFTER_DRAIN) { E(acc, cur, wr, wc, fr, fq); S.done(cur); }
        if (!has_next) break;
#pragma unroll
        for (int a = 0; a < 2; ++a)
#pragma unroll
            for (int b = 0; b < 2; ++b)
#pragma unroll
                for (int m = 0; m < 4; ++m)
#pragma unroll
                    for (int n = 0; n < 2; ++n) acc[a][b][m][n] = (f32x4){0.f, 0.f, 0.f, 0.f};
        cur = nxt; cA = nA; cB = nB; ++ui;
    }
    PG8_WAIT_V(0);
    if (wr == 0) PG8_BAR;
    PG8_BAR;
    if constexpr (Epi::AFTER_DRAIN) { E.fused(acc, cur, wr, wc, fr, fq, lds, wid, lane); S.done(cur); }
#undef PG8_SA
#undef PG8_SB
#undef PG8_STAGE
#undef PG8_LDA
#undef PG8_LDB
#undef PG8_MMA
#undef PG8_WAIT_V
#undef PG8_WAIT_L
#undef PG8_BAR
#undef PG8_SCHED
}
}

#endif

typedef unsigned short bf16;
#ifndef EMU
#define LAS __attribute__((address_space(3)))
#else
#define LAS
#endif
typedef short bf16x8 __attribute__((ext_vector_type(8)));
typedef float f32x4 __attribute__((ext_vector_type(4)));
typedef unsigned u32x4 __attribute__((ext_vector_type(4)));
typedef unsigned u32x2 __attribute__((ext_vector_type(2)));

#ifdef EMU
constexpr int BP = EMU_BP, LP = EMU_LP, BS = EMU_BS;
#else
constexpr int BP = 8, LP = 2048, BS = 128;
#endif
constexpr int D = 1024, LS = 4, TP = BP * LP, TS = BS * LS, T = TP + TS;
constexpr int INW = 7968, NZM = 4864, NZG = 3072, NZ = NZM + NZG, NSM = 32;
constexpr int NEXP = 16384;
constexpr int NTHREADS = 512, NWAVES = 8;
constexpr int LDS_BYTES = 160 * 1024;

constexpr size_t O_YP = 0, O_YS = O_YP + (size_t)TP * D, O_PC = O_YS + (size_t)TS * D, O_PN = O_PC + 2ull * BP * 4 * 128 * 128, O_PM = O_PN + 2ull * BP * 4 * 128,
    O_PG = O_PM + 2ull * BP * 4, O_PH = O_PG + 2ull * BP * 4 * 64 * 128, O_PV = O_PH + 2ull * BP * 8 * 64 * 64, O_SC = O_PV + 2ull * BP * 3 * 768,
    O_SN = O_SC + 2ull * BS * 4 * 128 * 128, O_SM = O_SN + 2ull * BS * 4 * 128, O_SG = O_SM + 2ull * BS * 4, O_SH = O_SG + 2ull * BS * 4 * 64 * 128,
    O_SV = O_SH + 2ull * BS * 8 * 64 * 64, O_END = O_SV + 2ull * BS * 3 * 768;

constexpr size_t al256(size_t x) { return (x + 255) & ~(size_t)255; }
constexpr size_t WS_CTL = 0, WS_CTL_BYTES = 65536;
constexpr size_t WB_WIN = 0, WB_WS = WB_WIN + (size_t)NZ * D * 2, WB_WBR = WB_WS + (size_t)NSM * D * 2, WB_WO = WB_WBR + 3ull * D * 512 * 2, WB_WQ = WB_WO + (size_t)D * D * 2,
    WB_KEYS = WB_WQ + 2048ull * D * 2, WB_BYTES = WB_KEYS + 16ull * 128 * 128 * 2;
constexpr size_t WS_WB = WS_CTL + WS_CTL_BYTES;
constexpr size_t WS_XB = WS_WB + 2 * WB_BYTES;
constexpr size_t WS_H = WS_XB + (size_t)T * D * 2;
constexpr size_t WS_ZS = WS_H + (size_t)T * D * 4;
constexpr size_t WS_BR = WS_ZS + (size_t)T * NSM * 4;
constexpr size_t WS_ZM = WS_BR + 3ull * T * 512 * 2;
constexpr size_t WS_ZG = WS_ZM + (size_t)T * NZM * 2;
constexpr size_t WS_END0 = WS_ZG + (size_t)T * NZG * 2;
constexpr size_t WS_Q = WS_ZM, WS_IDX = WS_Q + (size_t)T * 2048 * 2, WS_GT = WS_IDX + (size_t)T * 128 * 4;
#ifdef EMU
constexpr size_t WS_PU = WS_END0, WS_PV = WS_PU + (size_t)NEXP * D * 2, WS_END = WS_PV + (size_t)NEXP * D * 2;
#else
constexpr size_t WS_PU = WS_GT + (size_t)T * 128 * 4, WS_PV = WS_PU + (size_t)NEXP * D * 2, WS_ZM_END = WS_PV + (size_t)NEXP * D * 2, WS_END = WS_END0;
static_assert(WS_ZM_END <= WS_ZG, "ZM alias overflow");
#endif
static_assert((size_t)T * D * 4 <= (size_t)T * NZG * 2, "Y alias overflow");

#ifndef EMU
__device__ __forceinline__ f32x4 mfma16(bf16x8 a, bf16x8 b, f32x4 c) { return __builtin_amdgcn_mfma_f32_16x16x32_bf16(a, b, c, 0, 0, 0); }
#endif
struct Args { const float* in[31]; float* out; unsigned char* ws; int ph_lo, ph_hi; };
#ifndef EMU
typedef const __attribute__((address_space(4))) Args* ArgP;
#else
typedef const Args* ArgP;
#endif
#define A (*Ap)
#ifndef EMU
__device__ __forceinline__ int opaque_tid() { int t = threadIdx.x; asm volatile("" : "+v"(t)); return t; }
#else
static inline int opaque_tid() { return threadIdx.x; }
#endif

__device__ __forceinline__ bf16 f2bf(float f) { unsigned u = __float_as_uint(f); u += 0x7FFFu + ((u >> 16) & 1u); return (bf16)(u >> 16); }
__device__ __forceinline__ float bf2f(bf16 b) { return __uint_as_float(((unsigned)b) << 16); }
__device__ __forceinline__ unsigned pk2(float lo, float hi) { return (unsigned)f2bf(lo) | ((unsigned)f2bf(hi) << 16); }

__device__ __forceinline__ void tconv_tile(const float* __restrict__ src, int ldsrc, int k0, int c0, bf16* __restrict__ dst, int ldd, int n0, LAS float* tile) {
    const int t = opaque_tid(), i = t >> 3, jg = (t & 7) * 8;
    const float4 a = *(const float4*)(src + (size_t)(k0 + i) * ldsrc + c0 + jg), b = *(const float4*)(src + (size_t)(k0 + i) * ldsrc + c0 + jg + 4);
    LAS float* r = tile + i * 65 + jg;
    r[0] = a.x; r[1] = a.y; r[2] = a.z; r[3] = a.w; r[4] = b.x; r[5] = b.y; r[6] = b.z; r[7] = b.w;
    __syncthreads();
    const int j = t >> 3, ig = (t & 7) * 8;
    u32x4 w;
    w.x = pk2(tile[(ig + 0) * 65 + j], tile[(ig + 1) * 65 + j]); w.y = pk2(tile[(ig + 2) * 65 + j], tile[(ig + 3) * 65 + j]);
    w.z = pk2(tile[(ig + 4) * 65 + j], tile[(ig + 5) * 65 + j]); w.w = pk2(tile[(ig + 6) * 65 + j], tile[(ig + 7) * 65 + j]);
    *(u32x4*)(dst + (size_t)(n0 + j) * ldd + k0 + ig) = w;
    __syncthreads();
}
__device__ __forceinline__ int zcol_to_src(int zc) { return zc < 2048 ? zc : (zc < 3584 ? zc + 8 : (zc < 4864 ? zc + 24 : zc + 32)); }
__device__ __forceinline__ int scol_to_src(int sc) { return sc < 8 ? 2048 + sc : (sc < 24 ? 3592 + (sc - 8) : 4888 + (sc - 24)); }

__device__ __forceinline__ void convert_f32_bf16(const float* __restrict__ src, bf16* __restrict__ dst, size_t n, int gtid, int gthreads) {
    for (size_t i = (size_t)gtid * 8; i < n; i += (size_t)gthreads * 8) {
        const float4 a = *(const float4*)(src + i), b = *(const float4*)(src + i + 4);
        u32x4 w; w.x = pk2(a.x, a.y); w.y = pk2(a.z, a.w); w.z = pk2(b.x, b.y); w.w = pk2(b.z, b.w);
        *(u32x4*)(dst + i) = w;
    }
}

__device__ __forceinline__ void phase_convert(ArgP Ap, LAS unsigned char* lds) {
    LAS float* tile = (LAS float*)lds;
    const int G = gridDim.x, bid = blockIdx.x;
    constexpr int I_WIN = (NZ / 64) * (D / 64), I_WBR = 3 * (D / 64) * (512 / 64), I_WO = (D / 64) * (D / 64), I_WQ = (2048 / 64) * (D / 64), I_L = I_WIN + I_WBR + I_WO + I_WQ;
    for (int it = bid; it < 2 * I_L; it += G) {
        const int l = it / I_L; int r = it % I_L;
        unsigned char* wb = A.ws + WS_WB + (size_t)l * WB_BYTES;
        if (r < I_WIN) { const int nt = r / (D / 64), kt = r % (D / 64);
            tconv_tile(A.in[8] + (size_t)l * D * INW, INW, kt * 64, zcol_to_src(nt * 64), (bf16*)(wb + WB_WIN), D, nt * 64, tile); continue; }
        r -= I_WIN;
        if (r < I_WBR) { const int n = r / ((D / 64) * 8), rr = r % ((D / 64) * 8), nt = rr / 8, kt = rr % 8;
            tconv_tile(A.in[21] + ((size_t)l * 3 + n) * 512 * D, D, kt * 64, nt * 64, (bf16*)(wb + WB_WBR) + (size_t)n * D * 512, 512, nt * 64, tile); continue; }
        r -= I_WBR;
        if (r < I_WO) { const int nt = r / (D / 64), kt = r % (D / 64);
            tconv_tile(A.in[22] + (size_t)l * D * D, D, kt * 64, nt * 64, (bf16*)(wb + WB_WO), D, nt * 64, tile); continue; }
        r -= I_WO;
        { const int nt = r / (D / 64), kt = r % (D / 64);
            tconv_tile(A.in[25] + (size_t)l * D * 2048, 2048, kt * 64, nt * 64, (bf16*)(wb + WB_WQ), D, nt * 64, tile); }
    }
    const int gtid = bid * NTHREADS + opaque_tid(), gthreads = G * NTHREADS;
    for (int l = 0; l < 2; ++l) {
        unsigned char* wb = A.ws + WS_WB + (size_t)l * WB_BYTES;
        for (int e = gtid; e < NSM * D; e += gthreads) { const int n = e / D, k = e % D; ((bf16*)(wb + WB_WS))[e] = f2bf(A.in[8][(size_t)l * D * INW + (size_t)k * INW + scol_to_src(n)]); }
        convert_f32_bf16(A.in[26] + (size_t)l * 16 * 128 * 128, (bf16*)(wb + WB_KEYS), 16 * 128 * 128, gtid, gthreads);
    }
    convert_f32_bf16(A.in[0], (bf16*)(A.ws + WS_XB), (size_t)TP * D, gtid, gthreads);
    convert_f32_bf16(A.in[1], (bf16*)(A.ws + WS_XB) + (size_t)TP * D, (size_t)TS * D, gtid, gthreads);
}

#ifndef EMU
struct EpiZ {
    static constexpr bool PERM = true, AFTER_DRAIN = false;
    bf16* ZM; bf16* ZG;
    __device__ __forceinline__ void operator()(const pg8::f32x4 (&acc)[2][2][4][2], const pg8::Unit& u, int wr, int wc, int fr, int fq) const {
        const int row0 = u.pm * 256 + wr * 64 + fr; const bool gate = u.pn >= 19;
        bf16* base = gate ? ZG : ZM; const int ldc = gate ? NZG : NZM; const int col0 = (gate ? (u.pn - 19) : u.pn) * 256 + wc * 32 + 8 * fq;
#pragma unroll
        for (int ai = 0; ai < 2; ++ai)
#pragma unroll
            for (int m = 0; m < 4; ++m) { bf16* rowp = base + (size_t)(row0 + ai * 128 + m * 16) * ldc + col0;
#pragma unroll
                for (int bj = 0; bj < 2; ++bj) { f32x4 v0 = acc[ai][bj][m][0], v1 = acc[ai][bj][m][1];
                    if (gate) {
#pragma unroll
                        for (int j = 0; j < 4; ++j) { v0[j] = __builtin_amdgcn_rcpf(1.0f + __expf(-v0[j])); v1[j] = __builtin_amdgcn_rcpf(1.0f + __expf(-v1[j])); } }
                    u32x4 w; w.x = pg8::cvt_pk_bf16(v0[0], v0[1]); w.y = pg8::cvt_pk_bf16(v0[2], v0[3]); w.z = pg8::cvt_pk_bf16(v1[0], v1[1]); w.w = pg8::cvt_pk_bf16(v1[2], v1[3]);
                    *(u32x4*)(rowp + bj * 128) = w; } }
    }
};

#endif
__device__ __forceinline__ void small_gemm(const bf16* __restrict__ XB, const bf16* __restrict__ WsT, float* __restrict__ ZS) {
    const int tx = opaque_tid(), lane = tx & 63, wave = tx >> 6, gw = blockIdx.x * NWAVES + wave, NGW = gridDim.x * NWAVES, fr = lane & 15, fq = lane >> 4;
    for (int rg = gw; rg < T / 16; rg += NGW) {
        f32x4 a0 = {0.f, 0.f, 0.f, 0.f}, a1 = {0.f, 0.f, 0.f, 0.f};
        const bf16* ap = XB + (size_t)(rg * 16 + fr) * D + 8 * fq; const bf16* b0p = WsT + (size_t)fr * D + 8 * fq; const bf16* b1p = WsT + (size_t)(16 + fr) * D + 8 * fq;
#pragma unroll 4
        for (int k0 = 0; k0 < D; k0 += 32) {
            const bf16x8 a = *(const bf16x8*)(ap + k0), b0 = *(const bf16x8*)(b0p + k0), b1 = *(const bf16x8*)(b1p + k0);
            a0 = mfma16(a, b0, a0); a1 = mfma16(a, b1, a1);
        }
#pragma unroll
        for (int r = 0; r < 4; ++r) { float* o = ZS + (size_t)(rg * 16 + fq * 4 + r) * NSM + fr; o[0] = a0[r]; o[16] = a1[r]; }
    }
}

#ifndef EMU
__device__ __forceinline__ void phase_gemm1(ArgP Ap, LAS unsigned char* lds, int l) {
    unsigned char* wb = A.ws + WS_WB + (size_t)l * WB_BYTES;
    pg8::Gemm g{(const bf16*)(A.ws + WS_XB), (const bf16*)(wb + WB_WIN), T, NZ, D};
    pg8::StaticOrder S; S.init(T, NZ, gridDim.x, blockIdx.x);
    EpiZ E{(bf16*)(A.ws + WS_ZM), (bf16*)(A.ws + WS_ZG)};
    pg8::gemm_phase<EpiZ, pg8::StaticOrder>(lds, g, S, E);
    small_gemm((const bf16*)(A.ws + WS_XB), (const bf16*)(wb + WB_WS), (float*)(A.ws + WS_ZS));
}
#endif

#define mma_tile(...) mma_tile_(fr, fq, __VA_ARGS__)
__device__ __forceinline__ f32x4 mma_tile_(int fr, int fq, const LAS bf16* A_, int lda, int row0, const LAS bf16* Bt, int ldb, int col0, int K, f32x4 acc) {
    const LAS bf16* ap = A_ + (row0 + fr) * lda + 8 * fq; const LAS bf16* bp = Bt + (col0 + fr) * ldb + 8 * fq;
    for (int k0 = 0; k0 < K; k0 += 32) { const bf16x8 a = *(const LAS bf16x8*)(ap + k0), b = *(const LAS bf16x8*)(bp + k0); acc = mfma16(a, b, acc); }
    return acc;
}
__device__ __forceinline__ float scan_sum64(float v, int lane) {
#pragma unroll
    for (int d = 1; d < 64; d <<= 1) { const float t = __shfl_up(v, d); if (lane >= d) v += t; }
    return v;
}
__device__ __forceinline__ float scan_max64(float v, int lane) {
#pragma unroll
    for (int d = 1; d < 64; d <<= 1) { const float t = __shfl_up(v, d); if (lane >= d) v = fmaxf(v, t); }
    return v;
}
__device__ __forceinline__ float wave_max64(float v) {
#pragma unroll
    for (int m = 1; m < 64; m <<= 1) v = fmaxf(v, __shfl_xor(v, m));
    return v;
}
__device__ __forceinline__ float logsig(float x) { return fminf(x, 0.f) - log1pf(__expf(-fabsf(x))); }
__device__ __forceinline__ float softplusf(float x) { return fmaxf(x, 0.f) + log1pf(__expf(-fabsf(x))); }
__device__ __forceinline__ float sigmoidf(float x) { return 1.0f / (1.0f + __expf(-x)); }
__device__ __forceinline__ float siluf(float x) { return x / (1.0f + __expf(-x)); }
constexpr float NEG_INF = -__builtin_huge_valf();
constexpr float EPS_ = 1e-5f;
__device__ __forceinline__ void unpack8(const u32x4 w, float (&f)[8]) {
    f[0] = __uint_as_float(w.x << 16); f[1] = __uint_as_float(w.x & 0xffff0000u); f[2] = __uint_as_float(w.y << 16); f[3] = __uint_as_float(w.y & 0xffff0000u);
    f[4] = __uint_as_float(w.z << 16); f[5] = __uint_as_float(w.z & 0xffff0000u); f[6] = __uint_as_float(w.w << 16); f[7] = __uint_as_float(w.w & 0xffff0000u);
}
__device__ __forceinline__ u32x4 pack8(const float (&f)[8]) { u32x4 w; w.x = pk2(f[0], f[1]); w.y = pk2(f[2], f[3]); w.z = pk2(f[4], f[5]); w.w = pk2(f[6], f[7]); return w; }

__device__ __forceinline__ void mlstm_item(ArgP Ap, LAS unsigned char* lds, int l, int b, int h, bool sample) {
    int tid_o = threadIdx.x; asm volatile("" : "+v"(tid_o));
    const int tid = tid_o, lane = tid & 63, wave = tid >> 6, fr = lane & 15, fq = lane >> 4;
    LAS bf16* Qs = (LAS bf16*)(lds); LAS bf16* Ks = (LAS bf16*)(lds + 17408); LAS bf16* KTw = (LAS bf16*)(lds + 34816); LAS bf16* VT = (LAS bf16*)(lds + 53248);
    LAS bf16* Ss = (LAS bf16*)(lds + 73984); LAS bf16* Cb = (LAS bf16*)(lds + 83200); LAS float* Hs = (LAS float*)(lds); LAS float* gb = (LAS float*)(lds + 122368);
    LAS float* b_ = gb; LAS float* mt_ = gb + 64; LAS float* u_ = gb + 128; LAS float* ein_ = gb + 192; LAS float* wg_ = gb + 256; LAS float* den_ = gb + 320; LAS float* sc_ = gb + 384;
    const int L = sample ? LS : LP, tok0 = sample ? TP + b * LS : b * LP, NB = sample ? BS : BP;
    const bf16* ZM = (const bf16*)(A.ws + WS_ZM); const float* ZS = (const float*)(A.ws + WS_ZS); bf16* BR0 = (bf16*)(A.ws + WS_BR);
    const float ib = A.in[9][l * 4 + h], fb = A.in[10][l * 4 + h]; const float* mnorm = A.in[11] + l * 512 + h * 128;
    f32x4 accC[9];
#pragma unroll
    for (int vi = 0; vi < 9; ++vi) accC[vi] = (f32x4){0.f, 0.f, 0.f, 0.f};
    float m_run = 0.f;
    if (sample) {
        const float* C0 = A.in[2] + ((size_t)(l * BS + b) * 4 + h) * 16384; const float* n0 = A.in[3] + ((size_t)(l * BS + b) * 4 + h) * 128;
        const float* cp = C0 + (4 * fq) * 128 + 16 * wave + fr;
#pragma unroll
        for (int vi = 0; vi < 8; ++vi) {
#pragma unroll
            for (int r = 0; r < 4; ++r) accC[vi][r] = cp[r * 128];
            cp += 2048; asm volatile("" : "+v"(cp)); }
        if (fq == 0) accC[8][0] = n0[16 * wave + fr];
        m_run = A.in[4][(l * BS + b) * 4 + h];
    }
#pragma unroll
    for (int vi = 0; vi < 9; ++vi)
#pragma unroll
        for (int r = 0; r < 4; ++r) Cb[(16 * vi + 4 * fq + r) * 136 + 16 * wave + fr] = f2bf(accC[vi][r]);
    for (int e = tid; e < 16 * 72; e += NTHREADS) VT[128 * 72 + e] = (e < 72) ? (bf16)0x3F80 : (bf16)0;
    __syncthreads();
    for (int t0 = 0; t0 < L; t0 += 64) {
        const int nv = (L - t0) < 64 ? (L - t0) : 64;
        if (wave == 0) {
            float li = NEG_INF, lf = 0.f;
            if (lane < nv) { const size_t tok = tok0 + t0 + lane; li = ZS[tok * NSM + h] + ib; lf = logsig(ZS[tok * NSM + 4 + h] + fb); }
            const float bb = scan_sum64(lf, lane), a = bb + m_run, u = li - bb, M = scan_max64(u, lane), mt = fmaxf(a, bb + M);
            const float blast = __shfl(bb, 63), g = blast + u, gmax = wave_max64(g), mnew = fmaxf(blast + m_run, gmax);
            b_[lane] = bb; mt_[lane] = mt; u_[lane] = u; ein_[lane] = __expf(a - mt); wg_[lane] = __expf(g - mnew);
            if (lane == 0) sc_[1] = __expf(blast + m_run - mnew);
            m_run = mnew;
        }
        __syncthreads();
#pragma unroll 1
        for (int c = tid; c < 3072; c += NTHREADS) {
            const int mat = c >> 10, t = (c & 1023) >> 4, cc = (c & 15) * 8;
            u32x4 w = {0u, 0u, 0u, 0u};
            if (t < nv) w = *(const u32x4*)(ZM + (size_t)(tok0 + t0 + t) * NZM + mat * 512 + h * 128 + cc);
            if (mat == 0) *(LAS u32x4*)(Qs + t * 136 + cc) = w;
            else if (mat == 1) { *(LAS u32x4*)(Ks + t * 136 + cc) = w; float f[8]; unpack8(w, f); const float g = wg_[t];
#pragma unroll
                for (int i = 0; i < 8; ++i) KTw[(cc + i) * 72 + t] = f2bf(f[i] * g); }
            else {
                VT[(cc + 0) * 72 + t] = (bf16)(w.x & 0xffff); VT[(cc + 1) * 72 + t] = (bf16)(w.x >> 16); VT[(cc + 2) * 72 + t] = (bf16)(w.y & 0xffff); VT[(cc + 3) * 72 + t] = (bf16)(w.y >> 16);
                VT[(cc + 4) * 72 + t] = (bf16)(w.z & 0xffff); VT[(cc + 5) * 72 + t] = (bf16)(w.z >> 16); VT[(cc + 6) * 72 + t] = (bf16)(w.w & 0xffff); VT[(cc + 7) * 72 + t] = (bf16)(w.w >> 16); }
        }
        __syncthreads();
#pragma unroll
        for (int j = 0; j < 2; ++j) { const int idx = wave + 8 * j, ti = idx >> 2, si = idx & 3;
            f32x4 acc = {0.f, 0.f, 0.f, 0.f};
            if (si <= ti) acc = mma_tile(Qs, 136, 16 * ti, Ks, 136, 16 * si, 128, acc);
#pragma unroll
            for (int r = 0; r < 4; ++r) { const int t = 16 * ti + 4 * fq + r, s = 16 * si + fr;
                const float v = (s <= t) ? acc[r] * __expf(b_[t] + u_[s] - mt_[t]) : 0.f; Ss[t * 72 + s] = f2bf(v); } }
        __syncthreads();
        if (wave < 4) { const int ti = wave; f32x4 acc = {0.f, 0.f, 0.f, 0.f};
            acc = mma_tile(Qs, 136, 16 * ti, Cb, 136, 128, 128, acc);
#pragma unroll
            for (int r = 0; r < 4; ++r) acc[r] *= ein_[16 * ti + 4 * fq + r];
            acc = mma_tile(Ss, 72, 16 * ti, VT, 72, 128, 64, acc);
            if (fr == 0) {
#pragma unroll
                for (int r = 0; r < 4; ++r) den_[16 * ti + 4 * fq + r] = acc[r]; } }
        f32x4 accn[4];
#pragma unroll
        for (int j = 0; j < 4; ++j) { const int idx = wave + 8 * j, ti = idx >> 3, vi = idx & 7; accn[j] = (f32x4){0.f, 0.f, 0.f, 0.f};
            accn[j] = mma_tile(Qs, 136, 16 * ti, Cb, 136, 16 * vi, 128, accn[j]);
#pragma unroll
            for (int r = 0; r < 4; ++r) accn[j][r] *= ein_[16 * ti + 4 * fq + r];
            accn[j] = mma_tile(Ss, 72, 16 * ti, VT, 72, 16 * vi, 64, accn[j]);
            asm volatile("" ::: "memory"); }
        __syncthreads();
#pragma unroll
        for (int j = 0; j < 4; ++j) { const int idx = wave + 8 * j, ti = idx >> 3, vi = idx & 7;
#pragma unroll
            for (int r = 0; r < 4; ++r) { const int t = 16 * ti + 4 * fq + r; const float dn = den_[t] * 0.08838834764831845f;
                Hs[t * 132 + 16 * vi + fr] = accn[j][r] * 0.08838834764831845f / fmaxf(fabsf(dn), __expf(-mt_[t])); } }
        __syncthreads();
        { const int t = tid >> 3, part = tid & 7; float x[16]; float s1 = 0.f;
#pragma unroll
            for (int i = 0; i < 16; ++i) { x[i] = Hs[t * 132 + 16 * part + i]; s1 += x[i]; }
            s1 += __shfl_xor(s1, 1); s1 += __shfl_xor(s1, 2); s1 += __shfl_xor(s1, 4);
            const float mu = s1 * (1.0f / 128.0f); float s2 = 0.f;
#pragma unroll
            for (int i = 0; i < 16; ++i) { x[i] -= mu; s2 += x[i] * x[i]; }
            s2 += __shfl_xor(s2, 1); s2 += __shfl_xor(s2, 2); s2 += __shfl_xor(s2, 4);
            const float rstd = 1.0f / sqrtf(s2 * (1.0f / 128.0f) + EPS_);
            if (t < nv) { const size_t tok = tok0 + t0 + t; const bf16* mo = ZM + tok * NZM + 1536 + h * 128 + 16 * part;
                float o0[8], o1[8]; unpack8(*(const u32x4*)mo, o0); unpack8(*(const u32x4*)(mo + 8), o1); float y0[8], y1[8];
#pragma unroll
                for (int i = 0; i < 8; ++i) { y0[i] = x[i] * rstd * mnorm[16 * part + i] * sigmoidf(o0[i]); y1[i] = x[8 + i] * rstd * mnorm[16 * part + 8 + i] * sigmoidf(o1[i]); }
                bf16* o = BR0 + tok * 512 + h * 128 + 16 * part; *(u32x4*)o = pack8(y0); *(u32x4*)(o + 8) = pack8(y1); } }
        { const float ec = sc_[1];
#pragma unroll
            for (int vi = 0; vi < 9; ++vi) {
#pragma unroll
                for (int r = 0; r < 4; ++r) accC[vi][r] *= ec;
                accC[vi] = mma_tile(VT, 72, 16 * vi, KTw, 72, 16 * wave, 64, accC[vi]);
#pragma unroll
                for (int r = 0; r < 4; ++r) Cb[(16 * vi + 4 * fq + r) * 136 + 16 * wave + fr] = f2bf(accC[vi][r]);
                asm volatile("" ::: "memory"); } }
        __syncthreads();
    }
    float* Co = A.out + (sample ? O_SC : O_PC) + ((size_t)(l * NB + b) * 4 + h) * 16384; float* no = A.out + (sample ? O_SN : O_PN) + ((size_t)(l * NB + b) * 4 + h) * 128;
    { int fq_ = fq, cw_ = 16 * wave + fr; asm volatile("" : "+v"(fq_), "+v"(cw_));
      float* cp = Co + (4 * fq_) * 128 + cw_;
#pragma unroll
      for (int vi = 0; vi < 8; ++vi) {
#pragma unroll
        for (int r = 0; r < 4; ++r) cp[r * 128] = accC[vi][r];
        cp += 2048; asm volatile("" : "+v"(cp)); }
      if (fq_ == 0) no[cw_] = accC[8][0]; }
    if (tid == 0) A.out[(sample ? O_SM : O_PM) + (size_t)(l * NB + b) * 4 + h] = m_run;
    __syncthreads();
}

__device__ __forceinline__ void gla_item(ArgP Ap, LAS unsigned char* lds, int l, int b, int h, bool sample) {
    int tid_o = threadIdx.x; asm volatile("" : "+v"(tid_o));
    const int tid = tid_o, lane = tid & 63, wave = tid >> 6, fr = lane & 15, fq = lane >> 4;
    LAS bf16* QE = (LAS bf16*)(lds); LAS bf16* KE = (LAS bf16*)(lds + 9216); LAS bf16* KL = (LAS bf16*)(lds + 18432); LAS bf16* VT = (LAS bf16*)(lds + 27648);
    LAS bf16* ATT = (LAS bf16*)(lds + 46080); LAS bf16* STb = (LAS bf16*)(lds + 55296); LAS float* Os = (LAS float*)(lds + 73728); LAS float* LAM = (LAS float*)(lds + 107520);
    LAS float* GA = (LAS float*)(lds + 124160); LAS float* GUP = (LAS float*)(lds + 128256); LAS float* GBI = (LAS float*)(lds + 132352);
    const int L = sample ? LS : LP, tok0 = sample ? TP + b * LS : b * LP, NB = sample ? BS : BP;
    const bf16* ZM = (const bf16*)(A.ws + WS_ZM); const float* ZS = (const float*)(A.ws + WS_ZS); bf16* BR1 = (bf16*)(A.ws + WS_BR) + (size_t)T * 512;
    const float* gnorm = A.in[14] + l * 512 + h * 128;
    f32x4 accS[4];
#pragma unroll
    for (int ki = 0; ki < 4; ++ki) accS[ki] = (f32x4){0.f, 0.f, 0.f, 0.f};
    if (sample) { const float* S0 = A.in[5] + ((size_t)(l * BS + b) * 4 + h) * 8192;
        const float* sp = S0 + fr * 128 + 16 * wave + 4 * fq;
#pragma unroll
        for (int ki = 0; ki < 4; ++ki) {
#pragma unroll
            for (int r = 0; r < 4; ++r) accS[ki][r] = sp[r];
            sp += 2048; asm volatile("" : "+v"(sp)); } }
#pragma unroll
    for (int ki = 0; ki < 4; ++ki)
#pragma unroll
        for (int r = 0; r < 4; ++r) STb[(16 * wave + 4 * fq + r) * 72 + 16 * ki + fr] = f2bf(accS[ki][r]);
    for (int e = tid; e < 1024; e += NTHREADS) GUP[e] = A.in[12][(size_t)l * 16 * 256 + (e >> 6) * 256 + h * 64 + (e & 63)];
    if (tid < 64) GBI[tid] = A.in[13][l * 256 + h * 64 + tid];
    __syncthreads();
    for (int t0 = 0; t0 < L; t0 += 64) {
        const int nv = (L - t0) < 64 ? (L - t0) : 64;
        for (int e = tid; e < 1024; e += NTHREADS) { const int t = e >> 4, r = e & 15; GA[e] = (t < nv) ? ZS[(size_t)(tok0 + t0 + t) * NSM + 8 + r] : 0.f; }
        __syncthreads();
        for (int e = tid; e < 4096; e += NTHREADS) { const int t = e >> 6, k = e & 63; float x = GBI[k];
#pragma unroll
            for (int r = 0; r < 16; ++r) x += GA[t * 16 + r] * GUP[r * 64 + k];
            LAM[t * 65 + k] = (t < nv) ? logsig(x) * (1.0f / 16.0f) : 0.f; }
        __syncthreads();
        if (tid < 64) { float run = 0.f; for (int t = 0; t < 64; ++t) { run += LAM[t * 65 + tid]; LAM[t * 65 + tid] = run; } }
        __syncthreads();
        { const int t = tid >> 3, cc = (tid & 7) * 8; u32x4 wq = {0u, 0u, 0u, 0u}, wk = {0u, 0u, 0u, 0u};
            if (t < nv) { const bf16* zr = ZM + (size_t)(tok0 + t0 + t) * NZM + 2048 + h * 64 + cc; wq = *(const u32x4*)zr; wk = *(const u32x4*)(zr + 256); }
            float q[8], k[8], qe[8], ke[8]; unpack8(wq, q); unpack8(wk, k);
#pragma unroll
            for (int i = 0; i < 8; ++i) { const float lm = LAM[t * 65 + cc + i], ll = LAM[63 * 65 + cc + i]; qe[i] = q[i] * __expf(lm); ke[i] = k[i] * __expf(-lm);
                KL[(cc + i) * 72 + t] = f2bf(k[i] * __expf(ll - lm)); }
            *(LAS u32x4*)(QE + t * 72 + cc) = pack8(qe); *(LAS u32x4*)(KE + t * 72 + cc) = pack8(ke); }
#pragma unroll 1
        for (int c = tid; c < 1024; c += NTHREADS) { const int t = c >> 4, cc = (c & 15) * 8; u32x4 w = {0u, 0u, 0u, 0u};
            if (t < nv) w = *(const u32x4*)(ZM + (size_t)(tok0 + t0 + t) * NZM + 2560 + h * 128 + cc);
            VT[(cc + 0) * 72 + t] = (bf16)(w.x & 0xffff); VT[(cc + 1) * 72 + t] = (bf16)(w.x >> 16); VT[(cc + 2) * 72 + t] = (bf16)(w.y & 0xffff); VT[(cc + 3) * 72 + t] = (bf16)(w.y >> 16);
            VT[(cc + 4) * 72 + t] = (bf16)(w.z & 0xffff); VT[(cc + 5) * 72 + t] = (bf16)(w.z >> 16); VT[(cc + 6) * 72 + t] = (bf16)(w.w & 0xffff); VT[(cc + 7) * 72 + t] = (bf16)(w.w >> 16); }
        __syncthreads();
#pragma unroll
        for (int j = 0; j < 2; ++j) { const int idx = wave + 8 * j, ti = idx >> 2, si = idx & 3; f32x4 acc = {0.f, 0.f, 0.f, 0.f};
            if (si <= ti) acc = mma_tile(QE, 72, 16 * ti, KE, 72, 16 * si, 64, acc);
#pragma unroll
            for (int r = 0; r < 4; ++r) { const int t = 16 * ti + 4 * fq + r, s = 16 * si + fr; ATT[t * 72 + s] = f2bf((s <= t) ? acc[r] : 0.f); } }
        __syncthreads();
#pragma unroll
        for (int j = 0; j < 4; ++j) { const int idx = wave + 8 * j, ti = idx >> 3, vi = idx & 7; f32x4 acc = {0.f, 0.f, 0.f, 0.f};
            acc = mma_tile(QE, 72, 16 * ti, STb, 72, 16 * vi, 64, acc); acc = mma_tile(ATT, 72, 16 * ti, VT, 72, 16 * vi, 64, acc);
#pragma unroll
            for (int r = 0; r < 4; ++r) Os[(16 * ti + 4 * fq + r) * 132 + 16 * vi + fr] = acc[r] * 0.125f; }
        __syncthreads();
        { const int t = tid >> 3, part = tid & 7; float x[16]; float s2 = 0.f;
#pragma unroll
            for (int i = 0; i < 16; ++i) { x[i] = Os[t * 132 + 16 * part + i]; s2 += x[i] * x[i]; }
            s2 += __shfl_xor(s2, 1); s2 += __shfl_xor(s2, 2); s2 += __shfl_xor(s2, 4);
            const float rstd = 1.0f / sqrtf(s2 * (1.0f / 128.0f) + EPS_);
            if (t < nv) { const size_t tok = tok0 + t0 + t; const bf16* gr = ZM + tok * NZM + 3072 + h * 128 + 16 * part;
                float g0[8], g1[8]; unpack8(*(const u32x4*)gr, g0); unpack8(*(const u32x4*)(gr + 8), g1); float y0[8], y1[8];
#pragma unroll
                for (int i = 0; i < 8; ++i) { y0[i] = x[i] * rstd * gnorm[16 * part + i] * siluf(g0[i]); y1[i] = x[8 + i] * rstd * gnorm[16 * part + 8 + i] * siluf(g1[i]); }
                bf16* o = BR1 + tok * 512 + h * 128 + 16 * part; *(u32x4*)o = pack8(y0); *(u32x4*)(o + 8) = pack8(y1); } }
#pragma unroll
        for (int ki = 0; ki < 4; ++ki) { const float dec = __expf(LAM[63 * 65 + 16 * ki + fr]);
#pragma unroll
            for (int r = 0; r < 4; ++r) accS[ki][r] *= dec;
            accS[ki] = mma_tile(VT, 72, 16 * wave, KL, 72, 16 * ki, 64, accS[ki]);
#pragma unroll
            for (int r = 0; r < 4; ++r) STb[(16 * wave + 4 * fq + r) * 72 + 16 * ki + fr] = f2bf(accS[ki][r]); }
        __syncthreads();
    }
    float* So = A.out + (sample ? O_SG : O_PG) + ((size_t)(l * NB + b) * 4 + h) * 8192;
    { int o_ = fr * 128 + 16 * wave + 4 * fq; asm volatile("" : "+v"(o_)); float* sp = So + o_;
#pragma unroll
      for (int ki = 0; ki < 4; ++ki) {
#pragma unroll
        for (int r = 0; r < 4; ++r) sp[r] = accS[ki][r];
        sp += 2048; asm volatile("" : "+v"(sp)); } }
    __syncthreads();
}

__device__ __forceinline__ void conv8(ArgP Ap, int l, int b, bool sample, int tok0, int r, int ch0, float (&o)[8]) {
    const bf16* ZM = (const bf16*)(A.ws + WS_ZM); const float* cw = A.in[15] + (size_t)l * 4 * 768; const float* cb = A.in[16] + l * 768;
#pragma unroll
    for (int i = 0; i < 8; ++i) o[i] = cb[ch0 + i];
#pragma unroll
    for (int j = 0; j < 4; ++j) { const int rr = r - 3 + j; float x[8];
        if (rr >= 0) unpack8(*(const u32x4*)(ZM + (size_t)(tok0 + rr) * NZM + 4096 + ch0), x);
        else if (sample) { const float* c0 = A.in[7] + ((size_t)(l * BS + b) * 3 + (3 + rr)) * 768 + ch0;
#pragma unroll
            for (int i = 0; i < 8; ++i) x[i] = c0[i]; }
        else {
#pragma unroll
            for (int i = 0; i < 8; ++i) x[i] = 0.f; }
#pragma unroll
        for (int i = 0; i < 8; ++i) o[i] += cw[j * 768 + ch0 + i] * x[i]; }
}
__device__ __forceinline__ void ssd_item(ArgP Ap, LAS unsigned char* lds, int l, int b, int g, bool sample) {
    int tid_o = threadIdx.x; asm volatile("" : "+v"(tid_o));
    const int tid = tid_o, lane = tid & 63, wave = tid >> 6, fr = lane & 15, fq = lane >> 4;
    LAS bf16* XT = (LAS bf16*)(lds); LAS bf16* BTW = (LAS bf16*)(lds + 9216); LAS bf16* Cs = (LAS bf16*)(lds + 18432); LAS bf16* Bs = (LAS bf16*)(lds + 27648);
    LAS bf16* BT = (LAS bf16*)(lds + 36864); LAS bf16* W = (LAS bf16*)(lds + 46080); LAS bf16* Hb = (LAS bf16*)(lds + 55296); LAS bf16* Ys = (LAS bf16*)(lds + 92160);
    LAS float* DT = (LAS float*)(lds + 125952); LAS float* LM = DT + 256;
    const int L = sample ? LS : LP, tok0 = sample ? TP + b * LS : b * LP, NB = sample ? BS : BP;
    const bf16* ZM = (const bf16*)(A.ws + WS_ZM); const float* ZS = (const float*)(A.ws + WS_ZS); bf16* BR2 = (bf16*)(A.ws + WS_BR) + (size_t)T * 1024;
    const float* snorm = A.in[20] + l * 512 + g * 256;
    f32x4 accH[4][2];
#pragma unroll
    for (int hh = 0; hh < 4; ++hh)
#pragma unroll
        for (int j = 0; j < 2; ++j) { const int idx = wave + 8 * j, pi = idx >> 2, ni = idx & 3; accH[hh][j] = (f32x4){0.f, 0.f, 0.f, 0.f};
            if (sample) { const float* h0 = A.in[6] + ((size_t)(l * BS + b) * 8 + g * 4 + hh) * 4096;
                const float* hp = h0 + (16 * pi + 4 * fq) * 64 + 16 * ni + fr; asm volatile("" : "+v"(hp));
#pragma unroll
                for (int r = 0; r < 4; ++r) accH[hh][j][r] = hp[r * 64]; }
#pragma unroll
            for (int r = 0; r < 4; ++r) Hb[hh * 4608 + (16 * pi + 4 * fq + r) * 72 + 16 * ni + fr] = f2bf(accH[hh][j][r]); }
    __syncthreads();
    for (int t0 = 0; t0 < L; t0 += 64) {
        const int nv = (L - t0) < 64 ? (L - t0) : 64;
        if (wave < 4) { const int hd = g * 4 + wave; float dtv = 0.f;
            if (lane < nv) dtv = softplusf(ZS[(size_t)(tok0 + t0 + lane) * NSM + 24 + hd] + A.in[17][l * 8 + hd]);
            const float Ah = -__expf(A.in[18][l * 8 + hd]); const float lam = scan_sum64(dtv * Ah, lane);
            DT[wave * 64 + lane] = dtv; LM[wave * 64 + lane] = lam; }
#pragma unroll 1
        for (int c = tid; c < 1024; c += NTHREADS) { const int t = c >> 4, q = c & 15, isC = q >> 3, n0 = (q & 7) * 8; float v[8];
            if (t < nv) { conv8(Ap, l, b, sample, tok0, t0 + t, 512 + isC * 128 + g * 64 + n0, v);
#pragma unroll
                for (int i = 0; i < 8; ++i) v[i] = siluf(v[i]); }
            else {
#pragma unroll
                for (int i = 0; i < 8; ++i) v[i] = 0.f; }
            if (isC) *(LAS u32x4*)(Cs + t * 72 + n0) = pack8(v);
            else { *(LAS u32x4*)(Bs + t * 72 + n0) = pack8(v);
#pragma unroll
                for (int i = 0; i < 8; ++i) BT[(n0 + i) * 72 + t] = f2bf(v[i]); } }
        __syncthreads();
        f32x4 cb[2];
#pragma unroll
        for (int j = 0; j < 2; ++j) { const int idx = wave + 8 * j, ti = idx >> 2, si = idx & 3; cb[j] = (f32x4){0.f, 0.f, 0.f, 0.f};
            if (si <= ti) cb[j] = mma_tile(Cs, 72, 16 * ti, Bs, 72, 16 * si, 64, cb[j]); }
#pragma unroll 1
        for (int hh = 0; hh < 4; ++hh) {
            const int hd = g * 4 + hh; const float Dh = A.in[19][l * 8 + hd];
            { const int t = tid >> 3, cc = (tid & 7) * 8; float v[8];
                if (t < nv) { conv8(Ap, l, b, sample, tok0, t0 + t, hd * 64 + cc, v);
#pragma unroll
                    for (int i = 0; i < 8; ++i) v[i] = siluf(v[i]); }
                else {
#pragma unroll
                    for (int i = 0; i < 8; ++i) v[i] = 0.f; }
#pragma unroll
                for (int i = 0; i < 8; ++i) XT[(cc + i) * 72 + t] = f2bf(v[i]); }
#pragma unroll
            for (int j = 0; j < 2; ++j) { const int idx = wave + 8 * j, ti = idx >> 2, si = idx & 3;
#pragma unroll
                for (int r = 0; r < 4; ++r) { const int t = 16 * ti + 4 * fq + r, s = 16 * si + fr;
                    const float w = (s <= t) ? cb[j][r] * __expf(LM[hh * 64 + t] - LM[hh * 64 + s]) * DT[hh * 64 + s] : 0.f; W[t * 72 + s] = f2bf(w); } }
            { const int n = tid >> 3, s0 = (tid & 7) * 8; float v[8]; unpack8(*(const LAS u32x4*)(BT + n * 72 + s0), v); const float ll = LM[hh * 64 + 63];
#pragma unroll
                for (int i = 0; i < 8; ++i) v[i] *= __expf(ll - LM[hh * 64 + s0 + i]) * DT[hh * 64 + s0 + i];
                *(LAS u32x4*)(BTW + n * 72 + s0) = pack8(v); }
            __syncthreads();
#pragma unroll
            for (int j = 0; j < 2; ++j) { const int idx = wave + 8 * j, ti = idx >> 2, pi = idx & 3; f32x4 acc = {0.f, 0.f, 0.f, 0.f};
                acc = mma_tile(Cs, 72, 16 * ti, Hb + hh * 4608, 72, 16 * pi, 64, acc);
#pragma unroll
                for (int r = 0; r < 4; ++r) acc[r] *= __expf(LM[hh * 64 + 16 * ti + 4 * fq + r]);
                acc = mma_tile(W, 72, 16 * ti, XT, 72, 16 * pi, 64, acc);
#pragma unroll
                for (int r = 0; r < 4; ++r) { const int t = 16 * ti + 4 * fq + r, p = 16 * pi + fr; float y = 0.f;
                    if (t < nv) { y = acc[r] + Dh * bf2f(XT[p * 72 + t]); y *= siluf(bf2f(ZM[(size_t)(tok0 + t0 + t) * NZM + 3584 + hd * 64 + p])); }
                    Ys[t * 264 + hh * 64 + p] = f2bf(y); }
                asm volatile("" ::: "memory"); }
            { const float dec = __expf(LM[hh * 64 + 63]);
#pragma unroll
                for (int j = 0; j < 2; ++j) { const int idx = wave + 8 * j, pi = idx >> 2, ni = idx & 3;
#pragma unroll
                    for (int r = 0; r < 4; ++r) accH[0][j][r] *= dec;
                    accH[0][j] = mma_tile(XT, 72, 16 * pi, BTW, 72, 16 * ni, 64, accH[0][j]);
                    asm volatile("" ::: "memory"); } }
            __syncthreads();
#pragma unroll
            for (int j = 0; j < 2; ++j) { const int idx = wave + 8 * j, pi = idx >> 2, ni = idx & 3;
#pragma unroll
                for (int r = 0; r < 4; ++r) Hb[hh * 4608 + (16 * pi + 4 * fq + r) * 72 + 16 * ni + fr] = f2bf(accH[0][j][r]); }
        #pragma unroll
            for (int j = 0; j < 2; ++j) { const f32x4 tmp = accH[0][j]; accH[0][j] = accH[1][j]; accH[1][j] = accH[2][j]; accH[2][j] = accH[3][j]; accH[3][j] = tmp; }
        }
        { const int t = tid >> 3, part = tid & 7; float x[32]; float s2 = 0.f;
#pragma unroll
            for (int q = 0; q < 4; ++q) { float f[8]; unpack8(*(const LAS u32x4*)(Ys + t * 264 + 32 * part + 8 * q), f);
#pragma unroll
                for (int i = 0; i < 8; ++i) { x[8 * q + i] = f[i]; s2 += f[i] * f[i]; } }
            s2 += __shfl_xor(s2, 1); s2 += __shfl_xor(s2, 2); s2 += __shfl_xor(s2, 4);
            const float rstd = 1.0f / sqrtf(s2 * (1.0f / 256.0f) + EPS_);
            if (t < nv) { bf16* o = BR2 + (size_t)(tok0 + t0 + t) * 512 + g * 256 + 32 * part;
#pragma unroll
                for (int q = 0; q < 4; ++q) { float y[8];
#pragma unroll
                    for (int i = 0; i < 8; ++i) y[i] = x[8 * q + i] * rstd * snorm[32 * part + 8 * q + i];
                    *(u32x4*)(o + 8 * q) = pack8(y); } } }
        __syncthreads();
    }
#pragma unroll
    for (int hh = 0; hh < 4; ++hh) { float* ho = A.out + (sample ? O_SH : O_PH) + ((size_t)(l * NB + b) * 8 + g * 4 + hh) * 4096;
#pragma unroll
        for (int j = 0; j < 2; ++j) { const int idx = wave + 8 * j, pi = idx >> 2, ni = idx & 3;
            float* hp = ho + (16 * pi + 4 * fq) * 64 + 16 * ni + fr; asm volatile("" : "+v"(hp));
#pragma unroll
            for (int r = 0; r < 4; ++r) hp[r * 64] = accH[hh][j][r]; } }
    for (int e = tid; e < 3 * 384; e += NTHREADS) { const int r = e / 384, q = e % 384; const int ch = q < 256 ? g * 256 + q : (q < 320 ? 512 + g * 64 + (q - 256) : 640 + g * 64 + (q - 320));
        A.out[(sample ? O_SV : O_PV) + ((size_t)(l * NB + b) * 3 + r) * 768 + ch] = bf2f(ZM[(size_t)(tok0 + L - 3 + r) * NZM + 4096 + ch]); }
    __syncthreads();
}

__device__ __forceinline__ void mixer_item(ArgP Ap, LAS unsigned char* lds, int l, int it) {
    constexpr int NL0 = BP * 4, NL1 = NL0 + BP * 4, NL2 = NL1 + BP * 2, NS0 = NL2 + BS * 4, NS1 = NS0 + BS * 4;
    int kind, r; bool sample;
    if (it < NL0) { kind = 0; r = it; sample = false; } else if (it < NL1) { kind = 1; r = it - NL0; sample = false; } else if (it < NL2) { kind = 2; r = it - NL1; sample = false; }
    else if (it < NS0) { kind = 0; r = it - NL2; sample = true; } else if (it < NS1) { kind = 1; r = it - NS0; sample = true; } else { kind = 2; r = it - NS1; sample = true; }
#ifndef ONLYK
#define ONLYK -1
#endif
#ifndef EMU
#define OPQ() ArgP Ap_ = Ap; int l_ = l, r_ = r; asm volatile("" : "+s"(Ap_), "+s"(l_), "+s"(r_) :: "memory")
#else
#define OPQ() ArgP Ap_ = Ap; int l_ = l, r_ = r
#endif
    if ((ONLYK < 0 || ONLYK == 0) && kind == 0) { OPQ(); mlstm_item(Ap_, lds, l_, r_ >> 2, r_ & 3, sample); }
    else if ((ONLYK < 0 || ONLYK == 1) && kind == 1) { OPQ(); gla_item(Ap_, lds, l_, r_ >> 2, r_ & 3, sample); }
    else if ((ONLYK < 0 || ONLYK == 2) && kind == 2) { OPQ(); ssd_item(Ap_, lds, l_, r_ >> 1, r_ & 1, sample); }
#undef OPQ
}
__device__ __forceinline__ void phase_mixers(ArgP Ap, LAS unsigned char* lds, int l) {
    constexpr int NLONG = BP * 10, NSHORT = BS * 10; const int G = gridDim.x, bid = blockIdx.x;
    const bool split = G > NLONG;
    const int step = split ? (bid < NLONG ? (1 << 28) : G - NLONG) : G;
#pragma unroll 1
    for (int it = bid; it < NLONG + NSHORT; it += step) mixer_item(Ap, lds, l, it);
}

__device__ __forceinline__ float wave_sum64(float v) {
#pragma unroll
    for (int m = 1; m < 64; m <<= 1) v += __shfl_xor(v, m);
    return v;
}
constexpr float DN_ALPHA_ = 1.4142135623730951f;

__device__ __forceinline__ void phase_ln1(ArgP Ap, int l) {
    const int tx = opaque_tid(), lane = tx & 63, wave = tx >> 6, gw = blockIdx.x * NWAVES + wave, NGW = gridDim.x * NWAVES;
    const float* Y = (const float*)(A.ws + WS_ZG); float* H = (float*)(A.ws + WS_H); bf16* H1B = (bf16*)(A.ws + WS_BR);
    const float* lg = A.in[23] + l * D + 16 * lane; const float* lb = A.in[24] + l * D + 16 * lane;
    for (int tok = gw; tok < T; tok += NGW) {
        const float* xr = (l == 0) ? (tok < TP ? A.in[0] + (size_t)tok * D : A.in[1] + (size_t)(tok - TP) * D) : H + (size_t)tok * D;
        float y[16]; float s1 = 0.f;
#pragma unroll
        for (int q = 0; q < 4; ++q) { const float4 a = *(const float4*)(xr + 16 * lane + 4 * q), b = *(const float4*)(Y + (size_t)tok * D + 16 * lane + 4 * q);
            y[4 * q] = DN_ALPHA_ * a.x + b.x; y[4 * q + 1] = DN_ALPHA_ * a.y + b.y; y[4 * q + 2] = DN_ALPHA_ * a.z + b.z; y[4 * q + 3] = DN_ALPHA_ * a.w + b.w; }
#pragma unroll
        for (int i = 0; i < 16; ++i) s1 += y[i];
        const float mu = wave_sum64(s1) * (1.0f / D); float s2 = 0.f;
#pragma unroll
        for (int i = 0; i < 16; ++i) { y[i] -= mu; s2 += y[i] * y[i]; }
        const float rstd = 1.0f / sqrtf(wave_sum64(s2) * (1.0f / D) + EPS_);
#pragma unroll
        for (int i = 0; i < 16; ++i) y[i] = y[i] * rstd * lg[i] + lb[i];
#pragma unroll
        for (int q = 0; q < 4; ++q) *(float4*)(H + (size_t)tok * D + 16 * lane + 4 * q) = make_float4(y[4 * q], y[4 * q + 1], y[4 * q + 2], y[4 * q + 3]);
        float y0[8], y1[8];
#pragma unroll
        for (int i = 0; i < 8; ++i) { y0[i] = y[i]; y1[i] = y[8 + i]; }
        *(u32x4*)(H1B + (size_t)tok * D + 16 * lane) = pack8(y0); *(u32x4*)(H1B + (size_t)tok * D + 16 * lane + 8) = pack8(y1);
    }
    const int gtid = blockIdx.x * NTHREADS + tx, gthreads = gridDim.x * NTHREADS;
    convert_f32_bf16(A.in[27] + (size_t)l * NEXP * D, (bf16*)(A.ws + WS_PU), (size_t)NEXP * D, gtid, gthreads);
    convert_f32_bf16(A.in[28] + (size_t)l * NEXP * D, (bf16*)(A.ws + WS_PV), (size_t)NEXP * D, gtid, gthreads);
}

__device__ __forceinline__ unsigned ord_of(float f) { const unsigned u = __float_as_uint(f); return (u & 0x80000000u) ? ~u : (u | 0x80000000u); }
__device__ __forceinline__ float dec_ord(unsigned o) { const unsigned u = (o & 0x80000000u) ? (o & 0x7fffffffu) : ~o; return __uint_as_float(u); }
__device__ __forceinline__ unsigned umax_(unsigned a, unsigned b) { return a > b ? a : b; }
__device__ __forceinline__ unsigned umin_(unsigned a, unsigned b) { return a < b ? a : b; }
__device__ __forceinline__ void ins16(unsigned (&L)[16], unsigned x) {
#pragma unroll
    for (int p = 0; p < 16; ++p) { const unsigned hi = umax_(L[p], x); x = umin_(L[p], x); L[p] = hi; }
}
__device__ __forceinline__ unsigned sel16(const unsigned (&L)[16], int a) { unsigned r = L[0];
#pragma unroll
    for (int p = 1; p < 16; ++p) r = (a == p) ? L[p] : r;
    return r; }

__device__ __forceinline__ void route_topk(const bf16* __restrict__ Q, const LAS bf16* KEYS, int tokb, int h, int j, int fr, int fq, unsigned (&Lt)[16]) {
    f32x4 acc[8];
#pragma unroll
    for (int ki = 0; ki < 8; ++ki) acc[ki] = (f32x4){0.f, 0.f, 0.f, 0.f};
#pragma unroll
    for (int kk = 0; kk < 4; ++kk) { const bf16x8 bq = *(const bf16x8*)(Q + (size_t)(tokb + fr) * 2048 + h * 256 + j * 128 + 32 * kk + 8 * fq);
#pragma unroll
        for (int ki = 0; ki < 8; ++ki) { const bf16x8 ak = *(const LAS bf16x8*)(KEYS + (j * 128 + 16 * ki + fr) * 136 + 32 * kk + 8 * fq); acc[ki] = mfma16(ak, bq, acc[ki]); } }
#pragma unroll
    for (int p = 0; p < 16; ++p) Lt[p] = 0u;
#pragma unroll
    for (int ki = 0; ki < 8; ++ki)
#pragma unroll
        for (int r = 0; r < 4; ++r) ins16(Lt, (ord_of(acc[ki][r]) & ~127u) | (unsigned)(127 - (16 * ki + 4 * fq + r)));
#pragma unroll
    for (int m = 16; m < 64; m <<= 1) { unsigned R[16];
#pragma unroll
        for (int p = 0; p < 16; ++p) R[p] = __shfl_xor(Lt[p], m);
#pragma unroll
        for (int p = 0; p < 16; ++p) ins16(Lt, R[p]); }
}

__device__ __forceinline__ void phase_route(ArgP Ap, LAS unsigned char* lds, int l) {
    const int tid = opaque_tid(), lane = tid & 63, wave = tid >> 6, fr = lane & 15, fq = lane >> 4;
    LAS bf16* KEYS = (LAS bf16*)lds;
    LAS unsigned* LST = (LAS unsigned*)(lds + 69632);
    const bf16* Q = (const bf16*)(A.ws + WS_Q); int* IDX = (int*)(A.ws + WS_IDX); float* GT = (float*)(A.ws + WS_GT);
    const bf16* kg = (const bf16*)(A.ws + WS_WB + (size_t)l * WB_BYTES + WB_KEYS);
    constexpr int NG = T / 16, NCH = (NG + 7) / 8, NITEMS = NCH * 8;
    int last_h = -1;
    for (int it = blockIdx.x; it < NITEMS; it += gridDim.x) {
        const int h = it & 7, ch = it >> 3;
        if (h != last_h) { __syncthreads();
            for (int c = tid; c < 2 * 128 * 16; c += NTHREADS) { const int row = c >> 4, cc = (c & 15) * 8; *(LAS u32x4*)(KEYS + row * 136 + cc) = *(const u32x4*)(kg + ((size_t)h * 256 + row) * 128 + cc); }
            __syncthreads(); last_h = h; }
        const int grp = ch * 8 + wave;
        if (grp < NG) {
            const int tokb = grp * 16; unsigned L1[16], L2[16];
            route_topk(Q, KEYS, tokb, h, 0, fr, fq, L1); route_topk(Q, KEYS, tokb, h, 1, fr, fq, L2);
            unsigned C[16];
#pragma unroll
            for (int p = 0; p < 16; ++p) C[p] = 0u;
#pragma unroll
            for (int a = 0; a < 16; ++a)
#pragma unroll
                for (int b = 0; b < 16; ++b) if ((a + 1) * (b + 1) <= 16) {
                    const float s = dec_ord(L1[a] & ~127u) + dec_ord(L2[b] & ~127u); ins16(C, (ord_of(s) & ~255u) | (unsigned)(255 - (a * 16 + b))); }
            const float s0 = dec_ord(C[0] & ~255u); float e[16]; float sum = 0.f;
#pragma unroll
            for (int p = 0; p < 16; ++p) { e[p] = __expf(dec_ord(C[p] & ~255u) - s0); sum += e[p]; }
            const float inv = 1.0f / sum; const size_t ob = (size_t)(tokb + fr) * 128 + h * 16;
#pragma unroll
            for (int p = 0; p < 16; ++p) { LST[(wave * 32 + p) * 64 + lane] = L1[p]; LST[(wave * 32 + 16 + p) * 64 + lane] = L2[p]; }
#pragma unroll
            for (int p = 0; p < 16; ++p) { const int cid = 255 - (int)(C[p] & 255u); const int a = cid >> 4, b = cid & 15;
                const int e1 = 127 - (int)(LST[(wave * 32 + a) * 64 + lane] & 127u), e2 = 127 - (int)(LST[(wave * 32 + 16 + b) * 64 + lane] & 127u);
                if ((p >> 2) == fq) { IDX[ob + p] = e1 * 128 + e2; GT[ob + p] = e[p] * inv; } }
        }
    }
}

__device__ __forceinline__ void phase_gather(ArgP Ap, int l) {
    const int tx = opaque_tid(), lane = tx & 63, wave = tx >> 6, gw = blockIdx.x * NWAVES + wave, NGW = gridDim.x * NWAVES;
    float* H = (float*)(A.ws + WS_H); bf16* XB = (bf16*)(A.ws + WS_XB); const int* IDX = (const int*)(A.ws + WS_IDX); const float* GT = (const float*)(A.ws + WS_GT);
    const bf16* PU = (const bf16*)(A.ws + WS_PU); const bf16* PV = (const bf16*)(A.ws + WS_PV);
    const float* lg = A.in[29] + l * D; const float* lb = A.in[30] + l * D;
    for (int tok = gw; tok < T; tok += NGW) {
        float xa[8], xb[8];
        { const float4 a = *(const float4*)(H + (size_t)tok * D + 8 * lane), b = *(const float4*)(H + (size_t)tok * D + 8 * lane + 4);
          const float4 c = *(const float4*)(H + (size_t)tok * D + 512 + 8 * lane), d = *(const float4*)(H + (size_t)tok * D + 512 + 8 * lane + 4);
          xa[0] = a.x; xa[1] = a.y; xa[2] = a.z; xa[3] = a.w; xa[4] = b.x; xa[5] = b.y; xa[6] = b.z; xa[7] = b.w;
          xb[0] = c.x; xb[1] = c.y; xb[2] = c.z; xb[3] = c.w; xb[4] = d.x; xb[5] = d.y; xb[6] = d.z; xb[7] = d.w; }
        const int i0 = IDX[(size_t)tok * 128 + lane], i1 = IDX[(size_t)tok * 128 + 64 + lane]; const float g0 = GT[(size_t)tok * 128 + lane], g1 = GT[(size_t)tok * 128 + 64 + lane];
        float oa[8], ob[8];
#pragma unroll
        for (int i = 0; i < 8; ++i) { oa[i] = 0.f; ob[i] = 0.f; }
        for (int kb = 0; kb < 128; kb += 8) {
            u32x4 ua[8], ub[8], va[8], vb[8]; float gk[8];
#pragma unroll
            for (int kk = 0; kk < 8; ++kk) { const int k = kb + kk; const int e = __shfl(kb < 64 ? i0 : i1, k & 63); gk[kk] = __shfl(kb < 64 ? g0 : g1, k & 63);
                const bf16* ur = PU + (size_t)e * D + 8 * lane; const bf16* vr = PV + (size_t)e * D + 8 * lane;
                ua[kk] = *(const u32x4*)ur; ub[kk] = *(const u32x4*)(ur + 512); va[kk] = *(const u32x4*)vr; vb[kk] = *(const u32x4*)(vr + 512); }
#pragma unroll
            for (int kk = 0; kk < 8; ++kk) { float f[8], g[8]; unpack8(ua[kk], f); unpack8(ub[kk], g); float p = 0.f;
#pragma unroll
                for (int i = 0; i < 8; ++i) p += f[i] * xa[i] + g[i] * xb[i];
                p = wave_sum64(p);
                const float act = 0.5f * p * (1.0f + erff(p * 0.70710678118654752f)) * gk[kk];
                unpack8(va[kk], f); unpack8(vb[kk], g);
#pragma unroll
                for (int i = 0; i < 8; ++i) { oa[i] += act * f[i]; ob[i] += act * g[i]; } }
        }
        float s1 = 0.f;
#pragma unroll
        for (int i = 0; i < 8; ++i) { oa[i] += DN_ALPHA_ * xa[i]; ob[i] += DN_ALPHA_ * xb[i]; s1 += oa[i] + ob[i]; }
        const float mu = wave_sum64(s1) * (1.0f / D); float s2 = 0.f;
#pragma unroll
        for (int i = 0; i < 8; ++i) { oa[i] -= mu; ob[i] -= mu; s2 += oa[i] * oa[i] + ob[i] * ob[i]; }
        const float rstd = 1.0f / sqrtf(wave_sum64(s2) * (1.0f / D) + EPS_);
#pragma unroll
        for (int i = 0; i < 8; ++i) { oa[i] = oa[i] * rstd * lg[8 * lane + i] + lb[8 * lane + i]; ob[i] = ob[i] * rstd * lg[512 + 8 * lane + i] + lb[512 + 8 * lane + i]; }
        float* dst = (l == 1) ? A.out + (size_t)tok * D : H + (size_t)tok * D;
        *(float4*)(dst + 8 * lane) = make_float4(oa[0], oa[1], oa[2], oa[3]); *(float4*)(dst + 8 * lane + 4) = make_float4(oa[4], oa[5], oa[6], oa[7]);
        *(float4*)(dst + 512 + 8 * lane) = make_float4(ob[0], ob[1], ob[2], ob[3]); *(float4*)(dst + 512 + 8 * lane + 4) = make_float4(ob[4], ob[5], ob[6], ob[7]);
        if (l == 0) { *(u32x4*)(XB + (size_t)tok * D + 8 * lane) = pack8(oa); *(u32x4*)(XB + (size_t)tok * D + 512 + 8 * lane) = pack8(ob); }
    }
}

#ifndef EMU
struct MergeOrder {
    pg8::StaticOrder S;
    __device__ bool next(int i, pg8::Unit& u) const { pg8::Unit t; if (!S.next(i / 3, t)) return false; const int n = i % 3; u.pm = n * (T / 256) + t.pm; u.pn = n * 4 + t.pn; return true; }
    __device__ __forceinline__ void a_ready(const pg8::Unit&) const {}
    __device__ __forceinline__ void done(const pg8::Unit&) const {}
};
struct EpiMerge {
    static constexpr bool PERM = true, AFTER_DRAIN = false;
    const bf16* ZG; float* MIXF; bf16* MIXED;
    __device__ __forceinline__ void operator()(const pg8::f32x4 (&acc)[2][2][4][2], const pg8::Unit& u, int wr, int wc, int fr, int fq) const {
        const int n = u.pn >> 2, pn = u.pn & 3, pm = u.pm - n * (T / 256);
        const int row0 = pm * 256 + wr * 64 + fr, col0 = pn * 256 + wc * 32 + 8 * fq;
#pragma unroll
        for (int ai = 0; ai < 2; ++ai)
#pragma unroll
            for (int m = 0; m < 4; ++m) { const size_t row = (size_t)(row0 + ai * 128 + m * 16);
#pragma unroll
                for (int bj = 0; bj < 2; ++bj) { const int col = col0 + bj * 128;
                    float g[8]; unpack8(*(const u32x4*)(ZG + row * NZG + n * D + col), g);
                    float v[8];
#pragma unroll
                    for (int j = 0; j < 4; ++j) { v[j] = acc[ai][bj][m][0][j] * g[j]; v[4 + j] = acc[ai][bj][m][1][j] * g[4 + j]; }
                    float* mp = MIXF + row * D + col;
                    if (n > 0) { const float4 a = *(const float4*)mp, b = *(const float4*)(mp + 4);
                        v[0] += a.x; v[1] += a.y; v[2] += a.z; v[3] += a.w; v[4] += b.x; v[5] += b.y; v[6] += b.z; v[7] += b.w; }
                    if (n < 2) { *(float4*)mp = make_float4(v[0], v[1], v[2], v[3]); *(float4*)(mp + 4) = make_float4(v[4], v[5], v[6], v[7]); }
                    else *(u32x4*)(MIXED + row * D + col) = pack8(v); } }
    }
};
__device__ __forceinline__ void phase_merge(ArgP Ap, LAS unsigned char* lds, int l) {
    pg8::Gemm g{(const bf16*)(A.ws + WS_BR), (const bf16*)(A.ws + WS_WB + (size_t)l * WB_BYTES + WB_WBR), 3 * T, 3 * D, 512};
    MergeOrder S; S.S.init(T, D, gridDim.x, blockIdx.x);
    EpiMerge E{(const bf16*)(A.ws + WS_ZG), (float*)(A.ws + WS_ZM), (bf16*)(A.ws + WS_XB)};
    pg8::gemm_phase<EpiMerge, MergeOrder>(lds, g, S, E);
}
struct EpiF32 {
    static constexpr bool PERM = false, AFTER_DRAIN = false;
    float* C; int ldc;
    __device__ __forceinline__ void operator()(const pg8::f32x4 (&acc)[2][2][4][2], const pg8::Unit& u, int wr, int wc, int fr, int fq) const {
        const int row0 = u.pm * 256 + wr * 64 + fr, col0 = u.pn * 256 + wc * 32 + 4 * fq;
#pragma unroll
        for (int ai = 0; ai < 2; ++ai)
#pragma unroll
            for (int m = 0; m < 4; ++m) { float* rowp = C + (size_t)(row0 + ai * 128 + m * 16) * ldc + col0;
#pragma unroll
                for (int bj = 0; bj < 2; ++bj)
#pragma unroll
                    for (int n = 0; n < 2; ++n) *(pg8::f32x4*)(rowp + bj * 128 + n * 16) = acc[ai][bj][m][n]; }
    }
};
struct EpiB16 {
    static constexpr bool PERM = true, AFTER_DRAIN = false;
    bf16* O; int ldc;
    __device__ __forceinline__ void operator()(const pg8::f32x4 (&acc)[2][2][4][2], const pg8::Unit& u, int wr, int wc, int fr, int fq) const {
        const int row0 = u.pm * 256 + wr * 64 + fr, col0 = u.pn * 256 + wc * 32 + 8 * fq;
#pragma unroll
        for (int ai = 0; ai < 2; ++ai)
#pragma unroll
            for (int m = 0; m < 4; ++m) { bf16* rowp = O + (size_t)(row0 + ai * 128 + m * 16) * ldc + col0;
#pragma unroll
                for (int bj = 0; bj < 2; ++bj) { const pg8::f32x4 v0 = acc[ai][bj][m][0], v1 = acc[ai][bj][m][1];
                    u32x4 w; w.x = pg8::cvt_pk_bf16(v0[0], v0[1]); w.y = pg8::cvt_pk_bf16(v0[2], v0[3]); w.z = pg8::cvt_pk_bf16(v1[0], v1[1]); w.w = pg8::cvt_pk_bf16(v1[2], v1[3]);
                    *(u32x4*)(rowp + bj * 128) = w; } }
    }
};
__device__ __forceinline__ void phase_outproj(ArgP Ap, LAS unsigned char* lds, int l) {
    pg8::Gemm g{(const bf16*)(A.ws + WS_XB), (const bf16*)(A.ws + WS_WB + (size_t)l * WB_BYTES + WB_WO), T, D, D};
    pg8::StaticOrder S; S.init(T, D, gridDim.x, blockIdx.x);
    EpiF32 E{(float*)(A.ws + WS_ZG), D};
    pg8::gemm_phase<EpiF32, pg8::StaticOrder>(lds, g, S, E);
}
__device__ __forceinline__ void phase_qproj(ArgP Ap, LAS unsigned char* lds, int l) {
    pg8::Gemm g{(const bf16*)(A.ws + WS_BR), (const bf16*)(A.ws + WS_WB + (size_t)l * WB_BYTES + WB_WQ), T, 2048, D};
    pg8::StaticOrder S; S.init(T, 2048, gridDim.x, blockIdx.x);
    EpiB16 E{(bf16*)(A.ws + WS_Q), 2048};
    pg8::gemm_phase<EpiB16, pg8::StaticOrder>(lds, g, S, E);
}

__global__ void __launch_bounds__(NTHREADS, 2) mega_fwd(Args kargs) {
    extern __shared__ __attribute__((aligned(16))) unsigned char lds_raw[];
    LAS unsigned char* lds = (LAS unsigned char*)lds_raw;
    cg::grid_group grid = cg::this_grid();
    ArgP Ap = (ArgP)__builtin_amdgcn_kernarg_segment_ptr();
    const int lo = A.ph_lo, hi = A.ph_hi;
#define RUN(call) do { ArgP Ap_ = Ap; int l_ = l; asm volatile("" : "+s"(Ap_), "+s"(l_) :: "memory"); { ArgP Ap = Ap_; const int l = l_; call; } asm volatile("" ::: "memory"); } while (0)
#ifndef ONLYP
#define ONLYP -1
#endif
#define PSEL(q) (ONLYP < 0 || ONLYP == (q))
#define IN(k) (lo <= (k) && (k) < hi)
#define SEAM(k) do { if (IN(k) && IN((k) + 1)) grid.sync(); } while (0)
    { const int l = 0; if (PSEL(0) && IN(0)) RUN(phase_convert(Ap, lds)); (void)l; }
    SEAM(0);
    for (int l = 0; l < 2; ++l) {
        const int p = 1 + 8 * l;
        if (PSEL(1) && IN(p + 0)) RUN(phase_gemm1(Ap, lds, l));
        SEAM(p);
        if (PSEL(2) && IN(p + 1)) RUN(phase_mixers(Ap, lds, l));
        SEAM(p + 1);
        if (PSEL(3) && IN(p + 2)) RUN(phase_merge(Ap, lds, l));
        SEAM(p + 2);
        if (PSEL(4) && IN(p + 3)) RUN(phase_outproj(Ap, lds, l));
        SEAM(p + 3);
        if (PSEL(5) && IN(p + 4)) RUN(phase_ln1(Ap, l));
        SEAM(p + 4);
        if (PSEL(6) && IN(p + 5)) RUN(phase_qproj(Ap, lds, l));
        SEAM(p + 5);
        if (PSEL(7) && IN(p + 6)) RUN(phase_route(Ap, lds, l));
        SEAM(p + 6);
        if (PSEL(8) && IN(p + 7)) RUN(phase_gather(Ap, l));
        SEAM(p + 7);
    }
#undef IN
#undef RUN
#undef SEAM
}

extern "C" void kernel_launch(void* const* d_in, const int* in_sizes, int n_in, void* d_out, int out_size, void* d_ws, size_t ws_size, hipStream_t stream) {
    static int grid_blocks = 0;
    if (grid_blocks == 0) {
        if (n_in != 31 || (size_t)out_size != O_END || ws_size < WS_END) {
            fprintf(stderr, "kernel_launch: unexpected problem: n_in %d out %d (want %zu) ws %zu (want >= %zu)\n", n_in, out_size, (size_t)O_END, ws_size, (size_t)WS_END); grid_blocks = -1; return; }
        int dev = 0, cus = 0, per_cu = 0;
        (void)hipGetDevice(&dev); (void)hipDeviceGetAttribute(&cus, hipDeviceAttributeMultiprocessorCount, dev);
        if (hipFuncSetAttribute((const void*)mega_fwd, hipFuncAttributeMaxDynamicSharedMemorySize, LDS_BYTES) != hipSuccess) { fprintf(stderr, "kernel_launch: hipFuncSetAttribute failed\n"); grid_blocks = -1; return; }
        if (hipOccupancyMaxActiveBlocksPerMultiprocessor(&per_cu, (const void*)mega_fwd, NTHREADS, LDS_BYTES) != hipSuccess || per_cu < 1) { fprintf(stderr, "kernel_launch: occupancy query failed (%d)\n", per_cu); grid_blocks = -1; return; }
        grid_blocks = cus * per_cu;
        fprintf(stderr, "kernel_launch: %d CUs x %d = %d workgroups\n", cus, per_cu, grid_blocks);
    }
    if (grid_blocks < 0) return;
    Args a{};
    for (int i = 0; i < 31; ++i) a.in[i] = (const float*)d_in[i];
    a.out = (float*)d_out; a.ws = (unsigned char*)d_ws; a.ph_lo = 0; a.ph_hi = 64;
    void* args[] = {&a};
    hipError_t e = hipLaunchCooperativeKernel((const void*)mega_fwd, dim3(grid_blocks), dim3(NTHREADS), args, LDS_BYTES, stream);
    if (e != hipSuccess) fprintf(stderr, "kernel_launch: cooperative launch failed: %s (grid %d)\n", hipGetErrorString(e), grid_blocks);
}
#endif
```

```cpp
#ifndef EMU
#include <hip/hip_runtime.h>
#include <hip/hip_cooperative_groups.h>
#include <cstdio>
#include <cstdint>
namespace cg = cooperative_groups;
namespace pg8 {
#define PG8_LAS __attribute__((address_space(3)))
typedef unsigned short bf16_t;
typedef short bf16x8 __attribute__((ext_vector_type(8)));
typedef float f32x4 __attribute__((ext_vector_type(4)));
typedef unsigned u32x4 __attribute__((ext_vector_type(4)));
constexpr int BM = 256, BK = 64, HALF = 128, HTB = HALF * BK * 2  , STAGE_BYTES = 8 * HTB, NXCD = 8, WGM = 8;

__host__ __device__ __forceinline__ int lds_byte(int r, int c) { const int st = (r >> 4) * 2 + (c >> 5), rr = r & 15, cc = c & 31, ob = rr * 64 + cc * 2; return st * 1024 + (ob ^ (((ob >> 9) & 1) << 5)); }
__host__ __device__ __forceinline__ void stage_rc(int b, int& R, int& C) { const int st = b / 1024, sb = b % 1024, swz = sb ^ (((sb >> 9) & 1) << 5); R = (st >> 1) * 16 + swz / 64; C = (st & 1) * 32 + (swz % 64) / 2; }
__host__ __device__ __forceinline__ int perm32(int rho) { const int n = rho >> 4, i = rho & 15; return 8 * (i >> 2) + 4 * n + (i & 3); }

struct Unit { int pm, pn; };
struct Gemm { const bf16_t* A; const bf16_t* Bt; int M, N, K; };

struct StaticOrder {
    int nM, nN, nwg, G, c;
    __host__ __device__ void init(int M, int N, int G_, int c_) { nM = M / BM; nN = N / BM; nwg = nM * nN; G = G_; c = c_; }
    __host__ __device__ bool next(int i, Unit& u) const {
        const long L = (long)i * G + c; if (L >= nwg) return false;
        int wgid = (int)L; { const int q = nwg / NXCD, r = nwg % NXCD, xcd = wgid % NXCD, off = wgid / NXCD; wgid = (xcd < r ? xcd * (q + 1) : r * (q + 1) + (xcd - r) * q) + off; }
        const int nig = WGM * nN, gid = wgid / nig, fm = gid * WGM, gsz = (nM - fm) < WGM ? (nM - fm) : WGM;
        u.pm = fm + ((wgid % nig) % gsz); u.pn = (wgid % nig) / gsz; return true;
    }
    __device__ __forceinline__ void a_ready(const Unit&) const {}
    __device__ __forceinline__ void done(const Unit&) const {}
};

__device__ __forceinline__ unsigned cvt_pk_bf16(float lo, float hi) { unsigned r; asm volatile("v_cvt_pk_bf16_f32 %0, %1, %2" : "=v"(r) : "v"(lo), "v"(hi)); return r; }
typedef float f32x2 __attribute__((ext_vector_type(2)));
__device__ __forceinline__ f32x2 gelu_pk(f32x2 v) {
    const f32x2 av = __builtin_elementwise_abs(v), d = av * 0.2316418882f + 1.0f;
    f32x2 t; t.x = __builtin_amdgcn_rcpf(d.x); t.y = __builtin_amdgcn_rcpf(d.y);
    f32x2 q = t * 0.5307027145f + (-0.7265760135f); q = q * t + 0.7107068705f; q = q * t + (-0.142248368f); q = q * t + 0.127414796f; q = q * t;
    const f32x2 s = (v * v) * (-0.72134752044f);
    f32x2 e; e.x = __builtin_amdgcn_exp2f(s.x); e.y = __builtin_amdgcn_exp2f(s.y);
    const f32x2 m = v * (q * e), r = v - m;
    f32x2 o; o.x = v.x < 0.f ? m.x : r.x; o.y = v.y < 0.f ? m.y : r.y; return o;
}

template <class Epi, class Sched>
__device__ __forceinline__ void gemm_phase(PG8_LAS unsigned char* lds, const Gemm g, const Sched& S, const Epi& E) {
    int tid_o = threadIdx.x; asm volatile("" : "+v"(tid_o));
    const int tid = tid_o, wid = __builtin_amdgcn_readfirstlane(tid >> 6), lane = tid & 63, wr = wid >> 2, wc = wid & 3, fr = lane & 15, fq = lane >> 4;
    const int K = g.K, nt = K / BK;
    unsigned voffA[2], voffB[2];
#pragma unroll
    for (int i = 0; i < 2; ++i) { int R, C; stage_rc(tid * 16 + i * 8192, R, C); const int Rb = Epi::PERM ? ((R & ~31) + perm32(R & 31)) : R;
        voffA[i] = (unsigned)(R * K + C) * 2u; voffB[i] = (unsigned)(Rb * K + C) * 2u; }
    const size_t kstep = (size_t)(BK * 2);
    const size_t hstep = (size_t)HALF * K * 2;
    const size_t tstep = 2 * hstep;
    const unsigned ldsw = (unsigned)wid * 1024u;
    const int aoff = lds_byte(wr * 64 + fr, fq * 8), boff = lds_byte(wc * 32 + fr, fq * 8);
#define PG8_SA(b, h) (((b) * 2 + (h)) * HTB)
#define PG8_SB(b, h) ((4 + (b) * 2 + (h)) * HTB)
#define PG8_STAGE(bufoff, gbase, voff) do { _Pragma("unroll") for (int _i = 0; _i < 2; ++_i) \
        __builtin_amdgcn_global_load_lds((const unsigned*)((const char*)(gbase) + (voff)[_i]), (PG8_LAS unsigned*)(lds + (bufoff) + ldsw + _i * 8192), 16, 0, 0); } while (0)
#define PG8_LDA(dst, b, h) do { _Pragma("unroll") for (int m = 0; m < 4; ++m) _Pragma("unroll") for (int k = 0; k < 2; ++k) dst[m][k] = *(const PG8_LAS bf16x8*)(lds + PG8_SA(b, h) + aoff + m * 2048 + k * 1024); } while (0)
#define PG8_LDB(dst, b, h) do { _Pragma("unroll") for (int n = 0; n < 2; ++n) _Pragma("unroll") for (int k = 0; k < 2; ++k) dst[n][k] = *(const PG8_LAS bf16x8*)(lds + PG8_SB(b, h) + boff + n * 2048 + k * 1024); } while (0)
#define PG8_MMA(ai, bj, At, Bt) do { __builtin_amdgcn_s_setprio(1); _Pragma("unroll") for (int m = 0; m < 4; ++m) _Pragma("unroll") for (int n = 0; n < 2; ++n) _Pragma("unroll") for (int k = 0; k < 2; ++k) \
        acc[ai][bj][m][n] = __builtin_amdgcn_mfma_f32_16x16x32_bf16(Bt[n][k], At[m][k], acc[ai][bj][m][n], 0, 0, 0); __builtin_amdgcn_s_setprio(0); } while (0)
#define PG8_WAIT_V(n) asm volatile("s_waitcnt vmcnt(" #n ")" ::: "memory")
#define PG8_WAIT_L(n) asm volatile("s_waitcnt lgkmcnt(" #n ")" ::: "memory")
#define PG8_BAR __builtin_amdgcn_s_barrier()
#define PG8_SCHED __builtin_amdgcn_sched_barrier(0)
    Unit cur, nxt; int ui = 0;
    if (!S.next(0, cur)) return;
    f32x4 acc[2][2][4][2];
#pragma unroll
    for (int a = 0; a < 2; ++a)
#pragma unroll
        for (int b = 0; b < 2; ++b)
#pragma unroll
            for (int m = 0; m < 4; ++m)
#pragma unroll
                for (int n = 0; n < 2; ++n) acc[a][b][m][n] = (f32x4){0.f, 0.f, 0.f, 0.f};
    bf16x8 At[4][2], B0[2][2], B1[2][2];
    const char* cA = (const char*)g.A + (size_t)cur.pm * tstep; const char* cB = (const char*)g.Bt + (size_t)cur.pn * tstep;
    S.a_ready(cur);
    PG8_STAGE(PG8_SB(0, 0), cB, voffB); PG8_STAGE(PG8_SA(0, 0), cA, voffA); PG8_STAGE(PG8_SB(0, 1), cB + hstep, voffB); PG8_STAGE(PG8_SA(0, 1), cA + hstep, voffA);
    if (wr == 1) PG8_BAR;
    PG8_WAIT_V(4); PG8_BAR;
    PG8_STAGE(PG8_SB(1, 0), cB + kstep, voffB); PG8_STAGE(PG8_SA(1, 0), cA + kstep, voffA); PG8_STAGE(PG8_SB(1, 1), cB + hstep + kstep, voffB);
    PG8_WAIT_V(6); PG8_BAR;
    for (;;) {
        const bool has_next = S.next(ui + 1, nxt);
        const char* nA = has_next ? (const char*)g.A + (size_t)nxt.pm * tstep : cA; const char* nB = has_next ? (const char*)g.Bt + (size_t)nxt.pn * tstep : cB;
        for (int t = 0; t < nt; t += 2) {
            const bool last = (t == nt - 2);
            const char* a1 = cA + (size_t)(t + 1) * kstep;
            const char* a2 = last ? nA : cA + (size_t)(t + 2) * kstep; const char* b2 = last ? nB : cB + (size_t)(t + 2) * kstep;
            const char* a3 = a2 + kstep; const char* b3 = b2 + kstep;
            if (last && has_next) S.a_ready(nxt);
            PG8_LDB(B0, 0, 0); PG8_SCHED; PG8_LDA(At, 0, 0); PG8_STAGE(PG8_SA(1, 1), a1 + hstep, voffA);
            PG8_WAIT_L(8); PG8_BAR; PG8_WAIT_L(0); PG8_MMA(0, 0, At, B0); PG8_BAR; PG8_SCHED;
            PG8_LDB(B1, 0, 1); PG8_STAGE(PG8_SB(0, 0), b2, voffB);
            PG8_BAR; PG8_WAIT_L(0); PG8_MMA(0, 1, At, B1); PG8_BAR;
            PG8_LDA(At, 0, 1); PG8_STAGE(PG8_SA(0, 0), a2, voffA);
            PG8_BAR; PG8_WAIT_L(0); PG8_MMA(1, 0, At, B0); PG8_BAR; PG8_SCHED;
            PG8_STAGE(PG8_SB(0, 1), b2 + hstep, voffB);
            PG8_WAIT_V(6); PG8_BAR; PG8_MMA(1, 1, At, B1); PG8_BAR;
            PG8_LDB(B0, 1, 0); PG8_SCHED; PG8_LDA(At, 1, 0); PG8_STAGE(PG8_SA(0, 1), a2 + hstep, voffA);
            PG8_WAIT_L(8); PG8_BAR; PG8_WAIT_L(0); PG8_MMA(0, 0, At, B0); PG8_BAR; PG8_SCHED;
            PG8_LDB(B1, 1, 1); PG8_STAGE(PG8_SB(1, 0), b3, voffB);
            PG8_BAR; PG8_WAIT_L(0); PG8_MMA(0, 1, At, B1); PG8_BAR;
            PG8_LDA(At, 1, 1); PG8_STAGE(PG8_SA(1, 0), a3, voffA);
            PG8_BAR; PG8_WAIT_L(0); PG8_MMA(1, 0, At, B0); PG8_BAR; PG8_SCHED;
            PG8_STAGE(PG8_SB(1, 1), b3 + hstep, voffB);
            PG8_WAIT_V(6); PG8_BAR; PG8_MMA(1, 1, At, B1); PG8_BAR;
        }
        if constexpr (!Epi::AFTER_DRAIN) { E(acc, cur, wr, wc, fr, fq); S.done(cur); }
        if (!has_next) break;
#pragma unroll
        for (int a = 0; a < 2; ++a)
#pragma unroll
            for (int b = 0; b < 2; ++b)
#pragma unroll
                for (int m = 0; m < 4; ++m)
#pragma unroll
                    for (int n = 0; n < 2; ++n) acc[a][b][m][n] = (f32x4){0.f, 0.f, 0.f, 0.f};
        cur = nxt; cA = nA; cB = nB; ++ui;
    }
    PG8_WAIT_V(0);
    if (wr == 0) PG8_BAR;
    PG8_BAR;
    if constexpr (Epi::AFTER_DRAIN) { E.fused(acc, cur, wr, wc, fr, fq, lds, wid, lane); S.done(cur); }
#undef PG8_SA
#undef PG8_SB
#undef PG8_STAGE
#undef PG8_LDA
#undef PG8_LDB
#undef PG8_MMA
#undef PG8_WAIT_V
#undef PG8_WAIT_L
#undef PG8_BAR
#undef PG8_SCHED
}
}

#endif

typedef unsigned short bf16;
#ifndef EMU
#define LAS __attribute__((address_space(3)))
#else
#define LAS
#endif
typedef short bf16x8 __attribute__((ext_vector_type(8)));
typedef float f32x4 __attribute__((ext_vector_type(4)));
typedef unsigned u32x4 __attribute__((ext_vector_type(4)));
typedef unsigned u32x2 __attribute__((ext_vector_type(2)));

#ifdef EMU
constexpr int BP = EMU_BP, LP = EMU_LP, BS = EMU_BS;
#else
constexpr int BP = 8, LP = 2048, BS = 128;
#endif
constexpr int D = 1024, LS = 4, TP = BP * LP, TS = BS * LS, T = TP + TS;
constexpr int INW = 7968, NZM = 4864, NZG = 3072, NZ = NZM + NZG, NSM = 32;
constexpr int NEXP = 16384;
constexpr int NTHREADS = 512, NWAVES = 8;
constexpr int LDS_BYTES = 160 * 1024;

constexpr size_t O_YP = 0, O_YS = O_YP + (size_t)TP * D, O_PC = O_YS + (size_t)TS * D, O_PN = O_PC + 2ull * BP * 4 * 128 * 128, O_PM = O_PN + 2ull * BP * 4 * 128,
    O_PG = O_PM + 2ull * BP * 4, O_PH = O_PG + 2ull * BP * 4 * 64 * 128, O_PV = O_PH + 2ull * BP * 8 * 64 * 64, O_SC = O_PV + 2ull * BP * 3 * 768,
    O_SN = O_SC + 2ull * BS * 4 * 128 * 128, O_SM = O_SN + 2ull * BS * 4 * 128, O_SG = O_SM + 2ull * BS * 4, O_SH = O_SG + 2ull * BS * 4 * 64 * 128,
    O_SV = O_SH + 2ull * BS * 8 * 64 * 64, O_END = O_SV + 2ull * BS * 3 * 768;

constexpr size_t al256(size_t x) { return (x + 255) & ~(size_t)255; }
constexpr size_t WS_CTL = 0, WS_CTL_BYTES = 65536;
constexpr size_t WB_WIN = 0, WB_WS = WB_WIN + (size_t)NZ * D * 2, WB_WBR = WB_WS + (size_t)NSM * D * 2, WB_WO = WB_WBR + 3ull * D * 512 * 2, WB_WQ = WB_WO + (size_t)D * D * 2,
    WB_KEYS = WB_WQ + 2048ull * D * 2, WB_BYTES = WB_KEYS + 16ull * 128 * 128 * 2;
constexpr size_t WS_WB = WS_CTL + WS_CTL_BYTES;
constexpr size_t WS_XB = WS_WB + 2 * WB_BYTES;
constexpr size_t WS_H = WS_XB + (size_t)T * D * 2;
constexpr size_t WS_ZS = WS_H + (size_t)T * D * 4;
constexpr size_t WS_BR = WS_ZS + (size_t)T * NSM * 4;
constexpr size_t WS_ZM = WS_BR + 3ull * T * 512 * 2;
constexpr size_t WS_ZG = WS_ZM + (size_t)T * NZM * 2;
constexpr size_t WS_END0 = WS_ZG + (size_t)T * NZG * 2;
constexpr size_t WS_Q = WS_ZM, WS_IDX = WS_Q + (size_t)T * 2048 * 2, WS_GT = WS_IDX + (size_t)T * 128 * 4;
#ifdef EMU
constexpr size_t WS_PU = WS_END0, WS_PV = WS_PU + (size_t)NEXP * D * 2, WS_END = WS_PV + (size_t)NEXP * D * 2;
#else
constexpr size_t WS_PU = WS_GT + (size_t)T * 128 * 4, WS_PV = WS_PU + (size_t)NEXP * D * 2, WS_ZM_END = WS_PV + (size_t)NEXP * D * 2, WS_END = WS_END0;
static_assert(WS_ZM_END <= WS_ZG, "ZM alias overflow");
#endif
static_assert((size_t)T * D * 4 <= (size_t)T * NZG * 2, "Y alias overflow");

#ifndef EMU
__device__ __forceinline__ f32x4 mfma16(bf16x8 a, bf16x8 b, f32x4 c) { return __builtin_amdgcn_mfma_f32_16x16x32_bf16(a, b, c, 0, 0, 0); }
#endif
struct Args { const float* in[31]; float* out; unsigned char* ws; int ph_lo, ph_hi; };
#ifndef EMU
typedef const __attribute__((address_space(4))) Args* ArgP;
#else
typedef const Args* ArgP;
#endif
#define A (*Ap)
#ifndef EMU
__device__ __forceinline__ int opaque_tid() { int t = threadIdx.x; asm volatile("" : "+v"(t)); return t; }
#else
static inline int opaque_tid() { return threadIdx.x; }
#endif

__device__ __forceinline__ bf16 f2bf(float f) { unsigned u = __float_as_uint(f); u += 0x7FFFu + ((u >> 16) & 1u); return (bf16)(u >> 16); }
__device__ __forceinline__ float bf2f(bf16 b) { return __uint_as_float(((unsigned)b) << 16); }
__device__ __forceinline__ unsigned pk2(float lo, float hi) { return (unsigned)f2bf(lo) | ((unsigned)f2bf(hi) << 16); }

__device__ __forceinline__ void tconv_tile(const float* __restrict__ src, int ldsrc, int k0, int c0, bf16* __restrict__ dst, int ldd, int n0, LAS float* tile) {
    const int t = opaque_tid(), i = t >> 3, jg = (t & 7) * 8;
    const float4 a = *(const float4*)(src + (size_t)(k0 + i) * ldsrc + c0 + jg), b = *(const float4*)(src + (size_t)(k0 + i) * ldsrc + c0 + jg + 4);
    LAS float* r = tile + i * 65 + jg;
    r[0] = a.x; r[1] = a.y; r[2] = a.z; r[3] = a.w; r[4] = b.x; r[5] = b.y; r[6] = b.z; r[7] = b.w;
    __syncthreads();
    const int j = t >> 3, ig = (t & 7) * 8;
    u32x4 w;
    w.x = pk2(tile[(ig + 0) * 65 + j], tile[(ig + 1) * 65 + j]); w.y = pk2(tile[(ig + 2) * 65 + j], tile[(ig + 3) * 65 + j]);
    w.z = pk2(tile[(ig + 4) * 65 + j], tile[(ig + 5) * 65 + j]); w.w = pk2(tile[(ig + 6) * 65 + j], tile[(ig + 7) * 65 + j]);
    *(u32x4*)(dst + (size_t)(n0 + j) * ldd + k0 + ig) = w;
    __syncthreads();
}
__device__ __forceinline__ int zcol_to_src(int zc) { return zc < 2048 ? zc : (zc < 3584 ? zc + 8 : (zc < 4864 ? zc + 24 : zc + 32)); }
__device__ __forceinline__ int scol_to_src(int sc) { return sc < 8 ? 2048 + sc : (sc < 24 ? 3592 + (sc - 8) : 4888 + (sc - 24)); }

__device__ __forceinline__ void convert_f32_bf16(const float* __restrict__ src, bf16* __restrict__ dst, size_t n, int gtid, int gthreads) {
    for (size_t i = (size_t)gtid * 8; i < n; i += (size_t)gthreads * 8) {
        const float4 a = *(const float4*)(src + i), b = *(const float4*)(src + i + 4);
        u32x4 w; w.x = pk2(a.x, a.y); w.y = pk2(a.z, a.w); w.z = pk2(b.x, b.y); w.w = pk2(b.z, b.w);
        *(u32x4*)(dst + i) = w;
    }
}

__device__ __forceinline__ void phase_convert(ArgP Ap, LAS unsigned char* lds) {
    LAS float* tile = (LAS float*)lds;
    const int G = gridDim.x, bid = blockIdx.x;
    constexpr int I_WIN = (NZ / 64) * (D / 64), I_WBR = 3 * (D / 64) * (512 / 64), I_WO = (D / 64) * (D / 64), I_WQ = (2048 / 64) * (D / 64), I_L = I_WIN + I_WBR + I_WO + I_WQ;
    for (int it = bid; it < 2 * I_L; it += G) {
        const int l = it / I_L; int r = it % I_L;
        unsigned char* wb = A.ws + WS_WB + (size_t)l * WB_BYTES;
        if (r < I_WIN) { const int nt = r / (D / 64), kt = r % (D / 64);
            tconv_tile(A.in[8] + (size_t)l * D * INW, INW, kt * 64, zcol_to_src(nt * 64), (bf16*)(wb + WB_WIN), D, nt * 64, tile); continue; }
        r -= I_WIN;
        if (r < I_WBR) { const int n = r / ((D / 64) * 8), rr = r % ((D / 64) * 8), nt = rr / 8, kt = rr % 8;
            tconv_tile(A.in[21] + ((size_t)l * 3 + n) * 512 * D, D, kt * 64, nt * 64, (bf16*)(wb + WB_WBR) + (size_t)n * D * 512, 512, nt * 64, tile); continue; }
        r -= I_WBR;
        if (r < I_WO) { const int nt = r / (D / 64), kt = r % (D / 64);
            tconv_tile(A.in[22] + (size_t)l * D * D, D, kt * 64, nt * 64, (bf16*)(wb + WB_WO), D, nt * 64, tile); continue; }
        r -= I_WO;
        { const int nt = r / (D / 64), kt = r % (D / 64);
            tconv_tile(A.in[25] + (size_t)l * D * 2048, 2048, kt * 64, nt * 64, (bf16*)(wb + WB_WQ), D, nt * 64, tile); }
    }
    const int gtid = bid * NTHREADS + opaque_tid(), gthreads = G * NTHREADS;
    for (int l = 0; l < 2; ++l) {
        unsigned char* wb = A.ws + WS_WB + (size_t)l * WB_BYTES;
        for (int e = gtid; e < NSM * D; e += gthreads) { const int n = e / D, k = e % D; ((bf16*)(wb + WB_WS))[e] = f2bf(A.in[8][(size_t)l * D * INW + (size_t)k * INW + scol_to_src(n)]); }
        convert_f32_bf16(A.in[26] + (size_t)l * 16 * 128 * 128, (bf16*)(wb + WB_KEYS), 16 * 128 * 128, gtid, gthreads);
    }
    convert_f32_bf16(A.in[0], (bf16*)(A.ws + WS_XB), (size_t)TP * D, gtid, gthreads);
    convert_f32_bf16(A.in[1], (bf16*)(A.ws + WS_XB) + (size_t)TP * D, (size_t)TS * D, gtid, gthreads);
}

#ifndef EMU
struct EpiZ {
    static constexpr bool PERM = true, AFTER_DRAIN = false;
    bf16* ZM; bf16* ZG;
    __device__ __forceinline__ void operator()(const pg8::f32x4 (&acc)[2][2][4][2], const pg8::Unit& u, int wr, int wc, int fr, int fq) const {
        const int row0 = u.pm * 256 + wr * 64 + fr; const bool gate = u.pn >= 19;
        bf16* base = gate ? ZG : ZM; const int ldc = gate ? NZG : NZM; const int col0 = (gate ? (u.pn - 19) : u.pn) * 256 + wc * 32 + 8 * fq;
#pragma unroll
        for (int ai = 0; ai < 2; ++ai)
#pragma unroll
            for (int m = 0; m < 4; ++m) { bf16* rowp = base + (size_t)(row0 + ai * 128 + m * 16) * ldc + col0;
#pragma unroll
                for (int bj = 0; bj < 2; ++bj) { f32x4 v0 = acc[ai][bj][m][0], v1 = acc[ai][bj][m][1];
                    if (gate) {
#pragma unroll
                        for (int j = 0; j < 4; ++j) { v0[j] = __builtin_amdgcn_rcpf(1.0f + __expf(-v0[j])); v1[j] = __builtin_amdgcn_rcpf(1.0f + __expf(-v1[j])); } }
                    u32x4 w; w.x = pg8::cvt_pk_bf16(v0[0], v0[1]); w.y = pg8::cvt_pk_bf16(v0[2], v0[3]); w.z = pg8::cvt_pk_bf16(v1[0], v1[1]); w.w = pg8::cvt_pk_bf16(v1[2], v1[3]);
                    *(u32x4*)(rowp + bj * 128) = w; } }
    }
};

#endif
__device__ __forceinline__ void small_gemm(const bf16* __restrict__ XB, const bf16* __restrict__ WsT, float* __restrict__ ZS) {
    const int tx = opaque_tid(), lane = tx & 63, wave = tx >> 6, gw = blockIdx.x * NWAVES + wave, NGW = gridDim.x * NWAVES, fr = lane & 15, fq = lane >> 4;
    for (int rg = gw; rg < T / 16; rg += NGW) {
        f32x4 a0 = {0.f, 0.f, 0.f, 0.f}, a1 = {0.f, 0.f, 0.f, 0.f};
        const bf16* ap = XB + (size_t)(rg * 16 + fr) * D + 8 * fq; const bf16* b0p = WsT + (size_t)fr * D + 8 * fq; const bf16* b1p = WsT + (size_t)(16 + fr) * D + 8 * fq;
#pragma unroll 4
        for (int k0 = 0; k0 < D; k0 += 32) {
            const bf16x8 a = *(const bf16x8*)(ap + k0), b0 = *(const bf16x8*)(b0p + k0), b1 = *(const bf16x8*)(b1p + k0);
            a0 = mfma16(a, b0, a0); a1 = mfma16(a, b1, a1);
        }
#pragma unroll
        for (int r = 0; r < 4; ++r) { float* o = ZS + (size_t)(rg * 16 + fq * 4 + r) * NSM + fr; o[0] = a0[r]; o[16] = a1[r]; }
    }
}

#ifndef EMU
__device__ __forceinline__ void phase_gemm1(ArgP Ap, LAS unsigned char* lds, int l) {
    unsigned char* wb = A.ws + WS_WB + (size_t)l * WB_BYTES;
    pg8::Gemm g{(const bf16*)(A.ws + WS_XB), (const bf16*)(wb + WB_WIN), T, NZ, D};
    pg8::StaticOrder S; S.init(T, NZ, gridDim.x, blockIdx.x);
    EpiZ E{(bf16*)(A.ws + WS_ZM), (bf16*)(A.ws + WS_ZG)};
    pg8::gemm_phase<EpiZ, pg8::StaticOrder>(lds, g, S, E);
    small_gemm((const bf16*)(A.ws + WS_XB), (const bf16*)(wb + WB_WS), (float*)(A.ws + WS_ZS));
}
#endif

#ifndef EMU
#define XB_TMO      128
#define XB_XCNT(j)  (256  + 64 * (j))
#define XB_XSUB(j)  (1280 + 64 * (j))
#define XB_XGEN(j)  (2304 + 64 * (j))
#define XB_TOP      3328
#define XB_TOPGEN   3392
#define XCD_BAR_WORDS 3456
#define XB_SPIN_CAP (1u << 18)

__device__ __forceinline__ unsigned xb_ld(unsigned* p)              { return __hip_atomic_load(p, __ATOMIC_RELAXED, __HIP_MEMORY_SCOPE_AGENT); }
__device__ __forceinline__ unsigned xb_add(unsigned* p, unsigned v) { return __hip_atomic_fetch_add(p, v, __ATOMIC_RELAXED, __HIP_MEMORY_SCOPE_AGENT); }
__device__ __forceinline__ unsigned xb_xcc_id() { return (unsigned)__builtin_amdgcn_s_getreg((3 << 11) | 20) & 0xFu; }
#define XB_SPIN(cond, bar) do { unsigned _sp = 0; while (cond) { __builtin_amdgcn_s_sleep(1); \
    if ((++_sp & 255u) == 0u) { if (xb_ld(&(bar)[XB_TMO])) break; if (_sp > XB_SPIN_CAP) { atomicAdd(&(bar)[XB_TMO], 1u); break; } } } } while (0)

struct XcdBarrier {
    unsigned* bar; unsigned x;
    volatile LAS unsigned* st;
};

__device__ __forceinline__ XcdBarrier xcd_barrier_post(unsigned* bar, volatile LAS unsigned* st) {
    XcdBarrier b; b.bar = bar; b.x = xb_xcc_id(); b.st = st;
    if (threadIdx.x == 0) (void)xb_add(&bar[XB_XCNT(b.x)], 1u);
    return b;
}
__device__ __forceinline__ void xcd_barrier_complete(unsigned* bar, unsigned x, unsigned& nloc, unsigned& nx) {
    const unsigned G = gridDim.x * gridDim.y * gridDim.z;
    unsigned sum, cnt, mine, sp = 0u;
    for (;;) {
        sum = 0u; cnt = 0u; mine = 0u;
#pragma unroll
        for (unsigned j = 0; j < 16; ++j) { const unsigned c = xb_ld(&bar[XB_XCNT(j)]); sum += c; cnt += (c > 0u) ? 1u : 0u; mine = (j == x) ? c : mine; }
        if (sum == G) break;
        __builtin_amdgcn_s_sleep(1);
        if ((++sp & 255u) == 0u) { if (xb_ld(&bar[XB_TMO])) break; if (sp > XB_SPIN_CAP) { atomicAdd(&bar[XB_TMO], 1u); break; } }
    }
    nloc = mine > 0u ? mine : 1u; nx = cnt > 0u ? cnt : 1u;
}

__device__ __forceinline__ void xcd_barrier(const XcdBarrier& b) {
    asm volatile("s_waitcnt vmcnt(0)" ::: "memory");
    __syncthreads();
    if (threadIdx.x == 0) {
        unsigned* bar = b.bar;
        __builtin_amdgcn_s_waitcnt(0);
        unsigned nloc = b.st[0], nx = b.st[1];
        if (nloc == 0u) { xcd_barrier_complete(bar, b.x, nloc, nx); b.st[0] = nloc; b.st[1] = nx; }
        const unsigned old = xb_add(&bar[XB_XSUB(b.x)], 1u);
        const unsigned gen = old / nloc;
        if (old + 1u == (gen + 1u) * nloc) {
            __builtin_amdgcn_fence(__ATOMIC_RELEASE, "agent");
            asm volatile("s_waitcnt vmcnt(0)" ::: "memory");
            const unsigned og = xb_add(&bar[XB_TOP], 1u);
            const unsigned tg = og / nx;
            if (og + 1u == (tg + 1u) * nx) xb_add(&bar[XB_TOPGEN], 1u);
            else XB_SPIN(xb_ld(&bar[XB_TOPGEN]) == tg, bar);
            __builtin_amdgcn_fence(__ATOMIC_ACQUIRE, "agent");
            xb_add(&bar[XB_XGEN(b.x)], 1u);
            asm volatile("s_waitcnt vmcnt(0)" ::: "memory");
        } else {
            XB_SPIN(xb_ld(&bar[XB_XGEN(b.x)]) == gen, bar);
            __builtin_amdgcn_fence(__ATOMIC_ACQUIRE, "agent");
            asm volatile("s_waitcnt vmcnt(0)" ::: "memory");
        }
    }
    __syncthreads();
}

#endif

#define mma_tile(...) mma_tile_(fr, fq, __VA_ARGS__)
__device__ __forceinline__ f32x4 mma_tile_(int fr, int fq, const LAS bf16* A_, int lda, int row0, const LAS bf16* Bt, int ldb, int col0, int K, f32x4 acc) {
    const LAS bf16* ap = A_ + (row0 + fr) * lda + 8 * fq; const LAS bf16* bp = Bt + (col0 + fr) * ldb + 8 * fq;
    for (int k0 = 0; k0 < K; k0 += 32) { const bf16x8 a = *(const LAS bf16x8*)(ap + k0), b = *(const LAS bf16x8*)(bp + k0); acc = mfma16(a, b, acc); }
    return acc;
}
__device__ __forceinline__ float scan_sum64(float v, int lane) {
#pragma unroll
    for (int d = 1; d < 64; d <<= 1) { const float t = __shfl_up(v, d); if (lane >= d) v += t; }
    return v;
}
__device__ __forceinline__ float scan_max64(float v, int lane) {
#pragma unroll
    for (int d = 1; d < 64; d <<= 1) { const float t = __shfl_up(v, d); if (lane >= d) v = fmaxf(v, t); }
    return v;
}
__device__ __forceinline__ float wave_max64(float v) {
#pragma unroll
    for (int m = 1; m < 64; m <<= 1) v = fmaxf(v, __shfl_xor(v, m));
    return v;
}
__device__ __forceinline__ float logsig(float x) { return fminf(x, 0.f) - log1pf(__expf(-fabsf(x))); }
__device__ __forceinline__ float softplusf(float x) { return fmaxf(x, 0.f) + log1pf(__expf(-fabsf(x))); }
__device__ __forceinline__ float sigmoidf(float x) { return 1.0f / (1.0f + __expf(-x)); }
__device__ __forceinline__ float siluf(float x) { return x / (1.0f + __expf(-x)); }
constexpr float NEG_INF = -__builtin_huge_valf();
constexpr float EPS_ = 1e-5f;
__device__ __forceinline__ void unpack8(const u32x4 w, float (&f)[8]) {
    f[0] = __uint_as_float(w.x << 16); f[1] = __uint_as_float(w.x & 0xffff0000u); f[2] = __uint_as_float(w.y << 16); f[3] = __uint_as_float(w.y & 0xffff0000u);
    f[4] = __uint_as_float(w.z << 16); f[5] = __uint_as_float(w.z & 0xffff0000u); f[6] = __uint_as_float(w.w << 16); f[7] = __uint_as_float(w.w & 0xffff0000u);
}
__device__ __forceinline__ u32x4 pack8(const float (&f)[8]) { u32x4 w; w.x = pk2(f[0], f[1]); w.y = pk2(f[2], f[3]); w.z = pk2(f[4], f[5]); w.w = pk2(f[6], f[7]); return w; }

__device__ __forceinline__ void mlstm_item(ArgP Ap, LAS unsigned char* lds, int l, int b, int h, bool sample) {
    int tid_o = threadIdx.x; asm volatile("" : "+v"(tid_o));
    const int tid = tid_o, lane = tid & 63, wave = tid >> 6, fr = lane & 15, fq = lane >> 4;
    LAS bf16* Qs = (LAS bf16*)(lds); LAS bf16* Ks = (LAS bf16*)(lds + 17408); LAS bf16* KTw = (LAS bf16*)(lds + 34816); LAS bf16* VT = (LAS bf16*)(lds + 53248);
    LAS bf16* Ss = (LAS bf16*)(lds + 73984); LAS bf16* Cb = (LAS bf16*)(lds + 83200); LAS float* Hs = (LAS float*)(lds); LAS float* gb = (LAS float*)(lds + 122368);
    LAS float* b_ = gb; LAS float* mt_ = gb + 64; LAS float* u_ = gb + 128; LAS float* ein_ = gb + 192; LAS float* wg_ = gb + 256; LAS float* den_ = gb + 320; LAS float* sc_ = gb + 384;
    const int L = sample ? LS : LP, tok0 = sample ? TP + b * LS : b * LP, NB = sample ? BS : BP;
    const bf16* ZM = (const bf16*)(A.ws + WS_ZM); const float* ZS = (const float*)(A.ws + WS_ZS); bf16* BR0 = (bf16*)(A.ws + WS_BR);
    const float ib = A.in[9][l * 4 + h], fb = A.in[10][l * 4 + h]; const float* mnorm = A.in[11] + l * 512 + h * 128;
    f32x4 accC[9];
#pragma unroll
    for (int vi = 0; vi < 9; ++vi) accC[vi] = (f32x4){0.f, 0.f, 0.f, 0.f};
    float m_run = 0.f;
    if (sample) {
        const float* C0 = A.in[2] + ((size_t)(l * BS + b) * 4 + h) * 16384; const float* n0 = A.in[3] + ((size_t)(l * BS + b) * 4 + h) * 128;
        const float* cp = C0 + (4 * fq) * 128 + 16 * wave + fr;
#pragma unroll
        for (int vi = 0; vi < 8; ++vi) {
#pragma unroll
            for (int r = 0; r < 4; ++r) accC[vi][r] = cp[r * 128];
            cp += 2048; asm volatile("" : "+v"(cp)); }
        if (fq == 0) accC[8][0] = n0[16 * wave + fr];
        m_run = A.in[4][(l * BS + b) * 4 + h];
    }
#pragma unroll
    for (int vi = 0; vi < 9; ++vi)
#pragma unroll
        for (int r = 0; r < 4; ++r) Cb[(16 * vi + 4 * fq + r) * 136 + 16 * wave + fr] = f2bf(accC[vi][r]);
    for (int e = tid; e < 16 * 72; e += NTHREADS) VT[128 * 72 + e] = (e < 72) ? (bf16)0x3F80 : (bf16)0;
    __syncthreads();
    for (int t0 = 0; t0 < L; t0 += 64) {
        const int nv = (L - t0) < 64 ? (L - t0) : 64;
        if (wave == 0) {
            float li = NEG_INF, lf = 0.f;
            if (lane < nv) { const size_t tok = tok0 + t0 + lane; li = ZS[tok * NSM + h] + ib; lf = logsig(ZS[tok * NSM + 4 + h] + fb); }
            const float bb = scan_sum64(lf, lane), a = bb + m_run, u = li - bb, M = scan_max64(u, lane), mt = fmaxf(a, bb + M);
            const float blast = __shfl(bb, 63), g = blast + u, gmax = wave_max64(g), mnew = fmaxf(blast + m_run, gmax);
            b_[lane] = bb; mt_[lane] = mt; u_[lane] = u; ein_[lane] = __expf(a - mt); wg_[lane] = __expf(g - mnew);
            if (lane == 0) sc_[1] = __expf(blast + m_run - mnew);
            m_run = mnew;
        }
        __syncthreads();
#pragma unroll 1
        for (int c = tid; c < 3072; c += NTHREADS) {
            const int mat = c >> 10, t = (c & 1023) >> 4, cc = (c & 15) * 8;
            u32x4 w = {0u, 0u, 0u, 0u};
            if (t < nv) w = *(const u32x4*)(ZM + (size_t)(tok0 + t0 + t) * NZM + mat * 512 + h * 128 + cc);
            if (mat == 0) *(LAS u32x4*)(Qs + t * 136 + cc) = w;
            else if (mat == 1) { *(LAS u32x4*)(Ks + t * 136 + cc) = w; float f[8]; unpack8(w, f); const float g = wg_[t];
#pragma unroll
                for (int i = 0; i < 8; ++i) KTw[(cc + i) * 72 + t] = f2bf(f[i] * g); }
            else {
                VT[(cc + 0) * 72 + t] = (bf16)(w.x & 0xffff); VT[(cc + 1) * 72 + t] = (bf16)(w.x >> 16); VT[(cc + 2) * 72 + t] = (bf16)(w.y & 0xffff); VT[(cc + 3) * 72 + t] = (bf16)(w.y >> 16);
                VT[(cc + 4) * 72 + t] = (bf16)(w.z & 0xffff); VT[(cc + 5) * 72 + t] = (bf16)(w.z >> 16); VT[(cc + 6) * 72 + t] = (bf16)(w.w & 0xffff); VT[(cc + 7) * 72 + t] = (bf16)(w.w >> 16); }
        }
        __syncthreads();
#pragma unroll
        for (int j = 0; j < 2; ++j) { const int idx = wave + 8 * j, ti = idx >> 2, si = idx & 3;
            f32x4 acc = {0.f, 0.f, 0.f, 0.f};
            if (si <= ti) acc = mma_tile(Qs, 136, 16 * ti, Ks, 136, 16 * si, 128, acc);
#pragma unroll
            for (int r = 0; r < 4; ++r) { const int t = 16 * ti + 4 * fq + r, s = 16 * si + fr;
                const float v = (s <= t) ? acc[r] * __expf(b_[t] + u_[s] - mt_[t]) : 0.f; Ss[t * 72 + s] = f2bf(v); } }
        __syncthreads();
        if (wave < 4) { const int ti = wave; f32x4 acc = {0.f, 0.f, 0.f, 0.f};
            acc = mma_tile(Qs, 136, 16 * ti, Cb, 136, 128, 128, acc);
#pragma unroll
            for (int r = 0; r < 4; ++r) acc[r] *= ein_[16 * ti + 4 * fq + r];
            acc = mma_tile(Ss, 72, 16 * ti, VT, 72, 128, 64, acc);
            if (fr == 0) {
#pragma unroll
                for (int r = 0; r < 4; ++r) den_[16 * ti + 4 * fq + r] = acc[r]; } }
        f32x4 accn[4];
#pragma unroll
        for (int j = 0; j < 4; ++j) { const int idx = wave + 8 * j, ti = idx >> 3, vi = idx & 7; accn[j] = (f32x4){0.f, 0.f, 0.f, 0.f};
            accn[j] = mma_tile(Qs, 136, 16 * ti, Cb, 136, 16 * vi, 128, accn[j]);
#pragma unroll
            for (int r = 0; r < 4; ++r) accn[j][r] *= ein_[16 * ti + 4 * fq + r];
            accn[j] = mma_tile(Ss, 72, 16 * ti, VT, 72, 16 * vi, 64, accn[j]);
            asm volatile("" ::: "memory"); }
        __syncthreads();
#pragma unroll
        for (int j = 0; j < 4; ++j) { const int idx = wave + 8 * j, ti = idx >> 3, vi = idx & 7;
#pragma unroll
            for (int r = 0; r < 4; ++r) { const int t = 16 * ti + 4 * fq + r; const float dn = den_[t] * 0.08838834764831845f;
                Hs[t * 132 + 16 * vi + fr] = accn[j][r] * 0.08838834764831845f / fmaxf(fabsf(dn), __expf(-mt_[t])); } }
        __syncthreads();
        { const int t = tid >> 3, part = tid & 7; float x[16]; float s1 = 0.f;
#pragma unroll
            for (int i = 0; i < 16; ++i) { x[i] = Hs[t * 132 + 16 * part + i]; s1 += x[i]; }
            s1 += __shfl_xor(s1, 1); s1 += __shfl_xor(s1, 2); s1 += __shfl_xor(s1, 4);
            const float mu = s1 * (1.0f / 128.0f); float s2 = 0.f;
#pragma unroll
            for (int i = 0; i < 16; ++i) { x[i] -= mu; s2 += x[i] * x[i]; }
            s2 += __shfl_xor(s2, 1); s2 += __shfl_xor(s2, 2); s2 += __shfl_xor(s2, 4);
            const float rstd = 1.0f / sqrtf(s2 * (1.0f / 128.0f) + EPS_);
            if (t < nv) { const size_t tok = tok0 + t0 + t; const bf16* mo = ZM + tok * NZM + 1536 + h * 128 + 16 * part;
                float o0[8], o1[8]; unpack8(*(const u32x4*)mo, o0); unpack8(*(const u32x4*)(mo + 8), o1); float y0[8], y1[8];
#pragma unroll
                for (int i = 0; i < 8; ++i) { y0[i] = x[i] * rstd * mnorm[16 * part + i] * sigmoidf(o0[i]); y1[i] = x[8 + i] * rstd * mnorm[16 * part + 8 + i] * sigmoidf(o1[i]); }
                bf16* o = BR0 + tok * 512 + h * 128 + 16 * part; *(u32x4*)o = pack8(y0); *(u32x4*)(o + 8) = pack8(y1); } }
        { const float ec = sc_[1];
#pragma unroll
            for (int vi = 0; vi < 9; ++vi) {
#pragma unroll
                for (int r = 0; r < 4; ++r) accC[vi][r] *= ec;
                accC[vi] = mma_tile(VT, 72, 16 * vi, KTw, 72, 16 * wave, 64, accC[vi]);
#pragma unroll
                for (int r = 0; r < 4; ++r) Cb[(16 * vi + 4 * fq + r) * 136 + 16 * wave + fr] = f2bf(accC[vi][r]);
                asm volatile("" ::: "memory"); } }
        __syncthreads();
    }
    float* Co = A.out + (sample ? O_SC : O_PC) + ((size_t)(l * NB + b) * 4 + h) * 16384; float* no = A.out + (sample ? O_SN : O_PN) + ((size_t)(l * NB + b) * 4 + h) * 128;
    { int fq_ = fq, cw_ = 16 * wave + fr; asm volatile("" : "+v"(fq_), "+v"(cw_));
      float* cp = Co + (4 * fq_) * 128 + cw_;
#pragma unroll
      for (int vi = 0; vi < 8; ++vi) {
#pragma unroll
        for (int r = 0; r < 4; ++r) cp[r * 128] = accC[vi][r];
        cp += 2048; asm volatile("" : "+v"(cp)); }
      if (fq_ == 0) no[cw_] = accC[8][0]; }
    if (tid == 0) A.out[(sample ? O_SM : O_PM) + (size_t)(l * NB + b) * 4 + h] = m_run;
    __syncthreads();
}

__device__ __forceinline__ void gla_item(ArgP Ap, LAS unsigned char* lds, int l, int b, int h, bool sample) {
    int tid_o = threadIdx.x; asm volatile("" : "+v"(tid_o));
    const int tid = tid_o, lane = tid & 63, wave = tid >> 6, fr = lane & 15, fq = lane >> 4;
    LAS bf16* QE = (LAS bf16*)(lds); LAS bf16* KE = (LAS bf16*)(lds + 9216); LAS bf16* KL = (LAS bf16*)(lds + 18432); LAS bf16* VT = (LAS bf16*)(lds + 27648);
    LAS bf16* ATT = (LAS bf16*)(lds + 46080); LAS bf16* STb = (LAS bf16*)(lds + 55296); LAS float* Os = (LAS float*)(lds + 73728); LAS float* LAM = (LAS float*)(lds + 107520);
    LAS float* GA = (LAS float*)(lds + 124160); LAS float* GUP = (LAS float*)(lds + 128256); LAS float* GBI = (LAS float*)(lds + 132352);
    const int L = sample ? LS : LP, tok0 = sample ? TP + b * LS : b * LP, NB = sample ? BS : BP;
    const bf16* ZM = (const bf16*)(A.ws + WS_ZM); const float* ZS = (const float*)(A.ws + WS_ZS); bf16* BR1 = (bf16*)(A.ws + WS_BR) + (size_t)T * 512;
    const float* gnorm = A.in[14] + l * 512 + h * 128;
    f32x4 accS[4];
#pragma unroll
    for (int ki = 0; ki < 4; ++ki) accS[ki] = (f32x4){0.f, 0.f, 0.f, 0.f};
    if (sample) { const float* S0 = A.in[5] + ((size_t)(l * BS + b) * 4 + h) * 8192;
        const float* sp = S0 + fr * 128 + 16 * wave + 4 * fq;
#pragma unroll
        for (int ki = 0; ki < 4; ++ki) {
#pragma unroll
            for (int r = 0; r < 4; ++r) accS[ki][r] = sp[r];
            sp += 2048; asm volatile("" : "+v"(sp)); } }
#pragma unroll
    for (int ki = 0; ki < 4; ++ki)
#pragma unroll
        for (int r = 0; r < 4; ++r) STb[(16 * wave + 4 * fq + r) * 72 + 16 * ki + fr] = f2bf(accS[ki][r]);
    for (int e = tid; e < 1024; e += NTHREADS) GUP[e] = A.in[12][(size_t)l * 16 * 256 + (e >> 6) * 256 + h * 64 + (e & 63)];
    if (tid < 64) GBI[tid] = A.in[13][l * 256 + h * 64 + tid];
    __syncthreads();
    for (int t0 = 0; t0 < L; t0 += 64) {
        const int nv = (L - t0) < 64 ? (L - t0) : 64;
        for (int e = tid; e < 1024; e += NTHREADS) { const int t = e >> 4, r = e & 15; GA[e] = (t < nv) ? ZS[(size_t)(tok0 + t0 + t) * NSM + 8 + r] : 0.f; }
        __syncthreads();
        for (int e = tid; e < 4096; e += NTHREADS) { const int t = e >> 6, k = e & 63; float x = GBI[k];
#pragma unroll
            for (int r = 0; r < 16; ++r) x += GA[t * 16 + r] * GUP[r * 64 + k];
            LAM[t * 65 + k] = (t < nv) ? logsig(x) * (1.0f / 16.0f) : 0.f; }
        __syncthreads();
        if (tid < 64) { float run = 0.f; for (int t = 0; t < 64; ++t) { run += LAM[t * 65 + tid]; LAM[t * 65 + tid] = run; } }
        __syncthreads();
        { const int t = tid >> 3, cc = (tid & 7) * 8; u32x4 wq = {0u, 0u, 0u, 0u}, wk = {0u, 0u, 0u, 0u};
            if (t < nv) { const bf16* zr = ZM + (size_t)(tok0 + t0 + t) * NZM + 2048 + h * 64 + cc; wq = *(const u32x4*)zr; wk = *(const u32x4*)(zr + 256); }
            float q[8], k[8], qe[8], ke[8]; unpack8(wq, q); unpack8(wk, k);
#pragma unroll
            for (int i = 0; i < 8; ++i) { const float lm = LAM[t * 65 + cc + i], ll = LAM[63 * 65 + cc + i]; qe[i] = q[i] * __expf(lm); ke[i] = k[i] * __expf(-lm);
                KL[(cc + i) * 72 + t] = f2bf(k[i] * __expf(ll - lm)); }
            *(LAS u32x4*)(QE + t * 72 + cc) = pack8(qe); *(LAS u32x4*)(KE + t * 72 + cc) = pack8(ke); }
#pragma unroll 1
        for (int c = tid; c < 1024; c += NTHREADS) { const int t = c >> 4, cc = (c & 15) * 8; u32x4 w = {0u, 0u, 0u, 0u};
            if (t < nv) w = *(const u32x4*)(ZM + (size_t)(tok0 + t0 + t) * NZM + 2560 + h * 128 + cc);
            VT[(cc + 0) * 72 + t] = (bf16)(w.x & 0xffff); VT[(cc + 1) * 72 + t] = (bf16)(w.x >> 16); VT[(cc + 2) * 72 + t] = (bf16)(w.y & 0xffff); VT[(cc + 3) * 72 + t] = (bf16)(w.y >> 16);
            VT[(cc + 4) * 72 + t] = (bf16)(w.z & 0xffff); VT[(cc + 5) * 72 + t] = (bf16)(w.z >> 16); VT[(cc + 6) * 72 + t] = (bf16)(w.w & 0xffff); VT[(cc + 7) * 72 + t] = (bf16)(w.w >> 16); }
        __syncthreads();
#pragma unroll
        for (int j = 0; j < 2; ++j) { const int idx = wave + 8 * j, ti = idx >> 2, si = idx & 3; f32x4 acc = {0.f, 0.f, 0.f, 0.f};
            if (si <= ti) acc = mma_tile(QE, 72, 16 * ti, KE, 72, 16 * si, 64, acc);
#pragma unroll
            for (int r = 0; r < 4; ++r) { const int t = 16 * ti + 4 * fq + r, s = 16 * si + fr; ATT[t * 72 + s] = f2bf((s <= t) ? acc[r] : 0.f); } }
        __syncthreads();
#pragma unroll
        for (int j = 0; j < 4; ++j) { const int idx = wave + 8 * j, ti = idx >> 3, vi = idx & 7; f32x4 acc = {0.f, 0.f, 0.f, 0.f};
            acc = mma_tile(QE, 72, 16 * ti, STb, 72, 16 * vi, 64, acc); acc = mma_tile(ATT, 72, 16 * ti, VT, 72, 16 * vi, 64, acc);
#pragma unroll
            for (int r = 0; r < 4; ++r) Os[(16 * ti + 4 * fq + r) * 132 + 16 * vi + fr] = acc[r] * 0.125f; }
        __syncthreads();
        { const int t = tid >> 3, part = tid & 7; float x[16]; float s2 = 0.f;
#pragma unroll
            for (int i = 0; i < 16; ++i) { x[i] = Os[t * 132 + 16 * part + i]; s2 += x[i] * x[i]; }
            s2 += __shfl_xor(s2, 1); s2 += __shfl_xor(s2, 2); s2 += __shfl_xor(s2, 4);
            const float rstd = 1.0f / sqrtf(s2 * (1.0f / 128.0f) + EPS_);
            if (t < nv) { const size_t tok = tok0 + t0 + t; const bf16* gr = ZM + tok * NZM + 3072 + h * 128 + 16 * part;
                float g0[8], g1[8]; unpack8(*(const u32x4*)gr, g0); unpack8(*(const u32x4*)(gr + 8), g1); float y0[8], y1[8];
#pragma unroll
                for (int i = 0; i < 8; ++i) { y0[i] = x[i] * rstd * gnorm[16 * part + i] * siluf(g0[i]); y1[i] = x[8 + i] * rstd * gnorm[16 * part + 8 + i] * siluf(g1[i]); }
                bf16* o = BR1 + tok * 512 + h * 128 + 16 * part; *(u32x4*)o = pack8(y0); *(u32x4*)(o + 8) = pack8(y1); } }
#pragma unroll
        for (int ki = 0; ki < 4; ++ki) { const float dec = __expf(LAM[63 * 65 + 16 * ki + fr]);
#pragma unroll
            for (int r = 0; r < 4; ++r) accS[ki][r] *= dec;
            accS[ki] = mma_tile(VT, 72, 16 * wave, KL, 72, 16 * ki, 64, accS[ki]);
#pragma unroll
            for (int r = 0; r < 4; ++r) STb[(16 * wave + 4 * fq + r) * 72 + 16 * ki + fr] = f2bf(accS[ki][r]); }
        __syncthreads();
    }
    float* So = A.out + (sample ? O_SG : O_PG) + ((size_t)(l * NB + b) * 4 + h) * 8192;
    { int o_ = fr * 128 + 16 * wave + 4 * fq; asm volatile("" : "+v"(o_)); float* sp = So + o_;
#pragma unroll
      for (int ki = 0; ki < 4; ++ki) {
#pragma unroll
        for (int r = 0; r < 4; ++r) sp[r] = accS[ki][r];
        sp += 2048; asm volatile("" : "+v"(sp)); } }
    __syncthreads();
}

__device__ __forceinline__ void conv8(ArgP Ap, int l, int b, bool sample, int tok0, int r, int ch0, float (&o)[8]) {
    const bf16* ZM = (const bf16*)(A.ws + WS_ZM); const float* cw = A.in[15] + (size_t)l * 4 * 768; const float* cb = A.in[16] + l * 768;
#pragma unroll
    for (int i = 0; i < 8; ++i) o[i] = cb[ch0 + i];
#pragma unroll
    for (int j = 0; j < 4; ++j) { const int rr = r - 3 + j; float x[8];
        if (rr >= 0) unpack8(*(const u32x4*)(ZM + (size_t)(tok0 + rr) * NZM + 4096 + ch0), x);
        else if (sample) { const float* c0 = A.in[7] + ((size_t)(l * BS + b) * 3 + (3 + rr)) * 768 + ch0;
#pragma unroll
            for (int i = 0; i < 8; ++i) x[i] = c0[i]; }
        else {
#pragma unroll
            for (int i = 0; i < 8; ++i) x[i] = 0.f; }
#pragma unroll
        for (int i = 0; i < 8; ++i) o[i] += cw[j * 768 + ch0 + i] * x[i]; }
}
__device__ __forceinline__ void ssd_item(ArgP Ap, LAS unsigned char* lds, int l, int b, int g, bool sample) {
    int tid_o = threadIdx.x; asm volatile("" : "+v"(tid_o));
    const int tid = tid_o, lane = tid & 63, wave = tid >> 6, fr = lane & 15, fq = lane >> 4;
    LAS bf16* XT = (LAS bf16*)(lds); LAS bf16* BTW = (LAS bf16*)(lds + 9216); LAS bf16* Cs = (LAS bf16*)(lds + 18432); LAS bf16* Bs = (LAS bf16*)(lds + 27648);
    LAS bf16* BT = (LAS bf16*)(lds + 36864); LAS bf16* W = (LAS bf16*)(lds + 46080); LAS bf16* Hb = (LAS bf16*)(lds + 55296); LAS bf16* Ys = (LAS bf16*)(lds + 92160);
    LAS float* DT = (LAS float*)(lds + 125952); LAS float* LM = DT + 256;
    const int L = sample ? LS : LP, tok0 = sample ? TP + b * LS : b * LP, NB = sample ? BS : BP;
    const bf16* ZM = (const bf16*)(A.ws + WS_ZM); const float* ZS = (const float*)(A.ws + WS_ZS); bf16* BR2 = (bf16*)(A.ws + WS_BR) + (size_t)T * 1024;
    const float* snorm = A.in[20] + l * 512 + g * 256;
    f32x4 accH[4][2];
#pragma unroll
    for (int hh = 0; hh < 4; ++hh)
#pragma unroll
        for (int j = 0; j < 2; ++j) { const int idx = wave + 8 * j, pi = idx >> 2, ni = idx & 3; accH[hh][j] = (f32x4){0.f, 0.f, 0.f, 0.f};
            if (sample) { const float* h0 = A.in[6] + ((size_t)(l * BS + b) * 8 + g * 4 + hh) * 4096;
                const float* hp = h0 + (16 * pi + 4 * fq) * 64 + 16 * ni + fr; asm volatile("" : "+v"(hp));
#pragma unroll
                for (int r = 0; r < 4; ++r) accH[hh][j][r] = hp[r * 64]; }
#pragma unroll
            for (int r = 0; r < 4; ++r) Hb[hh * 4608 + (16 * pi + 4 * fq + r) * 72 + 16 * ni + fr] = f2bf(accH[hh][j][r]); }
    __syncthreads();
    for (int t0 = 0; t0 < L; t0 += 64) {
        const int nv = (L - t0) < 64 ? (L - t0) : 64;
        if (wave < 4) { const int hd = g * 4 + wave; float dtv = 0.f;
            if (lane < nv) dtv = softplusf(ZS[(size_t)(tok0 + t0 + lane) * NSM + 24 + hd] + A.in[17][l * 8 + hd]);
            const float Ah = -__expf(A.in[18][l * 8 + hd]); const float lam = scan_sum64(dtv * Ah, lane);
            DT[wave * 64 + lane] = dtv; LM[wave * 64 + lane] = lam; }
#pragma unroll 1
        for (int c = tid; c < 1024; c += NTHREADS) { const int t = c >> 4, q = c & 15, isC = q >> 3, n0 = (q & 7) * 8; float v[8];
            if (t < nv) { conv8(Ap, l, b, sample, tok0, t0 + t, 512 + isC * 128 + g * 64 + n0, v);
#pragma unroll
                for (int i = 0; i < 8; ++i) v[i] = siluf(v[i]); }
            else {
#pragma unroll
                for (int i = 0; i < 8; ++i) v[i] = 0.f; }
            if (isC) *(LAS u32x4*)(Cs + t * 72 + n0) = pack8(v);
            else { *(LAS u32x4*)(Bs + t * 72 + n0) = pack8(v);
#pragma unroll
                for (int i = 0; i < 8; ++i) BT[(n0 + i) * 72 + t] = f2bf(v[i]); } }
        __syncthreads();
        f32x4 cb[2];
#pragma unroll
        for (int j = 0; j < 2; ++j) { const int idx = wave + 8 * j, ti = idx >> 2, si = idx & 3; cb[j] = (f32x4){0.f, 0.f, 0.f, 0.f};
            if (si <= ti) cb[j] = mma_tile(Cs, 72, 16 * ti, Bs, 72, 16 * si, 64, cb[j]); }
#pragma unroll 1
        for (int hh = 0; hh < 4; ++hh) {
            const int hd = g * 4 + hh; const float Dh = A.in[19][l * 8 + hd];
            { const int t = tid >> 3, cc = (tid & 7) * 8; float v[8];
                if (t < nv) { conv8(Ap, l, b, sample, tok0, t0 + t, hd * 64 + cc, v);
#pragma unroll
                    for (int i = 0; i < 8; ++i) v[i] = siluf(v[i]); }
                else {
#pragma unroll
                    for (int i = 0; i < 8; ++i) v[i] = 0.f; }
#pragma unroll
                for (int i = 0; i < 8; ++i) XT[(cc + i) * 72 + t] = f2bf(v[i]); }
#pragma unroll
            for (int j = 0; j < 2; ++j) { const int idx = wave + 8 * j, ti = idx >> 2, si = idx & 3;
#pragma unroll
                for (int r = 0; r < 4; ++r) { const int t = 16 * ti + 4 * fq + r, s = 16 * si + fr;
                    const float w = (s <= t) ? cb[j][r] * __expf(LM[hh * 64 + t] - LM[hh * 64 + s]) * DT[hh * 64 + s] : 0.f; W[t * 72 + s] = f2bf(w); } }
            { const int n = tid >> 3, s0 = (tid & 7) * 8; float v[8]; unpack8(*(const LAS u32x4*)(BT + n * 72 + s0), v); const float ll = LM[hh * 64 + 63];
#pragma unroll
                for (int i = 0; i < 8; ++i) v[i] *= __expf(ll - LM[hh * 64 + s0 + i]) * DT[hh * 64 + s0 + i];
                *(LAS u32x4*)(BTW + n * 72 + s0) = pack8(v); }
            __syncthreads();
#pragma unroll
            for (int j = 0; j < 2; ++j) { const int idx = wave + 8 * j, ti = idx >> 2, pi = idx & 3; f32x4 acc = {0.f, 0.f, 0.f, 0.f};
                acc = mma_tile(Cs, 72, 16 * ti, Hb + hh * 4608, 72, 16 * pi, 64, acc);
#pragma unroll
                for (int r = 0; r < 4; ++r) acc[r] *= __expf(LM[hh * 64 + 16 * ti + 4 * fq + r]);
                acc = mma_tile(W, 72, 16 * ti, XT, 72, 16 * pi, 64, acc);
#pragma unroll
                for (int r = 0; r < 4; ++r) { const int t = 16 * ti + 4 * fq + r, p = 16 * pi + fr; float y = 0.f;
                    if (t < nv) { y = acc[r] + Dh * bf2f(XT[p * 72 + t]); y *= siluf(bf2f(ZM[(size_t)(tok0 + t0 + t) * NZM + 3584 + hd * 64 + p])); }
                    Ys[t * 264 + hh * 64 + p] = f2bf(y); }
                asm volatile("" ::: "memory"); }
            { const float dec = __expf(LM[hh * 64 + 63]);
#pragma unroll
                for (int j = 0; j < 2; ++j) { const int idx = wave + 8 * j, pi = idx >> 2, ni = idx & 3;
#pragma unroll
                    for (int r = 0; r < 4; ++r) accH[0][j][r] *= dec;
                    accH[0][j] = mma_tile(XT, 72, 16 * pi, BTW, 72, 16 * ni, 64, accH[0][j]);
                    asm volatile("" ::: "memory"); } }
            __syncthreads();
#pragma unroll
            for (int j = 0; j < 2; ++j) { const int idx = wave + 8 * j, pi = idx >> 2, ni = idx & 3;
#pragma unroll
                for (int r = 0; r < 4; ++r) Hb[hh * 4608 + (16 * pi + 4 * fq + r) * 72 + 16 * ni + fr] = f2bf(accH[0][j][r]); }
        #pragma unroll
            for (int j = 0; j < 2; ++j) { const f32x4 tmp = accH[0][j]; accH[0][j] = accH[1][j]; accH[1][j] = accH[2][j]; accH[2][j] = accH[3][j]; accH[3][j] = tmp; }
        }
        { const int t = tid >> 3, part = tid & 7; float x[32]; float s2 = 0.f;
#pragma unroll
            for (int q = 0; q < 4; ++q) { float f[8]; unpack8(*(const LAS u32x4*)(Ys + t * 264 + 32 * part + 8 * q), f);
#pragma unroll
                for (int i = 0; i < 8; ++i) { x[8 * q + i] = f[i]; s2 += f[i] * f[i]; } }
            s2 += __shfl_xor(s2, 1); s2 += __shfl_xor(s2, 2); s2 += __shfl_xor(s2, 4);
            const float rstd = 1.0f / sqrtf(s2 * (1.0f / 256.0f) + EPS_);
            if (t < nv) { bf16* o = BR2 + (size_t)(tok0 + t0 + t) * 512 + g * 256 + 32 * part;
#pragma unroll
                for (int q = 0; q < 4; ++q) { float y[8];
#pragma unroll
                    for (int i = 0; i < 8; ++i) y[i] = x[8 * q + i] * rstd * snorm[32 * part + 8 * q + i];
                    *(u32x4*)(o + 8 * q) = pack8(y); } } }
        __syncthreads();
    }
#pragma unroll
    for (int hh = 0; hh < 4; ++hh) { float* ho = A.out + (sample ? O_SH : O_PH) + ((size_t)(l * NB + b) * 8 + g * 4 + hh) * 4096;
#pragma unroll
        for (int j = 0; j < 2; ++j) { const int idx = wave + 8 * j, pi = idx >> 2, ni = idx & 3;
            float* hp = ho + (16 * pi + 4 * fq) * 64 + 16 * ni + fr; asm volatile("" : "+v"(hp));
#pragma unroll
            for (int r = 0; r < 4; ++r) hp[r * 64] = accH[hh][j][r]; } }
    for (int e = tid; e < 3 * 384; e += NTHREADS) { const int r = e / 384, q = e % 384; const int ch = q < 256 ? g * 256 + q : (q < 320 ? 512 + g * 64 + (q - 256) : 640 + g * 64 + (q - 320));
        A.out[(sample ? O_SV : O_PV) + ((size_t)(l * NB + b) * 3 + r) * 768 + ch] = bf2f(ZM[(size_t)(tok0 + L - 3 + r) * NZM + 4096 + ch]); }
    __syncthreads();
}

__device__ __forceinline__ void mixer_item(ArgP Ap, LAS unsigned char* lds, int l, int it) {
    constexpr int NL0 = BP * 4, NL1 = NL0 + BP * 4, NL2 = NL1 + BP * 2, NS0 = NL2 + BS * 4, NS1 = NS0 + BS * 4;
    int kind, r; bool sample;
    if (it < NL0) { kind = 0; r = it; sample = false; } else if (it < NL1) { kind = 1; r = it - NL0; sample = false; } else if (it < NL2) { kind = 2; r = it - NL1; sample = false; }
    else if (it < NS0) { kind = 0; r = it - NL2; sample = true; } else if (it < NS1) { kind = 1; r = it - NS0; sample = true; } else { kind = 2; r = it - NS1; sample = true; }
#ifndef ONLYK
#define ONLYK -1
#endif
#ifndef EMU
#define OPQ() ArgP Ap_ = Ap; int l_ = l, r_ = r; asm volatile("" : "+s"(Ap_), "+s"(l_), "+s"(r_) :: "memory")
#else
#define OPQ() ArgP Ap_ = Ap; int l_ = l, r_ = r
#endif
    if ((ONLYK < 0 || ONLYK == 0) && kind == 0) { OPQ(); mlstm_item(Ap_, lds, l_, r_ >> 2, r_ & 3, sample); }
    else if ((ONLYK < 0 || ONLYK == 1) && kind == 1) { OPQ(); gla_item(Ap_, lds, l_, r_ >> 2, r_ & 3, sample); }
    else if ((ONLYK < 0 || ONLYK == 2) && kind == 2) { OPQ(); ssd_item(Ap_, lds, l_, r_ >> 1, r_ & 1, sample); }
#undef OPQ
}
__device__ __forceinline__ void phase_mixers(ArgP Ap, LAS unsigned char* lds, int l) {
    constexpr int NLONG = BP * 10, NSHORT = BS * 10; const int G = gridDim.x, bid = blockIdx.x;
    const bool split = G > NLONG;
    const int step = split ? (bid < NLONG ? (1 << 28) : G - NLONG) : G;
#pragma unroll 1
    for (int it = bid; it < NLONG + NSHORT; it += step) mixer_item(Ap, lds, l, it);
}

__device__ __forceinline__ float wave_sum64(float v) {
#pragma unroll
    for (int m = 1; m < 64; m <<= 1) v += __shfl_xor(v, m);
    return v;
}
constexpr float DN_ALPHA_ = 1.4142135623730951f;

__device__ __forceinline__ void phase_ln1(ArgP Ap, int l) {
    const int tx = opaque_tid(), lane = tx & 63, wave = tx >> 6, gw = blockIdx.x * NWAVES + wave, NGW = gridDim.x * NWAVES;
    const float* Y = (const float*)(A.ws + WS_ZG); float* H = (float*)(A.ws + WS_H); bf16* H1B = (bf16*)(A.ws + WS_BR);
    const float* lg = A.in[23] + l * D + 16 * lane; const float* lb = A.in[24] + l * D + 16 * lane;
    for (int tok = gw; tok < T; tok += NGW) {
        const float* xr = (l == 0) ? (tok < TP ? A.in[0] + (size_t)tok * D : A.in[1] + (size_t)(tok - TP) * D) : H + (size_t)tok * D;
        float y[16]; float s1 = 0.f;
#pragma unroll
        for (int q = 0; q < 4; ++q) { const float4 a = *(const float4*)(xr + 16 * lane + 4 * q), b = *(const float4*)(Y + (size_t)tok * D + 16 * lane + 4 * q);
            y[4 * q] = DN_ALPHA_ * a.x + b.x; y[4 * q + 1] = DN_ALPHA_ * a.y + b.y; y[4 * q + 2] = DN_ALPHA_ * a.z + b.z; y[4 * q + 3] = DN_ALPHA_ * a.w + b.w; }
#pragma unroll
        for (int i = 0; i < 16; ++i) s1 += y[i];
        const float mu = wave_sum64(s1) * (1.0f / D); float s2 = 0.f;
#pragma unroll
        for (int i = 0; i < 16; ++i) { y[i] -= mu; s2 += y[i] * y[i]; }
        const float rstd = 1.0f / sqrtf(wave_sum64(s2) * (1.0f / D) + EPS_);
#pragma unroll
        for (int i = 0; i < 16; ++i) y[i] = y[i] * rstd * lg[i] + lb[i];
#pragma unroll
        for (int q = 0; q < 4; ++q) *(float4*)(H + (size_t)tok * D + 16 * lane + 4 * q) = make_float4(y[4 * q], y[4 * q + 1], y[4 * q + 2], y[4 * q + 3]);
        float y0[8], y1[8];
#pragma unroll
        for (int i = 0; i < 8; ++i) { y0[i] = y[i]; y1[i] = y[8 + i]; }
        *(u32x4*)(H1B + (size_t)tok * D + 16 * lane) = pack8(y0); *(u32x4*)(H1B + (size_t)tok * D + 16 * lane + 8) = pack8(y1);
    }
    const int gtid = blockIdx.x * NTHREADS + tx, gthreads = gridDim.x * NTHREADS;
    convert_f32_bf16(A.in[27] + (size_t)l * NEXP * D, (bf16*)(A.ws + WS_PU), (size_t)NEXP * D, gtid, gthreads);
    convert_f32_bf16(A.in[28] + (size_t)l * NEXP * D, (bf16*)(A.ws + WS_PV), (size_t)NEXP * D, gtid, gthreads);
}

__device__ __forceinline__ unsigned ord_of(float f) { const unsigned u = __float_as_uint(f); return (u & 0x80000000u) ? ~u : (u | 0x80000000u); }
__device__ __forceinline__ float dec_ord(unsigned o) { const unsigned u = (o & 0x80000000u) ? (o & 0x7fffffffu) : ~o; return __uint_as_float(u); }
__device__ __forceinline__ unsigned umax_(unsigned a, unsigned b) { return a > b ? a : b; }
__device__ __forceinline__ unsigned umin_(unsigned a, unsigned b) { return a < b ? a : b; }
__device__ __forceinline__ void ins16(unsigned (&L)[16], unsigned x) {
#pragma unroll
    for (int p = 0; p < 16; ++p) { const unsigned hi = umax_(L[p], x); x = umin_(L[p], x); L[p] = hi; }
}
__device__ __forceinline__ unsigned sel16(const unsigned (&L)[16], int a) { unsigned r = L[0];
#pragma unroll
    for (int p = 1; p < 16; ++p) r = (a == p) ? L[p] : r;
    return r; }

__device__ __forceinline__ void route_topk(const bf16* __restrict__ Q, const LAS bf16* KEYS, int tokb, int h, int j, int fr, int fq, unsigned (&Lt)[16]) {
    f32x4 acc[8];
#pragma unroll
    for (int ki = 0; ki < 8; ++ki) acc[ki] = (f32x4){0.f, 0.f, 0.f, 0.f};
#pragma unroll
    for (int kk = 0; kk < 4; ++kk) { const bf16x8 bq = *(const bf16x8*)(Q + (size_t)(tokb + fr) * 2048 + h * 256 + j * 128 + 32 * kk + 8 * fq);
#pragma unroll
        for (int ki = 0; ki < 8; ++ki) { const bf16x8 ak = *(const LAS bf16x8*)(KEYS + (j * 128 + 16 * ki + fr) * 136 + 32 * kk + 8 * fq); acc[ki] = mfma16(ak, bq, acc[ki]); } }
#pragma unroll
    for (int p = 0; p < 16; ++p) Lt[p] = 0u;
#pragma unroll
    for (int ki = 0; ki < 8; ++ki)
#pragma unroll
        for (int r = 0; r < 4; ++r) ins16(Lt, (ord_of(acc[ki][r]) & ~127u) | (unsigned)(127 - (16 * ki + 4 * fq + r)));
#pragma unroll
    for (int m = 16; m < 64; m <<= 1) { unsigned R[16];
#pragma unroll
        for (int p = 0; p < 16; ++p) R[p] = __shfl_xor(Lt[p], m);
#pragma unroll
        for (int p = 0; p < 16; ++p) ins16(Lt, R[p]); }
}

__device__ __forceinline__ void phase_route(ArgP Ap, LAS unsigned char* lds, int l) {
    const int tid = opaque_tid(), lane = tid & 63, wave = tid >> 6, fr = lane & 15, fq = lane >> 4;
    LAS bf16* KEYS = (LAS bf16*)lds;
    LAS unsigned* LST = (LAS unsigned*)(lds + 69632);
    const bf16* Q = (const bf16*)(A.ws + WS_Q); int* IDX = (int*)(A.ws + WS_IDX); float* GT = (float*)(A.ws + WS_GT);
    const bf16* kg = (const bf16*)(A.ws + WS_WB + (size_t)l * WB_BYTES + WB_KEYS);
    constexpr int NG = T / 16, NCH = (NG + 7) / 8, NITEMS = NCH * 8;
    int last_h = -1;
    for (int it = blockIdx.x; it < NITEMS; it += gridDim.x) {
        const int h = it & 7, ch = it >> 3;
        if (h != last_h) { __syncthreads();
            for (int c = tid; c < 2 * 128 * 16; c += NTHREADS) { const int row = c >> 4, cc = (c & 15) * 8; *(LAS u32x4*)(KEYS + row * 136 + cc) = *(const u32x4*)(kg + ((size_t)h * 256 + row) * 128 + cc); }
            __syncthreads(); last_h = h; }
        const int grp = ch * 8 + wave;
        if (grp < NG) {
            const int tokb = grp * 16; unsigned L1[16], L2[16];
            route_topk(Q, KEYS, tokb, h, 0, fr, fq, L1); route_topk(Q, KEYS, tokb, h, 1, fr, fq, L2);
            unsigned C[16];
#pragma unroll
            for (int p = 0; p < 16; ++p) C[p] = 0u;
#pragma unroll
            for (int a = 0; a < 16; ++a)
#pragma unroll
                for (int b = 0; b < 16; ++b) if ((a + 1) * (b + 1) <= 16) {
                    const float s = dec_ord(L1[a] & ~127u) + dec_ord(L2[b] & ~127u); ins16(C, (ord_of(s) & ~255u) | (unsigned)(255 - (a * 16 + b))); }
            const float s0 = dec_ord(C[0] & ~255u); float e[16]; float sum = 0.f;
#pragma unroll
            for (int p = 0; p < 16; ++p) { e[p] = __expf(dec_ord(C[p] & ~255u) - s0); sum += e[p]; }
            const float inv = 1.0f / sum; const size_t ob = (size_t)(tokb + fr) * 128 + h * 16;
#pragma unroll
            for (int p = 0; p < 16; ++p) { LST[(wave * 32 + p) * 64 + lane] = L1[p]; LST[(wave * 32 + 16 + p) * 64 + lane] = L2[p]; }
#pragma unroll
            for (int p = 0; p < 16; ++p) { const int cid = 255 - (int)(C[p] & 255u); const int a = cid >> 4, b = cid & 15;
                const int e1 = 127 - (int)(LST[(wave * 32 + a) * 64 + lane] & 127u), e2 = 127 - (int)(LST[(wave * 32 + 16 + b) * 64 + lane] & 127u);
                if ((p >> 2) == fq) { IDX[ob + p] = e1 * 128 + e2; GT[ob + p] = e[p] * inv; } }
        }
    }
}

__device__ __forceinline__ void phase_gather(ArgP Ap, int l) {
    const int tx = opaque_tid(), lane = tx & 63, wave = tx >> 6, gw = blockIdx.x * NWAVES + wave, NGW = gridDim.x * NWAVES;
    float* H = (float*)(A.ws + WS_H); bf16* XB = (bf16*)(A.ws + WS_XB); const int* IDX = (const int*)(A.ws + WS_IDX); const float* GT = (const float*)(A.ws + WS_GT);
    const bf16* PU = (const bf16*)(A.ws + WS_PU); const bf16* PV = (const bf16*)(A.ws + WS_PV);
    const float* lg = A.in[29] + l * D; const float* lb = A.in[30] + l * D;
    for (int tok = gw; tok < T; tok += NGW) {
        float xa[8], xb[8];
        { const float4 a = *(const float4*)(H + (size_t)tok * D + 8 * lane), b = *(const float4*)(H + (size_t)tok * D + 8 * lane + 4);
          const float4 c = *(const float4*)(H + (size_t)tok * D + 512 + 8 * lane), d = *(const float4*)(H + (size_t)tok * D + 512 + 8 * lane + 4);
          xa[0] = a.x; xa[1] = a.y; xa[2] = a.z; xa[3] = a.w; xa[4] = b.x; xa[5] = b.y; xa[6] = b.z; xa[7] = b.w;
          xb[0] = c.x; xb[1] = c.y; xb[2] = c.z; xb[3] = c.w; xb[4] = d.x; xb[5] = d.y; xb[6] = d.z; xb[7] = d.w; }
        const int i0 = IDX[(size_t)tok * 128 + lane], i1 = IDX[(size_t)tok * 128 + 64 + lane]; const float g0 = GT[(size_t)tok * 128 + lane], g1 = GT[(size_t)tok * 128 + 64 + lane];
        float oa[8], ob[8];
#pragma unroll
        for (int i = 0; i < 8; ++i) { oa[i] = 0.f; ob[i] = 0.f; }
        for (int kb = 0; kb < 128; kb += 8) {
            u32x4 ua[8], ub[8], va[8], vb[8]; float gk[8];
#pragma unroll
            for (int kk = 0; kk < 8; ++kk) { const int k = kb + kk; const int e = __shfl(kb < 64 ? i0 : i1, k & 63); gk[kk] = __shfl(kb < 64 ? g0 : g1, k & 63);
                const bf16* ur = PU + (size_t)e * D + 8 * lane; const bf16* vr = PV + (size_t)e * D + 8 * lane;
                ua[kk] = *(const u32x4*)ur; ub[kk] = *(const u32x4*)(ur + 512); va[kk] = *(const u32x4*)vr; vb[kk] = *(const u32x4*)(vr + 512); }
#pragma unroll
            for (int kk = 0; kk < 8; ++kk) { float f[8], g[8]; unpack8(ua[kk], f); unpack8(ub[kk], g); float p = 0.f;
#pragma unroll
                for (int i = 0; i < 8; ++i) p += f[i] * xa[i] + g[i] * xb[i];
                p = wave_sum64(p);
                const float act = 0.5f * p * (1.0f + erff(p * 0.70710678118654752f)) * gk[kk];
                unpack8(va[kk], f); unpack8(vb[kk], g);
#pragma unroll
                for (int i = 0; i < 8; ++i) { oa[i] += act * f[i]; ob[i] += act * g[i]; } }
        }
        float s1 = 0.f;
#pragma unroll
        for (int i = 0; i < 8; ++i) { oa[i] += DN_ALPHA_ * xa[i]; ob[i] += DN_ALPHA_ * xb[i]; s1 += oa[i] + ob[i]; }
        const float mu = wave_sum64(s1) * (1.0f / D); float s2 = 0.f;
#pragma unroll
        for (int i = 0; i < 8; ++i) { oa[i] -= mu; ob[i] -= mu; s2 += oa[i] * oa[i] + ob[i] * ob[i]; }
        const float rstd = 1.0f / sqrtf(wave_sum64(s2) * (1.0f / D) + EPS_);
#pragma unroll
        for (int i = 0; i < 8; ++i) { oa[i] = oa[i] * rstd * lg[8 * lane + i] + lb[8 * lane + i]; ob[i] = ob[i] * rstd * lg[512 + 8 * lane + i] + lb[512 + 8 * lane + i]; }
        float* dst = (l == 1) ? A.out + (size_t)tok * D : H + (size_t)tok * D;
        *(float4*)(dst + 8 * lane) = make_float4(oa[0], oa[1], oa[2], oa[3]); *(float4*)(dst + 8 * lane + 4) = make_float4(oa[4], oa[5], oa[6], oa[7]);
        *(float4*)(dst + 512 + 8 * lane) = make_float4(ob[0], ob[1], ob[2], ob[3]); *(float4*)(dst + 512 + 8 * lane + 4) = make_float4(ob[4], ob[5], ob[6], ob[7]);
        if (l == 0) { *(u32x4*)(XB + (size_t)tok * D + 8 * lane) = pack8(oa); *(u32x4*)(XB + (size_t)tok * D + 512 + 8 * lane) = pack8(ob); }
    }
}

#ifndef EMU
struct MergeOrder {
    pg8::StaticOrder S;
    __device__ bool next(int i, pg8::Unit& u) const { pg8::Unit t; if (!S.next(i / 3, t)) return false; const int n = i % 3; u.pm = n * (T / 256) + t.pm; u.pn = n * 4 + t.pn; return true; }
    __device__ __forceinline__ void a_ready(const pg8::Unit&) const {}
    __device__ __forceinline__ void done(const pg8::Unit&) const {}
};
struct EpiMerge {
    static constexpr bool PERM = true, AFTER_DRAIN = false;
    const bf16* ZG; float* MIXF; bf16* MIXED;
    __device__ __forceinline__ void operator()(const pg8::f32x4 (&acc)[2][2][4][2], const pg8::Unit& u, int wr, int wc, int fr, int fq) const {
        const int n = u.pn >> 2, pn = u.pn & 3, pm = u.pm - n * (T / 256);
        const int row0 = pm * 256 + wr * 64 + fr, col0 = pn * 256 + wc * 32 + 8 * fq;
#pragma unroll
        for (int ai = 0; ai < 2; ++ai)
#pragma unroll
            for (int m = 0; m < 4; ++m) { const size_t row = (size_t)(row0 + ai * 128 + m * 16);
#pragma unroll
                for (int bj = 0; bj < 2; ++bj) { const int col = col0 + bj * 128;
                    float g[8]; unpack8(*(const u32x4*)(ZG + row * NZG + n * D + col), g);
                    float v[8];
#pragma unroll
                    for (int j = 0; j < 4; ++j) { v[j] = acc[ai][bj][m][0][j] * g[j]; v[4 + j] = acc[ai][bj][m][1][j] * g[4 + j]; }
                    float* mp = MIXF + row * D + col;
                    if (n > 0) { const float4 a = *(const float4*)mp, b = *(const float4*)(mp + 4);
                        v[0] += a.x; v[1] += a.y; v[2] += a.z; v[3] += a.w; v[4] += b.x; v[5] += b.y; v[6] += b.z; v[7] += b.w; }
                    if (n < 2) { *(float4*)mp = make_float4(v[0], v[1], v[2], v[3]); *(float4*)(mp + 4) = make_float4(v[4], v[5], v[6], v[7]); }
                    else *(u32x4*)(MIXED + row * D + col) = pack8(v); } }
    }
};
__device__ __forceinline__ void phase_merge(ArgP Ap, LAS unsigned char* lds, int l) {
    pg8::Gemm g{(const bf16*)(A.ws + WS_BR), (const bf16*)(A.ws + WS_WB + (size_t)l * WB_BYTES + WB_WBR), 3 * T, 3 * D, 512};
    MergeOrder S; S.S.init(T, D, gridDim.x, blockIdx.x);
    EpiMerge E{(const bf16*)(A.ws + WS_ZG), (float*)(A.ws + WS_ZM), (bf16*)(A.ws + WS_XB)};
    pg8::gemm_phase<EpiMerge, MergeOrder>(lds, g, S, E);
}
struct EpiF32 {
    static constexpr bool PERM = false, AFTER_DRAIN = false;
    float* C; int ldc;
    __device__ __forceinline__ void operator()(const pg8::f32x4 (&acc)[2][2][4][2], const pg8::Unit& u, int wr, int wc, int fr, int fq) const {
        const int row0 = u.pm * 256 + wr * 64 + fr, col0 = u.pn * 256 + wc * 32 + 4 * fq;
#pragma unroll
        for (int ai = 0; ai < 2; ++ai)
#pragma unroll
            for (int m = 0; m < 4; ++m) { float* rowp = C + (size_t)(row0 + ai * 128 + m * 16) * ldc + col0;
#pragma unroll
                for (int bj = 0; bj < 2; ++bj)
#pragma unroll
                    for (int n = 0; n < 2; ++n) *(pg8::f32x4*)(rowp + bj * 128 + n * 16) = acc[ai][bj][m][n]; }
    }
};
struct EpiB16 {
    static constexpr bool PERM = true, AFTER_DRAIN = false;
    bf16* O; int ldc;
    __device__ __forceinline__ void operator()(const pg8::f32x4 (&acc)[2][2][4][2], const pg8::Unit& u, int wr, int wc, int fr, int fq) const {
        const int row0 = u.pm * 256 + wr * 64 + fr, col0 = u.pn * 256 + wc * 32 + 8 * fq;
#pragma unroll
        for (int ai = 0; ai < 2; ++ai)
#pragma unroll
            for (int m = 0; m < 4; ++m) { bf16* rowp = O + (size_t)(row0 + ai * 128 + m * 16) * ldc + col0;
#pragma unroll
                for (int bj = 0; bj < 2; ++bj) { const pg8::f32x4 v0 = acc[ai][bj][m][0], v1 = acc[ai][bj][m][1];
                    u32x4 w; w.x = pg8::cvt_pk_bf16(v0[0], v0[1]); w.y = pg8::cvt_pk_bf16(v0[2], v0[3]); w.z = pg8::cvt_pk_bf16(v1[0], v1[1]); w.w = pg8::cvt_pk_bf16(v1[2], v1[3]);
                    *(u32x4*)(rowp + bj * 128) = w; } }
    }
};
__device__ __forceinline__ void phase_outproj(ArgP Ap, LAS unsigned char* lds, int l) {
    pg8::Gemm g{(const bf16*)(A.ws + WS_XB), (const bf16*)(A.ws + WS_WB + (size_t)l * WB_BYTES + WB_WO), T, D, D};
    pg8::StaticOrder S; S.init(T, D, gridDim.x, blockIdx.x);
    EpiF32 E{(float*)(A.ws + WS_ZG), D};
    pg8::gemm_phase<EpiF32, pg8::StaticOrder>(lds, g, S, E);
}
__device__ __forceinline__ void phase_qproj(ArgP Ap, LAS unsigned char* lds, int l) {
    pg8::Gemm g{(const bf16*)(A.ws + WS_BR), (const bf16*)(A.ws + WS_WB + (size_t)l * WB_BYTES + WB_WQ), T, 2048, D};
    pg8::StaticOrder S; S.init(T, 2048, gridDim.x, blockIdx.x);
    EpiB16 E{(bf16*)(A.ws + WS_Q), 2048};
    pg8::gemm_phase<EpiB16, pg8::StaticOrder>(lds, g, S, E);
}

__global__ void __launch_bounds__(NTHREADS, 2) mega_fwd(Args kargs) {
    extern __shared__ __attribute__((aligned(16))) unsigned char lds_raw[];
    LAS unsigned char* lds = (LAS unsigned char*)lds_raw;
    cg::grid_group grid = cg::this_grid();
    volatile LAS unsigned* xst = (volatile LAS unsigned*)(lds + LDS_BYTES - 16);
    unsigned* xbar = (unsigned*)(kargs.ws + WS_CTL);
    if (threadIdx.x < 4) xst[threadIdx.x] = 0u;
    if (blockIdx.x == 0) for (int i = threadIdx.x; i < XCD_BAR_WORDS; i += NTHREADS) xbar[i] = 0u;
    __syncthreads();
    XcdBarrier xb; xb.bar = xbar; xb.x = 0; xb.st = xst; bool xposted = false;
    ArgP Ap = (ArgP)__builtin_amdgcn_kernarg_segment_ptr();
    const int lo = A.ph_lo, hi = A.ph_hi;
#define RUN(call) do { ArgP Ap_ = Ap; int l_ = l; asm volatile("" : "+s"(Ap_), "+s"(l_) :: "memory"); { ArgP Ap = Ap_; const int l = l_; call; } asm volatile("" ::: "memory"); } while (0)
#ifndef ONLYP
#define ONLYP -1
#endif
#define PSEL(q) (ONLYP < 0 || ONLYP == (q))
#define IN(k) (lo <= (k) && (k) < hi)
#define SEAM(k) do { if (IN(k) && IN((k) + 1)) { if (!xposted) { grid.sync(); xb = xcd_barrier_post(xbar, xst); xposted = true; } else xcd_barrier(xb); } } while (0)
    { const int l = 0; if (PSEL(0) && IN(0)) RUN(phase_convert(Ap, lds)); (void)l; }
    SEAM(0);
    for (int l = 0; l < 2; ++l) {
        const int p = 1 + 8 * l;
        if (PSEL(1) && IN(p + 0)) RUN(phase_gemm1(Ap, lds, l));
        SEAM(p);
        if (PSEL(2) && IN(p + 1)) RUN(phase_mixers(Ap, lds, l));
        SEAM(p + 1);
        if (PSEL(3) && IN(p + 2)) RUN(phase_merge(Ap, lds, l));
        SEAM(p + 2);
        if (PSEL(4) && IN(p + 3)) RUN(phase_outproj(Ap, lds, l));
        SEAM(p + 3);
        if (PSEL(5) && IN(p + 4)) RUN(phase_ln1(Ap, l));
        SEAM(p + 4);
        if (PSEL(6) && IN(p + 5)) RUN(phase_qproj(Ap, lds, l));
        SEAM(p + 5);
        if (PSEL(7) && IN(p + 6)) RUN(phase_route(Ap, lds, l));
        SEAM(p + 6);
        if (PSEL(8) && IN(p + 7)) RUN(phase_gather(Ap, l));
        SEAM(p + 7);
    }
#undef IN
#undef RUN
#undef SEAM
}

extern "C" void kernel_launch(void* const* d_in, const int* in_sizes, int n_in, void* d_out, int out_size, void* d_ws, size_t ws_size, hipStream_t stream) {
    static int grid_blocks = 0;
    if (grid_blocks == 0) {
        if (n_in != 31 || (size_t)out_size != O_END || ws_size < WS_END) {
            fprintf(stderr, "kernel_launch: unexpected problem: n_in %d out %d (want %zu) ws %zu (want >= %zu)\n", n_in, out_size, (size_t)O_END, ws_size, (size_t)WS_END); grid_blocks = -1; return; }
        int dev = 0, cus = 0, per_cu = 0;
        (void)hipGetDevice(&dev); (void)hipDeviceGetAttribute(&cus, hipDeviceAttributeMultiprocessorCount, dev);
        if (hipFuncSetAttribute((const void*)mega_fwd, hipFuncAttributeMaxDynamicSharedMemorySize, LDS_BYTES) != hipSuccess) { fprintf(stderr, "kernel_launch: hipFuncSetAttribute failed\n"); grid_blocks = -1; return; }
        if (hipOccupancyMaxActiveBlocksPerMultiprocessor(&per_cu, (const void*)mega_fwd, NTHREADS, LDS_BYTES) != hipSuccess || per_cu < 1) { fprintf(stderr, "kernel_launch: occupancy query failed (%d)\n", per_cu); grid_blocks = -1; return; }
        grid_blocks = cus * per_cu;
        fprintf(stderr, "kernel_launch: %d CUs x %d = %d workgroups\n", cus, per_cu, grid_blocks);
    }
    if (grid_blocks < 0) return;
    Args a{};
    for (int i = 0; i < 31; ++i) a.in[i] = (const float*)d_in[i];
    a.out = (float*)d_out; a.ws = (unsigned char*)d_ws; a.ph_lo = 0; a.ph_hi = 64;
    void* args[] = {&a};
    hipError_t e = hipLaunchCooperativeKernel((const void*)mega_fwd, dim3(grid_blocks), dim3(NTHREADS), args, LDS_BYTES, stream);
    if (e != hipSuccess) fprintf(stderr, "kernel_launch: cooperative launch failed: %s (grid %d)\n", hipGetErrorString(e), grid_blocks);
}
#endif
```

```cpp
#ifndef EMU
#include <hip/hip_runtime.h>
#include <hip/hip_cooperative_groups.h>
#include <cstdio>
#include <cstdint>
namespace cg = cooperative_groups;
namespace pg8 {
#define PG8_LAS __attribute__((address_space(3)))
typedef unsigned short bf16_t;
typedef short bf16x8 __attribute__((ext_vector_type(8)));
typedef float f32x4 __attribute__((ext_vector_type(4)));
typedef unsigned u32x4 __attribute__((ext_vector_type(4)));
constexpr int BM = 256, BK = 64, HALF = 128, HTB = HALF * BK * 2  , STAGE_BYTES = 8 * HTB, NXCD = 8, WGM = 8;

__host__ __device__ __forceinline__ int lds_byte(int r, int c) { const int st = (r >> 4) * 2 + (c >> 5), rr = r & 15, cc = c & 31, ob = rr * 64 + cc * 2; return st * 1024 + (ob ^ (((ob >> 9) & 1) << 5)); }
__host__ __device__ __forceinline__ void stage_rc(int b, int& R, int& C) { const int st = b / 1024, sb = b % 1024, swz = sb ^ (((sb >> 9) & 1) << 5); R = (st >> 1) * 16 + swz / 64; C = (st & 1) * 32 + (swz % 64) / 2; }
__host__ __device__ __forceinline__ int perm32(int rho) { const int n = rho >> 4, i = rho & 15; return 8 * (i >> 2) + 4 * n + (i & 3); }

struct Unit { int pm, pn; };
struct Gemm { const bf16_t* A; const bf16_t* Bt; int M, N, K; };

struct StaticOrder {
    int nM, nN, nwg, G, c;
    __host__ __device__ void init(int M, int N, int G_, int c_) { nM = M / BM; nN = N / BM; nwg = nM * nN; G = G_; c = c_; }
    __host__ __device__ bool next(int i, Unit& u) const {
        const long L = (long)i * G + c; if (L >= nwg) return false;
        int wgid = (int)L; { const int q = nwg / NXCD, r = nwg % NXCD, xcd = wgid % NXCD, off = wgid / NXCD; wgid = (xcd < r ? xcd * (q + 1) : r * (q + 1) + (xcd - r) * q) + off; }
        const int nig = WGM * nN, gid = wgid / nig, fm = gid * WGM, gsz = (nM - fm) < WGM ? (nM - fm) : WGM;
        u.pm = fm + ((wgid % nig) % gsz); u.pn = (wgid % nig) / gsz; return true;
    }
    __device__ __forceinline__ void a_ready(const Unit&) const {}
    __device__ __forceinline__ void done(const Unit&) const {}
};

__device__ __forceinline__ unsigned cvt_pk_bf16(float lo, float hi) { unsigned r; asm volatile("v_cvt_pk_bf16_f32 %0, %1, %2" : "=v"(r) : "v"(lo), "v"(hi)); return r; }
typedef float f32x2 __attribute__((ext_vector_type(2)));
__device__ __forceinline__ f32x2 gelu_pk(f32x2 v) {
    const f32x2 av = __builtin_elementwise_abs(v), d = av * 0.2316418882f + 1.0f;
    f32x2 t; t.x = __builtin_amdgcn_rcpf(d.x); t.y = __builtin_amdgcn_rcpf(d.y);
    f32x2 q = t * 0.5307027145f + (-0.7265760135f); q = q * t + 0.7107068705f; q = q * t + (-0.142248368f); q = q * t + 0.127414796f; q = q * t;
    const f32x2 s = (v * v) * (-0.72134752044f);
    f32x2 e; e.x = __builtin_amdgcn_exp2f(s.x); e.y = __builtin_amdgcn_exp2f(s.y);
    const f32x2 m = v * (q * e), r = v - m;
    f32x2 o; o.x = v.x < 0.f ? m.x : r.x; o.y = v.y < 0.f ? m.y : r.y; return o;
}

template <class Epi, class Sched>
__device__ __forceinline__ void gemm_phase(PG8_LAS unsigned char* lds, const Gemm g, const Sched& S, const Epi& E) {
    int tid_o = threadIdx.x; asm volatile("" : "+v"(tid_o));
    const int tid = tid_o, wid = __builtin_amdgcn_readfirstlane(tid >> 6), lane = tid & 63, wr = wid >> 2, wc = wid & 3, fr = lane & 15, fq = lane >> 4;
    const int K = g.K, nt = K / BK;
    unsigned voffA[2], voffB[2];
#pragma unroll
    for (int i = 0; i < 2; ++i) { int R, C; stage_rc(tid * 16 + i * 8192, R, C); const int Rb = Epi::PERM ? ((R & ~31) + perm32(R & 31)) : R;
        voffA[i] = (unsigned)(R * K + C) * 2u; voffB[i] = (unsigned)(Rb * K + C) * 2u; }
    const size_t kstep = (size_t)(BK * 2);
    const size_t hstep = (size_t)HALF * K * 2;
    const size_t tstep = 2 * hstep;
    const unsigned ldsw = (unsigned)wid * 1024u;
    const int aoff = lds_byte(wr * 64 + fr, fq * 8), boff = lds_byte(wc * 32 + fr, fq * 8);
#define PG8_SA(b, h) (((b) * 2 + (h)) * HTB)
#define PG8_SB(b, h) ((4 + (b) * 2 + (h)) * HTB)
#define PG8_STAGE(bufoff, gbase, voff) do { _Pragma("unroll") for (int _i = 0; _i < 2; ++_i) \
        __builtin_amdgcn_global_load_lds((const unsigned*)((const char*)(gbase) + (voff)[_i]), (PG8_LAS unsigned*)(lds + (bufoff) + ldsw + _i * 8192), 16, 0, 0); } while (0)
#define PG8_LDA(dst, b, h) do { _Pragma("unroll") for (int m = 0; m < 4; ++m) _Pragma("unroll") for (int k = 0; k < 2; ++k) dst[m][k] = *(const PG8_LAS bf16x8*)(lds + PG8_SA(b, h) + aoff + m * 2048 + k * 1024); } while (0)
#define PG8_LDB(dst, b, h) do { _Pragma("unroll") for (int n = 0; n < 2; ++n) _Pragma("unroll") for (int k = 0; k < 2; ++k) dst[n][k] = *(const PG8_LAS bf16x8*)(lds + PG8_SB(b, h) + boff + n * 2048 + k * 1024); } while (0)
#define PG8_MMA(ai, bj, At, Bt) do { __builtin_amdgcn_s_setprio(1); _Pragma("unroll") for (int m = 0; m < 4; ++m) _Pragma("unroll") for (int n = 0; n < 2; ++n) _Pragma("unroll") for (int k = 0; k < 2; ++k) \
        acc[ai][bj][m][n] = __builtin_amdgcn_mfma_f32_16x16x32_bf16(Bt[n][k], At[m][k], acc[ai][bj][m][n], 0, 0, 0); __builtin_amdgcn_s_setprio(0); } while (0)
#define PG8_WAIT_V(n) asm volatile("s_waitcnt vmcnt(" #n ")" ::: "memory")
#define PG8_WAIT_L(n) asm volatile("s_waitcnt lgkmcnt(" #n ")" ::: "memory")
#define PG8_BAR __builtin_amdgcn_s_barrier()
#define PG8_SCHED __builtin_amdgcn_sched_barrier(0)
    Unit cur, nxt; int ui = 0;
    if (!S.next(0, cur)) return;
    f32x4 acc[2][2][4][2];
#pragma unroll
    for (int a = 0; a < 2; ++a)
#pragma unroll
        for (int b = 0; b < 2; ++b)
#pragma unroll
            for (int m = 0; m < 4; ++m)
#pragma unroll
                for (int n = 0; n < 2; ++n) acc[a][b][m][n] = (f32x4){0.f, 0.f, 0.f, 0.f};
    bf16x8 At[4][2], B0[2][2], B1[2][2];
    const char* cA = (const char*)g.A + (size_t)cur.pm * tstep; const char* cB = (const char*)g.Bt + (size_t)cur.pn * tstep;
    S.a_ready(cur);
    PG8_STAGE(PG8_SB(0, 0), cB, voffB); PG8_STAGE(PG8_SA(0, 0), cA, voffA); PG8_STAGE(PG8_SB(0, 1), cB + hstep, voffB); PG8_STAGE(PG8_SA(0, 1), cA + hstep, voffA);
    if (wr == 1) PG8_BAR;
    PG8_WAIT_V(4); PG8_BAR;
    PG8_STAGE(PG8_SB(1, 0), cB + kstep, voffB); PG8_STAGE(PG8_SA(1, 0), cA + kstep, voffA); PG8_STAGE(PG8_SB(1, 1), cB + hstep + kstep, voffB);
    PG8_WAIT_V(6); PG8_BAR;
    for (;;) {
        const bool has_next = S.next(ui + 1, nxt);
        const char* nA = has_next ? (const char*)g.A + (size_t)nxt.pm * tstep : cA; const char* nB = has_next ? (const char*)g.Bt + (size_t)nxt.pn * tstep : cB;
        for (int t = 0; t < nt; t += 2) {
            const bool last = (t == nt - 2);
            const char* a1 = cA + (size_t)(t + 1) * kstep;
            const char* a2 = last ? nA : cA + (size_t)(t + 2) * kstep; const char* b2 = last ? nB : cB + (size_t)(t + 2) * kstep;
            const char* a3 = a2 + kstep; const char* b3 = b2 + kstep;
            if (last && has_next) S.a_ready(nxt);
            PG8_LDB(B0, 0, 0); PG8_SCHED; PG8_LDA(At, 0, 0); PG8_STAGE(PG8_SA(1, 1), a1 + hstep, voffA);
            PG8_WAIT_L(8); PG8_BAR; PG8_WAIT_L(0); PG8_MMA(0, 0, At, B0); PG8_BAR; PG8_SCHED;
            PG8_LDB(B1, 0, 1); PG8_STAGE(PG8_SB(0, 0), b2, voffB);
            PG8_BAR; PG8_WAIT_L(0); PG8_MMA(0, 1, At, B1); PG8_BAR;
            PG8_LDA(At, 0, 1); PG8_STAGE(PG8_SA(0, 0), a2, voffA);
            PG8_BAR; PG8_WAIT_L(0); PG8_MMA(1, 0, At, B0); PG8_BAR; PG8_SCHED;
            PG8_STAGE(PG8_SB(0, 1), b2 + hstep, voffB);
            PG8_WAIT_V(6); PG8_BAR; PG8_MMA(1, 1, At, B1); PG8_BAR;
            PG8_LDB(B0, 1, 0); PG8_SCHED; PG8_LDA(At, 1, 0); PG8_STAGE(PG8_SA(0, 1), a2 + hstep, voffA);
            PG8_WAIT_L(8); PG8_BAR; PG8_WAIT_L(0); PG8_MMA(0, 0, At, B0); PG8_BAR; PG8_SCHED;
            PG8_LDB(B1, 1, 1); PG8_STAGE(PG8_SB(1, 0), b3, voffB);
            PG8_BAR; PG8_WAIT_L(0); PG8_MMA(0, 1, At, B1); PG8_BAR;
            PG8_LDA(At, 1, 1); PG8_STAGE(PG8_SA(1, 0), a3, voffA);
            PG8_BAR; PG8_WAIT_L(0); PG8_MMA(1, 0, At, B0); PG8_BAR; PG8_SCHED;
            PG8_STAGE(PG8_SB(1, 1), b3 + hstep, voffB);
            PG8_WAIT_V(6); PG8_BAR; PG8_MMA(1, 1, At, B1); PG8_BAR;
        }
        if constexpr (!Epi::AFTER_DRAIN) { E(acc, cur, wr, wc, fr, fq); S.done(cur); }
        if (!has_next) break;
#pragma unroll
        for (int a = 0; a < 2; ++a)
#pragma unroll
            for (int b = 0; b < 2; ++b)
#pragma unroll
                for (int m = 0; m < 4; ++m)
#pragma unroll
                    for (int n = 0; n < 2; ++n) acc[a][b][m][n] = (f32x4){0.f, 0.f, 0.f, 0.f};
        cur = nxt; cA = nA; cB = nB; ++ui;
    }
    PG8_WAIT_V(0);
    if (wr == 0) PG8_BAR;
    PG8_BAR;
    if constexpr (Epi::AFTER_DRAIN) { E.fused(acc, cur, wr, wc, fr, fq, lds, wid, lane); S.done(cur); }
#undef PG8_SA
#undef PG8_SB
#undef PG8_STAGE
#undef PG8_LDA
#undef PG8_LDB
#undef PG8_MMA
#undef PG8_WAIT_V
#undef PG8_WAIT_L
#undef PG8_BAR
#undef PG8_SCHED
}
}

#endif

typedef unsigned short bf16;
#ifndef EMU
#define LAS __attribute__((address_space(3)))
#else
#define LAS
#endif
typedef short bf16x8 __attribute__((ext_vector_type(8)));
typedef float f32x4 __attribute__((ext_vector_type(4)));
typedef unsigned u32x4 __attribute__((ext_vector_type(4)));
typedef unsigned u32x2 __attribute__((ext_vector_type(2)));

#ifdef EMU
constexpr int BP = EMU_BP, LP = EMU_LP, BS = EMU_BS;
#else
constexpr int BP = 8, LP = 2048, BS = 128;
#endif
constexpr int D = 1024, LS = 4, TP = BP * LP, TS = BS * LS, T = TP + TS;
constexpr int INW = 7968, NZM = 4864, NZG = 3072, NZ = NZM + NZG, NSM = 32;
constexpr int NEXP = 16384;
constexpr int NTHREADS = 512, NWAVES = 8;
constexpr int LDS_BYTES = 160 * 1024;

constexpr size_t O_YP = 0, O_YS = O_YP + (size_t)TP * D, O_PC = O_YS + (size_t)TS * D, O_PN = O_PC + 2ull * BP * 4 * 128 * 128, O_PM = O_PN + 2ull * BP * 4 * 128,
    O_PG = O_PM + 2ull * BP * 4, O_PH = O_PG + 2ull * BP * 4 * 64 * 128, O_PV = O_PH + 2ull * BP * 8 * 64 * 64, O_SC = O_PV + 2ull * BP * 3 * 768,
    O_SN = O_SC + 2ull * BS * 4 * 128 * 128, O_SM = O_SN + 2ull * BS * 4 * 128, O_SG = O_SM + 2ull * BS * 4, O_SH = O_SG + 2ull * BS * 4 * 64 * 128,
    O_SV = O_SH + 2ull * BS * 8 * 64 * 64, O_END = O_SV + 2ull * BS * 3 * 768;

constexpr size_t al256(size_t x) { return (x + 255) & ~(size_t)255; }
constexpr size_t WS_CTL = 0, WS_CTL_BYTES = 65536;
constexpr size_t WB_WIN = 0, WB_WS = WB_WIN + (size_t)NZ * D * 2, WB_WBR = WB_WS + (size_t)NSM * D * 2, WB_WO = WB_WBR + 3ull * D * 512 * 2, WB_WQ = WB_WO + (size_t)D * D * 2,
    WB_KEYS = WB_WQ + 2048ull * D * 2, WB_BYTES = WB_KEYS + 16ull * 128 * 128 * 2;
constexpr size_t WS_WB = WS_CTL + WS_CTL_BYTES;
constexpr size_t WS_XB = WS_WB + 2 * WB_BYTES;
constexpr size_t WS_H = WS_XB + (size_t)T * D * 2;
constexpr size_t WS_ZS = WS_H + (size_t)T * D * 4;
constexpr size_t WS_BR = WS_ZS + (size_t)T * NSM * 4;
constexpr size_t WS_ZM = WS_BR + 3ull * T * 512 * 2;
constexpr size_t WS_ZG = WS_ZM + (size_t)T * NZM * 2;
constexpr size_t WS_END0 = WS_ZG + (size_t)T * NZG * 2;
constexpr size_t WS_Q = WS_ZM, WS_IDX = WS_Q + (size_t)T * 2048 * 2, WS_GT = WS_IDX + (size_t)T * 128 * 4;
#ifdef EMU
constexpr size_t WS_PU = WS_END0, WS_PV = WS_PU + (size_t)NEXP * D * 2, WS_END = WS_PV + (size_t)NEXP * D * 2;
#else
constexpr size_t WS_PU = WS_GT + (size_t)T * 128 * 4, WS_PV = WS_PU + (size_t)NEXP * D * 2, WS_ZM_END = WS_PV + (size_t)NEXP * D * 2, WS_END = WS_END0;
static_assert(WS_ZM_END <= WS_ZG, "ZM alias overflow");
#endif
static_assert((size_t)T * D * 4 <= (size_t)T * NZG * 2, "Y alias overflow");

#ifndef EMU
__device__ __forceinline__ f32x4 mfma16(bf16x8 a, bf16x8 b, f32x4 c) { return __builtin_amdgcn_mfma_f32_16x16x32_bf16(a, b, c, 0, 0, 0); }
#endif
struct Args { const float* in[31]; float* out; unsigned char* ws; int ph_lo, ph_hi; };
#ifndef EMU
typedef const __attribute__((address_space(4))) Args* ArgP;
#else
typedef const Args* ArgP;
#endif
#define A (*Ap)
#ifndef EMU
#define OPQV(x) asm volatile("" : "+v"(x))
#else
#define OPQV(x) (void)(x)
#endif
#ifndef EMU
__device__ __forceinline__ int opaque_tid() { int t = threadIdx.x; asm volatile("" : "+v"(t)); return t; }
#else
static inline int opaque_tid() { return threadIdx.x; }
#endif

__device__ __forceinline__ bf16 f2bf(float f) { unsigned u = __float_as_uint(f); u += 0x7FFFu + ((u >> 16) & 1u); return (bf16)(u >> 16); }
__device__ __forceinline__ float bf2f(bf16 b) { return __uint_as_float(((unsigned)b) << 16); }
__device__ __forceinline__ unsigned pk2(float lo, float hi) { return (unsigned)f2bf(lo) | ((unsigned)f2bf(hi) << 16); }

__device__ __forceinline__ void tconv_tile(const float* __restrict__ src, int ldsrc, int k0, int c0, bf16* __restrict__ dst, int ldd, int n0, LAS float* tile) {
    const int t = opaque_tid(), i = t >> 3, jg = (t & 7) * 8;
    const float4 a = *(const float4*)(src + (size_t)(k0 + i) * ldsrc + c0 + jg), b = *(const float4*)(src + (size_t)(k0 + i) * ldsrc + c0 + jg + 4);
    LAS float* r = tile + i * 65 + jg;
    r[0] = a.x; r[1] = a.y; r[2] = a.z; r[3] = a.w; r[4] = b.x; r[5] = b.y; r[6] = b.z; r[7] = b.w;
    __syncthreads();
    const int j = t >> 3, ig = (t & 7) * 8;
    u32x4 w;
    w.x = pk2(tile[(ig + 0) * 65 + j], tile[(ig + 1) * 65 + j]); w.y = pk2(tile[(ig + 2) * 65 + j], tile[(ig + 3) * 65 + j]);
    w.z = pk2(tile[(ig + 4) * 65 + j], tile[(ig + 5) * 65 + j]); w.w = pk2(tile[(ig + 6) * 65 + j], tile[(ig + 7) * 65 + j]);
    *(u32x4*)(dst + (size_t)(n0 + j) * ldd + k0 + ig) = w;
    __syncthreads();
}
__device__ __forceinline__ int zcol_to_src(int zc) { return zc < 2048 ? zc : (zc < 3584 ? zc + 8 : (zc < 4864 ? zc + 24 : zc + 32)); }
__device__ __forceinline__ int scol_to_src(int sc) { return sc < 8 ? 2048 + sc : (sc < 24 ? 3592 + (sc - 8) : 4888 + (sc - 24)); }

__device__ __forceinline__ void convert_f32_bf16(const float* __restrict__ src, bf16* __restrict__ dst, size_t n, int gtid, int gthreads) {
    for (size_t i = (size_t)gtid * 8; i < n; i += (size_t)gthreads * 8) {
        const float4 a = *(const float4*)(src + i), b = *(const float4*)(src + i + 4);
        u32x4 w; w.x = pk2(a.x, a.y); w.y = pk2(a.z, a.w); w.z = pk2(b.x, b.y); w.w = pk2(b.z, b.w);
        *(u32x4*)(dst + i) = w;
    }
}

__device__ __forceinline__ void phase_convert(ArgP Ap, LAS unsigned char* lds) {
    LAS float* tile = (LAS float*)lds;
    const int G = gridDim.x, bid = blockIdx.x;
    constexpr int I_WIN = (NZ / 64) * (D / 64), I_WBR = 3 * (D / 64) * (512 / 64), I_WO = (D / 64) * (D / 64), I_WQ = (2048 / 64) * (D / 64), I_L = I_WIN + I_WBR + I_WO + I_WQ;
    for (int it = bid; it < 2 * I_L; it += G) {
        const int l = it / I_L; int r = it % I_L;
        unsigned char* wb = A.ws + WS_WB + (size_t)l * WB_BYTES;
        if (r < I_WIN) { const int nt = r / (D / 64), kt = r % (D / 64);
            tconv_tile(A.in[8] + (size_t)l * D * INW, INW, kt * 64, zcol_to_src(nt * 64), (bf16*)(wb + WB_WIN), D, nt * 64, tile); continue; }
        r -= I_WIN;
        if (r < I_WBR) { const int n = r / ((D / 64) * 8), rr = r % ((D / 64) * 8), nt = rr / 8, kt = rr % 8;
            tconv_tile(A.in[21] + ((size_t)l * 3 + n) * 512 * D, D, kt * 64, nt * 64, (bf16*)(wb + WB_WBR) + (size_t)n * D * 512, 512, nt * 64, tile); continue; }
        r -= I_WBR;
        if (r < I_WO) { const int nt = r / (D / 64), kt = r % (D / 64);
            tconv_tile(A.in[22] + (size_t)l * D * D, D, kt * 64, nt * 64, (bf16*)(wb + WB_WO), D, nt * 64, tile); continue; }
        r -= I_WO;
        { const int nt = r / (D / 64), kt = r % (D / 64);
            tconv_tile(A.in[25] + (size_t)l * D * 2048, 2048, kt * 64, nt * 64, (bf16*)(wb + WB_WQ), D, nt * 64, tile); }
    }
    const int gtid = bid * NTHREADS + opaque_tid(), gthreads = G * NTHREADS;
    for (int l = 0; l < 2; ++l) {
        unsigned char* wb = A.ws + WS_WB + (size_t)l * WB_BYTES;
        for (int e = gtid; e < NSM * D; e += gthreads) { const int n = e / D, k = e % D; ((bf16*)(wb + WB_WS))[e] = f2bf(A.in[8][(size_t)l * D * INW + (size_t)k * INW + scol_to_src(n)]); }
        convert_f32_bf16(A.in[26] + (size_t)l * 16 * 128 * 128, (bf16*)(wb + WB_KEYS), 16 * 128 * 128, gtid, gthreads);
    }
    convert_f32_bf16(A.in[0], (bf16*)(A.ws + WS_XB), (size_t)TP * D, gtid, gthreads);
    convert_f32_bf16(A.in[1], (bf16*)(A.ws + WS_XB) + (size_t)TP * D, (size_t)TS * D, gtid, gthreads);
}

#ifndef EMU
struct EpiZ {
    static constexpr bool PERM = true, AFTER_DRAIN = false;
    bf16* ZM; bf16* ZG;
    __device__ __forceinline__ void operator()(const pg8::f32x4 (&acc)[2][2][4][2], const pg8::Unit& u, int wr, int wc, int fr, int fq) const {
        const int row0 = u.pm * 256 + wr * 64 + fr; const bool gate = u.pn >= 19;
        bf16* base = gate ? ZG : ZM; const int ldc = gate ? NZG : NZM; const int col0 = (gate ? (u.pn - 19) : u.pn) * 256 + wc * 32 + 8 * fq;
#pragma unroll
        for (int ai = 0; ai < 2; ++ai)
#pragma unroll
            for (int m = 0; m < 4; ++m) { bf16* rowp = base + (size_t)(row0 + ai * 128 + m * 16) * ldc + col0;
#pragma unroll
                for (int bj = 0; bj < 2; ++bj) { f32x4 v0 = acc[ai][bj][m][0], v1 = acc[ai][bj][m][1];
                    if (gate) {
#pragma unroll
                        for (int j = 0; j < 4; ++j) { v0[j] = __builtin_amdgcn_rcpf(1.0f + __expf(-v0[j])); v1[j] = __builtin_amdgcn_rcpf(1.0f + __expf(-v1[j])); } }
                    u32x4 w; w.x = pg8::cvt_pk_bf16(v0[0], v0[1]); w.y = pg8::cvt_pk_bf16(v0[2], v0[3]); w.z = pg8::cvt_pk_bf16(v1[0], v1[1]); w.w = pg8::cvt_pk_bf16(v1[2], v1[3]);
                    *(u32x4*)(rowp + bj * 128) = w; } }
    }
};

#endif
__device__ __forceinline__ void small_gemm(const bf16* __restrict__ XB, const bf16* __restrict__ WsT, float* __restrict__ ZS) {
    const int tx = opaque_tid(), lane = tx & 63, wave = tx >> 6, gw = blockIdx.x * NWAVES + wave, NGW = gridDim.x * NWAVES, fr = lane & 15, fq = lane >> 4;
    for (int rg = gw; rg < T / 16; rg += NGW) {
        f32x4 a0 = {0.f, 0.f, 0.f, 0.f}, a1 = {0.f, 0.f, 0.f, 0.f};
        const bf16* ap = XB + (size_t)(rg * 16 + fr) * D + 8 * fq; const bf16* b0p = WsT + (size_t)fr * D + 8 * fq; const bf16* b1p = WsT + (size_t)(16 + fr) * D + 8 * fq;
#pragma unroll 4
        for (int k0 = 0; k0 < D; k0 += 32) {
            const bf16x8 a = *(const bf16x8*)(ap + k0), b0 = *(const bf16x8*)(b0p + k0), b1 = *(const bf16x8*)(b1p + k0);
            a0 = mfma16(a, b0, a0); a1 = mfma16(a, b1, a1);
        }
#pragma unroll
        for (int r = 0; r < 4; ++r) { float* o = ZS + (size_t)(rg * 16 + fq * 4 + r) * NSM + fr; o[0] = a0[r]; o[16] = a1[r]; }
    }
}

#ifndef EMU
__device__ __forceinline__ void phase_gemm1(ArgP Ap, LAS unsigned char* lds, int l) {
    unsigned char* wb = A.ws + WS_WB + (size_t)l * WB_BYTES;
    pg8::Gemm g{(const bf16*)(A.ws + WS_XB), (const bf16*)(wb + WB_WIN), T, NZ, D};
    pg8::StaticOrder S; S.init(T, NZ, gridDim.x, blockIdx.x);
    EpiZ E{(bf16*)(A.ws + WS_ZM), (bf16*)(A.ws + WS_ZG)};
    pg8::gemm_phase<EpiZ, pg8::StaticOrder>(lds, g, S, E);
    small_gemm((const bf16*)(A.ws + WS_XB), (const bf16*)(wb + WB_WS), (float*)(A.ws + WS_ZS));
}
#endif

#ifndef EMU
#define XB_TMO      128
#define XB_XCNT(j)  (256  + 64 * (j))
#define XB_XSUB(j)  (1280 + 64 * (j))
#define XB_XGEN(j)  (2304 + 64 * (j))
#define XB_TOP      3328
#define XB_TOPGEN   3392
#define XCD_BAR_WORDS 3456
#define XB_SPIN_CAP (1u << 18)

__device__ __forceinline__ unsigned xb_ld(unsigned* p)              { return __hip_atomic_load(p, __ATOMIC_RELAXED, __HIP_MEMORY_SCOPE_AGENT); }
__device__ __forceinline__ unsigned xb_add(unsigned* p, unsigned v) { return __hip_atomic_fetch_add(p, v, __ATOMIC_RELAXED, __HIP_MEMORY_SCOPE_AGENT); }
__device__ __forceinline__ unsigned xb_xcc_id() { return (unsigned)__builtin_amdgcn_s_getreg((3 << 11) | 20) & 0xFu; }
#define XB_SPIN(cond, bar) do { unsigned _sp = 0; while (cond) { __builtin_amdgcn_s_sleep(1); \
    if ((++_sp & 255u) == 0u) { if (xb_ld(&(bar)[XB_TMO])) break; if (_sp > XB_SPIN_CAP) { atomicAdd(&(bar)[XB_TMO], 1u); break; } } } } while (0)

struct XcdBarrier {
    unsigned* bar; unsigned x;
    volatile LAS unsigned* st;
};

__device__ __forceinline__ XcdBarrier xcd_barrier_post(unsigned* bar, volatile LAS unsigned* st) {
    XcdBarrier b; b.bar = bar; b.x = xb_xcc_id(); b.st = st;
    if (threadIdx.x == 0) (void)xb_add(&bar[XB_XCNT(b.x)], 1u);
    return b;
}
__device__ __forceinline__ void xcd_barrier_complete(unsigned* bar, unsigned x, unsigned& nloc, unsigned& nx) {
    const unsigned G = gridDim.x * gridDim.y * gridDim.z;
    unsigned sum, cnt, mine, sp = 0u;
    for (;;) {
        sum = 0u; cnt = 0u; mine = 0u;
#pragma unroll
        for (unsigned j = 0; j < 16; ++j) { const unsigned c = xb_ld(&bar[XB_XCNT(j)]); sum += c; cnt += (c > 0u) ? 1u : 0u; mine = (j == x) ? c : mine; }
        if (sum == G) break;
        __builtin_amdgcn_s_sleep(1);
        if ((++sp & 255u) == 0u) { if (xb_ld(&bar[XB_TMO])) break; if (sp > XB_SPIN_CAP) { atomicAdd(&bar[XB_TMO], 1u); break; } }
    }
    nloc = mine > 0u ? mine : 1u; nx = cnt > 0u ? cnt : 1u;
}

__device__ __forceinline__ void xcd_barrier(const XcdBarrier& b) {
    asm volatile("s_waitcnt vmcnt(0)" ::: "memory");
    __syncthreads();
    if (threadIdx.x == 0) {
        unsigned* bar = b.bar;
        __builtin_amdgcn_s_waitcnt(0);
        unsigned nloc = b.st[0], nx = b.st[1];
        if (nloc == 0u) { xcd_barrier_complete(bar, b.x, nloc, nx); b.st[0] = nloc; b.st[1] = nx; }
        const unsigned old = xb_add(&bar[XB_XSUB(b.x)], 1u);
        const unsigned gen = old / nloc;
        if (old + 1u == (gen + 1u) * nloc) {
            __builtin_amdgcn_fence(__ATOMIC_RELEASE, "agent");
            asm volatile("s_waitcnt vmcnt(0)" ::: "memory");
            const unsigned og = xb_add(&bar[XB_TOP], 1u);
            const unsigned tg = og / nx;
            if (og + 1u == (tg + 1u) * nx) xb_add(&bar[XB_TOPGEN], 1u);
            else XB_SPIN(xb_ld(&bar[XB_TOPGEN]) == tg, bar);
            __builtin_amdgcn_fence(__ATOMIC_ACQUIRE, "agent");
            xb_add(&bar[XB_XGEN(b.x)], 1u);
            asm volatile("s_waitcnt vmcnt(0)" ::: "memory");
        } else {
            XB_SPIN(xb_ld(&bar[XB_XGEN(b.x)]) == gen, bar);
            __builtin_amdgcn_fence(__ATOMIC_ACQUIRE, "agent");
            asm volatile("s_waitcnt vmcnt(0)" ::: "memory");
        }
    }
    __syncthreads();
}

#endif

typedef short s16x4 __attribute__((ext_vector_type(4)));
#ifndef EMU
__device__ __forceinline__ s16x4 tr4(const LAS bf16* p) { return __builtin_amdgcn_ds_read_tr16_b64_v4i16((LAS s16x4*)p); }
#endif
#define FROW(M, ld, rc0, k0) (*(const LAS bf16x8*)((M) + ((rc0) + fr) * (ld) + (k0) + 8 * fq))
__device__ __forceinline__ bf16x8 ftr_(int fr, int fq, const LAS bf16* M, int ld, int k0, int rc0) {
    const LAS bf16* p = M + (k0 + 8 * fq + (fr >> 2)) * ld + rc0 + 4 * (fr & 3);
    const s16x4 lo = tr4(p), hi = tr4(p + 4 * ld);
    return (bf16x8){lo[0], lo[1], lo[2], lo[3], hi[0], hi[1], hi[2], hi[3]};
}
#define FTR(M, ld, k0, rc0) ftr_(fr, fq, M, ld, k0, rc0)
#define MMA_RR(acc, Am, lda, r0, Bm, ldb, c0, K) do { _Pragma("unroll") for (int k0_ = 0; k0_ < (K); k0_ += 32) acc = mfma16(FROW(Am, lda, r0, k0_), FROW(Bm, ldb, c0, k0_), acc); } while (0)
#define MMA_RT(acc, Am, lda, r0, Bk, ldb, c0, K) do { _Pragma("unroll") for (int k0_ = 0; k0_ < (K); k0_ += 32) acc = mfma16(FROW(Am, lda, r0, k0_), FTR(Bk, ldb, k0_, c0), acc); } while (0)
#define MMA_TT(acc, Ak, lda, m0, Bk, ldb, c0, K) do { _Pragma("unroll") for (int k0_ = 0; k0_ < (K); k0_ += 32) acc = mfma16(FTR(Ak, lda, k0_, m0), FTR(Bk, ldb, k0_, c0), acc); } while (0)
#define MMA_RC(acc, Am, lda, r0, cfrag, K) do { _Pragma("unroll") for (int k0_ = 0; k0_ < (K); k0_ += 32) acc = mfma16(FROW(Am, lda, r0, k0_), cfrag, acc); } while (0)
#define MMA_CT(acc, cfrag, Bk, ldb, c0, K) do { _Pragma("unroll") for (int k0_ = 0; k0_ < (K); k0_ += 32) acc = mfma16(cfrag, FTR(Bk, ldb, k0_, c0), acc); } while (0)
__device__ __forceinline__ u32x2 pack4(float a, float b, float c, float d) { u32x2 w; w.x = pk2(a, b); w.y = pk2(c, d); return w; }
__device__ __forceinline__ float scan_sum64(float v, int lane) {
#pragma unroll
    for (int d = 1; d < 64; d <<= 1) { const float t = __shfl_up(v, d); if (lane >= d) v += t; }
    return v;
}
__device__ __forceinline__ float scan_max64(float v, int lane) {
#pragma unroll
    for (int d = 1; d < 64; d <<= 1) { const float t = __shfl_up(v, d); if (lane >= d) v = fmaxf(v, t); }
    return v;
}
__device__ __forceinline__ float wave_max64(float v) {
#pragma unroll
    for (int m = 1; m < 64; m <<= 1) v = fmaxf(v, __shfl_xor(v, m));
    return v;
}
__device__ __forceinline__ float logsig(float x) { return fminf(x, 0.f) - log1pf(__expf(-fabsf(x))); }
__device__ __forceinline__ float softplusf(float x) { return fmaxf(x, 0.f) + log1pf(__expf(-fabsf(x))); }
__device__ __forceinline__ float sigmoidf(float x) { return 1.0f / (1.0f + __expf(-x)); }
__device__ __forceinline__ float siluf(float x) { return x / (1.0f + __expf(-x)); }
constexpr float NEG_INF = -__builtin_huge_valf();
constexpr float EPS_ = 1e-5f;
__device__ __forceinline__ void unpack8(const u32x4 w, float (&f)[8]) {
    f[0] = __uint_as_float(w.x << 16); f[1] = __uint_as_float(w.x & 0xffff0000u); f[2] = __uint_as_float(w.y << 16); f[3] = __uint_as_float(w.y & 0xffff0000u);
    f[4] = __uint_as_float(w.z << 16); f[5] = __uint_as_float(w.z & 0xffff0000u); f[6] = __uint_as_float(w.w << 16); f[7] = __uint_as_float(w.w & 0xffff0000u);
}
__device__ __forceinline__ u32x4 pack8(const float (&f)[8]) { u32x4 w; w.x = pk2(f[0], f[1]); w.y = pk2(f[2], f[3]); w.z = pk2(f[4], f[5]); w.w = pk2(f[6], f[7]); return w; }

__device__ __forceinline__ void mlstm_item(ArgP Ap, LAS unsigned char* lds, int l, int b, int h, bool sample) {
    int tid_o = threadIdx.x; OPQV(tid_o);
    const int tid = tid_o, lane = tid & 63, wave = tid >> 6, fr = lane & 15, fq = lane >> 4;
    LAS bf16* Qs = (LAS bf16*)(lds); LAS bf16* Ks = (LAS bf16*)(lds + 17408); LAS bf16* Kw = (LAS bf16*)(lds + 34816); LAS bf16* Vs = (LAS bf16*)(lds + 52224);
    LAS bf16* Ss = (LAS bf16*)(lds + 69632); LAS bf16* CbT = (LAS bf16*)(lds + 78848); LAS float* Hs = (LAS float*)(lds + 120320); LAS float* MN = (LAS float*)(lds + 117760); LAS float* gb = (LAS float*)(lds + 118272);
    LAS float* b_ = gb; LAS float* mt_ = gb + 64; LAS float* u_ = gb + 128; LAS float* ein_ = gb + 192; LAS float* wg_ = gb + 256; LAS float* den_ = gb + 320; LAS float* sc_ = gb + 384;
    const int L = sample ? LS : LP, tok0 = sample ? TP + b * LS : b * LP, NB = sample ? BS : BP;
    const bf16* ZM = (const bf16*)(A.ws + WS_ZM); const float* ZS = (const float*)(A.ws + WS_ZS); bf16* BR0 = (bf16*)(A.ws + WS_BR);
    const float ib = A.in[9][l * 4 + h], fb = A.in[10][l * 4 + h];
    const bf16x8 ones = (fr == 0) ? (bf16x8){0x3F80, 0x3F80, 0x3F80, 0x3F80, 0x3F80, 0x3F80, 0x3F80, 0x3F80} : (bf16x8){0, 0, 0, 0, 0, 0, 0, 0};
    f32x4 accC[9];
#pragma unroll
    for (int vi = 0; vi < 9; ++vi) accC[vi] = (f32x4){0.f, 0.f, 0.f, 0.f};
    float m_run = 0.f;
    if (sample) {
        const float* C0 = A.in[2] + ((size_t)(l * BS + b) * 4 + h) * 16384; const float* n0 = A.in[3] + ((size_t)(l * BS + b) * 4 + h) * 128;
        const float* cp = C0 + (4 * fq) * 128 + 16 * wave + fr;
#pragma unroll
        for (int vi = 0; vi < 8; ++vi) {
#pragma unroll
            for (int r = 0; r < 4; ++r) accC[vi][r] = cp[r * 128];
            cp += 2048; OPQV(cp); }
        if (fq == 0) accC[8][0] = n0[16 * wave + fr];
        m_run = A.in[4][(l * BS + b) * 4 + h];
    }
#pragma unroll
    for (int vi = 0; vi < 9; ++vi) *(LAS u32x2*)(CbT + (16 * wave + fr) * 152 + 16 * vi + 4 * fq) = pack4(accC[vi][0], accC[vi][1], accC[vi][2], accC[vi][3]);
    if (tid < 128) MN[tid] = A.in[11][l * 512 + h * 128 + tid];
    u32x4 pq[2], pk[2], pv[2], pm[2]; float pli = NEG_INF, plf = 0.f;
#define MLSTM_PREFETCH_MO(T0N) do { const int nvn_ = (L - (T0N)) < 64 ? (L - (T0N)) : 64; const int t = tid >> 3, part = tid & 7; pm[0] = (u32x4){0u, 0u, 0u, 0u}; pm[1] = pm[0]; \
        if (t < nvn_) { const bf16* mo = ZM + (size_t)(tok0 + (T0N) + t) * NZM + 1536 + h * 128 + 16 * part; pm[0] = *(const u32x4*)mo; pm[1] = *(const u32x4*)(mo + 8); } } while (0)
#define MLSTM_PREFETCH(T0N) do { const int nvn_ = (L - (T0N)) < 64 ? (L - (T0N)) : 64; \
        _Pragma("unroll") for (int i = 0; i < 2; ++i) { const int c = tid + 512 * i, t = c >> 4, cc = (c & 15) * 8; pq[i] = (u32x4){0u, 0u, 0u, 0u}; pk[i] = pq[i]; pv[i] = pq[i]; \
            if (t < nvn_) { const bf16* zp = ZM + (size_t)(tok0 + (T0N) + t) * NZM + h * 128 + cc; pq[i] = *(const u32x4*)zp; pk[i] = *(const u32x4*)(zp + 512); pv[i] = *(const u32x4*)(zp + 1024); } } \
        if (wave == 0) { pli = NEG_INF; plf = 0.f; if (lane < nvn_) { const size_t tok = tok0 + (T0N) + lane; pli = ZS[tok * NSM + h]; plf = ZS[tok * NSM + 4 + h]; } } } while (0)
    MLSTM_PREFETCH(0); MLSTM_PREFETCH_MO(0);
    __syncthreads();
    for (int t0 = 0; t0 < L; t0 += 64) {
        const int nv = (L - t0) < 64 ? (L - t0) : 64;
        if (wave == 0) {
            const float li = (lane < nv) ? pli + ib : NEG_INF, lf = (lane < nv) ? logsig(plf + fb) : 0.f;
            const float bb = scan_sum64(lf, lane), a = bb + m_run, u = li - bb, M = scan_max64(u, lane), mt = fmaxf(a, bb + M);
            const float blast = __shfl(bb, 63), g = blast + u, gmax = wave_max64(g), mnew = fmaxf(blast + m_run, gmax);
            b_[lane] = bb; mt_[lane] = mt; u_[lane] = u; ein_[lane] = __expf(a - mt); wg_[lane] = __expf(g - mnew);
            if (lane == 0) sc_[1] = __expf(blast + m_run - mnew);
            m_run = mnew;
        }
        __syncthreads();
#pragma unroll
        for (int i = 0; i < 2; ++i) { const int c = tid + 512 * i, t = c >> 4, cc = (c & 15) * 8;
            *(LAS u32x4*)(Qs + t * 136 + cc) = pq[i]; *(LAS u32x4*)(Ks + t * 136 + cc) = pk[i]; *(LAS u32x4*)(Vs + t * 136 + cc) = pv[i];
            float f[8]; unpack8(pk[i], f); const float g = wg_[t];
#pragma unroll
            for (int j = 0; j < 8; ++j) f[j] *= g;
            *(LAS u32x4*)(Kw + t * 136 + cc) = pack8(f); }
        MLSTM_PREFETCH(t0 + 64);
        __syncthreads();
#pragma unroll
        for (int j = 0; j < 2; ++j) { const int idx = wave + 8 * j, ti = idx >> 2, si = idx & 3;
            f32x4 acc = {0.f, 0.f, 0.f, 0.f};
            if (si <= ti) MMA_RR(acc, Ks, 136, 16 * si, Qs, 136, 16 * ti, 128);
            const int t = 16 * ti + fr; const float bt = b_[t] - mt_[t]; float v[4];
#pragma unroll
            for (int r = 0; r < 4; ++r) { const int s = 16 * si + 4 * fq + r; v[r] = (s <= t) ? acc[r] * __expf(bt + u_[s]) : 0.f; }
            *(LAS u32x2*)(Ss + t * 72 + 16 * si + 4 * fq) = pack4(v[0], v[1], v[2], v[3]); }
        __syncthreads();
        if (wave < 4) { const int ti = wave; f32x4 acc = {0.f, 0.f, 0.f, 0.f};
            MMA_RT(acc, Qs, 136, 16 * ti, CbT, 152, 128, 128);
#pragma unroll
            for (int r = 0; r < 4; ++r) acc[r] *= ein_[16 * ti + 4 * fq + r];
            MMA_RC(acc, Ss, 72, 16 * ti, ones, 64);
            if (fr == 0) {
#pragma unroll
                for (int r = 0; r < 4; ++r) den_[16 * ti + 4 * fq + r] = acc[r]; } }
        __syncthreads();
#pragma unroll
        for (int j = 0; j < 4; ++j) { const int idx = wave + 8 * j, ti = idx >> 3, vi = idx & 7; f32x4 accn = {0.f, 0.f, 0.f, 0.f};
            MMA_RT(accn, Qs, 136, 16 * ti, CbT, 152, 16 * vi, 128);
#pragma unroll
            for (int r = 0; r < 4; ++r) accn[r] *= ein_[16 * ti + 4 * fq + r];
            MMA_RT(accn, Ss, 72, 16 * ti, Vs, 136, 16 * vi, 64);
#pragma unroll
            for (int r = 0; r < 4; ++r) { const int t = 16 * ti + 4 * fq + r; const float dn = den_[t] * 0.08838834764831845f;
                Hs[t * 132 + 16 * vi + fr] = accn[r] * 0.08838834764831845f / fmaxf(fabsf(dn), __expf(-mt_[t])); }
            asm volatile("" ::: "memory"); }
        __syncthreads();
        { const int t = tid >> 3, part = tid & 7; float x[16]; float s1 = 0.f;
#pragma unroll
            for (int i = 0; i < 16; ++i) { x[i] = Hs[t * 132 + 16 * part + i]; s1 += x[i]; }
            s1 += __shfl_xor(s1, 1); s1 += __shfl_xor(s1, 2); s1 += __shfl_xor(s1, 4);
            const float mu = s1 * (1.0f / 128.0f); float s2 = 0.f;
#pragma unroll
            for (int i = 0; i < 16; ++i) { x[i] -= mu; s2 += x[i] * x[i]; }
            s2 += __shfl_xor(s2, 1); s2 += __shfl_xor(s2, 2); s2 += __shfl_xor(s2, 4);
            const float rstd = 1.0f / sqrtf(s2 * (1.0f / 128.0f) + EPS_);
            if (t < nv) { const size_t tok = tok0 + t0 + t;
                float o0[8], o1[8]; unpack8(pm[0], o0); unpack8(pm[1], o1); float y0[8], y1[8];
#pragma unroll
                for (int i = 0; i < 8; ++i) { y0[i] = x[i] * rstd * MN[16 * part + i] * sigmoidf(o0[i]); y1[i] = x[8 + i] * rstd * MN[16 * part + 8 + i] * sigmoidf(o1[i]); }
                bf16* o = BR0 + tok * 512 + h * 128 + 16 * part; *(u32x4*)o = pack8(y0); *(u32x4*)(o + 8) = pack8(y1); } }
        MLSTM_PREFETCH_MO(t0 + 64);
        { const float ec = sc_[1];
#pragma unroll
            for (int vi = 0; vi < 9; ++vi) {
#pragma unroll
                for (int r = 0; r < 4; ++r) accC[vi][r] *= ec;
                if (vi < 8) MMA_TT(accC[vi], Vs, 136, 16 * vi, Kw, 136, 16 * wave, 64); else MMA_CT(accC[vi], ones, Kw, 136, 16 * wave, 64);
                *(LAS u32x2*)(CbT + (16 * wave + fr) * 152 + 16 * vi + 4 * fq) = pack4(accC[vi][0], accC[vi][1], accC[vi][2], accC[vi][3]);
                asm volatile("" ::: "memory"); } }
        __syncthreads();
    }
#undef MLSTM_PREFETCH
#undef MLSTM_PREFETCH_MO
    float* Co = A.out + (sample ? O_SC : O_PC) + ((size_t)(l * NB + b) * 4 + h) * 16384; float* no = A.out + (sample ? O_SN : O_PN) + ((size_t)(l * NB + b) * 4 + h) * 128;
    { int fq_ = fq, cw_ = 16 * wave + fr; OPQV(fq_); OPQV(cw_);
      float* cp = Co + (4 * fq_) * 128 + cw_;
#pragma unroll
      for (int vi = 0; vi < 8; ++vi) {
#pragma unroll
        for (int r = 0; r < 4; ++r) cp[r * 128] = accC[vi][r];
        cp += 2048; OPQV(cp); }
      if (fq_ == 0) no[cw_] = accC[8][0]; }
    if (tid == 0) A.out[(sample ? O_SM : O_PM) + (size_t)(l * NB + b) * 4 + h] = m_run;
    __syncthreads();
}

__device__ __forceinline__ void gla_item(ArgP Ap, LAS unsigned char* lds, int l, int b, int h, bool sample) {
    int tid_o = threadIdx.x; OPQV(tid_o);
    const int tid = tid_o, lane = tid & 63, wave = tid >> 6, fr = lane & 15, fq = lane >> 4;
    LAS bf16* QE = (LAS bf16*)(lds); LAS bf16* KE = (LAS bf16*)(lds + 9216); LAS bf16* KLs = (LAS bf16*)(lds + 18432); LAS bf16* Vs = (LAS bf16*)(lds + 27648);
    LAS bf16* ATT = (LAS bf16*)(lds + 45056); LAS bf16* STbT = (LAS bf16*)(lds + 54272); LAS float* Os = (LAS float*)(lds + 71680); LAS float* LAM = (LAS float*)(lds + 105472);
    LAS float* GA = (LAS float*)(lds + 122112); LAS float* GUP = (LAS float*)(lds + 126208); LAS float* GBI = (LAS float*)(lds + 130304); LAS float* GN = (LAS float*)(lds + 130560);
    const int L = sample ? LS : LP, tok0 = sample ? TP + b * LS : b * LP, NB = sample ? BS : BP;
    const bf16* ZM = (const bf16*)(A.ws + WS_ZM); const float* ZS = (const float*)(A.ws + WS_ZS); bf16* BR1 = (bf16*)(A.ws + WS_BR) + (size_t)T * 512;
    f32x4 accS[4];
#pragma unroll
    for (int ki = 0; ki < 4; ++ki) accS[ki] = (f32x4){0.f, 0.f, 0.f, 0.f};
    if (sample) { const float* S0 = A.in[5] + ((size_t)(l * BS + b) * 4 + h) * 8192;
        const float* sp = S0 + fr * 128 + 16 * wave + 4 * fq;
#pragma unroll
        for (int ki = 0; ki < 4; ++ki) {
#pragma unroll
            for (int r = 0; r < 4; ++r) accS[ki][r] = sp[r];
            sp += 2048; OPQV(sp); } }
#pragma unroll
    for (int ki = 0; ki < 4; ++ki) *(LAS u32x2*)(STbT + (16 * ki + fr) * 136 + 16 * wave + 4 * fq) = pack4(accS[ki][0], accS[ki][1], accS[ki][2], accS[ki][3]);
    for (int e = tid; e < 1024; e += NTHREADS) GUP[e] = A.in[12][(size_t)l * 16 * 256 + (e >> 6) * 256 + h * 64 + (e & 63)];
    if (tid < 64) GBI[tid] = A.in[13][l * 256 + h * 64 + tid];
    if (tid < 128) GN[tid] = A.in[14][l * 512 + h * 128 + tid];
    u32x4 pq, pk, pv[2], pg[2], pgn[2]; float pga[2];
#define GLA_PREFETCH(T0N) do { const int nvn_ = (L - (T0N)) < 64 ? (L - (T0N)) : 64; \
        { const int t = tid >> 3, cc = (tid & 7) * 8; pq = (u32x4){0u, 0u, 0u, 0u}; pk = pq; pgn[0] = pq; pgn[1] = pq; \
            if (t < nvn_) { const bf16* zr = ZM + (size_t)(tok0 + (T0N) + t) * NZM + 2048 + h * 64 + cc; pq = *(const u32x4*)zr; pk = *(const u32x4*)(zr + 256); \
                const bf16* gr = ZM + (size_t)(tok0 + (T0N) + t) * NZM + 3072 + h * 128 + 16 * (tid & 7); pgn[0] = *(const u32x4*)gr; pgn[1] = *(const u32x4*)(gr + 8); } } \
        _Pragma("unroll") for (int i = 0; i < 2; ++i) { const int c = tid + 512 * i, t = c >> 4, cc = (c & 15) * 8; pv[i] = (u32x4){0u, 0u, 0u, 0u}; \
            if (t < nvn_) pv[i] = *(const u32x4*)(ZM + (size_t)(tok0 + (T0N) + t) * NZM + 2560 + h * 128 + cc); \
            const int e = tid + 512 * i, te = e >> 4; pga[i] = (te < nvn_) ? ZS[(size_t)(tok0 + (T0N) + te) * NSM + 8 + (e & 15)] : 0.f; } } while (0)
    GLA_PREFETCH(0);
    __syncthreads();
    for (int t0 = 0; t0 < L; t0 += 64) {
        const int nv = (L - t0) < 64 ? (L - t0) : 64;
        pg[0] = pgn[0]; pg[1] = pgn[1];
        GA[tid] = pga[0]; GA[tid + 512] = pga[1];
        __syncthreads();
#pragma unroll
        for (int i = 0; i < 8; ++i) { const int e = tid + 512 * i, t = e >> 6, k = e & 63; float x = GBI[k];
#pragma unroll
            for (int r = 0; r < 16; ++r) x += GA[t * 16 + r] * GUP[r * 64 + k];
            LAM[t * 65 + k] = (t < nv) ? logsig(x) * (1.0f / 16.0f) : 0.f; }
        __syncthreads();
#pragma unroll
        for (int c = 0; c < 8; ++c) { const int k = 8 * wave + c; const float v = scan_sum64(LAM[lane * 65 + k], lane); LAM[lane * 65 + k] = v; }
        __syncthreads();
        { const int t = tid >> 3, cc = (tid & 7) * 8; float q[8], k[8], qe[8], ke[8], kl[8]; unpack8(pq, q); unpack8(pk, k);
#pragma unroll
            for (int i = 0; i < 8; ++i) { const float lm = LAM[t * 65 + cc + i], ll = LAM[63 * 65 + cc + i]; qe[i] = q[i] * __expf(lm); ke[i] = k[i] * __expf(-lm); kl[i] = k[i] * __expf(ll - lm); }
            *(LAS u32x4*)(QE + t * 72 + cc) = pack8(qe); *(LAS u32x4*)(KE + t * 72 + cc) = pack8(ke); *(LAS u32x4*)(KLs + t * 72 + cc) = pack8(kl); }
#pragma unroll
        for (int i = 0; i < 2; ++i) { const int c = tid + 512 * i, t = c >> 4, cc = (c & 15) * 8; *(LAS u32x4*)(Vs + t * 136 + cc) = pv[i]; }
        GLA_PREFETCH(t0 + 64);
        __syncthreads();
#pragma unroll
        for (int j = 0; j < 2; ++j) { const int idx = wave + 8 * j, ti = idx >> 2, si = idx & 3; f32x4 acc = {0.f, 0.f, 0.f, 0.f};
            if (si <= ti) MMA_RR(acc, KE, 72, 16 * si, QE, 72, 16 * ti, 64);
            const int t = 16 * ti + fr; float v[4];
#pragma unroll
            for (int r = 0; r < 4; ++r) { const int s = 16 * si + 4 * fq + r; v[r] = (s <= t) ? acc[r] : 0.f; }
            *(LAS u32x2*)(ATT + t * 72 + 16 * si + 4 * fq) = pack4(v[0], v[1], v[2], v[3]); }
        __syncthreads();
#pragma unroll
        for (int j = 0; j < 4; ++j) { const int idx = wave + 8 * j, ti = idx >> 3, vi = idx & 7; f32x4 acc = {0.f, 0.f, 0.f, 0.f};
            MMA_RT(acc, QE, 72, 16 * ti, STbT, 136, 16 * vi, 64); MMA_RT(acc, ATT, 72, 16 * ti, Vs, 136, 16 * vi, 64);
#pragma unroll
            for (int r = 0; r < 4; ++r) Os[(16 * ti + 4 * fq + r) * 132 + 16 * vi + fr] = acc[r] * 0.125f;
            asm volatile("" ::: "memory"); }
        __syncthreads();
        { const int t = tid >> 3, part = tid & 7; float x[16]; float s2 = 0.f;
#pragma unroll
            for (int i = 0; i < 16; ++i) { x[i] = Os[t * 132 + 16 * part + i]; s2 += x[i] * x[i]; }
            s2 += __shfl_xor(s2, 1); s2 += __shfl_xor(s2, 2); s2 += __shfl_xor(s2, 4);
            const float rstd = 1.0f / sqrtf(s2 * (1.0f / 128.0f) + EPS_);
            if (t < nv) { const size_t tok = tok0 + t0 + t;
                float g0[8], g1[8]; unpack8(pg[0], g0); unpack8(pg[1], g1); float y0[8], y1[8];
#pragma unroll
                for (int i = 0; i < 8; ++i) { y0[i] = x[i] * rstd * GN[16 * part + i] * siluf(g0[i]); y1[i] = x[8 + i] * rstd * GN[16 * part + 8 + i] * siluf(g1[i]); }
                bf16* o = BR1 + tok * 512 + h * 128 + 16 * part; *(u32x4*)o = pack8(y0); *(u32x4*)(o + 8) = pack8(y1); } }
#pragma unroll
        for (int ki = 0; ki < 4; ++ki) { const float dec = __expf(LAM[63 * 65 + 16 * ki + fr]);
#pragma unroll
            for (int r = 0; r < 4; ++r) accS[ki][r] *= dec;
            MMA_TT(accS[ki], Vs, 136, 16 * wave, KLs, 72, 16 * ki, 64);
            *(LAS u32x2*)(STbT + (16 * ki + fr) * 136 + 16 * wave + 4 * fq) = pack4(accS[ki][0], accS[ki][1], accS[ki][2], accS[ki][3]);
            asm volatile("" ::: "memory"); }
        __syncthreads();
    }
#undef GLA_PREFETCH
    float* So = A.out + (sample ? O_SG : O_PG) + ((size_t)(l * NB + b) * 4 + h) * 8192;
    { int o_ = fr * 128 + 16 * wave + 4 * fq; OPQV(o_); float* sp = So + o_;
#pragma unroll
      for (int ki = 0; ki < 4; ++ki) {
#pragma unroll
        for (int r = 0; r < 4; ++r) sp[r] = accS[ki][r];
        sp += 2048; OPQV(sp); } }
    __syncthreads();
}

__device__ __forceinline__ int ssd_chmap(int g, int c) { return c < 256 ? g * 256 + c : (c < 320 ? 512 + g * 64 + (c - 256) : 640 + g * 64 + (c - 320)); }
__device__ __forceinline__ void ssd_item(ArgP Ap, LAS unsigned char* lds, int l, int b, int g, bool sample) {
    int tid_o = threadIdx.x; OPQV(tid_o);
    const int tid = tid_o, lane = tid & 63, wave = tid >> 6, fr = lane & 15, fq = lane >> 4;
    LAS bf16* RAW = (LAS bf16*)(lds); LAS bf16* Ys = (LAS bf16*)(lds); LAS bf16* W = (LAS bf16*)(lds + 33792); LAS bf16* Bw = (LAS bf16*)(lds + 43008);
    LAS bf16* Xs = (LAS bf16*)(lds + 53248); LAS bf16* Cs = (LAS bf16*)(lds + 90112); LAS bf16* Bs = (LAS bf16*)(lds + 99328); LAS bf16* HbT = (LAS bf16*)(lds + 108544);
    LAS bf16* HIST = (LAS bf16*)(lds + 145408); LAS float* DT = (LAS float*)(lds + 147776); LAS float* LM = (LAS float*)(lds + 148800); LAS float* SN = (LAS float*)(lds + 149824);
    LAS float* CW = (LAS float*)(lds + 150848); LAS float* CBI = CW + 4 * 384;
    const int L = sample ? LS : LP, tok0 = sample ? TP + b * LS : b * LP, NB = sample ? BS : BP;
    const bf16* ZM = (const bf16*)(A.ws + WS_ZM); const float* ZS = (const float*)(A.ws + WS_ZS); bf16* BR2 = (bf16*)(A.ws + WS_BR) + (size_t)T * 1024;
    f32x4 accH[4][2];
#pragma unroll
    for (int hh = 0; hh < 4; ++hh)
#pragma unroll
        for (int j = 0; j < 2; ++j) { const int idx = wave + 8 * j, pi = idx >> 2, ni = idx & 3; accH[hh][j] = (f32x4){0.f, 0.f, 0.f, 0.f};
            if (sample) { const float* h0 = A.in[6] + ((size_t)(l * BS + b) * 8 + g * 4 + hh) * 4096;
                const float* hp = h0 + (16 * pi + 4 * fq) * 64 + 16 * ni + fr; OPQV(hp);
#pragma unroll
                for (int r = 0; r < 4; ++r) accH[hh][j][r] = hp[r * 64]; }
            *(LAS u32x2*)(HbT + hh * 4608 + (16 * ni + fr) * 72 + 16 * pi + 4 * fq) = pack4(accH[hh][j][0], accH[hh][j][1], accH[hh][j][2], accH[hh][j][3]); }
    for (int e = tid; e < 5 * 384; e += NTHREADS) { const int j = e / 384, c = e % 384, ch = ssd_chmap(g, c); CW[e] = (j < 4) ? A.in[15][(size_t)l * 4 * 768 + j * 768 + ch] : A.in[16][l * 768 + ch]; }
    if (tid < 256) SN[tid] = A.in[20][l * 512 + g * 256 + tid];
    for (int e = tid; e < 3 * 392; e += NTHREADS) { const int r = e / 392, c = e % 392; float v = 0.f;
        if (sample && c < 384) v = A.in[7][((size_t)(l * BS + b) * 3 + r) * 768 + ssd_chmap(g, c)];
        HIST[e] = f2bf(v); }
    u32x4 pr[6], ps[4]; float pdt = 0.f;
#define SSD_PREFETCH_Z(T0N) do { const int nvn_ = (L - (T0N)) < 64 ? (L - (T0N)) : 64; const int t = tid >> 3, part = tid & 7; \
        _Pragma("unroll") for (int q = 0; q < 4; ++q) { ps[q] = (u32x4){0u, 0u, 0u, 0u}; if (t < nvn_) ps[q] = *(const u32x4*)(ZM + (size_t)(tok0 + (T0N) + t) * NZM + 3584 + g * 256 + 32 * part + 8 * q); } } while (0)
#define SSD_PREFETCH(T0N) do { const int nvn_ = (L - (T0N)) < 64 ? (L - (T0N)) : 64; \
        _Pragma("unroll") for (int i = 0; i < 6; ++i) { const int c = tid + 512 * i, t = c / 48, q = c % 48; pr[i] = (u32x4){0u, 0u, 0u, 0u}; \
            if (t < nvn_) pr[i] = *(const u32x4*)(ZM + (size_t)(tok0 + (T0N) + t) * NZM + 4096 + ssd_chmap(g, 8 * q)); } \
        if (wave < 4) { pdt = 0.f; if (lane < nvn_) pdt = ZS[(size_t)(tok0 + (T0N) + lane) * NSM + 24 + g * 4 + wave]; } } while (0)
    SSD_PREFETCH(0); SSD_PREFETCH_Z(0);
    __syncthreads();
    for (int t0 = 0; t0 < L; t0 += 64) {
        const int nv = (L - t0) < 64 ? (L - t0) : 64;
#pragma unroll
        for (int i = 0; i < 6; ++i) { const int c = tid + 512 * i, t = c / 48, q = c % 48; *(LAS u32x4*)(RAW + (3 + t) * 392 + 8 * q) = pr[i]; }
        if (tid < 3 * 49) { const int r = tid / 49, q = tid % 49; *(LAS u32x4*)(RAW + r * 392 + 8 * q) = *(const LAS u32x4*)(HIST + r * 392 + 8 * q); }
        if (wave < 4) { const int hd = g * 4 + wave; const float dtv = (lane < nv) ? softplusf(pdt + A.in[17][l * 8 + hd]) : 0.f;
            const float Ah = -__expf(A.in[18][l * 8 + hd]); const float lam = scan_sum64(dtv * Ah, lane);
            DT[wave * 64 + lane] = dtv; LM[wave * 64 + lane] = lam; }
        SSD_PREFETCH(t0 + 64);
        __syncthreads();
#pragma unroll
        for (int i = 0; i < 6; ++i) { const int c = tid + 512 * i, t = c / 48, q = c % 48; float o[8];
#pragma unroll
            for (int e = 0; e < 8; ++e) o[e] = CBI[8 * q + e];
#pragma unroll
            for (int j = 0; j < 4; ++j) { float x[8]; unpack8(*(const LAS u32x4*)(RAW + (t + j) * 392 + 8 * q), x);
#pragma unroll
                for (int e = 0; e < 8; ++e) o[e] += CW[j * 384 + 8 * q + e] * x[e]; }
#pragma unroll
            for (int e = 0; e < 8; ++e) o[e] = (t < nv) ? siluf(o[e]) : 0.f;
            LAS bf16* dst = (q < 32) ? Xs + (q >> 3) * 4608 + t * 72 + (q & 7) * 8 : (q < 40 ? Bs + t * 72 + (q - 32) * 8 : Cs + t * 72 + (q - 40) * 8);
            *(LAS u32x4*)dst = pack8(o); }
        __syncthreads();
        if (tid < 3 * 49) { const int r = tid / 49, q = tid % 49; *(LAS u32x4*)(HIST + r * 392 + 8 * q) = *(const LAS u32x4*)(RAW + (nv + r) * 392 + 8 * q); }
        f32x4 cbT[2];
#pragma unroll
        for (int j = 0; j < 2; ++j) { const int idx = wave + 8 * j, ti = idx >> 2, si = idx & 3; cbT[j] = (f32x4){0.f, 0.f, 0.f, 0.f};
            if (si <= ti) MMA_RR(cbT[j], Bs, 72, 16 * si, Cs, 72, 16 * ti, 64); }
        __syncthreads();
#pragma unroll 1
        for (int hh = 0; hh < 4; ++hh) {
            const int hd = g * 4 + hh; const float Dh = A.in[19][l * 8 + hd];
#pragma unroll
            for (int j = 0; j < 2; ++j) { const int idx = wave + 8 * j, ti = idx >> 2, si = idx & 3; const int t = 16 * ti + fr; const float lt = LM[hh * 64 + t]; float v[4];
#pragma unroll
                for (int r = 0; r < 4; ++r) { const int s = 16 * si + 4 * fq + r; v[r] = (s <= t) ? cbT[j][r] * __expf(lt - LM[hh * 64 + s]) * DT[hh * 64 + s] : 0.f; }
                *(LAS u32x2*)(W + t * 72 + 16 * si + 4 * fq) = pack4(v[0], v[1], v[2], v[3]); }
            { const int s = tid >> 3, n0 = (tid & 7) * 8; float v[8]; unpack8(*(const LAS u32x4*)(Bs + s * 72 + n0), v); const float ws = __expf(LM[hh * 64 + 63] - LM[hh * 64 + s]) * DT[hh * 64 + s];
#pragma unroll
                for (int i = 0; i < 8; ++i) v[i] *= ws;
                *(LAS u32x4*)(Bw + s * 72 + n0) = pack8(v); }
            __syncthreads();
#pragma unroll
            for (int j = 0; j < 2; ++j) { const int idx = wave + 8 * j, ti = idx >> 2, pi = idx & 3; f32x4 acc = {0.f, 0.f, 0.f, 0.f};
                MMA_RT(acc, Cs, 72, 16 * ti, HbT + hh * 4608, 72, 16 * pi, 64);
#pragma unroll
                for (int r = 0; r < 4; ++r) acc[r] *= __expf(LM[hh * 64 + 16 * ti + 4 * fq + r]);
                MMA_RT(acc, W, 72, 16 * ti, Xs + hh * 4608, 72, 16 * pi, 64);
#pragma unroll
                for (int r = 0; r < 4; ++r) { const int t = 16 * ti + 4 * fq + r, p = 16 * pi + fr;
                    Ys[t * 264 + hh * 64 + p] = f2bf(acc[r] + Dh * bf2f(Xs[hh * 4608 + t * 72 + p])); }
                asm volatile("" ::: "memory"); }
            { const float dec = __expf(LM[hh * 64 + 63]);
#pragma unroll
                for (int j = 0; j < 2; ++j) { const int idx = wave + 8 * j, pi = idx >> 2, ni = idx & 3;
#pragma unroll
                    for (int r = 0; r < 4; ++r) accH[0][j][r] *= dec;
                    MMA_TT(accH[0][j], Xs + hh * 4608, 72, 16 * pi, Bw, 72, 16 * ni, 64);
                    asm volatile("" ::: "memory"); } }
            __syncthreads();
#pragma unroll
            for (int j = 0; j < 2; ++j) { const int idx = wave + 8 * j, pi = idx >> 2, ni = idx & 3;
                *(LAS u32x2*)(HbT + hh * 4608 + (16 * ni + fr) * 72 + 16 * pi + 4 * fq) = pack4(accH[0][j][0], accH[0][j][1], accH[0][j][2], accH[0][j][3]); }
#pragma unroll
            for (int j = 0; j < 2; ++j) { const f32x4 tmp = accH[0][j]; accH[0][j] = accH[1][j]; accH[1][j] = accH[2][j]; accH[2][j] = accH[3][j]; accH[3][j] = tmp; }
        }
        { const int t = tid >> 3, part = tid & 7; float x[32]; float s2 = 0.f;
#pragma unroll
            for (int q = 0; q < 4; ++q) { float f[8], z[8]; unpack8(*(const LAS u32x4*)(Ys + t * 264 + 32 * part + 8 * q), f); unpack8(ps[q], z);
#pragma unroll
                for (int i = 0; i < 8; ++i) { const float y = f[i] * siluf(z[i]); x[8 * q + i] = y; s2 += y * y; } }
            s2 += __shfl_xor(s2, 1); s2 += __shfl_xor(s2, 2); s2 += __shfl_xor(s2, 4);
            const float rstd = 1.0f / sqrtf(s2 * (1.0f / 256.0f) + EPS_);
            if (t < nv) { bf16* o = BR2 + (size_t)(tok0 + t0 + t) * 512 + g * 256 + 32 * part;
#pragma unroll
                for (int q = 0; q < 4; ++q) { float y[8];
#pragma unroll
                    for (int i = 0; i < 8; ++i) y[i] = x[8 * q + i] * rstd * SN[32 * part + 8 * q + i];
                    *(u32x4*)(o + 8 * q) = pack8(y); } } }
        SSD_PREFETCH_Z(t0 + 64);
        __syncthreads();
    }
#undef SSD_PREFETCH_Z
#undef SSD_PREFETCH
#pragma unroll
    for (int hh = 0; hh < 4; ++hh) { float* ho = A.out + (sample ? O_SH : O_PH) + ((size_t)(l * NB + b) * 8 + g * 4 + hh) * 4096;
#pragma unroll
        for (int j = 0; j < 2; ++j) { const int idx = wave + 8 * j, pi = idx >> 2, ni = idx & 3;
            float* hp = ho + (16 * pi + 4 * fq) * 64 + 16 * ni + fr; OPQV(hp);
#pragma unroll
            for (int r = 0; r < 4; ++r) hp[r * 64] = accH[hh][j][r]; } }
    for (int e = tid; e < 3 * 384; e += NTHREADS) { const int r = e / 384, c = e % 384;
        A.out[(sample ? O_SV : O_PV) + ((size_t)(l * NB + b) * 3 + r) * 768 + ssd_chmap(g, c)] = bf2f(HIST[r * 392 + c]); }
    __syncthreads();
}

__device__ __forceinline__ void mixer_item(ArgP Ap, LAS unsigned char* lds, int l, int it) {
    constexpr int NL0 = BP * 4, NL1 = NL0 + BP * 4, NL2 = NL1 + BP * 2, NS0 = NL2 + BS * 4, NS1 = NS0 + BS * 4;
    int kind, r; bool sample;
    if (it < NL0) { kind = 0; r = it; sample = false; } else if (it < NL1) { kind = 1; r = it - NL0; sample = false; } else if (it < NL2) { kind = 2; r = it - NL1; sample = false; }
    else if (it < NS0) { kind = 0; r = it - NL2; sample = true; } else if (it < NS1) { kind = 1; r = it - NS0; sample = true; } else { kind = 2; r = it - NS1; sample = true; }
#ifndef ONLYK
#define ONLYK -1
#endif
#ifndef EMU
#define OPQ() ArgP Ap_ = Ap; int l_ = l, r_ = r; asm volatile("" : "+s"(Ap_), "+s"(l_), "+s"(r_) :: "memory")
#else
#define OPQ() ArgP Ap_ = Ap; int l_ = l, r_ = r
#endif
    if ((ONLYK < 0 || ONLYK == 0) && kind == 0) { OPQ(); mlstm_item(Ap_, lds, l_, r_ >> 2, r_ & 3, sample); }
    else if ((ONLYK < 0 || ONLYK == 1) && kind == 1) { OPQ(); gla_item(Ap_, lds, l_, r_ >> 2, r_ & 3, sample); }
    else if ((ONLYK < 0 || ONLYK == 2) && kind == 2) { OPQ(); ssd_item(Ap_, lds, l_, r_ >> 1, r_ & 1, sample); }
#undef OPQ
}
__device__ __forceinline__ void phase_mixers(ArgP Ap, LAS unsigned char* lds, int l) {
    constexpr int NLONG = BP * 10, NSHORT = BS * 10; const int G = gridDim.x, bid = blockIdx.x;
    const bool split = G > NLONG;
    const int step = split ? (bid < NLONG ? (1 << 28) : G - NLONG) : G;
#pragma unroll 1
    for (int it = bid; it < NLONG + NSHORT; it += step) mixer_item(Ap, lds, l, it);
}

__device__ __forceinline__ float wave_sum64(float v) {
#pragma unroll
    for (int m = 1; m < 64; m <<= 1) v += __shfl_xor(v, m);
    return v;
}
constexpr float DN_ALPHA_ = 1.4142135623730951f;

__device__ __forceinline__ void phase_ln1(ArgP Ap, int l) {
    const int tx = opaque_tid(), lane = tx & 63, wave = tx >> 6, gw = blockIdx.x * NWAVES + wave, NGW = gridDim.x * NWAVES;
    const float* Y = (const float*)(A.ws + WS_ZG); float* H = (float*)(A.ws + WS_H); bf16* H1B = (bf16*)(A.ws + WS_BR);
    const float* lg = A.in[23] + l * D + 16 * lane; const float* lb = A.in[24] + l * D + 16 * lane;
    for (int tok = gw; tok < T; tok += NGW) {
        const float* xr = (l == 0) ? (tok < TP ? A.in[0] + (size_t)tok * D : A.in[1] + (size_t)(tok - TP) * D) : H + (size_t)tok * D;
        float y[16]; float s1 = 0.f;
#pragma unroll
        for (int q = 0; q < 4; ++q) { const float4 a = *(const float4*)(xr + 16 * lane + 4 * q), b = *(const float4*)(Y + (size_t)tok * D + 16 * lane + 4 * q);
            y[4 * q] = DN_ALPHA_ * a.x + b.x; y[4 * q + 1] = DN_ALPHA_ * a.y + b.y; y[4 * q + 2] = DN_ALPHA_ * a.z + b.z; y[4 * q + 3] = DN_ALPHA_ * a.w + b.w; }
#pragma unroll
        for (int i = 0; i < 16; ++i) s1 += y[i];
        const float mu = wave_sum64(s1) * (1.0f / D); float s2 = 0.f;
#pragma unroll
        for (int i = 0; i < 16; ++i) { y[i] -= mu; s2 += y[i] * y[i]; }
        const float rstd = 1.0f / sqrtf(wave_sum64(s2) * (1.0f / D) + EPS_);
#pragma unroll
        for (int i = 0; i < 16; ++i) y[i] = y[i] * rstd * lg[i] + lb[i];
#pragma unroll
        for (int q = 0; q < 4; ++q) *(float4*)(H + (size_t)tok * D + 16 * lane + 4 * q) = make_float4(y[4 * q], y[4 * q + 1], y[4 * q + 2], y[4 * q + 3]);
        float y0[8], y1[8];
#pragma unroll
        for (int i = 0; i < 8; ++i) { y0[i] = y[i]; y1[i] = y[8 + i]; }
        *(u32x4*)(H1B + (size_t)tok * D + 16 * lane) = pack8(y0); *(u32x4*)(H1B + (size_t)tok * D + 16 * lane + 8) = pack8(y1);
    }
    const int gtid = blockIdx.x * NTHREADS + tx, gthreads = gridDim.x * NTHREADS;
    convert_f32_bf16(A.in[27] + (size_t)l * NEXP * D, (bf16*)(A.ws + WS_PU), (size_t)NEXP * D, gtid, gthreads);
    convert_f32_bf16(A.in[28] + (size_t)l * NEXP * D, (bf16*)(A.ws + WS_PV), (size_t)NEXP * D, gtid, gthreads);
}

__device__ __forceinline__ unsigned ord_of(float f) { const unsigned u = __float_as_uint(f); return (u & 0x80000000u) ? ~u : (u | 0x80000000u); }
__device__ __forceinline__ float dec_ord(unsigned o) { const unsigned u = (o & 0x80000000u) ? (o & 0x7fffffffu) : ~o; return __uint_as_float(u); }
__device__ __forceinline__ unsigned umax_(unsigned a, unsigned b) { return a > b ? a : b; }
__device__ __forceinline__ unsigned umin_(unsigned a, unsigned b) { return a < b ? a : b; }
__device__ __forceinline__ void ins16(unsigned (&L)[16], unsigned x) {
#pragma unroll
    for (int p = 0; p < 16; ++p) { const unsigned hi = umax_(L[p], x); x = umin_(L[p], x); L[p] = hi; }
}
__device__ __forceinline__ unsigned sel16(const unsigned (&L)[16], int a) { unsigned r = L[0];
#pragma unroll
    for (int p = 1; p < 16; ++p) r = (a == p) ? L[p] : r;
    return r; }

__device__ __forceinline__ void route_topk(const bf16* __restrict__ Q, const LAS bf16* KEYS, int tokb, int h, int j, int fr, int fq, unsigned (&Lt)[16]) {
    f32x4 acc[8];
#pragma unroll
    for (int ki = 0; ki < 8; ++ki) acc[ki] = (f32x4){0.f, 0.f, 0.f, 0.f};
#pragma unroll
    for (int kk = 0; kk < 4; ++kk) { const bf16x8 bq = *(const bf16x8*)(Q + (size_t)(tokb + fr) * 2048 + h * 256 + j * 128 + 32 * kk + 8 * fq);
#pragma unroll
        for (int ki = 0; ki < 8; ++ki) { const bf16x8 ak = *(const LAS bf16x8*)(KEYS + (j * 128 + 16 * ki + fr) * 136 + 32 * kk + 8 * fq); acc[ki] = mfma16(ak, bq, acc[ki]); } }
#pragma unroll
    for (int p = 0; p < 16; ++p) Lt[p] = 0u;
#pragma unroll
    for (int ki = 0; ki < 8; ++ki)
#pragma unroll
        for (int r = 0; r < 4; ++r) ins16(Lt, (ord_of(acc[ki][r]) & ~127u) | (unsigned)(127 - (16 * ki + 4 * fq + r)));
#pragma unroll
    for (int m = 16; m < 64; m <<= 1) { unsigned R[16];
#pragma unroll
        for (int p = 0; p < 16; ++p) R[p] = __shfl_xor(Lt[p], m);
#pragma unroll
        for (int p = 0; p < 16; ++p) ins16(Lt, R[p]); }
}

__device__ __forceinline__ void phase_route(ArgP Ap, LAS unsigned char* lds, int l) {
    const int tid = opaque_tid(), lane = tid & 63, wave = tid >> 6, fr = lane & 15, fq = lane >> 4;
    LAS bf16* KEYS = (LAS bf16*)lds;
    LAS unsigned* LST = (LAS unsigned*)(lds + 69632);
    const bf16* Q = (const bf16*)(A.ws + WS_Q); int* IDX = (int*)(A.ws + WS_IDX); float* GT = (float*)(A.ws + WS_GT);
    const bf16* kg = (const bf16*)(A.ws + WS_WB + (size_t)l * WB_BYTES + WB_KEYS);
    constexpr int NG = T / 16, NCH = (NG + 7) / 8, NITEMS = NCH * 8;
    int last_h = -1;
    for (int it = blockIdx.x; it < NITEMS; it += gridDim.x) {
        const int h = it & 7, ch = it >> 3;
        if (h != last_h) { __syncthreads();
            for (int c = tid; c < 2 * 128 * 16; c += NTHREADS) { const int row = c >> 4, cc = (c & 15) * 8; *(LAS u32x4*)(KEYS + row * 136 + cc) = *(const u32x4*)(kg + ((size_t)h * 256 + row) * 128 + cc); }
            __syncthreads(); last_h = h; }
        const int grp = ch * 8 + wave;
        if (grp < NG) {
            const int tokb = grp * 16; unsigned L1[16], L2[16];
            route_topk(Q, KEYS, tokb, h, 0, fr, fq, L1); route_topk(Q, KEYS, tokb, h, 1, fr, fq, L2);
            unsigned C[16];
#pragma unroll
            for (int p = 0; p < 16; ++p) C[p] = 0u;
#pragma unroll
            for (int a = 0; a < 16; ++a)
#pragma unroll
                for (int b = 0; b < 16; ++b) if ((a + 1) * (b + 1) <= 16) {
                    const float s = dec_ord(L1[a] & ~127u) + dec_ord(L2[b] & ~127u); ins16(C, (ord_of(s) & ~255u) | (unsigned)(255 - (a * 16 + b))); }
            const float s0 = dec_ord(C[0] & ~255u); float e[16]; float sum = 0.f;
#pragma unroll
            for (int p = 0; p < 16; ++p) { e[p] = __expf(dec_ord(C[p] & ~255u) - s0); sum += e[p]; }
            const float inv = 1.0f / sum; const size_t ob = (size_t)(tokb + fr) * 128 + h * 16;
#pragma unroll
            for (int p = 0; p < 16; ++p) { LST[(wave * 32 + p) * 64 + lane] = L1[p]; LST[(wave * 32 + 16 + p) * 64 + lane] = L2[p]; }
#pragma unroll
            for (int p = 0; p < 16; ++p) { const int cid = 255 - (int)(C[p] & 255u); const int a = cid >> 4, b = cid & 15;
                const int e1 = 127 - (int)(LST[(wave * 32 + a) * 64 + lane] & 127u), e2 = 127 - (int)(LST[(wave * 32 + 16 + b) * 64 + lane] & 127u);
                if ((p >> 2) == fq) { IDX[ob + p] = e1 * 128 + e2; GT[ob + p] = e[p] * inv; } }
        }
    }
}

__device__ __forceinline__ void phase_gather(ArgP Ap, int l) {
    const int tx = opaque_tid(), lane = tx & 63, wave = tx >> 6, gw = blockIdx.x * NWAVES + wave, NGW = gridDim.x * NWAVES;
    float* H = (float*)(A.ws + WS_H); bf16* XB = (bf16*)(A.ws + WS_XB); const int* IDX = (const int*)(A.ws + WS_IDX); const float* GT = (const float*)(A.ws + WS_GT);
    const bf16* PU = (const bf16*)(A.ws + WS_PU); const bf16* PV = (const bf16*)(A.ws + WS_PV);
    const float* lg = A.in[29] + l * D; const float* lb = A.in[30] + l * D;
    for (int tok = gw; tok < T; tok += NGW) {
        float xa[8], xb[8];
        { const float4 a = *(const float4*)(H + (size_t)tok * D + 8 * lane), b = *(const float4*)(H + (size_t)tok * D + 8 * lane + 4);
          const float4 c = *(const float4*)(H + (size_t)tok * D + 512 + 8 * lane), d = *(const float4*)(H + (size_t)tok * D + 512 + 8 * lane + 4);
          xa[0] = a.x; xa[1] = a.y; xa[2] = a.z; xa[3] = a.w; xa[4] = b.x; xa[5] = b.y; xa[6] = b.z; xa[7] = b.w;
          xb[0] = c.x; xb[1] = c.y; xb[2] = c.z; xb[3] = c.w; xb[4] = d.x; xb[5] = d.y; xb[6] = d.z; xb[7] = d.w; }
        const int i0 = IDX[(size_t)tok * 128 + lane], i1 = IDX[(size_t)tok * 128 + 64 + lane]; const float g0 = GT[(size_t)tok * 128 + lane], g1 = GT[(size_t)tok * 128 + 64 + lane];
        float oa[8], ob[8];
#pragma unroll
        for (int i = 0; i < 8; ++i) { oa[i] = 0.f; ob[i] = 0.f; }
        for (int kb = 0; kb < 128; kb += 8) {
            u32x4 ua[8], ub[8], va[8], vb[8]; float gk[8];
#pragma unroll
            for (int kk = 0; kk < 8; ++kk) { const int k = kb + kk; const int e = __shfl(kb < 64 ? i0 : i1, k & 63); gk[kk] = __shfl(kb < 64 ? g0 : g1, k & 63);
                const bf16* ur = PU + (size_t)e * D + 8 * lane; const bf16* vr = PV + (size_t)e * D + 8 * lane;
                ua[kk] = *(const u32x4*)ur; ub[kk] = *(const u32x4*)(ur + 512); va[kk] = *(const u32x4*)vr; vb[kk] = *(const u32x4*)(vr + 512); }
#pragma unroll
            for (int kk = 0; kk < 8; ++kk) { float f[8], g[8]; unpack8(ua[kk], f); unpack8(ub[kk], g); float p = 0.f;
#pragma unroll
                for (int i = 0; i < 8; ++i) p += f[i] * xa[i] + g[i] * xb[i];
                p = wave_sum64(p);
                const float act = 0.5f * p * (1.0f + erff(p * 0.70710678118654752f)) * gk[kk];
                unpack8(va[kk], f); unpack8(vb[kk], g);
#pragma unroll
                for (int i = 0; i < 8; ++i) { oa[i] += act * f[i]; ob[i] += act * g[i]; } }
        }
        float s1 = 0.f;
#pragma unroll
        for (int i = 0; i < 8; ++i) { oa[i] += DN_ALPHA_ * xa[i]; ob[i] += DN_ALPHA_ * xb[i]; s1 += oa[i] + ob[i]; }
        const float mu = wave_sum64(s1) * (1.0f / D); float s2 = 0.f;
#pragma unroll
        for (int i = 0; i < 8; ++i) { oa[i] -= mu; ob[i] -= mu; s2 += oa[i] * oa[i] + ob[i] * ob[i]; }
        const float rstd = 1.0f / sqrtf(wave_sum64(s2) * (1.0f / D) + EPS_);
#pragma unroll
        for (int i = 0; i < 8; ++i) { oa[i] = oa[i] * rstd * lg[8 * lane + i] + lb[8 * lane + i]; ob[i] = ob[i] * rstd * lg[512 + 8 * lane + i] + lb[512 + 8 * lane + i]; }
        float* dst = (l == 1) ? A.out + (size_t)tok * D : H + (size_t)tok * D;
        *(float4*)(dst + 8 * lane) = make_float4(oa[0], oa[1], oa[2], oa[3]); *(float4*)(dst + 8 * lane + 4) = make_float4(oa[4], oa[5], oa[6], oa[7]);
        *(float4*)(dst + 512 + 8 * lane) = make_float4(ob[0], ob[1], ob[2], ob[3]); *(float4*)(dst + 512 + 8 * lane + 4) = make_float4(ob[4], ob[5], ob[6], ob[7]);
        if (l == 0) { *(u32x4*)(XB + (size_t)tok * D + 8 * lane) = pack8(oa); *(u32x4*)(XB + (size_t)tok * D + 512 + 8 * lane) = pack8(ob); }
    }
}

#ifndef EMU
struct MergeOrder {
    pg8::StaticOrder S;
    __device__ bool next(int i, pg8::Unit& u) const { pg8::Unit t; if (!S.next(i / 3, t)) return false; const int n = i % 3; u.pm = n * (T / 256) + t.pm; u.pn = n * 4 + t.pn; return true; }
    __device__ __forceinline__ void a_ready(const pg8::Unit&) const {}
    __device__ __forceinline__ void done(const pg8::Unit&) const {}
};
struct EpiMerge {
    static constexpr bool PERM = true, AFTER_DRAIN = false;
    const bf16* ZG; float* MIXF; bf16* MIXED;
    __device__ __forceinline__ void operator()(const pg8::f32x4 (&acc)[2][2][4][2], const pg8::Unit& u, int wr, int wc, int fr, int fq) const {
        const int n = u.pn >> 2, pn = u.pn & 3, pm = u.pm - n * (T / 256);
        const int row0 = pm * 256 + wr * 64 + fr, col0 = pn * 256 + wc * 32 + 8 * fq;
#pragma unroll
        for (int ai = 0; ai < 2; ++ai)
#pragma unroll
            for (int m = 0; m < 4; ++m) { const size_t row = (size_t)(row0 + ai * 128 + m * 16);
#pragma unroll
                for (int bj = 0; bj < 2; ++bj) { const int col = col0 + bj * 128;
                    float g[8]; unpack8(*(const u32x4*)(ZG + row * NZG + n * D + col), g);
                    float v[8];
#pragma unroll
                    for (int j = 0; j < 4; ++j) { v[j] = acc[ai][bj][m][0][j] * g[j]; v[4 + j] = acc[ai][bj][m][1][j] * g[4 + j]; }
                    float* mp = MIXF + row * D + col;
                    if (n > 0) { const float4 a = *(const float4*)mp, b = *(const float4*)(mp + 4);
                        v[0] += a.x; v[1] += a.y; v[2] += a.z; v[3] += a.w; v[4] += b.x; v[5] += b.y; v[6] += b.z; v[7] += b.w; }
                    if (n < 2) { *(float4*)mp = make_float4(v[0], v[1], v[2], v[3]); *(float4*)(mp + 4) = make_float4(v[4], v[5], v[6], v[7]); }
                    else *(u32x4*)(MIXED + row * D + col) = pack8(v); } }
    }
};
__device__ __forceinline__ void phase_merge(ArgP Ap, LAS unsigned char* lds, int l) {
    pg8::Gemm g{(const bf16*)(A.ws + WS_BR), (const bf16*)(A.ws + WS_WB + (size_t)l * WB_BYTES + WB_WBR), 3 * T, 3 * D, 512};
    MergeOrder S; S.S.init(T, D, gridDim.x, blockIdx.x);
    EpiMerge E{(const bf16*)(A.ws + WS_ZG), (float*)(A.ws + WS_ZM), (bf16*)(A.ws + WS_XB)};
    pg8::gemm_phase<EpiMerge, MergeOrder>(lds, g, S, E);
}
struct EpiF32 {
    static constexpr bool PERM = false, AFTER_DRAIN = false;
    float* C; int ldc;
    __device__ __forceinline__ void operator()(const pg8::f32x4 (&acc)[2][2][4][2], const pg8::Unit& u, int wr, int wc, int fr, int fq) const {
        const int row0 = u.pm * 256 + wr * 64 + fr, col0 = u.pn * 256 + wc * 32 + 4 * fq;
#pragma unroll
        for (int ai = 0; ai < 2; ++ai)
#pragma unroll
            for (int m = 0; m < 4; ++m) { float* rowp = C + (size_t)(row0 + ai * 128 + m * 16) * ldc + col0;
#pragma unroll
                for (int bj = 0; bj < 2; ++bj)
#pragma unroll
                    for (int n = 0; n < 2; ++n) *(pg8::f32x4*)(rowp + bj * 128 + n * 16) = acc[ai][bj][m][n]; }
    }
};
struct EpiB16 {
    static constexpr bool PERM = true, AFTER_DRAIN = false;
    bf16* O; int ldc;
    __device__ __forceinline__ void operator()(const pg8::f32x4 (&acc)[2][2][4][2], const pg8::Unit& u, int wr, int wc, int fr, int fq) const {
        const int row0 = u.pm * 256 + wr * 64 + fr, col0 = u.pn * 256 + wc * 32 + 8 * fq;
#pragma unroll
        for (int ai = 0; ai < 2; ++ai)
#pragma unroll
            for (int m = 0; m < 4; ++m) { bf16* rowp = O + (size_t)(row0 + ai * 128 + m * 16) * ldc + col0;
#pragma unroll
                for (int bj = 0; bj < 2; ++bj) { const pg8::f32x4 v0 = acc[ai][bj][m][0], v1 = acc[ai][bj][m][1];
                    u32x4 w; w.x = pg8::cvt_pk_bf16(v0[0], v0[1]); w.y = pg8::cvt_pk_bf16(v0[2], v0[3]); w.z = pg8::cvt_pk_bf16(v1[0], v1[1]); w.w = pg8::cvt_pk_bf16(v1[2], v1[3]);
                    *(u32x4*)(rowp + bj * 128) = w; } }
    }
};
__device__ __forceinline__ void phase_outproj(ArgP Ap, LAS unsigned char* lds, int l) {
    pg8::Gemm g{(const bf16*)(A.ws + WS_XB), (const bf16*)(A.ws + WS_WB + (size_t)l * WB_BYTES + WB_WO), T, D, D};
    pg8::StaticOrder S; S.init(T, D, gridDim.x, blockIdx.x);
    EpiF32 E{(float*)(A.ws + WS_ZG), D};
    pg8::gemm_phase<EpiF32, pg8::StaticOrder>(lds, g, S, E);
}
__device__ __forceinline__ void phase_qproj(ArgP Ap, LAS unsigned char* lds, int l) {
    pg8::Gemm g{(const bf16*)(A.ws + WS_BR), (const bf16*)(A.ws + WS_WB + (size_t)l * WB_BYTES + WB_WQ), T, 2048, D};
    pg8::StaticOrder S; S.init(T, 2048, gridDim.x, blockIdx.x);
    EpiB16 E{(bf16*)(A.ws + WS_Q), 2048};
    pg8::gemm_phase<EpiB16, pg8::StaticOrder>(lds, g, S, E);
}

__global__ void __launch_bounds__(NTHREADS, 2) mega_fwd(Args kargs) {
    extern __shared__ __attribute__((aligned(16))) unsigned char lds_raw[];
    LAS unsigned char* lds = (LAS unsigned char*)lds_raw;
    cg::grid_group grid = cg::this_grid();
    volatile LAS unsigned* xst = (volatile LAS unsigned*)(lds + LDS_BYTES - 16);
    unsigned* xbar = (unsigned*)(kargs.ws + WS_CTL);
    if (threadIdx.x < 4) xst[threadIdx.x] = 0u;
    if (blockIdx.x == 0) for (int i = threadIdx.x; i < XCD_BAR_WORDS; i += NTHREADS) xbar[i] = 0u;
    __syncthreads();
    XcdBarrier xb; xb.bar = xbar; xb.x = 0; xb.st = xst; bool xposted = false;
    ArgP Ap = (ArgP)__builtin_amdgcn_kernarg_segment_ptr();
    const int lo = A.ph_lo, hi = A.ph_hi;
#define RUN(call) do { ArgP Ap_ = Ap; int l_ = l; asm volatile("" : "+s"(Ap_), "+s"(l_) :: "memory"); { ArgP Ap = Ap_; const int l = l_; call; } asm volatile("" ::: "memory"); } while (0)
#ifndef ONLYP
#define ONLYP -1
#endif
#define PSEL(q) (ONLYP < 0 || ONLYP == (q))
#ifndef REPMASK
#define REPMASK 0
#endif
#define REP(q, l) (((REPMASK >> (q)) & 1) && ((q) != 5 || (l) == 0) && ((q) != 8 || (l) == 1))
#define IN(k) (lo <= (k) && (k) < hi)
#define SEAM(k) do { if (IN(k) && IN((k) + 1)) { if (!xposted) { grid.sync(); xb = xcd_barrier_post(xbar, xst); xposted = true; } else xcd_barrier(xb); } } while (0)
    { const int l = 0; if (PSEL(0) && IN(0)) { RUN(phase_convert(Ap, lds)); if (REP(0, l)) RUN(phase_convert(Ap, lds)); } (void)l; }
    SEAM(0);
    for (int l = 0; l < 2; ++l) {
        const int p = 1 + 8 * l;
        if (PSEL(1) && IN(p + 0)) { RUN(phase_gemm1(Ap, lds, l)); if (REP(1, l)) RUN(phase_gemm1(Ap, lds, l)); }
        SEAM(p);
        if (PSEL(2) && IN(p + 1)) { RUN(phase_mixers(Ap, lds, l)); if (REP(2, l)) RUN(phase_mixers(Ap, lds, l)); }
        SEAM(p + 1);
        if (PSEL(3) && IN(p + 2)) { RUN(phase_merge(Ap, lds, l)); if (REP(3, l)) RUN(phase_merge(Ap, lds, l)); }
        SEAM(p + 2);
        if (PSEL(4) && IN(p + 3)) { RUN(phase_outproj(Ap, lds, l)); if (REP(4, l)) RUN(phase_outproj(Ap, lds, l)); }
        SEAM(p + 3);
        if (PSEL(5) && IN(p + 4)) { RUN(phase_ln1(Ap, l)); if (REP(5, l)) RUN(phase_ln1(Ap, l)); }
        SEAM(p + 4);
        if (PSEL(6) && IN(p + 5)) { RUN(phase_qproj(Ap, lds, l)); if (REP(6, l)) RUN(phase_qproj(Ap, lds, l)); }
        SEAM(p + 5);
        if (PSEL(7) && IN(p + 6)) { RUN(phase_route(Ap, lds, l)); if (REP(7, l)) RUN(phase_route(Ap, lds, l)); }
        SEAM(p + 6);
        if (PSEL(8) && IN(p + 7)) { RUN(phase_gather(Ap, l)); if (REP(8, l)) RUN(phase_gather(Ap, l)); }
        SEAM(p + 7);
    }
#undef IN
#undef RUN
#undef SEAM
}

extern "C" void kernel_launch(void* const* d_in, const int* in_sizes, int n_in, void* d_out, int out_size, void* d_ws, size_t ws_size, hipStream_t stream) {
    static int grid_blocks = 0;
    if (grid_blocks == 0) {
        if (n_in != 31 || (size_t)out_size != O_END || ws_size < WS_END) {
            fprintf(stderr, "kernel_launch: unexpected problem: n_in %d out %d (want %zu) ws %zu (want >= %zu)\n", n_in, out_size, (size_t)O_END, ws_size, (size_t)WS_END); grid_blocks = -1; return; }
        int dev = 0, cus = 0, per_cu = 0;
        (void)hipGetDevice(&dev); (void)hipDeviceGetAttribute(&cus, hipDeviceAttributeMultiprocessorCount, dev);
        if (hipFuncSetAttribute((const void*)mega_fwd, hipFuncAttributeMaxDynamicSharedMemorySize, LDS_BYTES) != hipSuccess) { fprintf(stderr, "kernel_launch: hipFuncSetAttribute failed\n"); grid_blocks = -1; return; }
        if (hipOccupancyMaxActiveBlocksPerMultiprocessor(&per_cu, (const void*)mega_fwd, NTHREADS, LDS_BYTES) != hipSuccess || per_cu < 1) { fprintf(stderr, "kernel_launch: occupancy query failed (%d)\n", per_cu); grid_blocks = -1; return; }
        grid_blocks = cus * per_cu;
        fprintf(stderr, "kernel_launch: %d CUs x %d = %d workgroups\n", cus, per_cu, grid_blocks);
    }
    if (grid_blocks < 0) return;
    Args a{};
    for (int i = 0; i < 31; ++i) a.in[i] = (const float*)d_in[i];
    a.out = (float*)d_out; a.ws = (unsigned char*)d_ws; a.ph_lo = 0; a.ph_hi = 64;
    void* args[] = {&a};
    hipError_t e = hipLaunchCooperativeKernel((const void*)mega_fwd, dim3(grid_blocks), dim3(NTHREADS), args, LDS_BYTES, stream);
    if (e != hipSuccess) fprintf(stderr, "kernel_launch: cooperative launch failed: %s (grid %d)\n", hipGetErrorString(e), grid_blocks);
}
#endif
```

```cpp
#ifndef EMU
#include <hip/hip_runtime.h>
#include <hip/hip_cooperative_groups.h>
#include <cstdio>
#include <cstdint>
namespace cg = cooperative_groups;
namespace pg8 {
#define PG8_LAS __attribute__((address_space(3)))
typedef unsigned short bf16_t;
typedef short bf16x8 __attribute__((ext_vector_type(8)));
typedef float f32x4 __attribute__((ext_vector_type(4)));
typedef unsigned u32x4 __attribute__((ext_vector_type(4)));
constexpr int BM = 256, BK = 64, HALF = 128, HTB = HALF * BK * 2  , STAGE_BYTES = 8 * HTB, NXCD = 8, WGM = 8;

__host__ __device__ __forceinline__ int lds_byte(int r, int c) { const int st = (r >> 4) * 2 + (c >> 5), rr = r & 15, cc = c & 31, ob = rr * 64 + cc * 2; return st * 1024 + (ob ^ (((ob >> 9) & 1) << 5)); }
__host__ __device__ __forceinline__ void stage_rc(int b, int& R, int& C) { const int st = b / 1024, sb = b % 1024, swz = sb ^ (((sb >> 9) & 1) << 5); R = (st >> 1) * 16 + swz / 64; C = (st & 1) * 32 + (swz % 64) / 2; }
__host__ __device__ __forceinline__ int perm32(int rho) { const int n = rho >> 4, i = rho & 15; return 8 * (i >> 2) + 4 * n + (i & 3); }

struct Unit { int pm, pn; };
struct Gemm { const bf16_t* A; const bf16_t* Bt; int M, N, K; };

struct StaticOrder {
    int nM, nN, nwg, G, c;
    __host__ __device__ void init(int M, int N, int G_, int c_) { nM = M / BM; nN = N / BM; nwg = nM * nN; G = G_; c = c_; }
    __host__ __device__ bool next(int i, Unit& u) const {
        const long L = (long)i * G + c; if (L >= nwg) return false;
        int wgid = (int)L; { const int q = nwg / NXCD, r = nwg % NXCD, xcd = wgid % NXCD, off = wgid / NXCD; wgid = (xcd < r ? xcd * (q + 1) : r * (q + 1) + (xcd - r) * q) + off; }
        const int nig = WGM * nN, gid = wgid / nig, fm = gid * WGM, gsz = (nM - fm) < WGM ? (nM - fm) : WGM;
        u.pm = fm + ((wgid % nig) % gsz); u.pn = (wgid % nig) / gsz; return true;
    }
    __device__ __forceinline__ void a_ready(const Unit&) const {}
    __device__ __forceinline__ void done(const Unit&) const {}
};

__device__ __forceinline__ unsigned cvt_pk_bf16(float lo, float hi) { unsigned r; asm volatile("v_cvt_pk_bf16_f32 %0, %1, %2" : "=v"(r) : "v"(lo), "v"(hi)); return r; }
typedef float f32x2 __attribute__((ext_vector_type(2)));
__device__ __forceinline__ f32x2 gelu_pk(f32x2 v) {
    const f32x2 av = __builtin_elementwise_abs(v), d = av * 0.2316418882f + 1.0f;
    f32x2 t; t.x = __builtin_amdgcn_rcpf(d.x); t.y = __builtin_amdgcn_rcpf(d.y);
    f32x2 q = t * 0.5307027145f + (-0.7265760135f); q = q * t + 0.7107068705f; q = q * t + (-0.142248368f); q = q * t + 0.127414796f; q = q * t;
    const f32x2 s = (v * v) * (-0.72134752044f);
    f32x2 e; e.x = __builtin_amdgcn_exp2f(s.x); e.y = __builtin_amdgcn_exp2f(s.y);
    const f32x2 m = v * (q * e), r = v - m;
    f32x2 o; o.x = v.x < 0.f ? m.x : r.x; o.y = v.y < 0.f ? m.y : r.y; return o;
}

template <class Epi, class Sched>
__device__ __forceinline__ void gemm_phase(PG8_LAS unsigned char* lds, const Gemm g, const Sched& S, const Epi& E) {
    int tid_o = threadIdx.x; asm volatile("" : "+v"(tid_o));
    const int tid = tid_o, wid = __builtin_amdgcn_readfirstlane(tid >> 6), lane = tid & 63, wr = wid >> 2, wc = wid & 3, fr = lane & 15, fq = lane >> 4;
    const int K = g.K, nt = K / BK;
    unsigned voffA[2], voffB[2];
#pragma unroll
    for (int i = 0; i < 2; ++i) { int R, C; stage_rc(tid * 16 + i * 8192, R, C); const int Rb = Epi::PERM ? ((R & ~31) + perm32(R & 31)) : R;
        voffA[i] = (unsigned)(R * K + C) * 2u; voffB[i] = (unsigned)(Rb * K + C) * 2u; }
    const size_t kstep = (size_t)(BK * 2);
    const size_t hstep = (size_t)HALF * K * 2;
    const size_t tstep = 2 * hstep;
    const unsigned ldsw = (unsigned)wid * 1024u;
    const int aoff = lds_byte(wr * 64 + fr, fq * 8), boff = lds_byte(wc * 32 + fr, fq * 8);
#define PG8_SA(b, h) (((b) * 2 + (h)) * HTB)
#define PG8_SB(b, h) ((4 + (b) * 2 + (h)) * HTB)
#define PG8_STAGE(bufoff, gbase, voff) do { _Pragma("unroll") for (int _i = 0; _i < 2; ++_i) \
        __builtin_amdgcn_global_load_lds((const unsigned*)((const char*)(gbase) + (voff)[_i]), (PG8_LAS unsigned*)(lds + (bufoff) + ldsw + _i * 8192), 16, 0, 0); } while (0)
#define PG8_LDA(dst, b, h) do { _Pragma("unroll") for (int m = 0; m < 4; ++m) _Pragma("unroll") for (int k = 0; k < 2; ++k) dst[m][k] = *(const PG8_LAS bf16x8*)(lds + PG8_SA(b, h) + aoff + m * 2048 + k * 1024); } while (0)
#define PG8_LDB(dst, b, h) do { _Pragma("unroll") for (int n = 0; n < 2; ++n) _Pragma("unroll") for (int k = 0; k < 2; ++k) dst[n][k] = *(const PG8_LAS bf16x8*)(lds + PG8_SB(b, h) + boff + n * 2048 + k * 1024); } while (0)
#define PG8_MMA(ai, bj, At, Bt) do { __builtin_amdgcn_s_setprio(1); _Pragma("unroll") for (int m = 0; m < 4; ++m) _Pragma("unroll") for (int n = 0; n < 2; ++n) _Pragma("unroll") for (int k = 0; k < 2; ++k) \
        acc[ai][bj][m][n] = __builtin_amdgcn_mfma_f32_16x16x32_bf16(Bt[n][k], At[m][k], acc[ai][bj][m][n], 0, 0, 0); __builtin_amdgcn_s_setprio(0); } while (0)
#define PG8_WAIT_V(n) asm volatile("s_waitcnt vmcnt(" #n ")" ::: "memory")
#define PG8_WAIT_L(n) asm volatile("s_waitcnt lgkmcnt(" #n ")" ::: "memory")
#define PG8_BAR __builtin_amdgcn_s_barrier()
#define PG8_SCHED __builtin_amdgcn_sched_barrier(0)
    Unit cur, nxt; int ui = 0;
    if (!S.next(0, cur)) return;
    f32x4 acc[2][2][4][2];
#pragma unroll
    for (int a = 0; a < 2; ++a)
#pragma unroll
        for (int b = 0; b < 2; ++b)
#pragma unroll
            for (int m = 0; m < 4; ++m)
#pragma unroll
                for (int n = 0; n < 2; ++n) acc[a][b][m][n] = (f32x4){0.f, 0.f, 0.f, 0.f};
    bf16x8 At[4][2], B0[2][2], B1[2][2];
    const char* cA = (const char*)g.A + (size_t)cur.pm * tstep; const char* cB = (const char*)g.Bt + (size_t)cur.pn * tstep;
    S.a_ready(cur);
    PG8_STAGE(PG8_SB(0, 0), cB, voffB); PG8_STAGE(PG8_SA(0, 0), cA, voffA); PG8_STAGE(PG8_SB(0, 1), cB + hstep, voffB); PG8_STAGE(PG8_SA(0, 1), cA + hstep, voffA);
    if (wr == 1) PG8_BAR;
    PG8_WAIT_V(4); PG8_BAR;
    PG8_STAGE(PG8_SB(1, 0), cB + kstep, voffB); PG8_STAGE(PG8_SA(1, 0), cA + kstep, voffA); PG8_STAGE(PG8_SB(1, 1), cB + hstep + kstep, voffB);
    PG8_WAIT_V(6); PG8_BAR;
    for (;;) {
        const bool has_next = S.next(ui + 1, nxt);
        const char* nA = has_next ? (const char*)g.A + (size_t)nxt.pm * tstep : cA; const char* nB = has_next ? (const char*)g.Bt + (size_t)nxt.pn * tstep : cB;
        for (int t = 0; t < nt; t += 2) {
            const bool last = (t == nt - 2);
            const char* a1 = cA + (size_t)(t + 1) * kstep;
            const char* a2 = last ? nA : cA + (size_t)(t + 2) * kstep; const char* b2 = last ? nB : cB + (size_t)(t + 2) * kstep;
            const char* a3 = a2 + kstep; const char* b3 = b2 + kstep;
            if (last && has_next) S.a_ready(nxt);
            PG8_LDB(B0, 0, 0); PG8_SCHED; PG8_LDA(At, 0, 0); PG8_STAGE(PG8_SA(1, 1), a1 + hstep, voffA);
            PG8_WAIT_L(8); PG8_BAR; PG8_WAIT_L(0); PG8_MMA(0, 0, At, B0); PG8_BAR; PG8_SCHED;
            PG8_LDB(B1, 0, 1); PG8_STAGE(PG8_SB(0, 0), b2, voffB);
            PG8_BAR; PG8_WAIT_L(0); PG8_MMA(0, 1, At, B1); PG8_BAR;
            PG8_LDA(At, 0, 1); PG8_STAGE(PG8_SA(0, 0), a2, voffA);
            PG8_BAR; PG8_WAIT_L(0); PG8_MMA(1, 0, At, B0); PG8_BAR; PG8_SCHED;
            PG8_STAGE(PG8_SB(0, 1), b2 + hstep, voffB);
            PG8_WAIT_V(6); PG8_BAR; PG8_MMA(1, 1, At, B1); PG8_BAR;
            PG8_LDB(B0, 1, 0); PG8_SCHED; PG8_LDA(At, 1, 0); PG8_STAGE(PG8_SA(0, 1), a2 + hstep, voffA);
            PG8_WAIT_L(8); PG8_BAR; PG8_WAIT_L(0); PG8_MMA(0, 0, At, B0); PG8_BAR; PG8_SCHED;
            PG8_LDB(B1, 1, 1); PG8_STAGE(PG8_SB(1, 0), b3, voffB);
            PG8_BAR; PG8_WAIT_L(0); PG8_MMA(0, 1, At, B1); PG8_BAR;
            PG8_LDA(At, 1, 1); PG8_STAGE(PG8_SA(1, 0), a3, voffA);
            PG8_BAR; PG8_WAIT_L(0); PG8_MMA(1, 0, At, B0); PG8_BAR; PG8_SCHED;
            PG8_STAGE(PG8_SB(1, 1), b3 + hstep, voffB);
            PG8_WAIT_V(6); PG8_BAR; PG8_MMA(1, 1, At, B1); PG8_BAR;
        }
        if constexpr (!Epi::AFTER_DRAIN) { E(acc, cur, wr, wc, fr, fq); S.done(cur); }
        if (!has_next) break;
#pragma unroll
        for (int a = 0; a < 2; ++a)
#pragma unroll
            for (int b = 0; b < 2; ++b)
#pragma unroll
                for (int m = 0; m < 4; ++m)
#pragma unroll
                    for (int n = 0; n < 2; ++n) acc[a][b][m][n] = (f32x4){0.f, 0.f, 0.f, 0.f};
        cur = nxt; cA = nA; cB = nB; ++ui;
    }
    PG8_WAIT_V(0);
    if (wr == 0) PG8_BAR;
    PG8_BAR;
    if constexpr (Epi::AFTER_DRAIN) { E.fused(acc, cur, wr, wc, fr, fq, lds, wid, lane); S.done(cur); }
#undef PG8_SA
#undef PG8_SB
#undef PG8_STAGE
#undef PG8_LDA
#undef PG8_LDB
#undef PG8_MMA
#undef PG8_WAIT_V
#undef PG8_WAIT_L
#undef PG8_BAR
#undef PG8_SCHED
}
}

#endif

typedef unsigned short bf16;
#ifndef EMU
#define LAS __attribute__((address_space(3)))
#else
#define LAS
#endif
typedef short bf16x8 __attribute__((ext_vector_type(8)));
typedef float f32x4 __attribute__((ext_vector_type(4)));
typedef unsigned u32x4 __attribute__((ext_vector_type(4)));
typedef unsigned u32x2 __attribute__((ext_vector_type(2)));

#ifdef EMU
constexpr int BP = EMU_BP, LP = EMU_LP, BS = EMU_BS;
#else
constexpr int BP = 8, LP = 2048, BS = 128;
#endif
constexpr int D = 1024, LS = 4, TP = BP * LP, TS = BS * LS, T = TP + TS;
constexpr int INW = 7968, NZM = 4864, NZG = 3072, NZ = NZM + NZG, NSM = 32;
constexpr int NEXP = 16384;
constexpr int NTHREADS = 512, NWAVES = 8;
constexpr int LDS_BYTES = 160 * 1024;

constexpr size_t O_YP = 0, O_YS = O_YP + (size_t)TP * D, O_PC = O_YS + (size_t)TS * D, O_PN = O_PC + 2ull * BP * 4 * 128 * 128, O_PM = O_PN + 2ull * BP * 4 * 128,
    O_PG = O_PM + 2ull * BP * 4, O_PH = O_PG + 2ull * BP * 4 * 64 * 128, O_PV = O_PH + 2ull * BP * 8 * 64 * 64, O_SC = O_PV + 2ull * BP * 3 * 768,
    O_SN = O_SC + 2ull * BS * 4 * 128 * 128, O_SM = O_SN + 2ull * BS * 4 * 128, O_SG = O_SM + 2ull * BS * 4, O_SH = O_SG + 2ull * BS * 4 * 64 * 128,
    O_SV = O_SH + 2ull * BS * 8 * 64 * 64, O_END = O_SV + 2ull * BS * 3 * 768;

constexpr size_t al256(size_t x) { return (x + 255) & ~(size_t)255; }
constexpr size_t WS_CTL = 0, WS_CTL_BYTES = 65536;
constexpr size_t WB_WIN = 0, WB_WS = WB_WIN + (size_t)NZ * D * 2, WB_WBR = WB_WS + (size_t)NSM * D * 2, WB_WO = WB_WBR + 3ull * D * 512 * 2, WB_WQ = WB_WO + (size_t)D * D * 2,
    WB_KEYS = WB_WQ + 2048ull * D * 2, WB_BYTES = WB_KEYS + 16ull * 128 * 128 * 2;
constexpr size_t WS_WB = WS_CTL + WS_CTL_BYTES;
constexpr size_t WS_XB = WS_WB + 2 * WB_BYTES;
constexpr size_t WS_H = WS_XB + (size_t)T * D * 2;
constexpr size_t WS_ZS = WS_H + (size_t)T * D * 4;
constexpr size_t WS_BR = WS_ZS + (size_t)T * NSM * 4;
constexpr size_t WS_ZM = WS_BR + 3ull * T * 512 * 2;
constexpr size_t WS_ZG = WS_ZM + (size_t)T * NZM * 2;
constexpr size_t WS_END0 = WS_ZG + (size_t)T * NZG * 2;
constexpr size_t WS_Q = WS_ZM, WS_IDX = WS_Q + (size_t)T * 2048 * 2, WS_GT = WS_IDX + (size_t)T * 128 * 4;
#ifdef EMU
constexpr size_t WS_PU = WS_END0, WS_PV = WS_PU + (size_t)NEXP * D * 2, WS_END = WS_PV + (size_t)NEXP * D * 2;
#else
constexpr size_t WS_PU = WS_GT + (size_t)T * 128 * 4, WS_PV = WS_PU + (size_t)NEXP * D * 2, WS_ZM_END = WS_PV + (size_t)NEXP * D * 2, WS_END = WS_END0;
static_assert(WS_ZM_END <= WS_ZG, "ZM alias overflow");
#endif
static_assert((size_t)T * D * 4 <= (size_t)T * NZG * 2, "Y alias overflow");

#ifndef EMU
__device__ __forceinline__ f32x4 mfma16(bf16x8 a, bf16x8 b, f32x4 c) { return __builtin_amdgcn_mfma_f32_16x16x32_bf16(a, b, c, 0, 0, 0); }
#endif
struct Args { const float* in[31]; float* out; unsigned char* ws; int ph_lo, ph_hi; };
#ifndef EMU
typedef const __attribute__((address_space(4))) Args* ArgP;
#else
typedef const Args* ArgP;
#endif
#define A (*Ap)
#ifndef EMU
#define OPQV(x) asm volatile("" : "+v"(x))
#define LDS_BARRIER() asm volatile("s_waitcnt lgkmcnt(0)\n\ts_barrier" ::: "memory")
#else
#define OPQV(x) (void)(x)
#define LDS_BARRIER() __syncthreads()
#endif
#ifndef EMU
__device__ __forceinline__ int opaque_tid() { int t = threadIdx.x; asm volatile("" : "+v"(t)); return t; }
#else
static inline int opaque_tid() { return threadIdx.x; }
#endif

__device__ __forceinline__ bf16 f2bf(float f) { unsigned u = __float_as_uint(f); u += 0x7FFFu + ((u >> 16) & 1u); return (bf16)(u >> 16); }
__device__ __forceinline__ float bf2f(bf16 b) { return __uint_as_float(((unsigned)b) << 16); }
__device__ __forceinline__ unsigned pk2(float lo, float hi) { return (unsigned)f2bf(lo) | ((unsigned)f2bf(hi) << 16); }

__device__ __forceinline__ void tconv_tile(const float* __restrict__ src, int ldsrc, int k0, int c0, bf16* __restrict__ dst, int ldd, int n0, LAS float* tile) {
    const int t = opaque_tid(), i = t >> 3, jg = (t & 7) * 8;
    const float4 a = *(const float4*)(src + (size_t)(k0 + i) * ldsrc + c0 + jg), b = *(const float4*)(src + (size_t)(k0 + i) * ldsrc + c0 + jg + 4);
    LAS float* r = tile + i * 65 + jg;
    r[0] = a.x; r[1] = a.y; r[2] = a.z; r[3] = a.w; r[4] = b.x; r[5] = b.y; r[6] = b.z; r[7] = b.w;
    __syncthreads();
    const int j = t >> 3, ig = (t & 7) * 8;
    u32x4 w;
    w.x = pk2(tile[(ig + 0) * 65 + j], tile[(ig + 1) * 65 + j]); w.y = pk2(tile[(ig + 2) * 65 + j], tile[(ig + 3) * 65 + j]);
    w.z = pk2(tile[(ig + 4) * 65 + j], tile[(ig + 5) * 65 + j]); w.w = pk2(tile[(ig + 6) * 65 + j], tile[(ig + 7) * 65 + j]);
    *(u32x4*)(dst + (size_t)(n0 + j) * ldd + k0 + ig) = w;
    __syncthreads();
}
__device__ __forceinline__ int zcol_to_src(int zc) { return zc < 2048 ? zc : (zc < 3584 ? zc + 8 : (zc < 4864 ? zc + 24 : zc + 32)); }
__device__ __forceinline__ int scol_to_src(int sc) { return sc < 8 ? 2048 + sc : (sc < 24 ? 3592 + (sc - 8) : 4888 + (sc - 24)); }

__device__ __forceinline__ void convert_f32_bf16(const float* __restrict__ src, bf16* __restrict__ dst, size_t n, int gtid, int gthreads) {
    for (size_t i = (size_t)gtid * 8; i < n; i += (size_t)gthreads * 8) {
        const float4 a = *(const float4*)(src + i), b = *(const float4*)(src + i + 4);
        u32x4 w; w.x = pk2(a.x, a.y); w.y = pk2(a.z, a.w); w.z = pk2(b.x, b.y); w.w = pk2(b.z, b.w);
        *(u32x4*)(dst + i) = w;
    }
}

__device__ __forceinline__ void phase_convert(ArgP Ap, LAS unsigned char* lds) {
    LAS float* tile = (LAS float*)lds;
    const int G = gridDim.x, bid = blockIdx.x;
    constexpr int I_WIN = (NZ / 64) * (D / 64), I_WBR = 3 * (D / 64) * (512 / 64), I_WO = (D / 64) * (D / 64), I_WQ = (2048 / 64) * (D / 64), I_L = I_WIN + I_WBR + I_WO + I_WQ;
    for (int it = bid; it < 2 * I_L; it += G) {
        const int l = it / I_L; int r = it % I_L;
        unsigned char* wb = A.ws + WS_WB + (size_t)l * WB_BYTES;
        if (r < I_WIN) { const int nt = r / (D / 64), kt = r % (D / 64);
            tconv_tile(A.in[8] + (size_t)l * D * INW, INW, kt * 64, zcol_to_src(nt * 64), (bf16*)(wb + WB_WIN), D, nt * 64, tile); continue; }
        r -= I_WIN;
        if (r < I_WBR) { const int n = r / ((D / 64) * 8), rr = r % ((D / 64) * 8), nt = rr / 8, kt = rr % 8;
            tconv_tile(A.in[21] + ((size_t)l * 3 + n) * 512 * D, D, kt * 64, nt * 64, (bf16*)(wb + WB_WBR) + (size_t)n * D * 512, 512, nt * 64, tile); continue; }
        r -= I_WBR;
        if (r < I_WO) { const int nt = r / (D / 64), kt = r % (D / 64);
            tconv_tile(A.in[22] + (size_t)l * D * D, D, kt * 64, nt * 64, (bf16*)(wb + WB_WO), D, nt * 64, tile); continue; }
        r -= I_WO;
        { const int nt = r / (D / 64), kt = r % (D / 64);
            tconv_tile(A.in[25] + (size_t)l * D * 2048, 2048, kt * 64, nt * 64, (bf16*)(wb + WB_WQ), D, nt * 64, tile); }
    }
    const int gtid = bid * NTHREADS + opaque_tid(), gthreads = G * NTHREADS;
    for (int l = 0; l < 2; ++l) {
        unsigned char* wb = A.ws + WS_WB + (size_t)l * WB_BYTES;
        for (int e = gtid; e < NSM * D; e += gthreads) { const int n = e / D, k = e % D; ((bf16*)(wb + WB_WS))[e] = f2bf(A.in[8][(size_t)l * D * INW + (size_t)k * INW + scol_to_src(n)]); }
        convert_f32_bf16(A.in[26] + (size_t)l * 16 * 128 * 128, (bf16*)(wb + WB_KEYS), 16 * 128 * 128, gtid, gthreads);
    }
    convert_f32_bf16(A.in[0], (bf16*)(A.ws + WS_XB), (size_t)TP * D, gtid, gthreads);
    convert_f32_bf16(A.in[1], (bf16*)(A.ws + WS_XB) + (size_t)TP * D, (size_t)TS * D, gtid, gthreads);
}

#ifndef EMU
struct EpiZ {
    static constexpr bool PERM = true, AFTER_DRAIN = false;
    bf16* ZM; bf16* ZG;
    __device__ __forceinline__ void operator()(const pg8::f32x4 (&acc)[2][2][4][2], const pg8::Unit& u, int wr, int wc, int fr, int fq) const {
        const int row0 = u.pm * 256 + wr * 64 + fr; const bool gate = u.pn >= 19;
        bf16* base = gate ? ZG : ZM; const int ldc = gate ? NZG : NZM; const int col0 = (gate ? (u.pn - 19) : u.pn) * 256 + wc * 32 + 8 * fq;
#pragma unroll
        for (int ai = 0; ai < 2; ++ai)
#pragma unroll
            for (int m = 0; m < 4; ++m) { bf16* rowp = base + (size_t)(row0 + ai * 128 + m * 16) * ldc + col0;
#pragma unroll
                for (int bj = 0; bj < 2; ++bj) { f32x4 v0 = acc[ai][bj][m][0], v1 = acc[ai][bj][m][1];
                    if (gate) {
#pragma unroll
                        for (int j = 0; j < 4; ++j) { v0[j] = __builtin_amdgcn_rcpf(1.0f + __expf(-v0[j])); v1[j] = __builtin_amdgcn_rcpf(1.0f + __expf(-v1[j])); } }
                    u32x4 w; w.x = pg8::cvt_pk_bf16(v0[0], v0[1]); w.y = pg8::cvt_pk_bf16(v0[2], v0[3]); w.z = pg8::cvt_pk_bf16(v1[0], v1[1]); w.w = pg8::cvt_pk_bf16(v1[2], v1[3]);
                    *(u32x4*)(rowp + bj * 128) = w; } }
    }
};

#endif
__device__ __forceinline__ void small_gemm(const bf16* __restrict__ XB, const bf16* __restrict__ WsT, float* __restrict__ ZS) {
    const int tx = opaque_tid(), lane = tx & 63, wave = tx >> 6, gw = blockIdx.x * NWAVES + wave, NGW = gridDim.x * NWAVES, fr = lane & 15, fq = lane >> 4;
    for (int rg = gw; rg < T / 16; rg += NGW) {
        f32x4 a0 = {0.f, 0.f, 0.f, 0.f}, a1 = {0.f, 0.f, 0.f, 0.f};
        const bf16* ap = XB + (size_t)(rg * 16 + fr) * D + 8 * fq; const bf16* b0p = WsT + (size_t)fr * D + 8 * fq; const bf16* b1p = WsT + (size_t)(16 + fr) * D + 8 * fq;
#pragma unroll 4
        for (int k0 = 0; k0 < D; k0 += 32) {
            const bf16x8 a = *(const bf16x8*)(ap + k0), b0 = *(const bf16x8*)(b0p + k0), b1 = *(const bf16x8*)(b1p + k0);
            a0 = mfma16(a, b0, a0); a1 = mfma16(a, b1, a1);
        }
#pragma unroll
        for (int r = 0; r < 4; ++r) { float* o = ZS + (size_t)(rg * 16 + fq * 4 + r) * NSM + fr; o[0] = a0[r]; o[16] = a1[r]; }
    }
}

#ifndef EMU
__device__ __forceinline__ void phase_gemm1(ArgP Ap, LAS unsigned char* lds, int l) {
    unsigned char* wb = A.ws + WS_WB + (size_t)l * WB_BYTES;
    pg8::Gemm g{(const bf16*)(A.ws + WS_XB), (const bf16*)(wb + WB_WIN), T, NZ, D};
    pg8::StaticOrder S; S.init(T, NZ, gridDim.x, blockIdx.x);
    EpiZ E{(bf16*)(A.ws + WS_ZM), (bf16*)(A.ws + WS_ZG)};
    pg8::gemm_phase<EpiZ, pg8::StaticOrder>(lds, g, S, E);
    small_gemm((const bf16*)(A.ws + WS_XB), (const bf16*)(wb + WB_WS), (float*)(A.ws + WS_ZS));
}
#endif

#ifndef EMU
#define XB_TMO      128
#define XB_XCNT(j)  (256  + 64 * (j))
#define XB_XSUB(j)  (1280 + 64 * (j))
#define XB_XGEN(j)  (2304 + 64 * (j))
#define XB_TOP      3328
#define XB_TOPGEN   3392
#define XCD_BAR_WORDS 3456
#define XB_SPIN_CAP (1u << 18)

__device__ __forceinline__ unsigned xb_ld(unsigned* p)              { return __hip_atomic_load(p, __ATOMIC_RELAXED, __HIP_MEMORY_SCOPE_AGENT); }
__device__ __forceinline__ unsigned xb_add(unsigned* p, unsigned v) { return __hip_atomic_fetch_add(p, v, __ATOMIC_RELAXED, __HIP_MEMORY_SCOPE_AGENT); }
__device__ __forceinline__ unsigned xb_xcc_id() { return (unsigned)__builtin_amdgcn_s_getreg((3 << 11) | 20) & 0xFu; }
#define XB_SPIN(cond, bar) do { unsigned _sp = 0; while (cond) { __builtin_amdgcn_s_sleep(1); \
    if ((++_sp & 255u) == 0u) { if (xb_ld(&(bar)[XB_TMO])) break; if (_sp > XB_SPIN_CAP) { atomicAdd(&(bar)[XB_TMO], 1u); break; } } } } while (0)

struct XcdBarrier {
    unsigned* bar; unsigned x;
    volatile LAS unsigned* st;
};

__device__ __forceinline__ XcdBarrier xcd_barrier_post(unsigned* bar, volatile LAS unsigned* st) {
    XcdBarrier b; b.bar = bar; b.x = xb_xcc_id(); b.st = st;
    if (threadIdx.x == 0) (void)xb_add(&bar[XB_XCNT(b.x)], 1u);
    return b;
}
__device__ __forceinline__ void xcd_barrier_complete(unsigned* bar, unsigned x, unsigned& nloc, unsigned& nx) {
    const unsigned G = gridDim.x * gridDim.y * gridDim.z;
    unsigned sum, cnt, mine, sp = 0u;
    for (;;) {
        sum = 0u; cnt = 0u; mine = 0u;
#pragma unroll
        for (unsigned j = 0; j < 16; ++j) { const unsigned c = xb_ld(&bar[XB_XCNT(j)]); sum += c; cnt += (c > 0u) ? 1u : 0u; mine = (j == x) ? c : mine; }
        if (sum == G) break;
        __builtin_amdgcn_s_sleep(1);
        if ((++sp & 255u) == 0u) { if (xb_ld(&bar[XB_TMO])) break; if (sp > XB_SPIN_CAP) { atomicAdd(&bar[XB_TMO], 1u); break; } }
    }
    nloc = mine > 0u ? mine : 1u; nx = cnt > 0u ? cnt : 1u;
}

__device__ __forceinline__ void xcd_barrier(const XcdBarrier& b) {
    asm volatile("s_waitcnt vmcnt(0)" ::: "memory");
    __syncthreads();
    if (threadIdx.x == 0) {
        unsigned* bar = b.bar;
        __builtin_amdgcn_s_waitcnt(0);
        unsigned nloc = b.st[0], nx = b.st[1];
        if (nloc == 0u) { xcd_barrier_complete(bar, b.x, nloc, nx); b.st[0] = nloc; b.st[1] = nx; }
        const unsigned old = xb_add(&bar[XB_XSUB(b.x)], 1u);
        const unsigned gen = old / nloc;
        if (old + 1u == (gen + 1u) * nloc) {
            __builtin_amdgcn_fence(__ATOMIC_RELEASE, "agent");
            asm volatile("s_waitcnt vmcnt(0)" ::: "memory");
            const unsigned og = xb_add(&bar[XB_TOP], 1u);
            const unsigned tg = og / nx;
            if (og + 1u == (tg + 1u) * nx) xb_add(&bar[XB_TOPGEN], 1u);
            else XB_SPIN(xb_ld(&bar[XB_TOPGEN]) == tg, bar);
            __builtin_amdgcn_fence(__ATOMIC_ACQUIRE, "agent");
            xb_add(&bar[XB_XGEN(b.x)], 1u);
            asm volatile("s_waitcnt vmcnt(0)" ::: "memory");
        } else {
            XB_SPIN(xb_ld(&bar[XB_XGEN(b.x)]) == gen, bar);
            __builtin_amdgcn_fence(__ATOMIC_ACQUIRE, "agent");
            asm volatile("s_waitcnt vmcnt(0)" ::: "memory");
        }
    }
    __syncthreads();
}

#endif

typedef short s16x4 __attribute__((ext_vector_type(4)));
#ifndef EMU
__device__ __forceinline__ s16x4 tr4(const LAS bf16* p) { return __builtin_amdgcn_ds_read_tr16_b64_v4i16((LAS s16x4*)p); }
#endif
#define FROW(M, ld, rc0, k0) (*(const LAS bf16x8*)((M) + ((rc0) + fr) * (ld) + (k0) + 8 * fq))
__device__ __forceinline__ bf16x8 ftr_(int fr, int fq, const LAS bf16* M, int ld, int k0, int rc0) {
    const LAS bf16* p = M + (k0 + 8 * fq + (fr >> 2)) * ld + rc0 + 4 * (fr & 3);
    const s16x4 lo = tr4(p), hi = tr4(p + 4 * ld);
    return (bf16x8){lo[0], lo[1], lo[2], lo[3], hi[0], hi[1], hi[2], hi[3]};
}
#define FTR(M, ld, k0, rc0) ftr_(fr, fq, M, ld, k0, rc0)
#define MMA_RR(acc, Am, lda, r0, Bm, ldb, c0, K) do { _Pragma("unroll") for (int k0_ = 0; k0_ < (K); k0_ += 32) acc = mfma16(FROW(Am, lda, r0, k0_), FROW(Bm, ldb, c0, k0_), acc); } while (0)
#define MMA_RT(acc, Am, lda, r0, Bk, ldb, c0, K) do { _Pragma("unroll") for (int k0_ = 0; k0_ < (K); k0_ += 32) acc = mfma16(FROW(Am, lda, r0, k0_), FTR(Bk, ldb, k0_, c0), acc); } while (0)
#define MMA_TT(acc, Ak, lda, m0, Bk, ldb, c0, K) do { _Pragma("unroll") for (int k0_ = 0; k0_ < (K); k0_ += 32) acc = mfma16(FTR(Ak, lda, k0_, m0), FTR(Bk, ldb, k0_, c0), acc); } while (0)
#define MMA_RC(acc, Am, lda, r0, cfrag, K) do { _Pragma("unroll") for (int k0_ = 0; k0_ < (K); k0_ += 32) acc = mfma16(FROW(Am, lda, r0, k0_), cfrag, acc); } while (0)
#define MMA_CT(acc, cfrag, Bk, ldb, c0, K) do { _Pragma("unroll") for (int k0_ = 0; k0_ < (K); k0_ += 32) acc = mfma16(cfrag, FTR(Bk, ldb, k0_, c0), acc); } while (0)
__device__ __forceinline__ u32x2 pack4(float a, float b, float c, float d) { u32x2 w; w.x = pk2(a, b); w.y = pk2(c, d); return w; }
__device__ __forceinline__ float scan_sum64(float v, int lane) {
#pragma unroll
    for (int d = 1; d < 64; d <<= 1) { const float t = __shfl_up(v, d); if (lane >= d) v += t; }
    return v;
}
__device__ __forceinline__ float scan_max64(float v, int lane) {
#pragma unroll
    for (int d = 1; d < 64; d <<= 1) { const float t = __shfl_up(v, d); if (lane >= d) v = fmaxf(v, t); }
    return v;
}
__device__ __forceinline__ float wave_max64(float v) {
#pragma unroll
    for (int m = 1; m < 64; m <<= 1) v = fmaxf(v, __shfl_xor(v, m));
    return v;
}
__device__ __forceinline__ float logsig(float x) { return fminf(x, 0.f) - log1pf(__expf(-fabsf(x))); }
__device__ __forceinline__ float softplusf(float x) { return fmaxf(x, 0.f) + log1pf(__expf(-fabsf(x))); }
__device__ __forceinline__ float sigmoidf(float x) { return 1.0f / (1.0f + __expf(-x)); }
__device__ __forceinline__ float siluf(float x) { return x / (1.0f + __expf(-x)); }
constexpr float NEG_INF = -__builtin_huge_valf();
constexpr float EPS_ = 1e-5f;
__device__ __forceinline__ void unpack8(const u32x4 w, float (&f)[8]) {
    f[0] = __uint_as_float(w.x << 16); f[1] = __uint_as_float(w.x & 0xffff0000u); f[2] = __uint_as_float(w.y << 16); f[3] = __uint_as_float(w.y & 0xffff0000u);
    f[4] = __uint_as_float(w.z << 16); f[5] = __uint_as_float(w.z & 0xffff0000u); f[6] = __uint_as_float(w.w << 16); f[7] = __uint_as_float(w.w & 0xffff0000u);
}
__device__ __forceinline__ u32x4 pack8(const float (&f)[8]) { u32x4 w; w.x = pk2(f[0], f[1]); w.y = pk2(f[2], f[3]); w.z = pk2(f[4], f[5]); w.w = pk2(f[6], f[7]); return w; }

__device__ __forceinline__ void mlstm_item(ArgP Ap, LAS unsigned char* lds, int l, int b, int h, bool sample) {
    int tid_o = threadIdx.x; OPQV(tid_o);
    const int tid = tid_o, lane = tid & 63, wave = tid >> 6, fr = lane & 15, fq = lane >> 4;
    LAS bf16* Qs = (LAS bf16*)(lds); LAS bf16* Ks = (LAS bf16*)(lds + 17408); LAS bf16* Kw = (LAS bf16*)(lds + 34816); LAS bf16* Vs = (LAS bf16*)(lds + 52224);
    LAS bf16* Ss = (LAS bf16*)(lds + 69632); LAS bf16* CbT = (LAS bf16*)(lds + 78848); LAS float* Hs = (LAS float*)(lds + 120320); LAS float* MN = (LAS float*)(lds + 117760); LAS float* gb = (LAS float*)(lds + 118272);
    LAS float* b_ = gb; LAS float* mt_ = gb + 64; LAS float* u_ = gb + 128; LAS float* ein_ = gb + 192; LAS float* wg_ = gb + 256; LAS float* den_ = gb + 320; LAS float* sc_ = gb + 384;
    const int L = sample ? LS : LP, tok0 = sample ? TP + b * LS : b * LP, NB = sample ? BS : BP;
    const bf16* ZM = (const bf16*)(A.ws + WS_ZM); const float* ZS = (const float*)(A.ws + WS_ZS); bf16* BR0 = (bf16*)(A.ws + WS_BR);
    const float ib = A.in[9][l * 4 + h], fb = A.in[10][l * 4 + h];
    const bf16x8 ones = (fr == 0) ? (bf16x8){0x3F80, 0x3F80, 0x3F80, 0x3F80, 0x3F80, 0x3F80, 0x3F80, 0x3F80} : (bf16x8){0, 0, 0, 0, 0, 0, 0, 0};
    f32x4 accC[9];
#pragma unroll
    for (int vi = 0; vi < 9; ++vi) accC[vi] = (f32x4){0.f, 0.f, 0.f, 0.f};
    float m_run = 0.f;
    if (sample) {
        const float* C0 = A.in[2] + ((size_t)(l * BS + b) * 4 + h) * 16384; const float* n0 = A.in[3] + ((size_t)(l * BS + b) * 4 + h) * 128;
        const float* cp = C0 + (4 * fq) * 128 + 16 * wave + fr;
#pragma unroll
        for (int vi = 0; vi < 8; ++vi) {
#pragma unroll
            for (int r = 0; r < 4; ++r) accC[vi][r] = cp[r * 128];
            cp += 2048; OPQV(cp); }
        if (fq == 0) accC[8][0] = n0[16 * wave + fr];
        m_run = A.in[4][(l * BS + b) * 4 + h];
    }
#pragma unroll
    for (int vi = 0; vi < 9; ++vi) *(LAS u32x2*)(CbT + (16 * wave + fr) * 152 + 16 * vi + 4 * fq) = pack4(accC[vi][0], accC[vi][1], accC[vi][2], accC[vi][3]);
    if (tid < 128) MN[tid] = A.in[11][l * 512 + h * 128 + tid];
    u32x4 pq[2], pk[2], pv[2], pm[2]; float pli = NEG_INF, plf = 0.f;
#define MLSTM_PREFETCH_MO(T0N) do { const int nvn_ = (L - (T0N)) < 64 ? (L - (T0N)) : 64; const int t = tid >> 3, part = tid & 7; pm[0] = (u32x4){0u, 0u, 0u, 0u}; pm[1] = pm[0]; \
        if (t < nvn_) { const bf16* mo = ZM + (size_t)(tok0 + (T0N) + t) * NZM + 1536 + h * 128 + 16 * part; pm[0] = *(const u32x4*)mo; pm[1] = *(const u32x4*)(mo + 8); } } while (0)
#define MLSTM_PREFETCH(T0N) do { const int nvn_ = (L - (T0N)) < 64 ? (L - (T0N)) : 64; \
        _Pragma("unroll") for (int i = 0; i < 2; ++i) { const int c = tid + 512 * i, t = c >> 4, cc = (c & 15) * 8; pq[i] = (u32x4){0u, 0u, 0u, 0u}; pk[i] = pq[i]; pv[i] = pq[i]; \
            if (t < nvn_) { const bf16* zp = ZM + (size_t)(tok0 + (T0N) + t) * NZM + h * 128 + cc; pq[i] = *(const u32x4*)zp; pk[i] = *(const u32x4*)(zp + 512); pv[i] = *(const u32x4*)(zp + 1024); } } \
        if (wave == 0) { pli = NEG_INF; plf = 0.f; if (lane < nvn_) { const size_t tok = tok0 + (T0N) + lane; pli = ZS[tok * NSM + h]; plf = ZS[tok * NSM + 4 + h]; } } } while (0)
    MLSTM_PREFETCH(0); MLSTM_PREFETCH_MO(0);
    __syncthreads();
    for (int t0 = 0; t0 < L; t0 += 64) {
        const int nv = (L - t0) < 64 ? (L - t0) : 64;
        if (wave == 0) {
            const float li = (lane < nv) ? pli + ib : NEG_INF, lf = (lane < nv) ? logsig(plf + fb) : 0.f;
            const float bb = scan_sum64(lf, lane), a = bb + m_run, u = li - bb, M = scan_max64(u, lane), mt = fmaxf(a, bb + M);
            const float blast = __shfl(bb, 63), g = blast + u, gmax = wave_max64(g), mnew = fmaxf(blast + m_run, gmax);
            b_[lane] = bb; mt_[lane] = mt; u_[lane] = u; ein_[lane] = __expf(a - mt); wg_[lane] = __expf(g - mnew);
            if (lane == 0) sc_[1] = __expf(blast + m_run - mnew);
            m_run = mnew;
        }
        LDS_BARRIER();
#pragma unroll
        for (int i = 0; i < 2; ++i) { const int c = tid + 512 * i, t = c >> 4, cc = (c & 15) * 8;
            *(LAS u32x4*)(Qs + t * 136 + cc) = pq[i]; *(LAS u32x4*)(Ks + t * 136 + cc) = pk[i]; *(LAS u32x4*)(Vs + t * 136 + cc) = pv[i];
            float f[8]; unpack8(pk[i], f); const float g = wg_[t];
#pragma unroll
            for (int j = 0; j < 8; ++j) f[j] *= g;
            *(LAS u32x4*)(Kw + t * 136 + cc) = pack8(f); }
        MLSTM_PREFETCH(t0 + 64);
        LDS_BARRIER();
#pragma unroll
        for (int j = 0; j < 2; ++j) { const int idx = wave + 8 * j, ti = idx >> 2, si = idx & 3;
            f32x4 acc = {0.f, 0.f, 0.f, 0.f};
            if (si <= ti) MMA_RR(acc, Ks, 136, 16 * si, Qs, 136, 16 * ti, 128);
            const int t = 16 * ti + fr; const float bt = b_[t] - mt_[t]; float v[4];
#pragma unroll
            for (int r = 0; r < 4; ++r) { const int s = 16 * si + 4 * fq + r; v[r] = (s <= t) ? acc[r] * __expf(bt + u_[s]) : 0.f; }
            *(LAS u32x2*)(Ss + t * 72 + 16 * si + 4 * fq) = pack4(v[0], v[1], v[2], v[3]); }
        LDS_BARRIER();
        if (wave < 4) { const int ti = wave; f32x4 acc = {0.f, 0.f, 0.f, 0.f};
            MMA_RT(acc, Qs, 136, 16 * ti, CbT, 152, 128, 128);
#pragma unroll
            for (int r = 0; r < 4; ++r) acc[r] *= ein_[16 * ti + 4 * fq + r];
            MMA_RC(acc, Ss, 72, 16 * ti, ones, 64);
            if (fr == 0) {
#pragma unroll
                for (int r = 0; r < 4; ++r) den_[16 * ti + 4 * fq + r] = acc[r]; } }
        LDS_BARRIER();
#pragma unroll
        for (int j = 0; j < 4; ++j) { const int idx = wave + 8 * j, ti = idx >> 3, vi = idx & 7; f32x4 accn = {0.f, 0.f, 0.f, 0.f};
            MMA_RT(accn, Qs, 136, 16 * ti, CbT, 152, 16 * vi, 128);
#pragma unroll
            for (int r = 0; r < 4; ++r) accn[r] *= ein_[16 * ti + 4 * fq + r];
            MMA_RT(accn, Ss, 72, 16 * ti, Vs, 136, 16 * vi, 64);
#pragma unroll
            for (int r = 0; r < 4; ++r) { const int t = 16 * ti + 4 * fq + r; const float dn = den_[t] * 0.08838834764831845f;
                Hs[t * 132 + 16 * vi + fr] = accn[r] * 0.08838834764831845f / fmaxf(fabsf(dn), __expf(-mt_[t])); }
            asm volatile("" ::: "memory"); }
        LDS_BARRIER();
        { const int t = tid >> 3, part = tid & 7; float x[16]; float s1 = 0.f;
#pragma unroll
            for (int i = 0; i < 16; ++i) { x[i] = Hs[t * 132 + 16 * part + i]; s1 += x[i]; }
            s1 += __shfl_xor(s1, 1); s1 += __shfl_xor(s1, 2); s1 += __shfl_xor(s1, 4);
            const float mu = s1 * (1.0f / 128.0f); float s2 = 0.f;
#pragma unroll
            for (int i = 0; i < 16; ++i) { x[i] -= mu; s2 += x[i] * x[i]; }
            s2 += __shfl_xor(s2, 1); s2 += __shfl_xor(s2, 2); s2 += __shfl_xor(s2, 4);
            const float rstd = 1.0f / sqrtf(s2 * (1.0f / 128.0f) + EPS_);
            if (t < nv) { const size_t tok = tok0 + t0 + t;
                float o0[8], o1[8]; unpack8(pm[0], o0); unpack8(pm[1], o1); float y0[8], y1[8];
#pragma unroll
                for (int i = 0; i < 8; ++i) { y0[i] = x[i] * rstd * MN[16 * part + i] * sigmoidf(o0[i]); y1[i] = x[8 + i] * rstd * MN[16 * part + 8 + i] * sigmoidf(o1[i]); }
                bf16* o = BR0 + tok * 512 + h * 128 + 16 * part; *(u32x4*)o = pack8(y0); *(u32x4*)(o + 8) = pack8(y1); } }
        MLSTM_PREFETCH_MO(t0 + 64);
        { const float ec = sc_[1];
#pragma unroll
            for (int vi = 0; vi < 9; ++vi) {
#pragma unroll
                for (int r = 0; r < 4; ++r) accC[vi][r] *= ec;
                if (vi < 8) MMA_TT(accC[vi], Vs, 136, 16 * vi, Kw, 136, 16 * wave, 64); else MMA_CT(accC[vi], ones, Kw, 136, 16 * wave, 64);
                *(LAS u32x2*)(CbT + (16 * wave + fr) * 152 + 16 * vi + 4 * fq) = pack4(accC[vi][0], accC[vi][1], accC[vi][2], accC[vi][3]);
                asm volatile("" ::: "memory"); } }
        LDS_BARRIER();
    }
#undef MLSTM_PREFETCH
#undef MLSTM_PREFETCH_MO
    float* Co = A.out + (sample ? O_SC : O_PC) + ((size_t)(l * NB + b) * 4 + h) * 16384; float* no = A.out + (sample ? O_SN : O_PN) + ((size_t)(l * NB + b) * 4 + h) * 128;
    { int fq_ = fq, cw_ = 16 * wave + fr; OPQV(fq_); OPQV(cw_);
      float* cp = Co + (4 * fq_) * 128 + cw_;
#pragma unroll
      for (int vi = 0; vi < 8; ++vi) {
#pragma unroll
        for (int r = 0; r < 4; ++r) cp[r * 128] = accC[vi][r];
        cp += 2048; OPQV(cp); }
      if (fq_ == 0) no[cw_] = accC[8][0]; }
    if (tid == 0) A.out[(sample ? O_SM : O_PM) + (size_t)(l * NB + b) * 4 + h] = m_run;
    __syncthreads();
}

__device__ __forceinline__ void gla_item(ArgP Ap, LAS unsigned char* lds, int l, int b, int h, bool sample) {
    int tid_o = threadIdx.x; OPQV(tid_o);
    const int tid = tid_o, lane = tid & 63, wave = tid >> 6, fr = lane & 15, fq = lane >> 4;
    LAS bf16* QE = (LAS bf16*)(lds); LAS bf16* KE = (LAS bf16*)(lds + 9216); LAS bf16* KLs = (LAS bf16*)(lds + 18432); LAS bf16* Vs = (LAS bf16*)(lds + 27648);
    LAS bf16* ATT = (LAS bf16*)(lds + 45056); LAS bf16* STbT = (LAS bf16*)(lds + 54272); LAS float* Os = (LAS float*)(lds + 71680); LAS float* LAM = (LAS float*)(lds + 105472);
    LAS float* GA = (LAS float*)(lds + 122112); LAS float* GUP = (LAS float*)(lds + 126208); LAS float* GBI = (LAS float*)(lds + 130304); LAS float* GN = (LAS float*)(lds + 130560);
    const int L = sample ? LS : LP, tok0 = sample ? TP + b * LS : b * LP, NB = sample ? BS : BP;
    const bf16* ZM = (const bf16*)(A.ws + WS_ZM); const float* ZS = (const float*)(A.ws + WS_ZS); bf16* BR1 = (bf16*)(A.ws + WS_BR) + (size_t)T * 512;
    f32x4 accS[4];
#pragma unroll
    for (int ki = 0; ki < 4; ++ki) accS[ki] = (f32x4){0.f, 0.f, 0.f, 0.f};
    if (sample) { const float* S0 = A.in[5] + ((size_t)(l * BS + b) * 4 + h) * 8192;
        const float* sp = S0 + fr * 128 + 16 * wave + 4 * fq;
#pragma unroll
        for (int ki = 0; ki < 4; ++ki) {
#pragma unroll
            for (int r = 0; r < 4; ++r) accS[ki][r] = sp[r];
            sp += 2048; OPQV(sp); } }
#pragma unroll
    for (int ki = 0; ki < 4; ++ki) *(LAS u32x2*)(STbT + (16 * ki + fr) * 136 + 16 * wave + 4 * fq) = pack4(accS[ki][0], accS[ki][1], accS[ki][2], accS[ki][3]);
    for (int e = tid; e < 1024; e += NTHREADS) GUP[e] = A.in[12][(size_t)l * 16 * 256 + (e >> 6) * 256 + h * 64 + (e & 63)];
    if (tid < 64) GBI[tid] = A.in[13][l * 256 + h * 64 + tid];
    if (tid < 128) GN[tid] = A.in[14][l * 512 + h * 128 + tid];
    u32x4 pq, pk, pv[2], pg[2], pgn[2]; float pga[2];
#define GLA_PREFETCH(T0N) do { const int nvn_ = (L - (T0N)) < 64 ? (L - (T0N)) : 64; \
        { const int t = tid >> 3, cc = (tid & 7) * 8; pq = (u32x4){0u, 0u, 0u, 0u}; pk = pq; pgn[0] = pq; pgn[1] = pq; \
            if (t < nvn_) { const bf16* zr = ZM + (size_t)(tok0 + (T0N) + t) * NZM + 2048 + h * 64 + cc; pq = *(const u32x4*)zr; pk = *(const u32x4*)(zr + 256); \
                const bf16* gr = ZM + (size_t)(tok0 + (T0N) + t) * NZM + 3072 + h * 128 + 16 * (tid & 7); pgn[0] = *(const u32x4*)gr; pgn[1] = *(const u32x4*)(gr + 8); } } \
        _Pragma("unroll") for (int i = 0; i < 2; ++i) { const int c = tid + 512 * i, t = c >> 4, cc = (c & 15) * 8; pv[i] = (u32x4){0u, 0u, 0u, 0u}; \
            if (t < nvn_) pv[i] = *(const u32x4*)(ZM + (size_t)(tok0 + (T0N) + t) * NZM + 2560 + h * 128 + cc); \
            const int e = tid + 512 * i, te = e >> 4; pga[i] = (te < nvn_) ? ZS[(size_t)(tok0 + (T0N) + te) * NSM + 8 + (e & 15)] : 0.f; } } while (0)
    GLA_PREFETCH(0);
    __syncthreads();
    for (int t0 = 0; t0 < L; t0 += 64) {
        const int nv = (L - t0) < 64 ? (L - t0) : 64;
        pg[0] = pgn[0]; pg[1] = pgn[1];
        GA[tid] = pga[0]; GA[tid + 512] = pga[1];
        LDS_BARRIER();
#pragma unroll
        for (int i = 0; i < 8; ++i) { const int e = tid + 512 * i, t = e >> 6, k = e & 63; float x = GBI[k];
#pragma unroll
            for (int r = 0; r < 16; ++r) x += GA[t * 16 + r] * GUP[r * 64 + k];
            LAM[t * 65 + k] = (t < nv) ? logsig(x) * (1.0f / 16.0f) : 0.f; }
        LDS_BARRIER();
#pragma unroll
        for (int c = 0; c < 8; ++c) { const int k = 8 * wave + c; const float v = scan_sum64(LAM[lane * 65 + k], lane); LAM[lane * 65 + k] = v; }
        LDS_BARRIER();
        { const int t = tid >> 3, cc = (tid & 7) * 8; float q[8], k[8], qe[8], ke[8], kl[8]; unpack8(pq, q); unpack8(pk, k);
#pragma unroll
            for (int i = 0; i < 8; ++i) { const float lm = LAM[t * 65 + cc + i], ll = LAM[63 * 65 + cc + i]; qe[i] = q[i] * __expf(lm); ke[i] = k[i] * __expf(-lm); kl[i] = k[i] * __expf(ll - lm); }
            *(LAS u32x4*)(QE + t * 72 + cc) = pack8(qe); *(LAS u32x4*)(KE + t * 72 + cc) = pack8(ke); *(LAS u32x4*)(KLs + t * 72 + cc) = pack8(kl); }
#pragma unroll
        for (int i = 0; i < 2; ++i) { const int c = tid + 512 * i, t = c >> 4, cc = (c & 15) * 8; *(LAS u32x4*)(Vs + t * 136 + cc) = pv[i]; }
        GLA_PREFETCH(t0 + 64);
        LDS_BARRIER();
#pragma unroll
        for (int j = 0; j < 2; ++j) { const int idx = wave + 8 * j, ti = idx >> 2, si = idx & 3; f32x4 acc = {0.f, 0.f, 0.f, 0.f};
            if (si <= ti) MMA_RR(acc, KE, 72, 16 * si, QE, 72, 16 * ti, 64);
            const int t = 16 * ti + fr; float v[4];
#pragma unroll
            for (int r = 0; r < 4; ++r) { const int s = 16 * si + 4 * fq + r; v[r] = (s <= t) ? acc[r] : 0.f; }
            *(LAS u32x2*)(ATT + t * 72 + 16 * si + 4 * fq) = pack4(v[0], v[1], v[2], v[3]); }
        LDS_BARRIER();
#pragma unroll
        for (int j = 0; j < 4; ++j) { const int idx = wave + 8 * j, ti = idx >> 3, vi = idx & 7; f32x4 acc = {0.f, 0.f, 0.f, 0.f};
            MMA_RT(acc, QE, 72, 16 * ti, STbT, 136, 16 * vi, 64); MMA_RT(acc, ATT, 72, 16 * ti, Vs, 136, 16 * vi, 64);
#pragma unroll
            for (int r = 0; r < 4; ++r) Os[(16 * ti + 4 * fq + r) * 132 + 16 * vi + fr] = acc[r] * 0.125f;
            asm volatile("" ::: "memory"); }
        LDS_BARRIER();
        { const int t = tid >> 3, part = tid & 7; float x[16]; float s2 = 0.f;
#pragma unroll
            for (int i = 0; i < 16; ++i) { x[i] = Os[t * 132 + 16 * part + i]; s2 += x[i] * x[i]; }
            s2 += __shfl_xor(s2, 1); s2 += __shfl_xor(s2, 2); s2 += __shfl_xor(s2, 4);
            const float rstd = 1.0f / sqrtf(s2 * (1.0f / 128.0f) + EPS_);
            if (t < nv) { const size_t tok = tok0 + t0 + t;
                float g0[8], g1[8]; unpack8(pg[0], g0); unpack8(pg[1], g1); float y0[8], y1[8];
#pragma unroll
                for (int i = 0; i < 8; ++i) { y0[i] = x[i] * rstd * GN[16 * part + i] * siluf(g0[i]); y1[i] = x[8 + i] * rstd * GN[16 * part + 8 + i] * siluf(g1[i]); }
                bf16* o = BR1 + tok * 512 + h * 128 + 16 * part; *(u32x4*)o = pack8(y0); *(u32x4*)(o + 8) = pack8(y1); } }
#pragma unroll
        for (int ki = 0; ki < 4; ++ki) { const float dec = __expf(LAM[63 * 65 + 16 * ki + fr]);
#pragma unroll
            for (int r = 0; r < 4; ++r) accS[ki][r] *= dec;
            MMA_TT(accS[ki], Vs, 136, 16 * wave, KLs, 72, 16 * ki, 64);
            *(LAS u32x2*)(STbT + (16 * ki + fr) * 136 + 16 * wave + 4 * fq) = pack4(accS[ki][0], accS[ki][1], accS[ki][2], accS[ki][3]);
            asm volatile("" ::: "memory"); }
        LDS_BARRIER();
    }
#undef GLA_PREFETCH
    float* So = A.out + (sample ? O_SG : O_PG) + ((size_t)(l * NB + b) * 4 + h) * 8192;
    { int o_ = fr * 128 + 16 * wave + 4 * fq; OPQV(o_); float* sp = So + o_;
#pragma unroll
      for (int ki = 0; ki < 4; ++ki) {
#pragma unroll
        for (int r = 0; r < 4; ++r) sp[r] = accS[ki][r];
        sp += 2048; OPQV(sp); } }
    __syncthreads();
}

__device__ __forceinline__ int ssd_chmap(int hd, int c) { const int g = hd >> 2; return c < 64 ? hd * 64 + c : (c < 128 ? 512 + g * 64 + (c - 64) : 640 + g * 64 + (c - 128)); }
__device__ __forceinline__ void ssd_item(ArgP Ap, LAS unsigned char* lds, int l, int b, int hd, bool sample) {
    int tid_o = threadIdx.x; OPQV(tid_o);
    const int tid = tid_o, lane = tid & 63, wave = tid >> 6, fr = lane & 15, fq = lane >> 4;
    LAS bf16* RAW = (LAS bf16*)(lds); LAS bf16* Ys = (LAS bf16*)(lds); LAS bf16* W = (LAS bf16*)(lds + 9216); LAS bf16* Bw = (LAS bf16*)(lds + 18432);
    LAS bf16* Xs = (LAS bf16*)(lds + 27648); LAS bf16* Cs = (LAS bf16*)(lds + 36864); LAS bf16* Bs = (LAS bf16*)(lds + 46080); LAS bf16* HbT = (LAS bf16*)(lds + 55296);
    LAS bf16* HIST = (LAS bf16*)(lds + 64512); LAS float* DT = (LAS float*)(lds + 65792); LAS float* LM = (LAS float*)(lds + 66048);
    LAS float* CW = (LAS float*)(lds + 66304); LAS float* CBI = CW + 4 * 192;
    const int L = sample ? LS : LP, tok0 = sample ? TP + b * LS : b * LP, NB = sample ? BS : BP;
    const bf16* ZM = (const bf16*)(A.ws + WS_ZM); const float* ZS = (const float*)(A.ws + WS_ZS); bf16* BR2 = (bf16*)(A.ws + WS_BR) + (size_t)T * 1024;
    const float Dh = A.in[19][l * 8 + hd], dtb = A.in[17][l * 8 + hd], Ah = -__expf(A.in[18][l * 8 + hd]);
    f32x4 accH[2];
#pragma unroll
    for (int j = 0; j < 2; ++j) { const int idx = wave + 8 * j, pi = idx >> 2, ni = idx & 3; accH[j] = (f32x4){0.f, 0.f, 0.f, 0.f};
        if (sample) { const float* h0 = A.in[6] + ((size_t)(l * BS + b) * 8 + hd) * 4096;
            const float* hp = h0 + (16 * pi + 4 * fq) * 64 + 16 * ni + fr; OPQV(hp);
#pragma unroll
            for (int r = 0; r < 4; ++r) accH[j][r] = hp[r * 64]; }
        *(LAS u32x2*)(HbT + (16 * ni + fr) * 72 + 16 * pi + 4 * fq) = pack4(accH[j][0], accH[j][1], accH[j][2], accH[j][3]); }
    for (int e = tid; e < 5 * 192; e += NTHREADS) { const int j = e / 192, c = e % 192, ch = ssd_chmap(hd, c); CW[e] = (j < 4) ? A.in[15][(size_t)l * 4 * 768 + j * 768 + ch] : A.in[16][l * 768 + ch]; }
    for (int e = tid; e < 3 * 200; e += NTHREADS) { const int r = e / 200, c = e % 200; float v = 0.f;
        if (sample && c < 192) v = A.in[7][((size_t)(l * BS + b) * 3 + r) * 768 + ssd_chmap(hd, c)];
        HIST[e] = f2bf(v); }
    u32x4 pr[3], ps; float pdt = 0.f;
#define SSD_PREFETCH(T0N) do { const int nvn_ = (L - (T0N)) < 64 ? (L - (T0N)) : 64; \
        _Pragma("unroll") for (int i = 0; i < 3; ++i) { const int c = tid + 512 * i, t = c / 24, q = c % 24; pr[i] = (u32x4){0u, 0u, 0u, 0u}; \
            if (t < nvn_) pr[i] = *(const u32x4*)(ZM + (size_t)(tok0 + (T0N) + t) * NZM + 4096 + ssd_chmap(hd, 8 * q)); } \
        if (wave == 0) { pdt = 0.f; if (lane < nvn_) pdt = ZS[(size_t)(tok0 + (T0N) + lane) * NSM + 24 + hd]; } } while (0)
#define SSD_PREFETCH_Z(T0N) do { const int nvn_ = (L - (T0N)) < 64 ? (L - (T0N)) : 64; const int t = tid >> 3, part = tid & 7; ps = (u32x4){0u, 0u, 0u, 0u}; \
        if (t < nvn_) ps = *(const u32x4*)(ZM + (size_t)(tok0 + (T0N) + t) * NZM + 3584 + hd * 64 + 8 * part); } while (0)
    SSD_PREFETCH(0); SSD_PREFETCH_Z(0);
    __syncthreads();
    for (int t0 = 0; t0 < L; t0 += 64) {
        const int nv = (L - t0) < 64 ? (L - t0) : 64;
#pragma unroll
        for (int i = 0; i < 3; ++i) { const int c = tid + 512 * i, t = c / 24, q = c % 24; *(LAS u32x4*)(RAW + (3 + t) * 200 + 8 * q) = pr[i]; }
        if (tid < 3 * 25) { const int r = tid / 25, q = tid % 25; *(LAS u32x4*)(RAW + r * 200 + 8 * q) = *(const LAS u32x4*)(HIST + r * 200 + 8 * q); }
        if (wave == 0) { const float dtv = (lane < nv) ? softplusf(pdt + dtb) : 0.f; const float lam = scan_sum64(dtv * Ah, lane); DT[lane] = dtv; LM[lane] = lam; }
        SSD_PREFETCH(t0 + 64);
        LDS_BARRIER();
#pragma unroll
        for (int i = 0; i < 3; ++i) { const int c = tid + 512 * i, t = c / 24, q = c % 24; float o[8];
#pragma unroll
            for (int e = 0; e < 8; ++e) o[e] = CBI[8 * q + e];
#pragma unroll
            for (int j = 0; j < 4; ++j) { float x[8]; unpack8(*(const LAS u32x4*)(RAW + (t + j) * 200 + 8 * q), x);
#pragma unroll
                for (int e = 0; e < 8; ++e) o[e] += CW[j * 192 + 8 * q + e] * x[e]; }
#pragma unroll
            for (int e = 0; e < 8; ++e) o[e] = (t < nv) ? siluf(o[e]) : 0.f;
            LAS bf16* dst = (q < 8) ? Xs + t * 72 + q * 8 : (q < 16 ? Bs + t * 72 + (q - 8) * 8 : Cs + t * 72 + (q - 16) * 8);
            *(LAS u32x4*)dst = pack8(o); }
        LDS_BARRIER();
        if (tid < 3 * 25) { const int r = tid / 25, q = tid % 25; *(LAS u32x4*)(HIST + r * 200 + 8 * q) = *(const LAS u32x4*)(RAW + (nv + r) * 200 + 8 * q); }
        f32x4 cbT[2];
#pragma unroll
        for (int j = 0; j < 2; ++j) { const int idx = wave + 8 * j, ti = idx >> 2, si = idx & 3; cbT[j] = (f32x4){0.f, 0.f, 0.f, 0.f};
            if (si <= ti) MMA_RR(cbT[j], Bs, 72, 16 * si, Cs, 72, 16 * ti, 64); }
        LDS_BARRIER();
#pragma unroll
        for (int j = 0; j < 2; ++j) { const int idx = wave + 8 * j, ti = idx >> 2, si = idx & 3; const int t = 16 * ti + fr; const float lt = LM[t]; float v[4];
#pragma unroll
            for (int r = 0; r < 4; ++r) { const int s = 16 * si + 4 * fq + r; v[r] = (s <= t) ? cbT[j][r] * __expf(lt - LM[s]) * DT[s] : 0.f; }
            *(LAS u32x2*)(W + t * 72 + 16 * si + 4 * fq) = pack4(v[0], v[1], v[2], v[3]); }
        { const int s = tid >> 3, n0 = (tid & 7) * 8; float v[8]; unpack8(*(const LAS u32x4*)(Bs + s * 72 + n0), v); const float ws = __expf(LM[63] - LM[s]) * DT[s];
#pragma unroll
            for (int i = 0; i < 8; ++i) v[i] *= ws;
            *(LAS u32x4*)(Bw + s * 72 + n0) = pack8(v); }
        LDS_BARRIER();
#pragma unroll
        for (int j = 0; j < 2; ++j) { const int idx = wave + 8 * j, ti = idx >> 2, pi = idx & 3; f32x4 acc = {0.f, 0.f, 0.f, 0.f};
            MMA_RT(acc, Cs, 72, 16 * ti, HbT, 72, 16 * pi, 64);
#pragma unroll
            for (int r = 0; r < 4; ++r) acc[r] *= __expf(LM[16 * ti + 4 * fq + r]);
            MMA_RT(acc, W, 72, 16 * ti, Xs, 72, 16 * pi, 64);
#pragma unroll
            for (int r = 0; r < 4; ++r) { const int t = 16 * ti + 4 * fq + r, p = 16 * pi + fr; Ys[t * 72 + p] = f2bf(acc[r] + Dh * bf2f(Xs[t * 72 + p])); } }
        { const float dec = __expf(LM[63]);
#pragma unroll
            for (int j = 0; j < 2; ++j) { const int idx = wave + 8 * j, pi = idx >> 2, ni = idx & 3;
#pragma unroll
                for (int r = 0; r < 4; ++r) accH[j][r] *= dec;
                MMA_TT(accH[j], Xs, 72, 16 * pi, Bw, 72, 16 * ni, 64); } }
        LDS_BARRIER();
#pragma unroll
        for (int j = 0; j < 2; ++j) { const int idx = wave + 8 * j, pi = idx >> 2, ni = idx & 3;
            *(LAS u32x2*)(HbT + (16 * ni + fr) * 72 + 16 * pi + 4 * fq) = pack4(accH[j][0], accH[j][1], accH[j][2], accH[j][3]); }
        { const int t = tid >> 3, part = tid & 7; float f[8], z[8]; unpack8(*(const LAS u32x4*)(Ys + t * 72 + 8 * part), f); unpack8(ps, z);
#pragma unroll
            for (int i = 0; i < 8; ++i) f[i] *= siluf(z[i]);
            if (t < nv) *(u32x4*)(BR2 + (size_t)(tok0 + t0 + t) * 512 + hd * 64 + 8 * part) = pack8(f); }
        SSD_PREFETCH_Z(t0 + 64);
        LDS_BARRIER();
    }
#undef SSD_PREFETCH_Z
#undef SSD_PREFETCH
    { float* ho = A.out + (sample ? O_SH : O_PH) + ((size_t)(l * NB + b) * 8 + hd) * 4096;
#pragma unroll
        for (int j = 0; j < 2; ++j) { const int idx = wave + 8 * j, pi = idx >> 2, ni = idx & 3;
            float* hp = ho + (16 * pi + 4 * fq) * 64 + 16 * ni + fr; OPQV(hp);
#pragma unroll
            for (int r = 0; r < 4; ++r) hp[r * 64] = accH[j][r]; } }
    for (int e = tid; e < 3 * 192; e += NTHREADS) { const int r = e / 192, c = e % 192;
        if (c < 64 || (hd & 3) == 0) A.out[(sample ? O_SV : O_PV) + ((size_t)(l * NB + b) * 3 + r) * 768 + ssd_chmap(hd, c)] = bf2f(HIST[r * 200 + c]); }
    __syncthreads();
}

__device__ __forceinline__ void phase_ssdnorm(ArgP Ap, int l) {
    const int tx = opaque_tid(), lane = tx & 63, wave = tx >> 6, gw = blockIdx.x * NWAVES + wave, NGW = gridDim.x * NWAVES;
    bf16* BR2 = (bf16*)(A.ws + WS_BR) + (size_t)T * 1024; const float* sn = A.in[20] + l * 512 + 8 * lane;
    for (int tok = gw; tok < T; tok += NGW) { float f[8]; unpack8(*(const u32x4*)(BR2 + (size_t)tok * 512 + 8 * lane), f); float s2 = 0.f;
#pragma unroll
        for (int i = 0; i < 8; ++i) s2 += f[i] * f[i];
#pragma unroll
        for (int m = 1; m < 32; m <<= 1) s2 += __shfl_xor(s2, m);
        const float rstd = 1.0f / sqrtf(s2 * (1.0f / 256.0f) + EPS_);
#pragma unroll
        for (int i = 0; i < 8; ++i) f[i] *= rstd * sn[i];
        *(u32x4*)(BR2 + (size_t)tok * 512 + 8 * lane) = pack8(f); }
}

__device__ __forceinline__ void mixer_item(ArgP Ap, LAS unsigned char* lds, int l, int it) {
    constexpr int NL0 = BP * 4, NL1 = NL0 + BP * 4, NL2 = NL1 + BP * 8, NS0 = NL2 + BS * 4, NS1 = NS0 + BS * 4;
    int kind, r; bool sample;
    if (it < NL0) { kind = 0; r = it; sample = false; } else if (it < NL1) { kind = 1; r = it - NL0; sample = false; } else if (it < NL2) { kind = 2; r = it - NL1; sample = false; }
    else if (it < NS0) { kind = 0; r = it - NL2; sample = true; } else if (it < NS1) { kind = 1; r = it - NS0; sample = true; } else { kind = 2; r = it - NS1; sample = true; }
#ifndef ONLYK
#define ONLYK -1
#endif
#ifndef EMU
#define OPQ() ArgP Ap_ = Ap; int l_ = __builtin_amdgcn_readfirstlane(l), r_ = __builtin_amdgcn_readfirstlane(r); asm volatile("" : "+s"(Ap_), "+s"(l_), "+s"(r_) :: "memory")
#else
#define OPQ() ArgP Ap_ = Ap; int l_ = l, r_ = r
#endif
    if ((ONLYK < 0 || ONLYK == 0) && kind == 0) { OPQ(); mlstm_item(Ap_, lds, l_, r_ >> 2, r_ & 3, sample); }
    else if ((ONLYK < 0 || ONLYK == 1) && kind == 1) { OPQ(); gla_item(Ap_, lds, l_, r_ >> 2, r_ & 3, sample); }
    else if ((ONLYK < 0 || ONLYK == 2) && kind == 2) { OPQ(); ssd_item(Ap_, lds, l_, r_ >> 3, r_ & 7, sample); }
#undef OPQ
}
__device__ __forceinline__ void phase_mixers(ArgP Ap, LAS unsigned char* lds, int l) {
    constexpr int NLONG = BP * 16, NSHORT = BS * 16; const int G = gridDim.x, bid = blockIdx.x;
    const bool split = G > NLONG;
    const int step = split ? (bid < NLONG ? (1 << 28) : G - NLONG) : G;
#ifndef MIXREP
#define MIXREP 0
#endif
#pragma unroll 1
    for (int it = bid; it < NLONG + NSHORT; it += step) {
        const int reps = ((MIXREP == 1 && it < NLONG) || (MIXREP == 2 && it >= NLONG) || (MIXREP == 3 && it < BP * 4) || (MIXREP == 4 && it >= BP * 4 && it < BP * 8) || (MIXREP == 5 && it >= BP * 8 && it < NLONG)) ? 2 : 1;
#pragma unroll 1
        for (int rp = 0; rp < reps; ++rp) mixer_item(Ap, lds, l, it);
    }
}

__device__ __forceinline__ float wave_sum64(float v) {
#pragma unroll
    for (int m = 1; m < 64; m <<= 1) v += __shfl_xor(v, m);
    return v;
}
constexpr float DN_ALPHA_ = 1.4142135623730951f;

__device__ __forceinline__ void phase_ln1(ArgP Ap, int l) {
    const int tx = opaque_tid(), lane = tx & 63, wave = tx >> 6, gw = blockIdx.x * NWAVES + wave, NGW = gridDim.x * NWAVES;
    const float* Y = (const float*)(A.ws + WS_ZG); float* H = (float*)(A.ws + WS_H); bf16* H1B = (bf16*)(A.ws + WS_BR);
    const float* lg = A.in[23] + l * D + 16 * lane; const float* lb = A.in[24] + l * D + 16 * lane;
    for (int tok = gw; tok < T; tok += NGW) {
        const float* xr = (l == 0) ? (tok < TP ? A.in[0] + (size_t)tok * D : A.in[1] + (size_t)(tok - TP) * D) : H + (size_t)tok * D;
        float y[16]; float s1 = 0.f;
#pragma unroll
        for (int q = 0; q < 4; ++q) { const float4 a = *(const float4*)(xr + 16 * lane + 4 * q), b = *(const float4*)(Y + (size_t)tok * D + 16 * lane + 4 * q);
            y[4 * q] = DN_ALPHA_ * a.x + b.x; y[4 * q + 1] = DN_ALPHA_ * a.y + b.y; y[4 * q + 2] = DN_ALPHA_ * a.z + b.z; y[4 * q + 3] = DN_ALPHA_ * a.w + b.w; }
#pragma unroll
        for (int i = 0; i < 16; ++i) s1 += y[i];
        const float mu = wave_sum64(s1) * (1.0f / D); float s2 = 0.f;
#pragma unroll
        for (int i = 0; i < 16; ++i) { y[i] -= mu; s2 += y[i] * y[i]; }
        const float rstd = 1.0f / sqrtf(wave_sum64(s2) * (1.0f / D) + EPS_);
#pragma unroll
        for (int i = 0; i < 16; ++i) y[i] = y[i] * rstd * lg[i] + lb[i];
#pragma unroll
        for (int q = 0; q < 4; ++q) *(float4*)(H + (size_t)tok * D + 16 * lane + 4 * q) = make_float4(y[4 * q], y[4 * q + 1], y[4 * q + 2], y[4 * q + 3]);
        float y0[8], y1[8];
#pragma unroll
        for (int i = 0; i < 8; ++i) { y0[i] = y[i]; y1[i] = y[8 + i]; }
        *(u32x4*)(H1B + (size_t)tok * D + 16 * lane) = pack8(y0); *(u32x4*)(H1B + (size_t)tok * D + 16 * lane + 8) = pack8(y1);
    }
    const int gtid = blockIdx.x * NTHREADS + tx, gthreads = gridDim.x * NTHREADS;
    convert_f32_bf16(A.in[27] + (size_t)l * NEXP * D, (bf16*)(A.ws + WS_PU), (size_t)NEXP * D, gtid, gthreads);
    convert_f32_bf16(A.in[28] + (size_t)l * NEXP * D, (bf16*)(A.ws + WS_PV), (size_t)NEXP * D, gtid, gthreads);
}

__device__ __forceinline__ unsigned ord_of(float f) { const unsigned u = __float_as_uint(f); return (u & 0x80000000u) ? ~u : (u | 0x80000000u); }
__device__ __forceinline__ float dec_ord(unsigned o) { const unsigned u = (o & 0x80000000u) ? (o & 0x7fffffffu) : ~o; return __uint_as_float(u); }
__device__ __forceinline__ unsigned umax_(unsigned a, unsigned b) { return a > b ? a : b; }
__device__ __forceinline__ unsigned umin_(unsigned a, unsigned b) { return a < b ? a : b; }
__device__ __forceinline__ void ins16(unsigned (&L)[16], unsigned x) {
#pragma unroll
    for (int p = 0; p < 16; ++p) { const unsigned hi = umax_(L[p], x); x = umin_(L[p], x); L[p] = hi; }
}
__device__ __forceinline__ unsigned sel16(const unsigned (&L)[16], int a) { unsigned r = L[0];
#pragma unroll
    for (int p = 1; p < 16; ++p) r = (a == p) ? L[p] : r;
    return r; }

__device__ __forceinline__ void route_topk(const bf16* __restrict__ Q, const LAS bf16* KEYS, int tokb, int h, int j, int fr, int fq, unsigned (&Lt)[16]) {
    f32x4 acc[8];
#pragma unroll
    for (int ki = 0; ki < 8; ++ki) acc[ki] = (f32x4){0.f, 0.f, 0.f, 0.f};
#pragma unroll
    for (int kk = 0; kk < 4; ++kk) { const bf16x8 bq = *(const bf16x8*)(Q + (size_t)(tokb + fr) * 2048 + h * 256 + j * 128 + 32 * kk + 8 * fq);
#pragma unroll
        for (int ki = 0; ki < 8; ++ki) { const bf16x8 ak = *(const LAS bf16x8*)(KEYS + (j * 128 + 16 * ki + fr) * 136 + 32 * kk + 8 * fq); acc[ki] = mfma16(ak, bq, acc[ki]); } }
#pragma unroll
    for (int p = 0; p < 16; ++p) Lt[p] = 0u;
#pragma unroll
    for (int ki = 0; ki < 8; ++ki)
#pragma unroll
        for (int r = 0; r < 4; ++r) ins16(Lt, (ord_of(acc[ki][r]) & ~127u) | (unsigned)(127 - (16 * ki + 4 * fq + r)));
#pragma unroll
    for (int m = 16; m < 64; m <<= 1) { unsigned R[16];
#pragma unroll
        for (int p = 0; p < 16; ++p) R[p] = __shfl_xor(Lt[p], m);
#pragma unroll
        for (int p = 0; p < 16; ++p) ins16(Lt, R[p]); }
}

__device__ __forceinline__ void phase_route(ArgP Ap, LAS unsigned char* lds, int l) {
    const int tid = opaque_tid(), lane = tid & 63, wave = tid >> 6, fr = lane & 15, fq = lane >> 4;
    LAS bf16* KEYS = (LAS bf16*)lds;
    LAS unsigned* LST = (LAS unsigned*)(lds + 69632);
    const bf16* Q = (const bf16*)(A.ws + WS_Q); int* IDX = (int*)(A.ws + WS_IDX); float* GT = (float*)(A.ws + WS_GT);
    const bf16* kg = (const bf16*)(A.ws + WS_WB + (size_t)l * WB_BYTES + WB_KEYS);
    constexpr int NG = T / 16, NCH = (NG + 7) / 8, NITEMS = NCH * 8;
    int last_h = -1;
    for (int it = blockIdx.x; it < NITEMS; it += gridDim.x) {
        const int h = it & 7, ch = it >> 3;
        if (h != last_h) { __syncthreads();
            for (int c = tid; c < 2 * 128 * 16; c += NTHREADS) { const int row = c >> 4, cc = (c & 15) * 8; *(LAS u32x4*)(KEYS + row * 136 + cc) = *(const u32x4*)(kg + ((size_t)h * 256 + row) * 128 + cc); }
            __syncthreads(); last_h = h; }
        const int grp = ch * 8 + wave;
        if (grp < NG) {
            const int tokb = grp * 16; unsigned L1[16], L2[16];
            route_topk(Q, KEYS, tokb, h, 0, fr, fq, L1); route_topk(Q, KEYS, tokb, h, 1, fr, fq, L2);
            unsigned C[16];
#pragma unroll
            for (int p = 0; p < 16; ++p) C[p] = 0u;
#pragma unroll
            for (int a = 0; a < 16; ++a)
#pragma unroll
                for (int b = 0; b < 16; ++b) if ((a + 1) * (b + 1) <= 16) {
                    const float s = dec_ord(L1[a] & ~127u) + dec_ord(L2[b] & ~127u); ins16(C, (ord_of(s) & ~255u) | (unsigned)(255 - (a * 16 + b))); }
            const float s0 = dec_ord(C[0] & ~255u); float e[16]; float sum = 0.f;
#pragma unroll
            for (int p = 0; p < 16; ++p) { e[p] = __expf(dec_ord(C[p] & ~255u) - s0); sum += e[p]; }
            const float inv = 1.0f / sum; const size_t ob = (size_t)(tokb + fr) * 128 + h * 16;
#pragma unroll
            for (int p = 0; p < 16; ++p) { LST[(wave * 32 + p) * 64 + lane] = L1[p]; LST[(wave * 32 + 16 + p) * 64 + lane] = L2[p]; }
#pragma unroll
            for (int p = 0; p < 16; ++p) { const int cid = 255 - (int)(C[p] & 255u); const int a = cid >> 4, b = cid & 15;
                const int e1 = 127 - (int)(LST[(wave * 32 + a) * 64 + lane] & 127u), e2 = 127 - (int)(LST[(wave * 32 + 16 + b) * 64 + lane] & 127u);
                if ((p >> 2) == fq) { IDX[ob + p] = e1 * 128 + e2; GT[ob + p] = e[p] * inv; } }
        }
    }
}

__device__ __forceinline__ void phase_gather(ArgP Ap, int l) {
    const int tx = opaque_tid(), lane = tx & 63, wave = tx >> 6, gw = blockIdx.x * NWAVES + wave, NGW = gridDim.x * NWAVES;
    float* H = (float*)(A.ws + WS_H); bf16* XB = (bf16*)(A.ws + WS_XB); const int* IDX = (const int*)(A.ws + WS_IDX); const float* GT = (const float*)(A.ws + WS_GT);
    const bf16* PU = (const bf16*)(A.ws + WS_PU); const bf16* PV = (const bf16*)(A.ws + WS_PV);
    const float* lg = A.in[29] + l * D; const float* lb = A.in[30] + l * D;
    for (int tok = gw; tok < T; tok += NGW) {
        float xa[8], xb[8];
        { const float4 a = *(const float4*)(H + (size_t)tok * D + 8 * lane), b = *(const float4*)(H + (size_t)tok * D + 8 * lane + 4);
          const float4 c = *(const float4*)(H + (size_t)tok * D + 512 + 8 * lane), d = *(const float4*)(H + (size_t)tok * D + 512 + 8 * lane + 4);
          xa[0] = a.x; xa[1] = a.y; xa[2] = a.z; xa[3] = a.w; xa[4] = b.x; xa[5] = b.y; xa[6] = b.z; xa[7] = b.w;
          xb[0] = c.x; xb[1] = c.y; xb[2] = c.z; xb[3] = c.w; xb[4] = d.x; xb[5] = d.y; xb[6] = d.z; xb[7] = d.w; }
        const int i0 = IDX[(size_t)tok * 128 + lane], i1 = IDX[(size_t)tok * 128 + 64 + lane]; const float g0 = GT[(size_t)tok * 128 + lane], g1 = GT[(size_t)tok * 128 + 64 + lane];
        float oa[8], ob[8];
#pragma unroll
        for (int i = 0; i < 8; ++i) { oa[i] = 0.f; ob[i] = 0.f; }
        for (int kb = 0; kb < 128; kb += 8) {
            u32x4 ua[8], ub[8], va[8], vb[8]; float gk[8];
#pragma unroll
            for (int kk = 0; kk < 8; ++kk) { const int k = kb + kk; const int e = __shfl(kb < 64 ? i0 : i1, k & 63); gk[kk] = __shfl(kb < 64 ? g0 : g1, k & 63);
                const bf16* ur = PU + (size_t)e * D + 8 * lane; const bf16* vr = PV + (size_t)e * D + 8 * lane;
                ua[kk] = *(const u32x4*)ur; ub[kk] = *(const u32x4*)(ur + 512); va[kk] = *(const u32x4*)vr; vb[kk] = *(const u32x4*)(vr + 512); }
#pragma unroll
            for (int kk = 0; kk < 8; ++kk) { float f[8], g[8]; unpack8(ua[kk], f); unpack8(ub[kk], g); float p = 0.f;
#pragma unroll
                for (int i = 0; i < 8; ++i) p += f[i] * xa[i] + g[i] * xb[i];
                p = wave_sum64(p);
                const float act = 0.5f * p * (1.0f + erff(p * 0.70710678118654752f)) * gk[kk];
                unpack8(va[kk], f); unpack8(vb[kk], g);
#pragma unroll
                for (int i = 0; i < 8; ++i) { oa[i] += act * f[i]; ob[i] += act * g[i]; } }
        }
        float s1 = 0.f;
#pragma unroll
        for (int i = 0; i < 8; ++i) { oa[i] += DN_ALPHA_ * xa[i]; ob[i] += DN_ALPHA_ * xb[i]; s1 += oa[i] + ob[i]; }
        const float mu = wave_sum64(s1) * (1.0f / D); float s2 = 0.f;
#pragma unroll
        for (int i = 0; i < 8; ++i) { oa[i] -= mu; ob[i] -= mu; s2 += oa[i] * oa[i] + ob[i] * ob[i]; }
        const float rstd = 1.0f / sqrtf(wave_sum64(s2) * (1.0f / D) + EPS_);
#pragma unroll
        for (int i = 0; i < 8; ++i) { oa[i] = oa[i] * rstd * lg[8 * lane + i] + lb[8 * lane + i]; ob[i] = ob[i] * rstd * lg[512 + 8 * lane + i] + lb[512 + 8 * lane + i]; }
        float* dst = (l == 1) ? A.out + (size_t)tok * D : H + (size_t)tok * D;
        *(float4*)(dst + 8 * lane) = make_float4(oa[0], oa[1], oa[2], oa[3]); *(float4*)(dst + 8 * lane + 4) = make_float4(oa[4], oa[5], oa[6], oa[7]);
        *(float4*)(dst + 512 + 8 * lane) = make_float4(ob[0], ob[1], ob[2], ob[3]); *(float4*)(dst + 512 + 8 * lane + 4) = make_float4(ob[4], ob[5], ob[6], ob[7]);
        if (l == 0) { *(u32x4*)(XB + (size_t)tok * D + 8 * lane) = pack8(oa); *(u32x4*)(XB + (size_t)tok * D + 512 + 8 * lane) = pack8(ob); }
    }
}

#ifndef EMU
struct MergeOrder {
    pg8::StaticOrder S;
    __device__ bool next(int i, pg8::Unit& u) const { pg8::Unit t; if (!S.next(i / 3, t)) return false; const int n = i % 3; u.pm = n * (T / 256) + t.pm; u.pn = n * 4 + t.pn; return true; }
    __device__ __forceinline__ void a_ready(const pg8::Unit&) const {}
    __device__ __forceinline__ void done(const pg8::Unit&) const {}
};
struct EpiMerge {
    static constexpr bool PERM = true, AFTER_DRAIN = false;
    const bf16* ZG; float* MIXF; bf16* MIXED;
    __device__ __forceinline__ void operator()(const pg8::f32x4 (&acc)[2][2][4][2], const pg8::Unit& u, int wr, int wc, int fr, int fq) const {
        const int n = u.pn >> 2, pn = u.pn & 3, pm = u.pm - n * (T / 256);
        const int row0 = pm * 256 + wr * 64 + fr, col0 = pn * 256 + wc * 32 + 8 * fq;
#pragma unroll
        for (int ai = 0; ai < 2; ++ai)
#pragma unroll
            for (int m = 0; m < 4; ++m) { const size_t row = (size_t)(row0 + ai * 128 + m * 16);
#pragma unroll
                for (int bj = 0; bj < 2; ++bj) { const int col = col0 + bj * 128;
                    float g[8]; unpack8(*(const u32x4*)(ZG + row * NZG + n * D + col), g);
                    float v[8];
#pragma unroll
                    for (int j = 0; j < 4; ++j) { v[j] = acc[ai][bj][m][0][j] * g[j]; v[4 + j] = acc[ai][bj][m][1][j] * g[4 + j]; }
                    float* mp = MIXF + row * D + col;
                    if (n > 0) { const float4 a = *(const float4*)mp, b = *(const float4*)(mp + 4);
                        v[0] += a.x; v[1] += a.y; v[2] += a.z; v[3] += a.w; v[4] += b.x; v[5] += b.y; v[6] += b.z; v[7] += b.w; }
                    if (n < 2) { *(float4*)mp = make_float4(v[0], v[1], v[2], v[3]); *(float4*)(mp + 4) = make_float4(v[4], v[5], v[6], v[7]); }
                    else *(u32x4*)(MIXED + row * D + col) = pack8(v); } }
    }
};
__device__ __forceinline__ void phase_merge(ArgP Ap, LAS unsigned char* lds, int l) {
    pg8::Gemm g{(const bf16*)(A.ws + WS_BR), (const bf16*)(A.ws + WS_WB + (size_t)l * WB_BYTES + WB_WBR), 3 * T, 3 * D, 512};
    MergeOrder S; S.S.init(T, D, gridDim.x, blockIdx.x);
    EpiMerge E{(const bf16*)(A.ws + WS_ZG), (float*)(A.ws + WS_ZM), (bf16*)(A.ws + WS_XB)};
    pg8::gemm_phase<EpiMerge, MergeOrder>(lds, g, S, E);
}
struct EpiF32 {
    static constexpr bool PERM = false, AFTER_DRAIN = false;
    float* C; int ldc;
    __device__ __forceinline__ void operator()(const pg8::f32x4 (&acc)[2][2][4][2], const pg8::Unit& u, int wr, int wc, int fr, int fq) const {
        const int row0 = u.pm * 256 + wr * 64 + fr, col0 = u.pn * 256 + wc * 32 + 4 * fq;
#pragma unroll
        for (int ai = 0; ai < 2; ++ai)
#pragma unroll
            for (int m = 0; m < 4; ++m) { float* rowp = C + (size_t)(row0 + ai * 128 + m * 16) * ldc + col0;
#pragma unroll
                for (int bj = 0; bj < 2; ++bj)
#pragma unroll
                    for (int n = 0; n < 2; ++n) *(pg8::f32x4*)(rowp + bj * 128 + n * 16) = acc[ai][bj][m][n]; }
    }
};
struct EpiB16 {
    static constexpr bool PERM = true, AFTER_DRAIN = false;
    bf16* O; int ldc;
    __device__ __forceinline__ void operator()(const pg8::f32x4 (&acc)[2][2][4][2], const pg8::Unit& u, int wr, int wc, int fr, int fq) const {
        const int row0 = u.pm * 256 + wr * 64 + fr, col0 = u.pn * 256 + wc * 32 + 8 * fq;
#pragma unroll
        for (int ai = 0; ai < 2; ++ai)
#pragma unroll
            for (int m = 0; m < 4; ++m) { bf16* rowp = O + (size_t)(row0 + ai * 128 + m * 16) * ldc + col0;
#pragma unroll
                for (int bj = 0; bj < 2; ++bj) { const pg8::f32x4 v0 = acc[ai][bj][m][0], v1 = acc[ai][bj][m][1];
                    u32x4 w; w.x = pg8::cvt_pk_bf16(v0[0], v0[1]); w.y = pg8::cvt_pk_bf16(v0[2], v0[3]); w.z = pg8::cvt_pk_bf16(v1[0], v1[1]); w.w = pg8::cvt_pk_bf16(v1[2], v1[3]);
                    *(u32x4*)(rowp + bj * 128) = w; } }
    }
};
__device__ __forceinline__ void phase_outproj(ArgP Ap, LAS unsigned char* lds, int l) {
    pg8::Gemm g{(const bf16*)(A.ws + WS_XB), (const bf16*)(A.ws + WS_WB + (size_t)l * WB_BYTES + WB_WO), T, D, D};
    pg8::StaticOrder S; S.init(T, D, gridDim.x, blockIdx.x);
    EpiF32 E{(float*)(A.ws + WS_ZG), D};
    pg8::gemm_phase<EpiF32, pg8::StaticOrder>(lds, g, S, E);
}
__device__ __forceinline__ void phase_qproj(ArgP Ap, LAS unsigned char* lds, int l) {
    pg8::Gemm g{(const bf16*)(A.ws + WS_BR), (const bf16*)(A.ws + WS_WB + (size_t)l * WB_BYTES + WB_WQ), T, 2048, D};
    pg8::StaticOrder S; S.init(T, 2048, gridDim.x, blockIdx.x);
    EpiB16 E{(bf16*)(A.ws + WS_Q), 2048};
    pg8::gemm_phase<EpiB16, pg8::StaticOrder>(lds, g, S, E);
}

__global__ void __launch_bounds__(NTHREADS, 2) mega_fwd(Args kargs) {
    extern __shared__ __attribute__((aligned(16))) unsigned char lds_raw[];
    LAS unsigned char* lds = (LAS unsigned char*)lds_raw;
    cg::grid_group grid = cg::this_grid();
    volatile LAS unsigned* xst = (volatile LAS unsigned*)(lds + LDS_BYTES - 16);
    unsigned* xbar = (unsigned*)(kargs.ws + WS_CTL);
    if (threadIdx.x < 4) xst[threadIdx.x] = 0u;
    if (blockIdx.x == 0) for (int i = threadIdx.x; i < XCD_BAR_WORDS; i += NTHREADS) xbar[i] = 0u;
    __syncthreads();
    XcdBarrier xb; xb.bar = xbar; xb.x = 0; xb.st = xst; bool xposted = false;
    ArgP Ap = (ArgP)__builtin_amdgcn_kernarg_segment_ptr();
    const int lo = A.ph_lo, hi = A.ph_hi;
#define RUN(call) do { ArgP Ap_ = Ap; int l_ = l; asm volatile("" : "+s"(Ap_), "+s"(l_) :: "memory"); { ArgP Ap = Ap_; const int l = l_; call; } asm volatile("" ::: "memory"); } while (0)
#ifndef ONLYP
#define ONLYP -1
#endif
#define PSEL(q) (ONLYP < 0 || ONLYP == (q))
#ifndef REPMASK
#define REPMASK 0
#endif
#define REP(q, l) (((REPMASK >> (q)) & 1) && ((q) != 5 || (l) == 0) && ((q) != 8 || (l) == 1))
#define IN(k) (lo <= (k) && (k) < hi)
#define SEAM(k) do { if (IN(k) && IN((k) + 1)) { if (!xposted) { grid.sync(); xb = xcd_barrier_post(xbar, xst); xposted = true; } else xcd_barrier(xb); } } while (0)
    { const int l = 0; if (PSEL(0) && IN(0)) { RUN(phase_convert(Ap, lds)); if (REP(0, l)) RUN(phase_convert(Ap, lds)); } (void)l; }
    SEAM(0);
    for (int l = 0; l < 2; ++l) {
        const int p = 1 + 9 * l;
        if (PSEL(1) && IN(p + 0)) { RUN(phase_gemm1(Ap, lds, l)); if (REP(1, l)) RUN(phase_gemm1(Ap, lds, l)); }
        SEAM(p);
        if (PSEL(2) && IN(p + 1)) { RUN(phase_mixers(Ap, lds, l)); if (REP(2, l)) RUN(phase_mixers(Ap, lds, l)); }
        SEAM(p + 1);
        if (PSEL(9) && IN(p + 2)) RUN(phase_ssdnorm(Ap, l));
        SEAM(p + 2);
        if (PSEL(3) && IN(p + 3)) { RUN(phase_merge(Ap, lds, l)); if (REP(3, l)) RUN(phase_merge(Ap, lds, l)); }
        SEAM(p + 3);
        if (PSEL(4) && IN(p + 4)) { RUN(phase_outproj(Ap, lds, l)); if (REP(4, l)) RUN(phase_outproj(Ap, lds, l)); }
        SEAM(p + 4);
        if (PSEL(5) && IN(p + 5)) { RUN(phase_ln1(Ap, l)); if (REP(5, l)) RUN(phase_ln1(Ap, l)); }
        SEAM(p + 5);
        if (PSEL(6) && IN(p + 6)) { RUN(phase_qproj(Ap, lds, l)); if (REP(6, l)) RUN(phase_qproj(Ap, lds, l)); }
        SEAM(p + 6);
        if (PSEL(7) && IN(p + 7)) { RUN(phase_route(Ap, lds, l)); if (REP(7, l)) RUN(phase_route(Ap, lds, l)); }
        SEAM(p + 7);
        if (PSEL(8) && IN(p + 8)) { RUN(phase_gather(Ap, l)); if (REP(8, l)) RUN(phase_gather(Ap, l)); }
        SEAM(p + 8);
    }
#undef IN
#undef RUN
#undef SEAM
}

extern "C" void kernel_launch(void* const* d_in, const int* in_sizes, int n_in, void* d_out, int out_size, void* d_ws, size_t ws_size, hipStream_t stream) {
    static int grid_blocks = 0;
    if (grid_blocks == 0) {
        if (n_in != 31 || (size_t)out_size != O_END || ws_size < WS_END) {
            fprintf(stderr, "kernel_launch: unexpected problem: n_in %d out %d (want %zu) ws %zu (want >= %zu)\n", n_in, out_size, (size_t)O_END, ws_size, (size_t)WS_END); grid_blocks = -1; return; }
        int dev = 0, cus = 0, per_cu = 0;
        (void)hipGetDevice(&dev); (void)hipDeviceGetAttribute(&cus, hipDeviceAttributeMultiprocessorCount, dev);
        if (hipFuncSetAttribute((const void*)mega_fwd, hipFuncAttributeMaxDynamicSharedMemorySize, LDS_BYTES) != hipSuccess) { fprintf(stderr, "kernel_launch: hipFuncSetAttribute failed\n"); grid_blocks = -1; return; }
        if (hipOccupancyMaxActiveBlocksPerMultiprocessor(&per_cu, (const void*)mega_fwd, NTHREADS, LDS_BYTES) != hipSuccess || per_cu < 1) { fprintf(stderr, "kernel_launch: occupancy query failed (%d)\n", per_cu); grid_blocks = -1; return; }
        grid_blocks = cus * per_cu;
        fprintf(stderr, "kernel_launch: %d CUs x %d = %d workgroups\n", cus, per_cu, grid_blocks);
    }
    if (grid_blocks < 0) return;
    Args a{};
    for (int i = 0; i < 31; ++i) a.in[i] = (const float*)d_in[i];
    a.out = (float*)d_out; a.ws = (unsigned char*)d_ws; a.ph_lo = 0; a.ph_hi = 64;
    void* args[] = {&a};
    hipError_t e = hipLaunchCooperativeKernel((const void*)mega_fwd, dim3(grid_blocks), dim3(NTHREADS), args, LDS_BYTES, stream);
    if (e != hipSuccess) fprintf(stderr, "kernel_launch: cooperative launch failed: %s (grid %d)\n", hipGetErrorString(e), grid_blocks);
}
#endif
```

```cpp
#ifndef EMU
#include <hip/hip_runtime.h>
#include <hip/hip_cooperative_groups.h>
#include <cstdio>
#include <cstdint>
namespace cg = cooperative_groups;
namespace pg8 {
#define PG8_LAS __attribute__((address_space(3)))
typedef unsigned short bf16_t;
typedef short bf16x8 __attribute__((ext_vector_type(8)));
typedef float f32x4 __attribute__((ext_vector_type(4)));
typedef unsigned u32x4 __attribute__((ext_vector_type(4)));
constexpr int BM = 256, BK = 64, HALF = 128, HTB = HALF * BK * 2  , STAGE_BYTES = 8 * HTB, NXCD = 8, WGM = 8;

__host__ __device__ __forceinline__ int lds_byte(int r, int c) { const int st = (r >> 4) * 2 + (c >> 5), rr = r & 15, cc = c & 31, ob = rr * 64 + cc * 2; return st * 1024 + (ob ^ (((ob >> 9) & 1) << 5)); }
__host__ __device__ __forceinline__ void stage_rc(int b, int& R, int& C) { const int st = b / 1024, sb = b % 1024, swz = sb ^ (((sb >> 9) & 1) << 5); R = (st >> 1) * 16 + swz / 64; C = (st & 1) * 32 + (swz % 64) / 2; }
__host__ __device__ __forceinline__ int perm32(int rho) { const int n = rho >> 4, i = rho & 15; return 8 * (i >> 2) + 4 * n + (i & 3); }

struct Unit { int pm, pn; };
struct Gemm { const bf16_t* A; const bf16_t* Bt; int M, N, K; };

struct StaticOrder {
    int nM, nN, nwg, G, c;
    __host__ __device__ void init(int M, int N, int G_, int c_) { nM = M / BM; nN = N / BM; nwg = nM * nN; G = G_; c = c_; }
    __host__ __device__ bool next(int i, Unit& u) const {
        const long L = (long)i * G + c; if (L >= nwg) return false;
        int wgid = (int)L; { const int q = nwg / NXCD, r = nwg % NXCD, xcd = wgid % NXCD, off = wgid / NXCD; wgid = (xcd < r ? xcd * (q + 1) : r * (q + 1) + (xcd - r) * q) + off; }
        const int nig = WGM * nN, gid = wgid / nig, fm = gid * WGM, gsz = (nM - fm) < WGM ? (nM - fm) : WGM;
        u.pm = fm + ((wgid % nig) % gsz); u.pn = (wgid % nig) / gsz; return true;
    }
    __device__ __forceinline__ void a_ready(const Unit&) const {}
    __device__ __forceinline__ void done(const Unit&) const {}
};

__device__ __forceinline__ unsigned cvt_pk_bf16(float lo, float hi) { unsigned r; asm volatile("v_cvt_pk_bf16_f32 %0, %1, %2" : "=v"(r) : "v"(lo), "v"(hi)); return r; }
typedef float f32x2 __attribute__((ext_vector_type(2)));
__device__ __forceinline__ f32x2 gelu_pk(f32x2 v) {
    const f32x2 av = __builtin_elementwise_abs(v), d = av * 0.2316418882f + 1.0f;
    f32x2 t; t.x = __builtin_amdgcn_rcpf(d.x); t.y = __builtin_amdgcn_rcpf(d.y);
    f32x2 q = t * 0.5307027145f + (-0.7265760135f); q = q * t + 0.7107068705f; q = q * t + (-0.142248368f); q = q * t + 0.127414796f; q = q * t;
    const f32x2 s = (v * v) * (-0.72134752044f);
    f32x2 e; e.x = __builtin_amdgcn_exp2f(s.x); e.y = __builtin_amdgcn_exp2f(s.y);
    const f32x2 m = v * (q * e), r = v - m;
    f32x2 o; o.x = v.x < 0.f ? m.x : r.x; o.y = v.y < 0.f ? m.y : r.y; return o;
}

template <class Epi, class Sched>
__device__ __forceinline__ void gemm_phase(PG8_LAS unsigned char* lds, const Gemm g, const Sched& S, const Epi& E) {
    int tid_o = threadIdx.x; asm volatile("" : "+v"(tid_o));
    const int tid = tid_o, wid = __builtin_amdgcn_readfirstlane(tid >> 6), lane = tid & 63, wr = wid >> 2, wc = wid & 3, fr = lane & 15, fq = lane >> 4;
    const int K = g.K, nt = K / BK;
    unsigned voffA[2], voffB[2];
#pragma unroll
    for (int i = 0; i < 2; ++i) { int R, C; stage_rc(tid * 16 + i * 8192, R, C); const int Rb = Epi::PERM ? ((R & ~31) + perm32(R & 31)) : R;
        voffA[i] = (unsigned)(R * K + C) * 2u; voffB[i] = (unsigned)(Rb * K + C) * 2u; }
    const size_t kstep = (size_t)(BK * 2);
    const size_t hstep = (size_t)HALF * K * 2;
    const size_t tstep = 2 * hstep;
    const unsigned ldsw = (unsigned)wid * 1024u;
    const int aoff = lds_byte(wr * 64 + fr, fq * 8), boff = lds_byte(wc * 32 + fr, fq * 8);
#define PG8_SA(b, h) (((b) * 2 + (h)) * HTB)
#define PG8_SB(b, h) ((4 + (b) * 2 + (h)) * HTB)
#define PG8_STAGE(bufoff, gbase, voff) do { _Pragma("unroll") for (int _i = 0; _i < 2; ++_i) \
        __builtin_amdgcn_global_load_lds((const unsigned*)((const char*)(gbase) + (voff)[_i]), (PG8_LAS unsigned*)(lds + (bufoff) + ldsw + _i * 8192), 16, 0, 0); } while (0)
#define PG8_LDA(dst, b, h) do { _Pragma("unroll") for (int m = 0; m < 4; ++m) _Pragma("unroll") for (int k = 0; k < 2; ++k) dst[m][k] = *(const PG8_LAS bf16x8*)(lds + PG8_SA(b, h) + aoff + m * 2048 + k * 1024); } while (0)
#define PG8_LDB(dst, b, h) do { _Pragma("unroll") for (int n = 0; n < 2; ++n) _Pragma("unroll") for (int k = 0; k < 2; ++k) dst[n][k] = *(const PG8_LAS bf16x8*)(lds + PG8_SB(b, h) + boff + n * 2048 + k * 1024); } while (0)
#define PG8_MMA(ai, bj, At, Bt) do { __builtin_amdgcn_s_setprio(1); _Pragma("unroll") for (int m = 0; m < 4; ++m) _Pragma("unroll") for (int n = 0; n < 2; ++n) _Pragma("unroll") for (int k = 0; k < 2; ++k) \
        acc[ai][bj][m][n] = __builtin_amdgcn_mfma_f32_16x16x32_bf16(Bt[n][k], At[m][k], acc[ai][bj][m][n], 0, 0, 0); __builtin_amdgcn_s_setprio(0); } while (0)
#define PG8_WAIT_V(n) asm volatile("s_waitcnt vmcnt(" #n ")" ::: "memory")
#define PG8_WAIT_L(n) asm volatile("s_waitcnt lgkmcnt(" #n ")" ::: "memory")
#define PG8_BAR __builtin_amdgcn_s_barrier()
#define PG8_SCHED __builtin_amdgcn_sched_barrier(0)
    Unit cur, nxt; int ui = 0;
    if (!S.next(0, cur)) return;
    f32x4 acc[2][2][4][2];
#pragma unroll
    for (int a = 0; a < 2; ++a)
#pragma unroll
        for (int b = 0; b < 2; ++b)
#pragma unroll
            for (int m = 0; m < 4; ++m)
#pragma unroll
                for (int n = 0; n < 2; ++n) acc[a][b][m][n] = (f32x4){0.f, 0.f, 0.f, 0.f};
    bf16x8 At[4][2], B0[2][2], B1[2][2];
    const char* cA = (const char*)g.A + (size_t)cur.pm * tstep; const char* cB = (const char*)g.Bt + (size_t)cur.pn * tstep;
    S.a_ready(cur);
    PG8_STAGE(PG8_SB(0, 0), cB, voffB); PG8_STAGE(PG8_SA(0, 0), cA, voffA); PG8_STAGE(PG8_SB(0, 1), cB + hstep, voffB); PG8_STAGE(PG8_SA(0, 1), cA + hstep, voffA);
    if (wr == 1) PG8_BAR;
    PG8_WAIT_V(4); PG8_BAR;
    PG8_STAGE(PG8_SB(1, 0), cB + kstep, voffB); PG8_STAGE(PG8_SA(1, 0), cA + kstep, voffA); PG8_STAGE(PG8_SB(1, 1), cB + hstep + kstep, voffB);
    PG8_WAIT_V(6); PG8_BAR;
    for (;;) {
        const bool has_next = S.next(ui + 1, nxt);
        const char* nA = has_next ? (const char*)g.A + (size_t)nxt.pm * tstep : cA; const char* nB = has_next ? (const char*)g.Bt + (size_t)nxt.pn * tstep : cB;
        for (int t = 0; t < nt; t += 2) {
            const bool last = (t == nt - 2);
            const char* a1 = cA + (size_t)(t + 1) * kstep;
            const char* a2 = last ? nA : cA + (size_t)(t + 2) * kstep; const char* b2 = last ? nB : cB + (size_t)(t + 2) * kstep;
            const char* a3 = a2 + kstep; const char* b3 = b2 + kstep;
            if (last && has_next) S.a_ready(nxt);
            PG8_LDB(B0, 0, 0); PG8_SCHED; PG8_LDA(At, 0, 0); PG8_STAGE(PG8_SA(1, 1), a1 + hstep, voffA);
            PG8_WAIT_L(8); PG8_BAR; PG8_WAIT_L(0); PG8_MMA(0, 0, At, B0); PG8_BAR; PG8_SCHED;
            PG8_LDB(B1, 0, 1); PG8_STAGE(PG8_SB(0, 0), b2, voffB);
            PG8_BAR; PG8_WAIT_L(0); PG8_MMA(0, 1, At, B1); PG8_BAR;
            PG8_LDA(At, 0, 1); PG8_STAGE(PG8_SA(0, 0), a2, voffA);
            PG8_BAR; PG8_WAIT_L(0); PG8_MMA(1, 0, At, B0); PG8_BAR; PG8_SCHED;
            PG8_STAGE(PG8_SB(0, 1), b2 + hstep, voffB);
            PG8_WAIT_V(6); PG8_BAR; PG8_MMA(1, 1, At, B1); PG8_BAR;
            PG8_LDB(B0, 1, 0); PG8_SCHED; PG8_LDA(At, 1, 0); PG8_STAGE(PG8_SA(0, 1), a2 + hstep, voffA);
            PG8_WAIT_L(8); PG8_BAR; PG8_WAIT_L(0); PG8_MMA(0, 0, At, B0); PG8_BAR; PG8_SCHED;
            PG8_LDB(B1, 1, 1); PG8_STAGE(PG8_SB(1, 0), b3, voffB);
            PG8_BAR; PG8_WAIT_L(0); PG8_MMA(0, 1, At, B1); PG8_BAR;
            PG8_LDA(At, 1, 1); PG8_STAGE(PG8_SA(1, 0), a3, voffA);
            PG8_BAR; PG8_WAIT_L(0); PG8_MMA(1, 0, At, B0); PG8_BAR; PG8_SCHED;
            PG8_STAGE(PG8_SB(1, 1), b3 + hstep, voffB);
            PG8_WAIT_V(6); PG8_BAR; PG8_MMA(1, 1, At, B1); PG8_BAR;
        }
        if constexpr (!Epi::AFTER_DRAIN) { E(acc, cur, wr, wc, fr, fq); S.done(cur); }
        if (!has_next) break;
#pragma unroll
        for (int a = 0; a < 2; ++a)
#pragma unroll
            for (int b = 0; b < 2; ++b)
#pragma unroll
                for (int m = 0; m < 4; ++m)
#pragma unroll
                    for (int n = 0; n < 2; ++n) acc[a][b][m][n] = (f32x4){0.f, 0.f, 0.f, 0.f};
        cur = nxt; cA = nA; cB = nB; ++ui;
    }
    PG8_WAIT_V(0);
    if (wr == 0) PG8_BAR;
    PG8_BAR;
    if constexpr (Epi::AFTER_DRAIN) { E.fused(acc, cur, wr, wc, fr, fq, lds, wid, lane); S.done(cur); }
#undef PG8_SA
#undef PG8_SB
#undef PG8_STAGE
#undef PG8_LDA
#undef PG8_LDB
#undef PG8_MMA
#undef PG8_WAIT_V
#undef PG8_WAIT_L
#undef PG8_BAR
#undef PG8_SCHED
}
}

#endif

typedef unsigned short bf16;
#ifndef EMU
#define LAS __attribute__((address_space(3)))
#else
#define LAS
#endif
typedef short bf16x8 __attribute__((ext_vector_type(8)));
typedef float f32x4 __attribute__((ext_vector_type(4)));
typedef unsigned u32x4 __attribute__((ext_vector_type(4)));
typedef unsigned u32x2 __attribute__((ext_vector_type(2)));

#ifdef EMU
constexpr int BP = EMU_BP, LP = EMU_LP, BS = EMU_BS;
#else
constexpr int BP = 8, LP = 2048, BS = 128;
#endif
constexpr int D = 1024, LS = 4, TP = BP * LP, TS = BS * LS, T = TP + TS;
constexpr int INW = 7968, NZM = 4864, NZG = 3072, NZ = NZM + NZG, NSM = 32;
constexpr int NEXP = 16384;
constexpr int NTHREADS = 512, NWAVES = 8;
constexpr int LDS_BYTES = 160 * 1024;

constexpr size_t O_YP = 0, O_YS = O_YP + (size_t)TP * D, O_PC = O_YS + (size_t)TS * D, O_PN = O_PC + 2ull * BP * 4 * 128 * 128, O_PM = O_PN + 2ull * BP * 4 * 128,
    O_PG = O_PM + 2ull * BP * 4, O_PH = O_PG + 2ull * BP * 4 * 64 * 128, O_PV = O_PH + 2ull * BP * 8 * 64 * 64, O_SC = O_PV + 2ull * BP * 3 * 768,
    O_SN = O_SC + 2ull * BS * 4 * 128 * 128, O_SM = O_SN + 2ull * BS * 4 * 128, O_SG = O_SM + 2ull * BS * 4, O_SH = O_SG + 2ull * BS * 4 * 64 * 128,
    O_SV = O_SH + 2ull * BS * 8 * 64 * 64, O_END = O_SV + 2ull * BS * 3 * 768;

constexpr size_t al256(size_t x) { return (x + 255) & ~(size_t)255; }
constexpr size_t WS_CTL = 0, WS_CTL_BYTES = 65536;
constexpr size_t WB_WIN = 0, WB_WS = WB_WIN + (size_t)NZ * D * 2, WB_WBR = WB_WS + (size_t)NSM * D * 2, WB_WO = WB_WBR + 3ull * D * 512 * 2, WB_WQ = WB_WO + (size_t)D * D * 2,
    WB_KEYS = WB_WQ + 2048ull * D * 2, WB_BYTES = WB_KEYS + 16ull * 128 * 128 * 2;
constexpr size_t WS_WB = WS_CTL + WS_CTL_BYTES;
constexpr size_t WS_XB = WS_WB + 2 * WB_BYTES;
constexpr size_t WS_H = WS_XB + (size_t)T * D * 2;
constexpr size_t WS_ZS = WS_H + (size_t)T * D * 4;
constexpr size_t WS_BR = WS_ZS + (size_t)T * NSM * 4;
constexpr size_t WS_ZM = WS_BR + 3ull * T * 512 * 2;
constexpr size_t WS_ZG = WS_ZM + (size_t)T * NZM * 2;
constexpr size_t WS_END0 = WS_ZG + (size_t)T * NZG * 2;
constexpr size_t WS_Q = WS_ZM, WS_IDX = WS_Q + (size_t)T * 2048 * 2, WS_GT = WS_IDX + (size_t)T * 128 * 4;
#ifdef EMU
constexpr size_t WS_PU = WS_END0;
#else
constexpr size_t WS_PU = WS_GT + (size_t)T * 128 * 4;
#endif
constexpr size_t WS_PV = WS_PU + (size_t)NEXP * D, WS_PUS = WS_PV + (size_t)NEXP * D, WS_PVS = WS_PUS + (size_t)NEXP * 4, WS_PEND = WS_PVS + (size_t)NEXP * 4;
#ifdef EMU
constexpr size_t WS_END = WS_PEND;
#else
constexpr size_t WS_END = WS_END0;
static_assert(WS_PEND <= WS_ZG, "ZM alias overflow");
#endif
static_assert((size_t)T * D * 4 <= (size_t)T * NZG * 2, "Y alias overflow");

#ifndef EMU
__device__ __forceinline__ f32x4 mfma16(bf16x8 a, bf16x8 b, f32x4 c) { return __builtin_amdgcn_mfma_f32_16x16x32_bf16(a, b, c, 0, 0, 0); }
#endif
struct Args { const float* in[31]; float* out; unsigned char* ws; int ph_lo, ph_hi; };
#ifndef EMU
typedef const __attribute__((address_space(4))) Args* ArgP;
#else
typedef const Args* ArgP;
#endif
#define A (*Ap)
#ifndef EMU
#define OPQV(x) asm volatile("" : "+v"(x))
#define LDS_BARRIER() asm volatile("s_waitcnt lgkmcnt(0)\n\ts_barrier" ::: "memory")
#else
#define OPQV(x) (void)(x)
#define LDS_BARRIER() __syncthreads()
#endif
#ifndef EMU
__device__ __forceinline__ int opaque_tid() { int t = threadIdx.x; asm volatile("" : "+v"(t)); return t; }
#else
static inline int opaque_tid() { return threadIdx.x; }
#endif

#ifndef EMU
__device__ __forceinline__ unsigned pk_fp8x4(float a, float b, float c, float d) { int w = __builtin_amdgcn_cvt_pk_fp8_f32(a, b, 0, false); w = __builtin_amdgcn_cvt_pk_fp8_f32(c, d, w, true); return (unsigned)w; }
__device__ __forceinline__ void unpk_fp8x4(unsigned w, float* f) { typedef float f32x2_ __attribute__((ext_vector_type(2)));
    const f32x2_ lo = __builtin_amdgcn_cvt_pk_f32_fp8((int)w, false), hi = __builtin_amdgcn_cvt_pk_f32_fp8((int)w, true); f[0] = lo.x; f[1] = lo.y; f[2] = hi.x; f[3] = hi.y; }
#endif
__device__ __forceinline__ bf16 f2bf(float f) { unsigned u = __float_as_uint(f); u += 0x7FFFu + ((u >> 16) & 1u); return (bf16)(u >> 16); }
__device__ __forceinline__ float bf2f(bf16 b) { return __uint_as_float(((unsigned)b) << 16); }
__device__ __forceinline__ unsigned pk2(float lo, float hi) { return (unsigned)f2bf(lo) | ((unsigned)f2bf(hi) << 16); }

__device__ __forceinline__ void tconv_tile(const float* __restrict__ src, int ldsrc, int k0, int c0, bf16* __restrict__ dst, int ldd, int n0, LAS float* tile) {
    const int t = opaque_tid(), i = t >> 3, jg = (t & 7) * 8;
    const float4 a = *(const float4*)(src + (size_t)(k0 + i) * ldsrc + c0 + jg), b = *(const float4*)(src + (size_t)(k0 + i) * ldsrc + c0 + jg + 4);
    LAS float* r = tile + i * 65 + jg;
    r[0] = a.x; r[1] = a.y; r[2] = a.z; r[3] = a.w; r[4] = b.x; r[5] = b.y; r[6] = b.z; r[7] = b.w;
    __syncthreads();
    const int j = t >> 3, ig = (t & 7) * 8;
    u32x4 w;
    w.x = pk2(tile[(ig + 0) * 65 + j], tile[(ig + 1) * 65 + j]); w.y = pk2(tile[(ig + 2) * 65 + j], tile[(ig + 3) * 65 + j]);
    w.z = pk2(tile[(ig + 4) * 65 + j], tile[(ig + 5) * 65 + j]); w.w = pk2(tile[(ig + 6) * 65 + j], tile[(ig + 7) * 65 + j]);
    *(u32x4*)(dst + (size_t)(n0 + j) * ldd + k0 + ig) = w;
    __syncthreads();
}
__device__ __forceinline__ int zcol_to_src(int zc) { return zc < 2048 ? zc : (zc < 3584 ? zc + 8 : (zc < 4864 ? zc + 24 : zc + 32)); }
__device__ __forceinline__ int scol_to_src(int sc) { return sc < 8 ? 2048 + sc : (sc < 24 ? 3592 + (sc - 8) : 4888 + (sc - 24)); }

__device__ __forceinline__ void convert_f32_bf16(const float* __restrict__ src, bf16* __restrict__ dst, size_t n, int gtid, int gthreads) {
    for (size_t i = (size_t)gtid * 8; i < n; i += (size_t)gthreads * 8) {
        const float4 a = *(const float4*)(src + i), b = *(const float4*)(src + i + 4);
        u32x4 w; w.x = pk2(a.x, a.y); w.y = pk2(a.z, a.w); w.z = pk2(b.x, b.y); w.w = pk2(b.z, b.w);
        *(u32x4*)(dst + i) = w;
    }
}

__device__ __forceinline__ void phase_convert(ArgP Ap, LAS unsigned char* lds) {
    LAS float* tile = (LAS float*)lds;
    const int G = gridDim.x, bid = blockIdx.x;
    constexpr int I_WIN = (NZ / 64) * (D / 64), I_WBR = 3 * (D / 64) * (512 / 64), I_WO = (D / 64) * (D / 64), I_WQ = (2048 / 64) * (D / 64), I_L = I_WIN + I_WBR + I_WO + I_WQ;
    for (int it = bid; it < 2 * I_L; it += G) {
        const int l = it / I_L; int r = it % I_L;
        unsigned char* wb = A.ws + WS_WB + (size_t)l * WB_BYTES;
        if (r < I_WIN) { const int nt = r / (D / 64), kt = r % (D / 64);
            tconv_tile(A.in[8] + (size_t)l * D * INW, INW, kt * 64, zcol_to_src(nt * 64), (bf16*)(wb + WB_WIN), D, nt * 64, tile); continue; }
        r -= I_WIN;
        if (r < I_WBR) { const int n = r / ((D / 64) * 8), rr = r % ((D / 64) * 8), nt = rr / 8, kt = rr % 8;
            tconv_tile(A.in[21] + ((size_t)l * 3 + n) * 512 * D, D, kt * 64, nt * 64, (bf16*)(wb + WB_WBR) + (size_t)n * D * 512, 512, nt * 64, tile); continue; }
        r -= I_WBR;
        if (r < I_WO) { const int nt = r / (D / 64), kt = r % (D / 64);
            tconv_tile(A.in[22] + (size_t)l * D * D, D, kt * 64, nt * 64, (bf16*)(wb + WB_WO), D, nt * 64, tile); continue; }
        r -= I_WO;
        { const int nt = r / (D / 64), kt = r % (D / 64);
            tconv_tile(A.in[25] + (size_t)l * D * 2048, 2048, kt * 64, nt * 64, (bf16*)(wb + WB_WQ), D, nt * 64, tile); }
    }
    const int gtid = bid * NTHREADS + opaque_tid(), gthreads = G * NTHREADS;
    for (int l = 0; l < 2; ++l) {
        unsigned char* wb = A.ws + WS_WB + (size_t)l * WB_BYTES;
        for (int e = gtid; e < NSM * D; e += gthreads) { const int n = e / D, k = e % D; ((bf16*)(wb + WB_WS))[e] = f2bf(A.in[8][(size_t)l * D * INW + (size_t)k * INW + scol_to_src(n)]); }
        convert_f32_bf16(A.in[26] + (size_t)l * 16 * 128 * 128, (bf16*)(wb + WB_KEYS), 16 * 128 * 128, gtid, gthreads);
    }
    convert_f32_bf16(A.in[0], (bf16*)(A.ws + WS_XB), (size_t)TP * D, gtid, gthreads);
    convert_f32_bf16(A.in[1], (bf16*)(A.ws + WS_XB) + (size_t)TP * D, (size_t)TS * D, gtid, gthreads);
}

#ifndef EMU
struct EpiZ {
    static constexpr bool PERM = true, AFTER_DRAIN = false;
    bf16* ZM; bf16* ZG;
    __device__ __forceinline__ void operator()(const pg8::f32x4 (&acc)[2][2][4][2], const pg8::Unit& u, int wr, int wc, int fr, int fq) const {
        const int row0 = u.pm * 256 + wr * 64 + fr; const bool gate = u.pn >= 19;
        bf16* base = gate ? ZG : ZM; const int ldc = gate ? NZG : NZM; const int col0 = (gate ? (u.pn - 19) : u.pn) * 256 + wc * 32 + 8 * fq;
#pragma unroll
        for (int ai = 0; ai < 2; ++ai)
#pragma unroll
            for (int m = 0; m < 4; ++m) { bf16* rowp = base + (size_t)(row0 + ai * 128 + m * 16) * ldc + col0;
#pragma unroll
                for (int bj = 0; bj < 2; ++bj) { f32x4 v0 = acc[ai][bj][m][0], v1 = acc[ai][bj][m][1];
                    if (gate) {
#pragma unroll
                        for (int j = 0; j < 4; ++j) { v0[j] = __builtin_amdgcn_rcpf(1.0f + __expf(-v0[j])); v1[j] = __builtin_amdgcn_rcpf(1.0f + __expf(-v1[j])); } }
                    u32x4 w; w.x = pg8::cvt_pk_bf16(v0[0], v0[1]); w.y = pg8::cvt_pk_bf16(v0[2], v0[3]); w.z = pg8::cvt_pk_bf16(v1[0], v1[1]); w.w = pg8::cvt_pk_bf16(v1[2], v1[3]);
                    *(u32x4*)(rowp + bj * 128) = w; } }
    }
};

#endif
__device__ __forceinline__ void small_gemm(const bf16* __restrict__ XB, const bf16* __restrict__ WsT, float* __restrict__ ZS) {
    const int tx = opaque_tid(), lane = tx & 63, wave = tx >> 6, gw = blockIdx.x * NWAVES + wave, NGW = gridDim.x * NWAVES, fr = lane & 15, fq = lane >> 4;
    for (int rg = gw; rg < T / 16; rg += NGW) {
        f32x4 a0 = {0.f, 0.f, 0.f, 0.f}, a1 = {0.f, 0.f, 0.f, 0.f};
        const bf16* ap = XB + (size_t)(rg * 16 + fr) * D + 8 * fq; const bf16* b0p = WsT + (size_t)fr * D + 8 * fq; const bf16* b1p = WsT + (size_t)(16 + fr) * D + 8 * fq;
#pragma unroll 4
        for (int k0 = 0; k0 < D; k0 += 32) {
            const bf16x8 a = *(const bf16x8*)(ap + k0), b0 = *(const bf16x8*)(b0p + k0), b1 = *(const bf16x8*)(b1p + k0);
            a0 = mfma16(a, b0, a0); a1 = mfma16(a, b1, a1);
        }
#pragma unroll
        for (int r = 0; r < 4; ++r) { float* o = ZS + (size_t)(rg * 16 + fq * 4 + r) * NSM + fr; o[0] = a0[r]; o[16] = a1[r]; }
    }
}

#ifndef EMU
__device__ __forceinline__ void phase_gemm1(ArgP Ap, LAS unsigned char* lds, int l) {
    unsigned char* wb = A.ws + WS_WB + (size_t)l * WB_BYTES;
    pg8::Gemm g{(const bf16*)(A.ws + WS_XB), (const bf16*)(wb + WB_WIN), T, NZ, D};
    pg8::StaticOrder S; S.init(T, NZ, gridDim.x, blockIdx.x);
    EpiZ E{(bf16*)(A.ws + WS_ZM), (bf16*)(A.ws + WS_ZG)};
    pg8::gemm_phase<EpiZ, pg8::StaticOrder>(lds, g, S, E);
    small_gemm((const bf16*)(A.ws + WS_XB), (const bf16*)(wb + WB_WS), (float*)(A.ws + WS_ZS));
}
#endif

#ifndef EMU
#define XB_TMO      128
#define XB_XCNT(j)  (256  + 64 * (j))
#define XB_XSUB(j)  (1280 + 64 * (j))
#define XB_XGEN(j)  (2304 + 64 * (j))
#define XB_TOP      3328
#define XB_TOPGEN   3392
#define XCD_BAR_WORDS 3456
#define XB_SPIN_CAP (1u << 18)

__device__ __forceinline__ unsigned xb_ld(unsigned* p)              { return __hip_atomic_load(p, __ATOMIC_RELAXED, __HIP_MEMORY_SCOPE_AGENT); }
__device__ __forceinline__ unsigned xb_add(unsigned* p, unsigned v) { return __hip_atomic_fetch_add(p, v, __ATOMIC_RELAXED, __HIP_MEMORY_SCOPE_AGENT); }
__device__ __forceinline__ unsigned xb_xcc_id() { return (unsigned)__builtin_amdgcn_s_getreg((3 << 11) | 20) & 0xFu; }
#define XB_SPIN(cond, bar) do { unsigned _sp = 0; while (cond) { __builtin_amdgcn_s_sleep(1); \
    if ((++_sp & 255u) == 0u) { if (xb_ld(&(bar)[XB_TMO])) break; if (_sp > XB_SPIN_CAP) { atomicAdd(&(bar)[XB_TMO], 1u); break; } } } } while (0)

struct XcdBarrier {
    unsigned* bar; unsigned x;
    volatile LAS unsigned* st;
};

__device__ __forceinline__ XcdBarrier xcd_barrier_post(unsigned* bar, volatile LAS unsigned* st) {
    XcdBarrier b; b.bar = bar; b.x = xb_xcc_id(); b.st = st;
    if (threadIdx.x == 0) (void)xb_add(&bar[XB_XCNT(b.x)], 1u);
    return b;
}
__device__ __forceinline__ void xcd_barrier_complete(unsigned* bar, unsigned x, unsigned& nloc, unsigned& nx) {
    const unsigned G = gridDim.x * gridDim.y * gridDim.z;
    unsigned sum, cnt, mine, sp = 0u;
    for (;;) {
        sum = 0u; cnt = 0u; mine = 0u;
#pragma unroll
        for (unsigned j = 0; j < 16; ++j) { const unsigned c = xb_ld(&bar[XB_XCNT(j)]); sum += c; cnt += (c > 0u) ? 1u : 0u; mine = (j == x) ? c : mine; }
        if (sum == G) break;
        __builtin_amdgcn_s_sleep(1);
        if ((++sp & 255u) == 0u) { if (xb_ld(&bar[XB_TMO])) break; if (sp > XB_SPIN_CAP) { atomicAdd(&bar[XB_TMO], 1u); break; } }
    }
    nloc = mine > 0u ? mine : 1u; nx = cnt > 0u ? cnt : 1u;
}

__device__ __forceinline__ void xcd_barrier(const XcdBarrier& b) {
    asm volatile("s_waitcnt vmcnt(0)" ::: "memory");
    __syncthreads();
    if (threadIdx.x == 0) {
        unsigned* bar = b.bar;
        __builtin_amdgcn_s_waitcnt(0);
        unsigned nloc = b.st[0], nx = b.st[1];
        if (nloc == 0u) { xcd_barrier_complete(bar, b.x, nloc, nx); b.st[0] = nloc; b.st[1] = nx; }
        const unsigned old = xb_add(&bar[XB_XSUB(b.x)], 1u);
        const unsigned gen = old / nloc;
        if (old + 1u == (gen + 1u) * nloc) {
            __builtin_amdgcn_fence(__ATOMIC_RELEASE, "agent");
            asm volatile("s_waitcnt vmcnt(0)" ::: "memory");
            const unsigned og = xb_add(&bar[XB_TOP], 1u);
            const unsigned tg = og / nx;
            if (og + 1u == (tg + 1u) * nx) xb_add(&bar[XB_TOPGEN], 1u);
            else XB_SPIN(xb_ld(&bar[XB_TOPGEN]) == tg, bar);
            __builtin_amdgcn_fence(__ATOMIC_ACQUIRE, "agent");
            xb_add(&bar[XB_XGEN(b.x)], 1u);
            asm volatile("s_waitcnt vmcnt(0)" ::: "memory");
        } else {
            XB_SPIN(xb_ld(&bar[XB_XGEN(b.x)]) == gen, bar);
            __builtin_amdgcn_fence(__ATOMIC_ACQUIRE, "agent");
            asm volatile("s_waitcnt vmcnt(0)" ::: "memory");
        }
    }
    __syncthreads();
}

#endif

typedef short s16x4 __attribute__((ext_vector_type(4)));
#ifndef EMU
__device__ __forceinline__ s16x4 tr4(const LAS bf16* p) { return __builtin_amdgcn_ds_read_tr16_b64_v4i16((LAS s16x4*)p); }
#endif
#define FROW(M, ld, rc0, k0) (*(const LAS bf16x8*)((M) + ((rc0) + fr) * (ld) + (k0) + 8 * fq))
__device__ __forceinline__ bf16x8 ftr_(int fr, int fq, const LAS bf16* M, int ld, int k0, int rc0) {
    const LAS bf16* p = M + (k0 + 8 * fq + (fr >> 2)) * ld + rc0 + 4 * (fr & 3);
    const s16x4 lo = tr4(p), hi = tr4(p + 4 * ld);
    return (bf16x8){lo[0], lo[1], lo[2], lo[3], hi[0], hi[1], hi[2], hi[3]};
}
#define FTR(M, ld, k0, rc0) ftr_(fr, fq, M, ld, k0, rc0)
#define MMA_RR(acc, Am, lda, r0, Bm, ldb, c0, K) do { _Pragma("unroll") for (int k0_ = 0; k0_ < (K); k0_ += 32) acc = mfma16(FROW(Am, lda, r0, k0_), FROW(Bm, ldb, c0, k0_), acc); } while (0)
#define MMA_RT(acc, Am, lda, r0, Bk, ldb, c0, K) do { _Pragma("unroll") for (int k0_ = 0; k0_ < (K); k0_ += 32) acc = mfma16(FROW(Am, lda, r0, k0_), FTR(Bk, ldb, k0_, c0), acc); } while (0)
#define MMA_TT(acc, Ak, lda, m0, Bk, ldb, c0, K) do { _Pragma("unroll") for (int k0_ = 0; k0_ < (K); k0_ += 32) acc = mfma16(FTR(Ak, lda, k0_, m0), FTR(Bk, ldb, k0_, c0), acc); } while (0)
#define MMA_RC(acc, Am, lda, r0, cfrag, K) do { _Pragma("unroll") for (int k0_ = 0; k0_ < (K); k0_ += 32) acc = mfma16(FROW(Am, lda, r0, k0_), cfrag, acc); } while (0)
#define MMA_CT(acc, cfrag, Bk, ldb, c0, K) do { _Pragma("unroll") for (int k0_ = 0; k0_ < (K); k0_ += 32) acc = mfma16(cfrag, FTR(Bk, ldb, k0_, c0), acc); } while (0)
__device__ __forceinline__ u32x2 pack4(float a, float b, float c, float d) { u32x2 w; w.x = pk2(a, b); w.y = pk2(c, d); return w; }
__device__ __forceinline__ float scan_sum64(float v, int lane) {
#pragma unroll
    for (int d = 1; d < 64; d <<= 1) { const float t = __shfl_up(v, d); if (lane >= d) v += t; }
    return v;
}
__device__ __forceinline__ float scan_max64(float v, int lane) {
#pragma unroll
    for (int d = 1; d < 64; d <<= 1) { const float t = __shfl_up(v, d); if (lane >= d) v = fmaxf(v, t); }
    return v;
}
__device__ __forceinline__ float wave_max64(float v) {
#pragma unroll
    for (int m = 1; m < 64; m <<= 1) v = fmaxf(v, __shfl_xor(v, m));
    return v;
}
__device__ __forceinline__ float logsig(float x) { return fminf(x, 0.f) - log1pf(__expf(-fabsf(x))); }
__device__ __forceinline__ float softplusf(float x) { return fmaxf(x, 0.f) + log1pf(__expf(-fabsf(x))); }
__device__ __forceinline__ float sigmoidf(float x) { return 1.0f / (1.0f + __expf(-x)); }
__device__ __forceinline__ float siluf(float x) { return x / (1.0f + __expf(-x)); }
constexpr float NEG_INF = -__builtin_huge_valf();
constexpr float EPS_ = 1e-5f;
__device__ __forceinline__ void unpack8(const u32x4 w, float (&f)[8]) {
    f[0] = __uint_as_float(w.x << 16); f[1] = __uint_as_float(w.x & 0xffff0000u); f[2] = __uint_as_float(w.y << 16); f[3] = __uint_as_float(w.y & 0xffff0000u);
    f[4] = __uint_as_float(w.z << 16); f[5] = __uint_as_float(w.z & 0xffff0000u); f[6] = __uint_as_float(w.w << 16); f[7] = __uint_as_float(w.w & 0xffff0000u);
}
__device__ __forceinline__ u32x4 pack8(const float (&f)[8]) { u32x4 w; w.x = pk2(f[0], f[1]); w.y = pk2(f[2], f[3]); w.z = pk2(f[4], f[5]); w.w = pk2(f[6], f[7]); return w; }

__device__ __forceinline__ void mlstm_item(ArgP Ap, LAS unsigned char* lds, int l, int b, int h, bool sample) {
    int tid_o = threadIdx.x; OPQV(tid_o);
    const int tid = tid_o, lane = tid & 63, wave = tid >> 6, fr = lane & 15, fq = lane >> 4;
    LAS bf16* Qs = (LAS bf16*)(lds); LAS bf16* Ks = (LAS bf16*)(lds + 17408); LAS bf16* Kw = (LAS bf16*)(lds + 34816); LAS bf16* Vs = (LAS bf16*)(lds + 52224);
    LAS bf16* Ss = (LAS bf16*)(lds + 69632); LAS bf16* CbT = (LAS bf16*)(lds + 78848); LAS float* Hs = (LAS float*)(lds + 120320); LAS float* MN = (LAS float*)(lds + 117760); LAS float* gb = (LAS float*)(lds + 118272);
    LAS float* b_ = gb; LAS float* mt_ = gb + 64; LAS float* u_ = gb + 128; LAS float* ein_ = gb + 192; LAS float* wg_ = gb + 256; LAS float* den_ = gb + 320; LAS float* sc_ = gb + 384;
    const int L = sample ? LS : LP, tok0 = sample ? TP + b * LS : b * LP, NB = sample ? BS : BP;
    const bf16* ZM = (const bf16*)(A.ws + WS_ZM); const float* ZS = (const float*)(A.ws + WS_ZS); bf16* BR0 = (bf16*)(A.ws + WS_BR);
    const float ib = A.in[9][l * 4 + h], fb = A.in[10][l * 4 + h];
    const bf16x8 ones = (fr == 0) ? (bf16x8){0x3F80, 0x3F80, 0x3F80, 0x3F80, 0x3F80, 0x3F80, 0x3F80, 0x3F80} : (bf16x8){0, 0, 0, 0, 0, 0, 0, 0};
    f32x4 accC[9];
#pragma unroll
    for (int vi = 0; vi < 9; ++vi) accC[vi] = (f32x4){0.f, 0.f, 0.f, 0.f};
    float m_run = 0.f;
    if (sample) {
        const float* C0 = A.in[2] + ((size_t)(l * BS + b) * 4 + h) * 16384; const float* n0 = A.in[3] + ((size_t)(l * BS + b) * 4 + h) * 128;
        const float* cp = C0 + (4 * fq) * 128 + 16 * wave + fr;
#pragma unroll
        for (int vi = 0; vi < 8; ++vi) {
#pragma unroll
            for (int r = 0; r < 4; ++r) accC[vi][r] = cp[r * 128];
            cp += 2048; OPQV(cp); }
        if (fq == 0) accC[8][0] = n0[16 * wave + fr];
        m_run = A.in[4][(l * BS + b) * 4 + h];
    }
#pragma unroll
    for (int vi = 0; vi < 9; ++vi) *(LAS u32x2*)(CbT + (16 * wave + fr) * 152 + 16 * vi + 4 * fq) = pack4(accC[vi][0], accC[vi][1], accC[vi][2], accC[vi][3]);
    if (tid < 128) MN[tid] = A.in[11][l * 512 + h * 128 + tid];
    u32x4 pq[2], pk[2], pv[2], pm[2]; float pli = NEG_INF, plf = 0.f;
#define MLSTM_PREFETCH_MO(T0N) do { const int nvn_ = (L - (T0N)) < 64 ? (L - (T0N)) : 64; const int t = tid >> 3, part = tid & 7; pm[0] = (u32x4){0u, 0u, 0u, 0u}; pm[1] = pm[0]; \
        if (t < nvn_) { const bf16* mo = ZM + (size_t)(tok0 + (T0N) + t) * NZM + 1536 + h * 128 + 16 * part; pm[0] = *(const u32x4*)mo; pm[1] = *(const u32x4*)(mo + 8); } } while (0)
#define MLSTM_PREFETCH(T0N) do { const int nvn_ = (L - (T0N)) < 64 ? (L - (T0N)) : 64; \
        _Pragma("unroll") for (int i = 0; i < 2; ++i) { const int c = tid + 512 * i, t = c >> 4, cc = (c & 15) * 8; pq[i] = (u32x4){0u, 0u, 0u, 0u}; pk[i] = pq[i]; pv[i] = pq[i]; \
            if (t < nvn_) { const bf16* zp = ZM + (size_t)(tok0 + (T0N) + t) * NZM + h * 128 + cc; pq[i] = *(const u32x4*)zp; pk[i] = *(const u32x4*)(zp + 512); pv[i] = *(const u32x4*)(zp + 1024); } } \
        if (wave == 0) { pli = NEG_INF; plf = 0.f; if (lane < nvn_) { const size_t tok = tok0 + (T0N) + lane; pli = ZS[tok * NSM + h]; plf = ZS[tok * NSM + 4 + h]; } } } while (0)
    MLSTM_PREFETCH(0); MLSTM_PREFETCH_MO(0);
    __syncthreads();
    for (int t0 = 0; t0 < L; t0 += 64) {
        const int nv = (L - t0) < 64 ? (L - t0) : 64;
        if (wave == 0) {
            const float li = (lane < nv) ? pli + ib : NEG_INF, lf = (lane < nv) ? logsig(plf + fb) : 0.f;
            const float bb = scan_sum64(lf, lane), a = bb + m_run, u = li - bb, M = scan_max64(u, lane), mt = fmaxf(a, bb + M);
            const float blast = __shfl(bb, 63), g = blast + u, gmax = wave_max64(g), mnew = fmaxf(blast + m_run, gmax);
            b_[lane] = bb; mt_[lane] = mt; u_[lane] = u; ein_[lane] = __expf(a - mt); wg_[lane] = __expf(g - mnew);
            if (lane == 0) sc_[1] = __expf(blast + m_run - mnew);
            m_run = mnew;
        }
        LDS_BARRIER();
#pragma unroll
        for (int i = 0; i < 2; ++i) { const int c = tid + 512 * i, t = c >> 4, cc = (c & 15) * 8;
            *(LAS u32x4*)(Qs + t * 136 + cc) = pq[i]; *(LAS u32x4*)(Ks + t * 136 + cc) = pk[i]; *(LAS u32x4*)(Vs + t * 136 + cc) = pv[i];
            float f[8]; unpack8(pk[i], f); const float g = wg_[t];
#pragma unroll
            for (int j = 0; j < 8; ++j) f[j] *= g;
            *(LAS u32x4*)(Kw + t * 136 + cc) = pack8(f); }
        MLSTM_PREFETCH(t0 + 64);
        LDS_BARRIER();
#pragma unroll
        for (int j = 0; j < 2; ++j) { const int idx = wave + 8 * j, ti = idx >> 2, si = idx & 3;
            f32x4 acc = {0.f, 0.f, 0.f, 0.f};
            if (si <= ti) MMA_RR(acc, Ks, 136, 16 * si, Qs, 136, 16 * ti, 128);
            const int t = 16 * ti + fr; const float bt = b_[t] - mt_[t]; float v[4];
#pragma unroll
            for (int r = 0; r < 4; ++r) { const int s = 16 * si + 4 * fq + r; v[r] = (s <= t) ? acc[r] * __expf(bt + u_[s]) : 0.f; }
            *(LAS u32x2*)(Ss + t * 72 + 16 * si + 4 * fq) = pack4(v[0], v[1], v[2], v[3]); }
        LDS_BARRIER();
        if (wave < 4) { const int ti = wave; f32x4 acc = {0.f, 0.f, 0.f, 0.f};
            MMA_RT(acc, Qs, 136, 16 * ti, CbT, 152, 128, 128);
#pragma unroll
            for (int r = 0; r < 4; ++r) acc[r] *= ein_[16 * ti + 4 * fq + r];
            MMA_RC(acc, Ss, 72, 16 * ti, ones, 64);
            if (fr == 0) {
#pragma unroll
                for (int r = 0; r < 4; ++r) den_[16 * ti + 4 * fq + r] = acc[r]; } }
        LDS_BARRIER();
#pragma unroll
        for (int j = 0; j < 4; ++j) { const int idx = wave + 8 * j, ti = idx >> 3, vi = idx & 7; f32x4 accn = {0.f, 0.f, 0.f, 0.f};
            MMA_RT(accn, Qs, 136, 16 * ti, CbT, 152, 16 * vi, 128);
#pragma unroll
            for (int r = 0; r < 4; ++r) accn[r] *= ein_[16 * ti + 4 * fq + r];
            MMA_RT(accn, Ss, 72, 16 * ti, Vs, 136, 16 * vi, 64);
#pragma unroll
            for (int r = 0; r < 4; ++r) { const int t = 16 * ti + 4 * fq + r; const float dn = den_[t] * 0.08838834764831845f;
                Hs[t * 132 + 16 * vi + fr] = accn[r] * 0.08838834764831845f / fmaxf(fabsf(dn), __expf(-mt_[t])); }
            asm volatile("" ::: "memory"); }
        LDS_BARRIER();
        { const int t = tid >> 3, part = tid & 7; float x[16]; float s1 = 0.f;
#pragma unroll
            for (int i = 0; i < 16; ++i) { x[i] = Hs[t * 132 + 16 * part + i]; s1 += x[i]; }
            s1 += __shfl_xor(s1, 1); s1 += __shfl_xor(s1, 2); s1 += __shfl_xor(s1, 4);
            const float mu = s1 * (1.0f / 128.0f); float s2 = 0.f;
#pragma unroll
            for (int i = 0; i < 16; ++i) { x[i] -= mu; s2 += x[i] * x[i]; }
            s2 += __shfl_xor(s2, 1); s2 += __shfl_xor(s2, 2); s2 += __shfl_xor(s2, 4);
            const float rstd = 1.0f / sqrtf(s2 * (1.0f / 128.0f) + EPS_);
            if (t < nv) { const size_t tok = tok0 + t0 + t;
                float o0[8], o1[8]; unpack8(pm[0], o0); unpack8(pm[1], o1); float y0[8], y1[8];
#pragma unroll
                for (int i = 0; i < 8; ++i) { y0[i] = x[i] * rstd * MN[16 * part + i] * sigmoidf(o0[i]); y1[i] = x[8 + i] * rstd * MN[16 * part + 8 + i] * sigmoidf(o1[i]); }
                bf16* o = BR0 + tok * 512 + h * 128 + 16 * part; *(u32x4*)o = pack8(y0); *(u32x4*)(o + 8) = pack8(y1); } }
        MLSTM_PREFETCH_MO(t0 + 64);
        { const float ec = sc_[1];
#pragma unroll
            for (int vi = 0; vi < 9; ++vi) {
#pragma unroll
                for (int r = 0; r < 4; ++r) accC[vi][r] *= ec;
                if (vi < 8) MMA_TT(accC[vi], Vs, 136, 16 * vi, Kw, 136, 16 * wave, 64); else MMA_CT(accC[vi], ones, Kw, 136, 16 * wave, 64);
                *(LAS u32x2*)(CbT + (16 * wave + fr) * 152 + 16 * vi + 4 * fq) = pack4(accC[vi][0], accC[vi][1], accC[vi][2], accC[vi][3]);
                asm volatile("" ::: "memory"); } }
        LDS_BARRIER();
    }
#undef MLSTM_PREFETCH
#undef MLSTM_PREFETCH_MO
    float* Co = A.out + (sample ? O_SC : O_PC) + ((size_t)(l * NB + b) * 4 + h) * 16384; float* no = A.out + (sample ? O_SN : O_PN) + ((size_t)(l * NB + b) * 4 + h) * 128;
    { int fq_ = fq, cw_ = 16 * wave + fr; OPQV(fq_); OPQV(cw_);
      float* cp = Co + (4 * fq_) * 128 + cw_;
#pragma unroll
      for (int vi = 0; vi < 8; ++vi) {
#pragma unroll
        for (int r = 0; r < 4; ++r) cp[r * 128] = accC[vi][r];
        cp += 2048; OPQV(cp); }
      if (fq_ == 0) no[cw_] = accC[8][0]; }
    if (tid == 0) A.out[(sample ? O_SM : O_PM) + (size_t)(l * NB + b) * 4 + h] = m_run;
    __syncthreads();
}

__device__ __forceinline__ void gla_item(ArgP Ap, LAS unsigned char* lds, int l, int b, int h, bool sample) {
    int tid_o = threadIdx.x; OPQV(tid_o);
    const int tid = tid_o, lane = tid & 63, wave = tid >> 6, fr = lane & 15, fq = lane >> 4;
    LAS bf16* QE = (LAS bf16*)(lds); LAS bf16* KE = (LAS bf16*)(lds + 9216); LAS bf16* KLs = (LAS bf16*)(lds + 18432); LAS bf16* Vs = (LAS bf16*)(lds + 27648);
    LAS bf16* ATT = (LAS bf16*)(lds + 45056); LAS bf16* STbT = (LAS bf16*)(lds + 54272); LAS float* Os = (LAS float*)(lds + 71680); LAS float* LAM = (LAS float*)(lds + 105472);
    LAS float* GA = (LAS float*)(lds + 122112); LAS float* GUP = (LAS float*)(lds + 126208); LAS float* GBI = (LAS float*)(lds + 130304); LAS float* GN = (LAS float*)(lds + 130560);
    const int L = sample ? LS : LP, tok0 = sample ? TP + b * LS : b * LP, NB = sample ? BS : BP;
    const bf16* ZM = (const bf16*)(A.ws + WS_ZM); const float* ZS = (const float*)(A.ws + WS_ZS); bf16* BR1 = (bf16*)(A.ws + WS_BR) + (size_t)T * 512;
    f32x4 accS[4];
#pragma unroll
    for (int ki = 0; ki < 4; ++ki) accS[ki] = (f32x4){0.f, 0.f, 0.f, 0.f};
    if (sample) { const float* S0 = A.in[5] + ((size_t)(l * BS + b) * 4 + h) * 8192;
        const float* sp = S0 + fr * 128 + 16 * wave + 4 * fq;
#pragma unroll
        for (int ki = 0; ki < 4; ++ki) {
#pragma unroll
            for (int r = 0; r < 4; ++r) accS[ki][r] = sp[r];
            sp += 2048; OPQV(sp); } }
#pragma unroll
    for (int ki = 0; ki < 4; ++ki) *(LAS u32x2*)(STbT + (16 * ki + fr) * 136 + 16 * wave + 4 * fq) = pack4(accS[ki][0], accS[ki][1], accS[ki][2], accS[ki][3]);
    for (int e = tid; e < 1024; e += NTHREADS) GUP[e] = A.in[12][(size_t)l * 16 * 256 + (e >> 6) * 256 + h * 64 + (e & 63)];
    if (tid < 64) GBI[tid] = A.in[13][l * 256 + h * 64 + tid];
    if (tid < 128) GN[tid] = A.in[14][l * 512 + h * 128 + tid];
    u32x4 pq, pk, pv[2], pg[2], pgn[2]; float pga[2];
#define GLA_PREFETCH(T0N) do { const int nvn_ = (L - (T0N)) < 64 ? (L - (T0N)) : 64; \
        { const int t = tid >> 3, cc = (tid & 7) * 8; pq = (u32x4){0u, 0u, 0u, 0u}; pk = pq; pgn[0] = pq; pgn[1] = pq; \
            if (t < nvn_) { const bf16* zr = ZM + (size_t)(tok0 + (T0N) + t) * NZM + 2048 + h * 64 + cc; pq = *(const u32x4*)zr; pk = *(const u32x4*)(zr + 256); \
                const bf16* gr = ZM + (size_t)(tok0 + (T0N) + t) * NZM + 3072 + h * 128 + 16 * (tid & 7); pgn[0] = *(const u32x4*)gr; pgn[1] = *(const u32x4*)(gr + 8); } } \
        _Pragma("unroll") for (int i = 0; i < 2; ++i) { const int c = tid + 512 * i, t = c >> 4, cc = (c & 15) * 8; pv[i] = (u32x4){0u, 0u, 0u, 0u}; \
            if (t < nvn_) pv[i] = *(const u32x4*)(ZM + (size_t)(tok0 + (T0N) + t) * NZM + 2560 + h * 128 + cc); \
            const int e = tid + 512 * i, te = e >> 4; pga[i] = (te < nvn_) ? ZS[(size_t)(tok0 + (T0N) + te) * NSM + 8 + (e & 15)] : 0.f; } } while (0)
    GLA_PREFETCH(0);
    __syncthreads();
    for (int t0 = 0; t0 < L; t0 += 64) {
        const int nv = (L - t0) < 64 ? (L - t0) : 64;
        pg[0] = pgn[0]; pg[1] = pgn[1];
        GA[tid] = pga[0]; GA[tid + 512] = pga[1];
        LDS_BARRIER();
#pragma unroll
        for (int i = 0; i < 8; ++i) { const int e = tid + 512 * i, t = e >> 6, k = e & 63; float x = GBI[k];
#pragma unroll
            for (int r = 0; r < 16; ++r) x += GA[t * 16 + r] * GUP[r * 64 + k];
            LAM[t * 65 + k] = (t < nv) ? logsig(x) * (1.0f / 16.0f) : 0.f; }
        LDS_BARRIER();
#pragma unroll
        for (int c = 0; c < 8; ++c) { const int k = 8 * wave + c; const float v = scan_sum64(LAM[lane * 65 + k], lane); LAM[lane * 65 + k] = v; }
        LDS_BARRIER();
        { const int t = tid >> 3, cc = (tid & 7) * 8; float q[8], k[8], qe[8], ke[8], kl[8]; unpack8(pq, q); unpack8(pk, k);
#pragma unroll
            for (int i = 0; i < 8; ++i) { const float lm = LAM[t * 65 + cc + i], ll = LAM[63 * 65 + cc + i]; qe[i] = q[i] * __expf(lm); ke[i] = k[i] * __expf(-lm); kl[i] = k[i] * __expf(ll - lm); }
            *(LAS u32x4*)(QE + t * 72 + cc) = pack8(qe); *(LAS u32x4*)(KE + t * 72 + cc) = pack8(ke); *(LAS u32x4*)(KLs + t * 72 + cc) = pack8(kl); }
#pragma unroll
        for (int i = 0; i < 2; ++i) { const int c = tid + 512 * i, t = c >> 4, cc = (c & 15) * 8; *(LAS u32x4*)(Vs + t * 136 + cc) = pv[i]; }
        GLA_PREFETCH(t0 + 64);
        LDS_BARRIER();
#pragma unroll
        for (int j = 0; j < 2; ++j) { const int idx = wave + 8 * j, ti = idx >> 2, si = idx & 3; f32x4 acc = {0.f, 0.f, 0.f, 0.f};
            if (si <= ti) MMA_RR(acc, KE, 72, 16 * si, QE, 72, 16 * ti, 64);
            const int t = 16 * ti + fr; float v[4];
#pragma unroll
            for (int r = 0; r < 4; ++r) { const int s = 16 * si + 4 * fq + r; v[r] = (s <= t) ? acc[r] : 0.f; }
            *(LAS u32x2*)(ATT + t * 72 + 16 * si + 4 * fq) = pack4(v[0], v[1], v[2], v[3]); }
        LDS_BARRIER();
#pragma unroll
        for (int j = 0; j < 4; ++j) { const int idx = wave + 8 * j, ti = idx >> 3, vi = idx & 7; f32x4 acc = {0.f, 0.f, 0.f, 0.f};
            MMA_RT(acc, QE, 72, 16 * ti, STbT, 136, 16 * vi, 64); MMA_RT(acc, ATT, 72, 16 * ti, Vs, 136, 16 * vi, 64);
#pragma unroll
            for (int r = 0; r < 4; ++r) Os[(16 * ti + 4 * fq + r) * 132 + 16 * vi + fr] = acc[r] * 0.125f;
            asm volatile("" ::: "memory"); }
        LDS_BARRIER();
        { const int t = tid >> 3, part = tid & 7; float x[16]; float s2 = 0.f;
#pragma unroll
            for (int i = 0; i < 16; ++i) { x[i] = Os[t * 132 + 16 * part + i]; s2 += x[i] * x[i]; }
            s2 += __shfl_xor(s2, 1); s2 += __shfl_xor(s2, 2); s2 += __shfl_xor(s2, 4);
            const float rstd = 1.0f / sqrtf(s2 * (1.0f / 128.0f) + EPS_);
            if (t < nv) { const size_t tok = tok0 + t0 + t;
                float g0[8], g1[8]; unpack8(pg[0], g0); unpack8(pg[1], g1); float y0[8], y1[8];
#pragma unroll
                for (int i = 0; i < 8; ++i) { y0[i] = x[i] * rstd * GN[16 * part + i] * siluf(g0[i]); y1[i] = x[8 + i] * rstd * GN[16 * part + 8 + i] * siluf(g1[i]); }
                bf16* o = BR1 + tok * 512 + h * 128 + 16 * part; *(u32x4*)o = pack8(y0); *(u32x4*)(o + 8) = pack8(y1); } }
#pragma unroll
        for (int ki = 0; ki < 4; ++ki) { const float dec = __expf(LAM[63 * 65 + 16 * ki + fr]);
#pragma unroll
            for (int r = 0; r < 4; ++r) accS[ki][r] *= dec;
            MMA_TT(accS[ki], Vs, 136, 16 * wave, KLs, 72, 16 * ki, 64);
            *(LAS u32x2*)(STbT + (16 * ki + fr) * 136 + 16 * wave + 4 * fq) = pack4(accS[ki][0], accS[ki][1], accS[ki][2], accS[ki][3]);
            asm volatile("" ::: "memory"); }
        LDS_BARRIER();
    }
#undef GLA_PREFETCH
    float* So = A.out + (sample ? O_SG : O_PG) + ((size_t)(l * NB + b) * 4 + h) * 8192;
    { int o_ = fr * 128 + 16 * wave + 4 * fq; OPQV(o_); float* sp = So + o_;
#pragma unroll
      for (int ki = 0; ki < 4; ++ki) {
#pragma unroll
        for (int r = 0; r < 4; ++r) sp[r] = accS[ki][r];
        sp += 2048; OPQV(sp); } }
    __syncthreads();
}

__device__ __forceinline__ int ssd_chmap(int hd, int c) { const int g = hd >> 2; return c < 64 ? hd * 64 + c : (c < 128 ? 512 + g * 64 + (c - 64) : 640 + g * 64 + (c - 128)); }
__device__ __forceinline__ void ssd_item(ArgP Ap, LAS unsigned char* lds, int l, int b, int hd, bool sample) {
    int tid_o = threadIdx.x; OPQV(tid_o);
    const int tid = tid_o, lane = tid & 63, wave = tid >> 6, fr = lane & 15, fq = lane >> 4;
    LAS bf16* RAW = (LAS bf16*)(lds); LAS bf16* Ys = (LAS bf16*)(lds); LAS bf16* W = (LAS bf16*)(lds + 9216); LAS bf16* Bw = (LAS bf16*)(lds + 18432);
    LAS bf16* Xs = (LAS bf16*)(lds + 27648); LAS bf16* Cs = (LAS bf16*)(lds + 36864); LAS bf16* Bs = (LAS bf16*)(lds + 46080); LAS bf16* HbT = (LAS bf16*)(lds + 55296);
    LAS bf16* HIST = (LAS bf16*)(lds + 64512); LAS float* DT = (LAS float*)(lds + 65792); LAS float* LM = (LAS float*)(lds + 66048);
    LAS float* CW = (LAS float*)(lds + 66304); LAS float* CBI = CW + 4 * 192;
    const int L = sample ? LS : LP, tok0 = sample ? TP + b * LS : b * LP, NB = sample ? BS : BP;
    const bf16* ZM = (const bf16*)(A.ws + WS_ZM); const float* ZS = (const float*)(A.ws + WS_ZS); bf16* BR2 = (bf16*)(A.ws + WS_BR) + (size_t)T * 1024;
    const float Dh = A.in[19][l * 8 + hd], dtb = A.in[17][l * 8 + hd], Ah = -__expf(A.in[18][l * 8 + hd]);
    f32x4 accH[2];
#pragma unroll
    for (int j = 0; j < 2; ++j) { const int idx = wave + 8 * j, pi = idx >> 2, ni = idx & 3; accH[j] = (f32x4){0.f, 0.f, 0.f, 0.f};
        if (sample) { const float* h0 = A.in[6] + ((size_t)(l * BS + b) * 8 + hd) * 4096;
            const float* hp = h0 + (16 * pi + 4 * fq) * 64 + 16 * ni + fr; OPQV(hp);
#pragma unroll
            for (int r = 0; r < 4; ++r) accH[j][r] = hp[r * 64]; }
        *(LAS u32x2*)(HbT + (16 * ni + fr) * 72 + 16 * pi + 4 * fq) = pack4(accH[j][0], accH[j][1], accH[j][2], accH[j][3]); }
    for (int e = tid; e < 5 * 192; e += NTHREADS) { const int j = e / 192, c = e % 192, ch = ssd_chmap(hd, c); CW[e] = (j < 4) ? A.in[15][(size_t)l * 4 * 768 + j * 768 + ch] : A.in[16][l * 768 + ch]; }
    for (int e = tid; e < 3 * 200; e += NTHREADS) { const int r = e / 200, c = e % 200; float v = 0.f;
        if (sample && c < 192) v = A.in[7][((size_t)(l * BS + b) * 3 + r) * 768 + ssd_chmap(hd, c)];
        HIST[e] = f2bf(v); }
    u32x4 pr[3], ps; float pdt = 0.f;
#define SSD_PREFETCH(T0N) do { const int nvn_ = (L - (T0N)) < 64 ? (L - (T0N)) : 64; \
        _Pragma("unroll") for (int i = 0; i < 3; ++i) { const int c = tid + 512 * i, t = c / 24, q = c % 24; pr[i] = (u32x4){0u, 0u, 0u, 0u}; \
            if (t < nvn_) pr[i] = *(const u32x4*)(ZM + (size_t)(tok0 + (T0N) + t) * NZM + 4096 + ssd_chmap(hd, 8 * q)); } \
        if (wave == 0) { pdt = 0.f; if (lane < nvn_) pdt = ZS[(size_t)(tok0 + (T0N) + lane) * NSM + 24 + hd]; } } while (0)
#define SSD_PREFETCH_Z(T0N) do { const int nvn_ = (L - (T0N)) < 64 ? (L - (T0N)) : 64; const int t = tid >> 3, part = tid & 7; ps = (u32x4){0u, 0u, 0u, 0u}; \
        if (t < nvn_) ps = *(const u32x4*)(ZM + (size_t)(tok0 + (T0N) + t) * NZM + 3584 + hd * 64 + 8 * part); } while (0)
    SSD_PREFETCH(0); SSD_PREFETCH_Z(0);
    __syncthreads();
    for (int t0 = 0; t0 < L; t0 += 64) {
        const int nv = (L - t0) < 64 ? (L - t0) : 64;
#pragma unroll
        for (int i = 0; i < 3; ++i) { const int c = tid + 512 * i, t = c / 24, q = c % 24; *(LAS u32x4*)(RAW + (3 + t) * 200 + 8 * q) = pr[i]; }
        if (tid < 3 * 25) { const int r = tid / 25, q = tid % 25; *(LAS u32x4*)(RAW + r * 200 + 8 * q) = *(const LAS u32x4*)(HIST + r * 200 + 8 * q); }
        if (wave == 0) { const float dtv = (lane < nv) ? softplusf(pdt + dtb) : 0.f; const float lam = scan_sum64(dtv * Ah, lane); DT[lane] = dtv; LM[lane] = lam; }
        SSD_PREFETCH(t0 + 64);
        LDS_BARRIER();
#pragma unroll
        for (int i = 0; i < 3; ++i) { const int c = tid + 512 * i, t = c / 24, q = c % 24; float o[8];
#pragma unroll
            for (int e = 0; e < 8; ++e) o[e] = CBI[8 * q + e];
#pragma unroll
            for (int j = 0; j < 4; ++j) { float x[8]; unpack8(*(const LAS u32x4*)(RAW + (t + j) * 200 + 8 * q), x);
#pragma unroll
                for (int e = 0; e < 8; ++e) o[e] += CW[j * 192 + 8 * q + e] * x[e]; }
#pragma unroll
            for (int e = 0; e < 8; ++e) o[e] = (t < nv) ? siluf(o[e]) : 0.f;
            LAS bf16* dst = (q < 8) ? Xs + t * 72 + q * 8 : (q < 16 ? Bs + t * 72 + (q - 8) * 8 : Cs + t * 72 + (q - 16) * 8);
            *(LAS u32x4*)dst = pack8(o); }
        LDS_BARRIER();
        if (tid < 3 * 25) { const int r = tid / 25, q = tid % 25; *(LAS u32x4*)(HIST + r * 200 + 8 * q) = *(const LAS u32x4*)(RAW + (nv + r) * 200 + 8 * q); }
        f32x4 cbT[2];
#pragma unroll
        for (int j = 0; j < 2; ++j) { const int idx = wave + 8 * j, ti = idx >> 2, si = idx & 3; cbT[j] = (f32x4){0.f, 0.f, 0.f, 0.f};
            if (si <= ti) MMA_RR(cbT[j], Bs, 72, 16 * si, Cs, 72, 16 * ti, 64); }
        LDS_BARRIER();
#pragma unroll
        for (int j = 0; j < 2; ++j) { const int idx = wave + 8 * j, ti = idx >> 2, si = idx & 3; const int t = 16 * ti + fr; const float lt = LM[t]; float v[4];
#pragma unroll
            for (int r = 0; r < 4; ++r) { const int s = 16 * si + 4 * fq + r; v[r] = (s <= t) ? cbT[j][r] * __expf(lt - LM[s]) * DT[s] : 0.f; }
            *(LAS u32x2*)(W + t * 72 + 16 * si + 4 * fq) = pack4(v[0], v[1], v[2], v[3]); }
        { const int s = tid >> 3, n0 = (tid & 7) * 8; float v[8]; unpack8(*(const LAS u32x4*)(Bs + s * 72 + n0), v); const float ws = __expf(LM[63] - LM[s]) * DT[s];
#pragma unroll
            for (int i = 0; i < 8; ++i) v[i] *= ws;
            *(LAS u32x4*)(Bw + s * 72 + n0) = pack8(v); }
        LDS_BARRIER();
#pragma unroll
        for (int j = 0; j < 2; ++j) { const int idx = wave + 8 * j, ti = idx >> 2, pi = idx & 3; f32x4 acc = {0.f, 0.f, 0.f, 0.f};
            MMA_RT(acc, Cs, 72, 16 * ti, HbT, 72, 16 * pi, 64);
#pragma unroll
            for (int r = 0; r < 4; ++r) acc[r] *= __expf(LM[16 * ti + 4 * fq + r]);
            MMA_RT(acc, W, 72, 16 * ti, Xs, 72, 16 * pi, 64);
#pragma unroll
            for (int r = 0; r < 4; ++r) { const int t = 16 * ti + 4 * fq + r, p = 16 * pi + fr; Ys[t * 72 + p] = f2bf(acc[r] + Dh * bf2f(Xs[t * 72 + p])); } }
        { const float dec = __expf(LM[63]);
#pragma unroll
            for (int j = 0; j < 2; ++j) { const int idx = wave + 8 * j, pi = idx >> 2, ni = idx & 3;
#pragma unroll
                for (int r = 0; r < 4; ++r) accH[j][r] *= dec;
                MMA_TT(accH[j], Xs, 72, 16 * pi, Bw, 72, 16 * ni, 64); } }
        LDS_BARRIER();
#pragma unroll
        for (int j = 0; j < 2; ++j) { const int idx = wave + 8 * j, pi = idx >> 2, ni = idx & 3;
            *(LAS u32x2*)(HbT + (16 * ni + fr) * 72 + 16 * pi + 4 * fq) = pack4(accH[j][0], accH[j][1], accH[j][2], accH[j][3]); }
        { const int t = tid >> 3, part = tid & 7; float f[8], z[8]; unpack8(*(const LAS u32x4*)(Ys + t * 72 + 8 * part), f); unpack8(ps, z);
#pragma unroll
            for (int i = 0; i < 8; ++i) f[i] *= siluf(z[i]);
            if (t < nv) *(u32x4*)(BR2 + (size_t)(tok0 + t0 + t) * 512 + hd * 64 + 8 * part) = pack8(f); }
        SSD_PREFETCH_Z(t0 + 64);
        LDS_BARRIER();
    }
#undef SSD_PREFETCH_Z
#undef SSD_PREFETCH
    { float* ho = A.out + (sample ? O_SH : O_PH) + ((size_t)(l * NB + b) * 8 + hd) * 4096;
#pragma unroll
        for (int j = 0; j < 2; ++j) { const int idx = wave + 8 * j, pi = idx >> 2, ni = idx & 3;
            float* hp = ho + (16 * pi + 4 * fq) * 64 + 16 * ni + fr; OPQV(hp);
#pragma unroll
            for (int r = 0; r < 4; ++r) hp[r * 64] = accH[j][r]; } }
    for (int e = tid; e < 3 * 192; e += NTHREADS) { const int r = e / 192, c = e % 192;
        if (c < 64 || (hd & 3) == 0) A.out[(sample ? O_SV : O_PV) + ((size_t)(l * NB + b) * 3 + r) * 768 + ssd_chmap(hd, c)] = bf2f(HIST[r * 200 + c]); }
    __syncthreads();
}

__device__ __forceinline__ void phase_ssdnorm(ArgP Ap, int l) {
    const int tx = opaque_tid(), lane = tx & 63, wave = tx >> 6, gw = blockIdx.x * NWAVES + wave, NGW = gridDim.x * NWAVES;
    bf16* BR2 = (bf16*)(A.ws + WS_BR) + (size_t)T * 1024; const float* sn = A.in[20] + l * 512 + 8 * lane;
    for (int tok = gw; tok < T; tok += NGW) { float f[8]; unpack8(*(const u32x4*)(BR2 + (size_t)tok * 512 + 8 * lane), f); float s2 = 0.f;
#pragma unroll
        for (int i = 0; i < 8; ++i) s2 += f[i] * f[i];
#pragma unroll
        for (int m = 1; m < 32; m <<= 1) s2 += __shfl_xor(s2, m);
        const float rstd = 1.0f / sqrtf(s2 * (1.0f / 256.0f) + EPS_);
#pragma unroll
        for (int i = 0; i < 8; ++i) f[i] *= rstd * sn[i];
        *(u32x4*)(BR2 + (size_t)tok * 512 + 8 * lane) = pack8(f); }
}

__device__ __forceinline__ void mixer_item(ArgP Ap, LAS unsigned char* lds, int l, int it) {
    constexpr int NL0 = BP * 4, NL1 = NL0 + BP * 4, NL2 = NL1 + BP * 8, NS0 = NL2 + BS * 4, NS1 = NS0 + BS * 4;
    int kind, r; bool sample;
    if (it < NL0) { kind = 0; r = it; sample = false; } else if (it < NL1) { kind = 1; r = it - NL0; sample = false; } else if (it < NL2) { kind = 2; r = it - NL1; sample = false; }
    else if (it < NS0) { kind = 0; r = it - NL2; sample = true; } else if (it < NS1) { kind = 1; r = it - NS0; sample = true; } else { kind = 2; r = it - NS1; sample = true; }
#ifndef ONLYK
#define ONLYK -1
#endif
#ifndef EMU
#define OPQ() ArgP Ap_ = Ap; int l_ = __builtin_amdgcn_readfirstlane(l), r_ = __builtin_amdgcn_readfirstlane(r); asm volatile("" : "+s"(Ap_), "+s"(l_), "+s"(r_) :: "memory")
#else
#define OPQ() ArgP Ap_ = Ap; int l_ = l, r_ = r
#endif
    if ((ONLYK < 0 || ONLYK == 0) && kind == 0) { OPQ(); mlstm_item(Ap_, lds, l_, r_ >> 2, r_ & 3, sample); }
    else if ((ONLYK < 0 || ONLYK == 1) && kind == 1) { OPQ(); gla_item(Ap_, lds, l_, r_ >> 2, r_ & 3, sample); }
    else if ((ONLYK < 0 || ONLYK == 2) && kind == 2) { OPQ(); ssd_item(Ap_, lds, l_, r_ >> 3, r_ & 7, sample); }
#undef OPQ
}
__device__ __forceinline__ void phase_mixers(ArgP Ap, LAS unsigned char* lds, int l) {
    constexpr int NLONG = BP * 16, NSHORT = BS * 16; const int G = gridDim.x, bid = blockIdx.x;
    const bool split = G > NLONG;
    const int step = split ? (bid < NLONG ? (1 << 28) : G - NLONG) : G;
#ifndef MIXREP
#define MIXREP 0
#endif
#pragma unroll 1
    for (int it = bid; it < NLONG + NSHORT; it += step) {
        const int reps = ((MIXREP == 1 && it < NLONG) || (MIXREP == 2 && it >= NLONG) || (MIXREP == 3 && it < BP * 4) || (MIXREP == 4 && it >= BP * 4 && it < BP * 8) || (MIXREP == 5 && it >= BP * 8 && it < NLONG)) ? 2 : 1;
#pragma unroll 1
        for (int rp = 0; rp < reps; ++rp) mixer_item(Ap, lds, l, it);
    }
}

__device__ __forceinline__ float wave_sum64(float v) {
#pragma unroll
    for (int m = 1; m < 64; m <<= 1) v += __shfl_xor(v, m);
    return v;
}
constexpr float DN_ALPHA_ = 1.4142135623730951f;

__device__ __forceinline__ void phase_ln1(ArgP Ap, int l) {
    const int tx = opaque_tid(), lane = tx & 63, wave = tx >> 6, gw = blockIdx.x * NWAVES + wave, NGW = gridDim.x * NWAVES;
    const float* Y = (const float*)(A.ws + WS_ZG); float* H = (float*)(A.ws + WS_H); bf16* H1B = (bf16*)(A.ws + WS_BR);
    const float* lg = A.in[23] + l * D + 16 * lane; const float* lb = A.in[24] + l * D + 16 * lane;
    for (int tok = gw; tok < T; tok += NGW) {
        const float* xr = (l == 0) ? (tok < TP ? A.in[0] + (size_t)tok * D : A.in[1] + (size_t)(tok - TP) * D) : H + (size_t)tok * D;
        float y[16]; float s1 = 0.f;
#pragma unroll
        for (int q = 0; q < 4; ++q) { const float4 a = *(const float4*)(xr + 16 * lane + 4 * q), b = *(const float4*)(Y + (size_t)tok * D + 16 * lane + 4 * q);
            y[4 * q] = DN_ALPHA_ * a.x + b.x; y[4 * q + 1] = DN_ALPHA_ * a.y + b.y; y[4 * q + 2] = DN_ALPHA_ * a.z + b.z; y[4 * q + 3] = DN_ALPHA_ * a.w + b.w; }
#pragma unroll
        for (int i = 0; i < 16; ++i) s1 += y[i];
        const float mu = wave_sum64(s1) * (1.0f / D); float s2 = 0.f;
#pragma unroll
        for (int i = 0; i < 16; ++i) { y[i] -= mu; s2 += y[i] * y[i]; }
        const float rstd = 1.0f / sqrtf(wave_sum64(s2) * (1.0f / D) + EPS_);
#pragma unroll
        for (int i = 0; i < 16; ++i) y[i] = y[i] * rstd * lg[i] + lb[i];
#pragma unroll
        for (int q = 0; q < 4; ++q) *(float4*)(H + (size_t)tok * D + 16 * lane + 4 * q) = make_float4(y[4 * q], y[4 * q + 1], y[4 * q + 2], y[4 * q + 3]);
        float y0[8], y1[8];
#pragma unroll
        for (int i = 0; i < 8; ++i) { y0[i] = y[i]; y1[i] = y[8 + i]; }
        *(u32x4*)(H1B + (size_t)tok * D + 16 * lane) = pack8(y0); *(u32x4*)(H1B + (size_t)tok * D + 16 * lane + 8) = pack8(y1);
    }
    for (int r2 = gw; r2 < 2 * NEXP; r2 += NGW) { const int tab = r2 >= NEXP, row = r2 - tab * NEXP;
        const float* src = A.in[27 + tab] + ((size_t)l * NEXP + row) * D + 16 * lane; float v[16]; float mx = 0.f;
#pragma unroll
        for (int q = 0; q < 4; ++q) { const float4 a = *(const float4*)(src + 4 * q); v[4 * q] = a.x; v[4 * q + 1] = a.y; v[4 * q + 2] = a.z; v[4 * q + 3] = a.w; }
#pragma unroll
        for (int i = 0; i < 16; ++i) mx = fmaxf(mx, fabsf(v[i]));
#pragma unroll
        for (int m = 1; m < 64; m <<= 1) mx = fmaxf(mx, __shfl_xor(mx, m));
        const float sc = (mx > 0.f) ? exp2f(floorf(log2f(224.0f / mx))) : 1.0f;
        u32x4 w; w.x = pk_fp8x4(v[0] * sc, v[1] * sc, v[2] * sc, v[3] * sc); w.y = pk_fp8x4(v[4] * sc, v[5] * sc, v[6] * sc, v[7] * sc);
        w.z = pk_fp8x4(v[8] * sc, v[9] * sc, v[10] * sc, v[11] * sc); w.w = pk_fp8x4(v[12] * sc, v[13] * sc, v[14] * sc, v[15] * sc);
        *(u32x4*)(A.ws + (tab ? WS_PV : WS_PU) + (size_t)row * D + 16 * lane) = w;
        if (lane == 0) ((float*)(A.ws + (tab ? WS_PVS : WS_PUS)))[row] = 1.0f / sc; }
}

__device__ __forceinline__ unsigned ord_of(float f) { const unsigned u = __float_as_uint(f); return (u & 0x80000000u) ? ~u : (u | 0x80000000u); }
__device__ __forceinline__ float dec_ord(unsigned o) { const unsigned u = (o & 0x80000000u) ? (o & 0x7fffffffu) : ~o; return __uint_as_float(u); }
__device__ __forceinline__ unsigned umax_(unsigned a, unsigned b) { return a > b ? a : b; }
__device__ __forceinline__ unsigned umin_(unsigned a, unsigned b) { return a < b ? a : b; }
__device__ __forceinline__ void ins16(unsigned (&L)[16], unsigned x) {
#pragma unroll
    for (int p = 0; p < 16; ++p) { const unsigned hi = umax_(L[p], x); x = umin_(L[p], x); L[p] = hi; }
}
__device__ __forceinline__ unsigned sel16(const unsigned (&L)[16], int a) { unsigned r = L[0];
#pragma unroll
    for (int p = 1; p < 16; ++p) r = (a == p) ? L[p] : r;
    return r; }

__device__ __forceinline__ void route_topk(const bf16* __restrict__ Q, const LAS bf16* KEYS, int tokb, int h, int j, int fr, int fq, unsigned (&Lt)[16]) {
    f32x4 acc[8];
#pragma unroll
    for (int ki = 0; ki < 8; ++ki) acc[ki] = (f32x4){0.f, 0.f, 0.f, 0.f};
#pragma unroll
    for (int kk = 0; kk < 4; ++kk) { const bf16x8 bq = *(const bf16x8*)(Q + (size_t)(tokb + fr) * 2048 + h * 256 + j * 128 + 32 * kk + 8 * fq);
#pragma unroll
        for (int ki = 0; ki < 8; ++ki) { const bf16x8 ak = *(const LAS bf16x8*)(KEYS + (j * 128 + 16 * ki + fr) * 136 + 32 * kk + 8 * fq); acc[ki] = mfma16(ak, bq, acc[ki]); } }
#pragma unroll
    for (int p = 0; p < 16; ++p) Lt[p] = 0u;
#pragma unroll
    for (int ki = 0; ki < 8; ++ki)
#pragma unroll
        for (int r = 0; r < 4; ++r) ins16(Lt, (ord_of(acc[ki][r]) & ~127u) | (unsigned)(127 - (16 * ki + 4 * fq + r)));
#pragma unroll
    for (int m = 16; m < 64; m <<= 1) { unsigned R[16];
#pragma unroll
        for (int p = 0; p < 16; ++p) R[p] = __shfl_xor(Lt[p], m);
#pragma unroll
        for (int p = 0; p < 16; ++p) ins16(Lt, R[p]); }
}

__device__ __forceinline__ void phase_route(ArgP Ap, LAS unsigned char* lds, int l) {
    const int tid = opaque_tid(), lane = tid & 63, wave = tid >> 6, fr = lane & 15, fq = lane >> 4;
    LAS bf16* KEYS = (LAS bf16*)lds;
    LAS unsigned* LST = (LAS unsigned*)(lds + 69632);
    const bf16* Q = (const bf16*)(A.ws + WS_Q); int* IDX = (int*)(A.ws + WS_IDX); float* GT = (float*)(A.ws + WS_GT);
    const bf16* kg = (const bf16*)(A.ws + WS_WB + (size_t)l * WB_BYTES + WB_KEYS);
    constexpr int NG = T / 16, NCH = (NG + 7) / 8, NITEMS = NCH * 8;
    int last_h = -1;
    for (int it = blockIdx.x; it < NITEMS; it += gridDim.x) {
        const int h = it & 7, ch = it >> 3;
        if (h != last_h) { __syncthreads();
            for (int c = tid; c < 2 * 128 * 16; c += NTHREADS) { const int row = c >> 4, cc = (c & 15) * 8; *(LAS u32x4*)(KEYS + row * 136 + cc) = *(const u32x4*)(kg + ((size_t)h * 256 + row) * 128 + cc); }
            __syncthreads(); last_h = h; }
        const int grp = ch * 8 + wave;
        if (grp < NG) {
            const int tokb = grp * 16; unsigned L1[16], L2[16];
            route_topk(Q, KEYS, tokb, h, 0, fr, fq, L1); route_topk(Q, KEYS, tokb, h, 1, fr, fq, L2);
            unsigned C[16];
#pragma unroll
            for (int p = 0; p < 16; ++p) C[p] = 0u;
#pragma unroll
            for (int a = 0; a < 16; ++a)
#pragma unroll
                for (int b = 0; b < 16; ++b) if ((a + 1) * (b + 1) <= 16) {
                    const float s = dec_ord(L1[a] & ~127u) + dec_ord(L2[b] & ~127u); ins16(C, (ord_of(s) & ~255u) | (unsigned)(255 - (a * 16 + b))); }
            const float s0 = dec_ord(C[0] & ~255u); float e[16]; float sum = 0.f;
#pragma unroll
            for (int p = 0; p < 16; ++p) { e[p] = __expf(dec_ord(C[p] & ~255u) - s0); sum += e[p]; }
            const float inv = 1.0f / sum; const size_t ob = (size_t)(tokb + fr) * 128 + h * 16;
#pragma unroll
            for (int p = 0; p < 16; ++p) { LST[(wave * 32 + p) * 64 + lane] = L1[p]; LST[(wave * 32 + 16 + p) * 64 + lane] = L2[p]; }
#pragma unroll
            for (int p = 0; p < 16; ++p) { const int cid = 255 - (int)(C[p] & 255u); const int a = cid >> 4, b = cid & 15;
                const int e1 = 127 - (int)(LST[(wave * 32 + a) * 64 + lane] & 127u), e2 = 127 - (int)(LST[(wave * 32 + 16 + b) * 64 + lane] & 127u);
                if ((p >> 2) == fq) { IDX[ob + p] = e1 * 128 + e2; GT[ob + p] = e[p] * inv; } }
        }
    }
}

__device__ __forceinline__ void phase_gather(ArgP Ap, int l) {
    const int tx = opaque_tid(), lane = tx & 63, wave = tx >> 6, gw = blockIdx.x * NWAVES + wave, NGW = gridDim.x * NWAVES;
    float* H = (float*)(A.ws + WS_H); bf16* XB = (bf16*)(A.ws + WS_XB); const int* IDX = (const int*)(A.ws + WS_IDX); const float* GT = (const float*)(A.ws + WS_GT);
    const unsigned char* PU = A.ws + WS_PU; const unsigned char* PV = A.ws + WS_PV; const float* PUS = (const float*)(A.ws + WS_PUS); const float* PVS = (const float*)(A.ws + WS_PVS);
    const float* lg = A.in[29] + l * D + 16 * lane; const float* lb = A.in[30] + l * D + 16 * lane;
    for (int tok = gw; tok < T; tok += NGW) {
        float x[16];
#pragma unroll
        for (int q = 0; q < 4; ++q) { const float4 a = *(const float4*)(H + (size_t)tok * D + 16 * lane + 4 * q); x[4 * q] = a.x; x[4 * q + 1] = a.y; x[4 * q + 2] = a.z; x[4 * q + 3] = a.w; }
        const int i0 = IDX[(size_t)tok * 128 + lane], i1 = IDX[(size_t)tok * 128 + 64 + lane];
        const float su0 = PUS[i0], su1 = PUS[i1];
        const float gv0 = GT[(size_t)tok * 128 + lane] * PVS[i0], gv1 = GT[(size_t)tok * 128 + 64 + lane] * PVS[i1];
        float o[16];
#pragma unroll
        for (int i = 0; i < 16; ++i) o[i] = 0.f;
#pragma unroll 1
        for (int kb = 0; kb < 128; kb += 16) {
            u32x4 uu[16], vv[16]; float su[16], gk[16];
#pragma unroll
            for (int kk = 0; kk < 16; ++kk) { const int k = kb + kk; const int e = __shfl(kb < 64 ? i0 : i1, k & 63); su[kk] = __shfl(kb < 64 ? su0 : su1, k & 63); gk[kk] = __shfl(kb < 64 ? gv0 : gv1, k & 63);
                uu[kk] = *(const u32x4*)(PU + (size_t)e * D + 16 * lane); vv[kk] = *(const u32x4*)(PV + (size_t)e * D + 16 * lane); }
#pragma unroll
            for (int kk = 0; kk < 16; ++kk) { float f[16]; unpk_fp8x4(uu[kk].x, f); unpk_fp8x4(uu[kk].y, f + 4); unpk_fp8x4(uu[kk].z, f + 8); unpk_fp8x4(uu[kk].w, f + 12); float p = 0.f;
#pragma unroll
                for (int i = 0; i < 16; ++i) p += f[i] * x[i];
                p = wave_sum64(p) * su[kk];
                const float act = 0.5f * p * (1.0f + erff(p * 0.70710678118654752f)) * gk[kk];
                unpk_fp8x4(vv[kk].x, f); unpk_fp8x4(vv[kk].y, f + 4); unpk_fp8x4(vv[kk].z, f + 8); unpk_fp8x4(vv[kk].w, f + 12);
#pragma unroll
                for (int i = 0; i < 16; ++i) o[i] += act * f[i]; }
        }
        float s1 = 0.f;
#pragma unroll
        for (int i = 0; i < 16; ++i) { o[i] += DN_ALPHA_ * x[i]; s1 += o[i]; }
        const float mu = wave_sum64(s1) * (1.0f / D); float s2 = 0.f;
#pragma unroll
        for (int i = 0; i < 16; ++i) { o[i] -= mu; s2 += o[i] * o[i]; }
        const float rstd = 1.0f / sqrtf(wave_sum64(s2) * (1.0f / D) + EPS_);
#pragma unroll
        for (int i = 0; i < 16; ++i) o[i] = o[i] * rstd * lg[i] + lb[i];
        float* dst = (l == 1) ? A.out + (size_t)tok * D + 16 * lane : H + (size_t)tok * D + 16 * lane;
#pragma unroll
        for (int q = 0; q < 4; ++q) *(float4*)(dst + 4 * q) = make_float4(o[4 * q], o[4 * q + 1], o[4 * q + 2], o[4 * q + 3]);
        if (l == 0) { float y0[8], y1[8];
#pragma unroll
            for (int i = 0; i < 8; ++i) { y0[i] = o[i]; y1[i] = o[8 + i]; }
            *(u32x4*)(XB + (size_t)tok * D + 16 * lane) = pack8(y0); *(u32x4*)(XB + (size_t)tok * D + 16 * lane + 8) = pack8(y1); }
    }
}

#ifndef EMU
struct MergeOrder {
    pg8::StaticOrder S;
    __device__ bool next(int i, pg8::Unit& u) const { pg8::Unit t; if (!S.next(i / 3, t)) return false; const int n = i % 3; u.pm = n * (T / 256) + t.pm; u.pn = n * 4 + t.pn; return true; }
    __device__ __forceinline__ void a_ready(const pg8::Unit&) const {}
    __device__ __forceinline__ void done(const pg8::Unit&) const {}
};
struct EpiMerge {
    static constexpr bool PERM = true, AFTER_DRAIN = false;
    const bf16* ZG; float* MIXF; bf16* MIXED;
    __device__ __forceinline__ void operator()(const pg8::f32x4 (&acc)[2][2][4][2], const pg8::Unit& u, int wr, int wc, int fr, int fq) const {
        const int n = u.pn >> 2, pn = u.pn & 3, pm = u.pm - n * (T / 256);
        const int row0 = pm * 256 + wr * 64 + fr, col0 = pn * 256 + wc * 32 + 8 * fq;
#pragma unroll
        for (int ai = 0; ai < 2; ++ai)
#pragma unroll
            for (int m = 0; m < 4; ++m) { const size_t row = (size_t)(row0 + ai * 128 + m * 16);
#pragma unroll
                for (int bj = 0; bj < 2; ++bj) { const int col = col0 + bj * 128;
                    float g[8]; unpack8(*(const u32x4*)(ZG + row * NZG + n * D + col), g);
                    float v[8];
#pragma unroll
                    for (int j = 0; j < 4; ++j) { v[j] = acc[ai][bj][m][0][j] * g[j]; v[4 + j] = acc[ai][bj][m][1][j] * g[4 + j]; }
                    float* mp = MIXF + row * D + col;
                    if (n > 0) { const float4 a = *(const float4*)mp, b = *(const float4*)(mp + 4);
                        v[0] += a.x; v[1] += a.y; v[2] += a.z; v[3] += a.w; v[4] += b.x; v[5] += b.y; v[6] += b.z; v[7] += b.w; }
                    if (n < 2) { *(float4*)mp = make_float4(v[0], v[1], v[2], v[3]); *(float4*)(mp + 4) = make_float4(v[4], v[5], v[6], v[7]); }
                    else *(u32x4*)(MIXED + row * D + col) = pack8(v); } }
    }
};
__device__ __forceinline__ void phase_merge(ArgP Ap, LAS unsigned char* lds, int l) {
    pg8::Gemm g{(const bf16*)(A.ws + WS_BR), (const bf16*)(A.ws + WS_WB + (size_t)l * WB_BYTES + WB_WBR), 3 * T, 3 * D, 512};
    MergeOrder S; S.S.init(T, D, gridDim.x, blockIdx.x);
    EpiMerge E{(const bf16*)(A.ws + WS_ZG), (float*)(A.ws + WS_ZM), (bf16*)(A.ws + WS_XB)};
    pg8::gemm_phase<EpiMerge, MergeOrder>(lds, g, S, E);
}
struct EpiF32 {
    static constexpr bool PERM = false, AFTER_DRAIN = false;
    float* C; int ldc;
    __device__ __forceinline__ void operator()(const pg8::f32x4 (&acc)[2][2][4][2], const pg8::Unit& u, int wr, int wc, int fr, int fq) const {
        const int row0 = u.pm * 256 + wr * 64 + fr, col0 = u.pn * 256 + wc * 32 + 4 * fq;
#pragma unroll
        for (int ai = 0; ai < 2; ++ai)
#pragma unroll
            for (int m = 0; m < 4; ++m) { float* rowp = C + (size_t)(row0 + ai * 128 + m * 16) * ldc + col0;
#pragma unroll
                for (int bj = 0; bj < 2; ++bj)
#pragma unroll
                    for (int n = 0; n < 2; ++n) *(pg8::f32x4*)(rowp + bj * 128 + n * 16) = acc[ai][bj][m][n]; }
    }
};
struct EpiB16 {
    static constexpr bool PERM = true, AFTER_DRAIN = false;
    bf16* O; int ldc;
    __device__ __forceinline__ void operator()(const pg8::f32x4 (&acc)[2][2][4][2], const pg8::Unit& u, int wr, int wc, int fr, int fq) const {
        const int row0 = u.pm * 256 + wr * 64 + fr, col0 = u.pn * 256 + wc * 32 + 8 * fq;
#pragma unroll
        for (int ai = 0; ai < 2; ++ai)
#pragma unroll
            for (int m = 0; m < 4; ++m) { bf16* rowp = O + (size_t)(row0 + ai * 128 + m * 16) * ldc + col0;
#pragma unroll
                for (int bj = 0; bj < 2; ++bj) { const pg8::f32x4 v0 = acc[ai][bj][m][0], v1 = acc[ai][bj][m][1];
                    u32x4 w; w.x = pg8::cvt_pk_bf16(v0[0], v0[1]); w.y = pg8::cvt_pk_bf16(v0[2], v0[3]); w.z = pg8::cvt_pk_bf16(v1[0], v1[1]); w.w = pg8::cvt_pk_bf16(v1[2], v1[3]);
                    *(u32x4*)(rowp + bj * 128) = w; } }
    }
};
__device__ __forceinline__ void phase_outproj(ArgP Ap, LAS unsigned char* lds, int l) {
    pg8::Gemm g{(const bf16*)(A.ws + WS_XB), (const bf16*)(A.ws + WS_WB + (size_t)l * WB_BYTES + WB_WO), T, D, D};
    pg8::StaticOrder S; S.init(T, D, gridDim.x, blockIdx.x);
    EpiF32 E{(float*)(A.ws + WS_ZG), D};
    pg8::gemm_phase<EpiF32, pg8::StaticOrder>(lds, g, S, E);
}
__device__ __forceinline__ void phase_qproj(ArgP Ap, LAS unsigned char* lds, int l) {
    pg8::Gemm g{(const bf16*)(A.ws + WS_BR), (const bf16*)(A.ws + WS_WB + (size_t)l * WB_BYTES + WB_WQ), T, 2048, D};
    pg8::StaticOrder S; S.init(T, 2048, gridDim.x, blockIdx.x);
    EpiB16 E{(bf16*)(A.ws + WS_Q), 2048};
    pg8::gemm_phase<EpiB16, pg8::StaticOrder>(lds, g, S, E);
}

__global__ void __launch_bounds__(NTHREADS, 2) mega_fwd(Args kargs) {
    extern __shared__ __attribute__((aligned(16))) unsigned char lds_raw[];
    LAS unsigned char* lds = (LAS unsigned char*)lds_raw;
    cg::grid_group grid = cg::this_grid();
    volatile LAS unsigned* xst = (volatile LAS unsigned*)(lds + LDS_BYTES - 16);
    unsigned* xbar = (unsigned*)(kargs.ws + WS_CTL);
    if (threadIdx.x < 4) xst[threadIdx.x] = 0u;
    if (blockIdx.x == 0) for (int i = threadIdx.x; i < XCD_BAR_WORDS; i += NTHREADS) xbar[i] = 0u;
    __syncthreads();
    XcdBarrier xb; xb.bar = xbar; xb.x = 0; xb.st = xst; bool xposted = false;
    ArgP Ap = (ArgP)__builtin_amdgcn_kernarg_segment_ptr();
    const int lo = A.ph_lo, hi = A.ph_hi;
#define RUN(call) do { ArgP Ap_ = Ap; int l_ = l; asm volatile("" : "+s"(Ap_), "+s"(l_) :: "memory"); { ArgP Ap = Ap_; const int l = l_; call; } asm volatile("" ::: "memory"); } while (0)
#ifndef ONLYP
#define ONLYP -1
#endif
#define PSEL(q) (ONLYP < 0 || ONLYP == (q))
#ifndef REPMASK
#define REPMASK 0
#endif
#define REP(q, l) (((REPMASK >> (q)) & 1) && ((q) != 5 || (l) == 0) && ((q) != 8 || (l) == 1))
#define IN(k) (lo <= (k) && (k) < hi)
#define SEAM(k) do { if (IN(k) && IN((k) + 1)) { if (!xposted) { grid.sync(); xb = xcd_barrier_post(xbar, xst); xposted = true; } else xcd_barrier(xb); } } while (0)
    { const int l = 0; if (PSEL(0) && IN(0)) { RUN(phase_convert(Ap, lds)); if (REP(0, l)) RUN(phase_convert(Ap, lds)); } (void)l; }
    SEAM(0);
    for (int l = 0; l < 2; ++l) {
        const int p = 1 + 9 * l;
        if (PSEL(1) && IN(p + 0)) { RUN(phase_gemm1(Ap, lds, l)); if (REP(1, l)) RUN(phase_gemm1(Ap, lds, l)); }
        SEAM(p);
        if (PSEL(2) && IN(p + 1)) { RUN(phase_mixers(Ap, lds, l)); if (REP(2, l)) RUN(phase_mixers(Ap, lds, l)); }
        SEAM(p + 1);
#ifdef XBAR_EXTRA
        for (int xe = 0; xe < XBAR_EXTRA; ++xe) xcd_barrier(xb);
#endif
        if (PSEL(9) && IN(p + 2)) RUN(phase_ssdnorm(Ap, l));
        SEAM(p + 2);
        if (PSEL(3) && IN(p + 3)) { RUN(phase_merge(Ap, lds, l)); if (REP(3, l)) RUN(phase_merge(Ap, lds, l)); }
        SEAM(p + 3);
        if (PSEL(4) && IN(p + 4)) { RUN(phase_outproj(Ap, lds, l)); if (REP(4, l)) RUN(phase_outproj(Ap, lds, l)); }
        SEAM(p + 4);
        if (PSEL(5) && IN(p + 5)) { RUN(phase_ln1(Ap, l)); if (REP(5, l)) RUN(phase_ln1(Ap, l)); }
        SEAM(p + 5);
        if (PSEL(6) && IN(p + 6)) { RUN(phase_qproj(Ap, lds, l)); if (REP(6, l)) RUN(phase_qproj(Ap, lds, l)); }
        SEAM(p + 6);
        if (PSEL(7) && IN(p + 7)) { RUN(phase_route(Ap, lds, l)); if (REP(7, l)) RUN(phase_route(Ap, lds, l)); }
        SEAM(p + 7);
        if (PSEL(8) && IN(p + 8)) { RUN(phase_gather(Ap, l)); if (REP(8, l)) RUN(phase_gather(Ap, l)); }
        SEAM(p + 8);
    }
#undef IN
#undef RUN
#undef SEAM
}

extern "C" void kernel_launch(void* const* d_in, const int* in_sizes, int n_in, void* d_out, int out_size, void* d_ws, size_t ws_size, hipStream_t stream) {
    static int grid_blocks = 0;
    if (grid_blocks == 0) {
        if (n_in != 31 || (size_t)out_size != O_END || ws_size < WS_END) {
            fprintf(stderr, "kernel_launch: unexpected problem: n_in %d out %d (want %zu) ws %zu (want >= %zu)\n", n_in, out_size, (size_t)O_END, ws_size, (size_t)WS_END); grid_blocks = -1; return; }
        int dev = 0, cus = 0, per_cu = 0;
        (void)hipGetDevice(&dev); (void)hipDeviceGetAttribute(&cus, hipDeviceAttributeMultiprocessorCount, dev);
        if (hipFuncSetAttribute((const void*)mega_fwd, hipFuncAttributeMaxDynamicSharedMemorySize, LDS_BYTES) != hipSuccess) { fprintf(stderr, "kernel_launch: hipFuncSetAttribute failed\n"); grid_blocks = -1; return; }
        if (hipOccupancyMaxActiveBlocksPerMultiprocessor(&per_cu, (const void*)mega_fwd, NTHREADS, LDS_BYTES) != hipSuccess || per_cu < 1) { fprintf(stderr, "kernel_launch: occupancy query failed (%d)\n", per_cu); grid_blocks = -1; return; }
        grid_blocks = cus * per_cu;
        fprintf(stderr, "kernel_launch: %d CUs x %d = %d workgroups\n", cus, per_cu, grid_blocks);
    }
    if (grid_blocks < 0) return;
    Args a{};
    for (int i = 0; i < 31; ++i) a.in[i] = (const float*)d_in[i];
    a.out = (float*)d_out; a.ws = (unsigned char*)d_ws; a.ph_lo = 0; a.ph_hi = 64;
    void* args[] = {&a};
    hipError_t e = hipLaunchCooperativeKernel((const void*)mega_fwd, dim3(grid_blocks), dim3(NTHREADS), args, LDS_BYTES, stream);
    if (e != hipSuccess) fprintf(stderr, "kernel_launch: cooperative launch failed: %s (grid %d)\n", hipGetErrorString(e), grid_blocks);
}
#endif
```

```cpp
#ifndef EMU
#include <hip/hip_runtime.h>
#include <hip/hip_cooperative_groups.h>
#include <cstdio>
#include <cstdint>
namespace cg = cooperative_groups;
namespace pg8 {
#define PG8_LAS __attribute__((address_space(3)))
typedef unsigned short bf16_t;
typedef short bf16x8 __attribute__((ext_vector_type(8)));
typedef float f32x4 __attribute__((ext_vector_type(4)));
typedef unsigned u32x4 __attribute__((ext_vector_type(4)));
constexpr int BM = 256, BK = 64, HALF = 128, HTB = HALF * BK * 2  , STAGE_BYTES = 8 * HTB, NXCD = 8, WGM = 8;

__host__ __device__ __forceinline__ int lds_byte(int r, int c) { const int st = (r >> 4) * 2 + (c >> 5), rr = r & 15, cc = c & 31, ob = rr * 64 + cc * 2; return st * 1024 + (ob ^ (((ob >> 9) & 1) << 5)); }
__host__ __device__ __forceinline__ void stage_rc(int b, int& R, int& C) { const int st = b / 1024, sb = b % 1024, swz = sb ^ (((sb >> 9) & 1) << 5); R = (st >> 1) * 16 + swz / 64; C = (st & 1) * 32 + (swz % 64) / 2; }
__host__ __device__ __forceinline__ int perm32(int rho) { const int n = rho >> 4, i = rho & 15; return 8 * (i >> 2) + 4 * n + (i & 3); }

struct Unit { int pm, pn; };
struct Gemm { const bf16_t* A; const bf16_t* Bt; int M, N, K; };

struct StaticOrder {
    int nM, nN, nwg, G, c;
    __host__ __device__ void init(int M, int N, int G_, int c_) { nM = M / BM; nN = N / BM; nwg = nM * nN; G = G_; c = c_; }
    __host__ __device__ bool next(int i, Unit& u) const {
        const long L = (long)i * G + c; if (L >= nwg) return false;
        int wgid = (int)L; { const int q = nwg / NXCD, r = nwg % NXCD, xcd = wgid % NXCD, off = wgid / NXCD; wgid = (xcd < r ? xcd * (q + 1) : r * (q + 1) + (xcd - r) * q) + off; }
        const int nig = WGM * nN, gid = wgid / nig, fm = gid * WGM, gsz = (nM - fm) < WGM ? (nM - fm) : WGM;
        u.pm = fm + ((wgid % nig) % gsz); u.pn = (wgid % nig) / gsz; return true;
    }
    __device__ __forceinline__ void a_ready(const Unit&) const {}
    __device__ __forceinline__ void done(const Unit&) const {}
};

__device__ __forceinline__ unsigned cvt_pk_bf16(float lo, float hi) { unsigned r; asm volatile("v_cvt_pk_bf16_f32 %0, %1, %2" : "=v"(r) : "v"(lo), "v"(hi)); return r; }
typedef float f32x2 __attribute__((ext_vector_type(2)));
__device__ __forceinline__ f32x2 gelu_pk(f32x2 v) {
    const f32x2 av = __builtin_elementwise_abs(v), d = av * 0.2316418882f + 1.0f;
    f32x2 t; t.x = __builtin_amdgcn_rcpf(d.x); t.y = __builtin_amdgcn_rcpf(d.y);
    f32x2 q = t * 0.5307027145f + (-0.7265760135f); q = q * t + 0.7107068705f; q = q * t + (-0.142248368f); q = q * t + 0.127414796f; q = q * t;
    const f32x2 s = (v * v) * (-0.72134752044f);
    f32x2 e; e.x = __builtin_amdgcn_exp2f(s.x); e.y = __builtin_amdgcn_exp2f(s.y);
    const f32x2 m = v * (q * e), r = v - m;
    f32x2 o; o.x = v.x < 0.f ? m.x : r.x; o.y = v.y < 0.f ? m.y : r.y; return o;
}

template <class Epi, class Sched>
__device__ __forceinline__ void gemm_phase(PG8_LAS unsigned char* lds, const Gemm g, const Sched& S, const Epi& E) {
    int tid_o = threadIdx.x; asm volatile("" : "+v"(tid_o));
    const int tid = tid_o, wid = __builtin_amdgcn_readfirstlane(tid >> 6), lane = tid & 63, wr = wid >> 2, wc = wid & 3, fr = lane & 15, fq = lane >> 4;
    const int K = g.K, nt = K / BK;
    unsigned voffA[2], voffB[2];
#pragma unroll
    for (int i = 0; i < 2; ++i) { int R, C; stage_rc(tid * 16 + i * 8192, R, C); const int Rb = Epi::PERM ? ((R & ~31) + perm32(R & 31)) : R;
        voffA[i] = (unsigned)(R * K + C) * 2u; voffB[i] = (unsigned)(Rb * K + C) * 2u; }
    const size_t kstep = (size_t)(BK * 2);
    const size_t hstep = (size_t)HALF * K * 2;
    const size_t tstep = 2 * hstep;
    const unsigned ldsw = (unsigned)wid * 1024u;
    const int aoff = lds_byte(wr * 64 + fr, fq * 8), boff = lds_byte(wc * 32 + fr, fq * 8);
#define PG8_SA(b, h) (((b) * 2 + (h)) * HTB)
#define PG8_SB(b, h) ((4 + (b) * 2 + (h)) * HTB)
#define PG8_STAGE(bufoff, gbase, voff) do { _Pragma("unroll") for (int _i = 0; _i < 2; ++_i) \
        __builtin_amdgcn_global_load_lds((const unsigned*)((const char*)(gbase) + (voff)[_i]), (PG8_LAS unsigned*)(lds + (bufoff) + ldsw + _i * 8192), 16, 0, 0); } while (0)
#define PG8_LDA(dst, b, h) do { _Pragma("unroll") for (int m = 0; m < 4; ++m) _Pragma("unroll") for (int k = 0; k < 2; ++k) dst[m][k] = *(const PG8_LAS bf16x8*)(lds + PG8_SA(b, h) + aoff + m * 2048 + k * 1024); } while (0)
#define PG8_LDB(dst, b, h) do { _Pragma("unroll") for (int n = 0; n < 2; ++n) _Pragma("unroll") for (int k = 0; k < 2; ++k) dst[n][k] = *(const PG8_LAS bf16x8*)(lds + PG8_SB(b, h) + boff + n * 2048 + k * 1024); } while (0)
#define PG8_MMA(ai, bj, At, Bt) do { __builtin_amdgcn_s_setprio(1); _Pragma("unroll") for (int m = 0; m < 4; ++m) _Pragma("unroll") for (int n = 0; n < 2; ++n) _Pragma("unroll") for (int k = 0; k < 2; ++k) \
        acc[ai][bj][m][n] = __builtin_amdgcn_mfma_f32_16x16x32_bf16(Bt[n][k], At[m][k], acc[ai][bj][m][n], 0, 0, 0); __builtin_amdgcn_s_setprio(0); } while (0)
#define PG8_WAIT_V(n) asm volatile("s_waitcnt vmcnt(" #n ")" ::: "memory")
#define PG8_WAIT_L(n) asm volatile("s_waitcnt lgkmcnt(" #n ")" ::: "memory")
#define PG8_BAR __builtin_amdgcn_s_barrier()
#define PG8_SCHED __builtin_amdgcn_sched_barrier(0)
    Unit cur, nxt; int ui = 0;
    if (!S.next(0, cur)) return;
    f32x4 acc[2][2][4][2];
#pragma unroll
    for (int a = 0; a < 2; ++a)
#pragma unroll
        for (int b = 0; b < 2; ++b)
#pragma unroll
            for (int m = 0; m < 4; ++m)
#pragma unroll
                for (int n = 0; n < 2; ++n) acc[a][b][m][n] = (f32x4){0.f, 0.f, 0.f, 0.f};
    bf16x8 At[4][2], B0[2][2], B1[2][2];
    const char* cA = (const char*)g.A + (size_t)cur.pm * tstep; const char* cB = (const char*)g.Bt + (size_t)cur.pn * tstep;
    S.a_ready(cur);
    PG8_STAGE(PG8_SB(0, 0), cB, voffB); PG8_STAGE(PG8_SA(0, 0), cA, voffA); PG8_STAGE(PG8_SB(0, 1), cB + hstep, voffB); PG8_STAGE(PG8_SA(0, 1), cA + hstep, voffA);
    if (wr == 1) PG8_BAR;
    PG8_WAIT_V(4); PG8_BAR;
    PG8_STAGE(PG8_SB(1, 0), cB + kstep, voffB); PG8_STAGE(PG8_SA(1, 0), cA + kstep, voffA); PG8_STAGE(PG8_SB(1, 1), cB + hstep + kstep, voffB);
    PG8_WAIT_V(6); PG8_BAR;
    for (;;) {
        const bool has_next = S.next(ui + 1, nxt);
        const char* nA = has_next ? (const char*)g.A + (size_t)nxt.pm * tstep : cA; const char* nB = has_next ? (const char*)g.Bt + (size_t)nxt.pn * tstep : cB;
        for (int t = 0; t < nt; t += 2) {
            const bool last = (t == nt - 2);
            const char* a1 = cA + (size_t)(t + 1) * kstep;
            const char* a2 = last ? nA : cA + (size_t)(t + 2) * kstep; const char* b2 = last ? nB : cB + (size_t)(t + 2) * kstep;
            const char* a3 = a2 + kstep; const char* b3 = b2 + kstep;
            if (last && has_next) S.a_ready(nxt);
            PG8_LDB(B0, 0, 0); PG8_SCHED; PG8_LDA(At, 0, 0); PG8_STAGE(PG8_SA(1, 1), a1 + hstep, voffA);
            PG8_WAIT_L(8); PG8_BAR; PG8_WAIT_L(0); PG8_MMA(0, 0, At, B0); PG8_BAR; PG8_SCHED;
            PG8_LDB(B1, 0, 1); PG8_STAGE(PG8_SB(0, 0), b2, voffB);
            PG8_BAR; PG8_WAIT_L(0); PG8_MMA(0, 1, At, B1); PG8_BAR;
            PG8_LDA(At, 0, 1); PG8_STAGE(PG8_SA(0, 0), a2, voffA);
            PG8_BAR; PG8_WAIT_L(0); PG8_MMA(1, 0, At, B0); PG8_BAR; PG8_SCHED;
            PG8_STAGE(PG8_SB(0, 1), b2 + hstep, voffB);
            PG8_WAIT_V(6); PG8_BAR; PG8_MMA(1, 1, At, B1); PG8_BAR;
            PG8_LDB(B0, 1, 0); PG8_SCHED; PG8_LDA(At, 1, 0); PG8_STAGE(PG8_SA(0, 1), a2 + hstep, voffA);
            PG8_WAIT_L(8); PG8_BAR; PG8_WAIT_L(0); PG8_MMA(0, 0, At, B0); PG8_BAR; PG8_SCHED;
            PG8_LDB(B1, 1, 1); PG8_STAGE(PG8_SB(1, 0), b3, voffB);
            PG8_BAR; PG8_WAIT_L(0); PG8_MMA(0, 1, At, B1); PG8_BAR;
            PG8_LDA(At, 1, 1); PG8_STAGE(PG8_SA(1, 0), a3, voffA);
            PG8_BAR; PG8_WAIT_L(0); PG8_MMA(1, 0, At, B0); PG8_BAR; PG8_SCHED;
            PG8_STAGE(PG8_SB(1, 1), b3 + hstep, voffB);
            PG8_WAIT_V(6); PG8_BAR; PG8_MMA(1, 1, At, B1); PG8_BAR;
        }
        if constexpr (!Epi::AFTER_DRAIN) { E(acc, cur, wr, wc, fr, fq); S.done(cur); }
        if (!has_next) break;
#pragma unroll
        for (int a = 0; a < 2; ++a)
#pragma unroll
            for (int b = 0; b < 2; ++b)
#pragma unroll
                for (int m = 0; m < 4; ++m)
#pragma unroll
                    for (int n = 0; n < 2; ++n) acc[a][b][m][n] = (f32x4){0.f, 0.f, 0.f, 0.f};
        cur = nxt; cA = nA; cB = nB; ++ui;
    }
    PG8_WAIT_V(0);
    if (wr == 0) PG8_BAR;
    PG8_BAR;
    if constexpr (Epi::AFTER_DRAIN) { E.fused(acc, cur, wr, wc, fr, fq, lds, wid, lane); S.done(cur); }
#undef PG8_SA
#undef PG8_SB
#undef PG8_STAGE
#undef PG8_LDA
#undef PG8_LDB
#undef PG8_MMA
#undef PG8_WAIT_V
#undef PG8_WAIT_L
#undef PG8_BAR
#undef PG8_SCHED
}
}

#endif

typedef unsigned short bf16;
#ifndef EMU
#define LAS __attribute__((address_space(3)))
#else
#define LAS
#endif
typedef short bf16x8 __attribute__((ext_vector_type(8)));
typedef float f32x4 __attribute__((ext_vector_type(4)));
typedef unsigned u32x4 __attribute__((ext_vector_type(4)));
typedef unsigned u32x2 __attribute__((ext_vector_type(2)));

#ifdef EMU
constexpr int BP = EMU_BP, LP = EMU_LP, BS = EMU_BS;
#else
constexpr int BP = 8, LP = 2048, BS = 128;
#endif
constexpr int D = 1024, LS = 4, TP = BP * LP, TS = BS * LS, T = TP + TS;
constexpr int INW = 7968, NZM = 4864, NZG = 3072, NZ = NZM + NZG, NSM = 32;
constexpr int NEXP = 16384;
constexpr int NTHREADS = 512, NWAVES = 8;
constexpr int LDS_BYTES = 160 * 1024;

constexpr size_t O_YP = 0, O_YS = O_YP + (size_t)TP * D, O_PC = O_YS + (size_t)TS * D, O_PN = O_PC + 2ull * BP * 4 * 128 * 128, O_PM = O_PN + 2ull * BP * 4 * 128,
    O_PG = O_PM + 2ull * BP * 4, O_PH = O_PG + 2ull * BP * 4 * 64 * 128, O_PV = O_PH + 2ull * BP * 8 * 64 * 64, O_SC = O_PV + 2ull * BP * 3 * 768,
    O_SN = O_SC + 2ull * BS * 4 * 128 * 128, O_SM = O_SN + 2ull * BS * 4 * 128, O_SG = O_SM + 2ull * BS * 4, O_SH = O_SG + 2ull * BS * 4 * 64 * 128,
    O_SV = O_SH + 2ull * BS * 8 * 64 * 64, O_END = O_SV + 2ull * BS * 3 * 768;

constexpr size_t al256(size_t x) { return (x + 255) & ~(size_t)255; }
constexpr size_t WS_CTL = 0, WS_CTL_BYTES = 65536;
constexpr size_t WB_WIN = 0, WB_WS = WB_WIN + (size_t)NZ * D * 2, WB_WBR = WB_WS + (size_t)NSM * D * 2, WB_WO = WB_WBR + 3ull * D * 512 * 2, WB_WQ = WB_WO + (size_t)D * D * 2,
    WB_KEYS = WB_WQ + 2048ull * D * 2, WB_BYTES = WB_KEYS + 16ull * 128 * 128 * 2;
constexpr size_t WS_WB = WS_CTL + WS_CTL_BYTES;
constexpr size_t WS_XB = WS_WB + 2 * WB_BYTES;
constexpr size_t WS_H = WS_XB + (size_t)T * D * 2;
constexpr size_t WS_ZS = WS_H + (size_t)T * D * 4;
constexpr size_t WS_BR = WS_ZS + (size_t)T * NSM * 4;
constexpr size_t WS_ZM = WS_BR + 3ull * T * 512 * 2;
constexpr size_t WS_ZG = WS_ZM + (size_t)T * NZM * 2;
constexpr size_t WS_END0 = WS_ZG + (size_t)T * NZG * 2;
constexpr size_t WS_Q = WS_ZM, WS_IDX = WS_Q + (size_t)T * 2048 * 2, WS_GT = WS_IDX + (size_t)T * 128 * 4;
#ifdef EMU
constexpr size_t WS_PU = WS_END0;
#else
constexpr size_t WS_PU = WS_GT + (size_t)T * 128 * 4;
#endif
constexpr size_t WS_PV = WS_PU + (size_t)NEXP * D, WS_PUS = WS_PV + (size_t)NEXP * D, WS_PVS = WS_PUS + (size_t)NEXP * 4, WS_PEND = WS_PVS + (size_t)NEXP * 4;
#ifdef EMU
constexpr size_t WS_END = WS_PEND;
#else
constexpr size_t WS_END = WS_END0;
static_assert(WS_PEND <= WS_ZG, "ZM alias overflow");
#endif
static_assert((size_t)T * D * 4 <= (size_t)T * NZG * 2, "Y alias overflow");

#ifndef EMU
__device__ __forceinline__ f32x4 mfma16(bf16x8 a, bf16x8 b, f32x4 c) { return __builtin_amdgcn_mfma_f32_16x16x32_bf16(a, b, c, 0, 0, 0); }
#endif
struct Args { const float* in[31]; float* out; unsigned char* ws; int ph_lo, ph_hi; };
#ifndef EMU
typedef const __attribute__((address_space(4))) Args* ArgP;
#else
typedef const Args* ArgP;
#endif
#define A (*Ap)
#ifdef STAGE_AMP
#define STG_INIT() LAS unsigned long long* stg_acc_ = (LAS unsigned long long*)(lds + LDS_BYTES - 256); if (tid == 0) { for (int i_ = 0; i_ < 16; ++i_) stg_acc_[i_] = 0; stg_acc_[15] = __builtin_amdgcn_s_memrealtime(); }
#define STG(k) do { if (tid == 0) { const unsigned long long n_ = __builtin_amdgcn_s_memrealtime(); stg_acc_[k] += n_ - stg_acc_[15]; stg_acc_[15] = n_; } } while (0)
#define STG_FINI(slot) do { if (tid == 0 && !sample && b == 0 && (slot) >= 0) { unsigned long long* g_ = (unsigned long long*)(A.ws + WS_CTL + 40960) + (slot) * 16; for (int i_ = 0; i_ < 15; ++i_) g_[i_] += stg_acc_[i_]; } } while (0)
#else
#define STG_INIT() do {} while (0)
#define STG(k) do {} while (0)
#define STG_FINI(slot) do {} while (0)
#endif
#ifndef EMU
#define OPQV(x) asm volatile("" : "+v"(x))
#define OPQS(x) asm volatile("" : "+s"(x))
#define LDS_BARRIER() asm volatile("s_waitcnt lgkmcnt(0)\n\ts_barrier" ::: "memory")
#else
#define OPQV(x) (void)(x)
#define OPQS(x) (void)(x)
#define LDS_BARRIER() __syncthreads()
#endif
#ifndef EMU
__device__ __forceinline__ int opaque_tid() { int t = threadIdx.x; asm volatile("" : "+v"(t)); return t; }
#else
static inline int opaque_tid() { return threadIdx.x; }
#endif

#ifndef EMU
__device__ __forceinline__ unsigned pk_fp8x4(float a, float b, float c, float d) { int w = __builtin_amdgcn_cvt_pk_fp8_f32(a, b, 0, false); w = __builtin_amdgcn_cvt_pk_fp8_f32(c, d, w, true); return (unsigned)w; }
__device__ __forceinline__ void unpk_fp8x4(unsigned w, float* f) { typedef float f32x2_ __attribute__((ext_vector_type(2)));
    const f32x2_ lo = __builtin_amdgcn_cvt_pk_f32_fp8((int)w, false), hi = __builtin_amdgcn_cvt_pk_f32_fp8((int)w, true); f[0] = lo.x; f[1] = lo.y; f[2] = hi.x; f[3] = hi.y; }
#endif
__device__ __forceinline__ bf16 f2bf(float f) { unsigned u = __float_as_uint(f); u += 0x7FFFu + ((u >> 16) & 1u); return (bf16)(u >> 16); }
__device__ __forceinline__ float bf2f(bf16 b) { return __uint_as_float(((unsigned)b) << 16); }
__device__ __forceinline__ unsigned pk2(float lo, float hi) { return (unsigned)f2bf(lo) | ((unsigned)f2bf(hi) << 16); }

__device__ __forceinline__ void tconv_tile(const float* __restrict__ src, int ldsrc, int k0, int c0, bf16* __restrict__ dst, int ldd, int n0, LAS float* tile) {
    const int t = opaque_tid(), i = t >> 3, jg = (t & 7) * 8;
    const float4 a = *(const float4*)(src + (size_t)(k0 + i) * ldsrc + c0 + jg), b = *(const float4*)(src + (size_t)(k0 + i) * ldsrc + c0 + jg + 4);
    LAS float* r = tile + i * 65 + jg;
    r[0] = a.x; r[1] = a.y; r[2] = a.z; r[3] = a.w; r[4] = b.x; r[5] = b.y; r[6] = b.z; r[7] = b.w;
    __syncthreads();
    const int j = t >> 3, ig = (t & 7) * 8;
    u32x4 w;
    w.x = pk2(tile[(ig + 0) * 65 + j], tile[(ig + 1) * 65 + j]); w.y = pk2(tile[(ig + 2) * 65 + j], tile[(ig + 3) * 65 + j]);
    w.z = pk2(tile[(ig + 4) * 65 + j], tile[(ig + 5) * 65 + j]); w.w = pk2(tile[(ig + 6) * 65 + j], tile[(ig + 7) * 65 + j]);
    *(u32x4*)(dst + (size_t)(n0 + j) * ldd + k0 + ig) = w;
    __syncthreads();
}
__device__ __forceinline__ int zcol_to_src(int zc) { return zc < 2048 ? zc : (zc < 3584 ? zc + 8 : (zc < 4864 ? zc + 24 : zc + 32)); }
__device__ __forceinline__ int scol_to_src(int sc) { return sc < 8 ? 2048 + sc : (sc < 24 ? 3592 + (sc - 8) : 4888 + (sc - 24)); }

__device__ __forceinline__ void convert_f32_bf16(const float* __restrict__ src, bf16* __restrict__ dst, size_t n, int gtid, int gthreads) {
    for (size_t i = (size_t)gtid * 8; i < n; i += (size_t)gthreads * 8) {
        const float4 a = *(const float4*)(src + i), b = *(const float4*)(src + i + 4);
        u32x4 w; w.x = pk2(a.x, a.y); w.y = pk2(a.z, a.w); w.z = pk2(b.x, b.y); w.w = pk2(b.z, b.w);
        *(u32x4*)(dst + i) = w;
    }
}

__device__ __forceinline__ void phase_convert(ArgP Ap, LAS unsigned char* lds) {
    LAS float* tile = (LAS float*)lds;
    const int G = gridDim.x, bid = blockIdx.x;
    constexpr int I_WIN = (NZ / 64) * (D / 64), I_WBR = 3 * (D / 64) * (512 / 64), I_WO = (D / 64) * (D / 64), I_WQ = (2048 / 64) * (D / 64), I_L = I_WIN + I_WBR + I_WO + I_WQ;
    for (int it = bid; it < 2 * I_L; it += G) {
        const int l = it / I_L; int r = it % I_L;
        unsigned char* wb = A.ws + WS_WB + (size_t)l * WB_BYTES;
        if (r < I_WIN) { const int nt = r / (D / 64), kt = r % (D / 64);
            tconv_tile(A.in[8] + (size_t)l * D * INW, INW, kt * 64, zcol_to_src(nt * 64), (bf16*)(wb + WB_WIN), D, nt * 64, tile); continue; }
        r -= I_WIN;
        if (r < I_WBR) { const int n = r / ((D / 64) * 8), rr = r % ((D / 64) * 8), nt = rr / 8, kt = rr % 8;
            tconv_tile(A.in[21] + ((size_t)l * 3 + n) * 512 * D, D, kt * 64, nt * 64, (bf16*)(wb + WB_WBR) + (size_t)n * D * 512, 512, nt * 64, tile); continue; }
        r -= I_WBR;
        if (r < I_WO) { const int nt = r / (D / 64), kt = r % (D / 64);
            tconv_tile(A.in[22] + (size_t)l * D * D, D, kt * 64, nt * 64, (bf16*)(wb + WB_WO), D, nt * 64, tile); continue; }
        r -= I_WO;
        { const int nt = r / (D / 64), kt = r % (D / 64);
            tconv_tile(A.in[25] + (size_t)l * D * 2048, 2048, kt * 64, nt * 64, (bf16*)(wb + WB_WQ), D, nt * 64, tile); }
    }
    const int gtid = bid * NTHREADS + opaque_tid(), gthreads = G * NTHREADS;
    for (int l = 0; l < 2; ++l) {
        unsigned char* wb = A.ws + WS_WB + (size_t)l * WB_BYTES;
        for (int e = gtid; e < NSM * D; e += gthreads) { const int n = e / D, k = e % D; ((bf16*)(wb + WB_WS))[e] = f2bf(A.in[8][(size_t)l * D * INW + (size_t)k * INW + scol_to_src(n)]); }
        convert_f32_bf16(A.in[26] + (size_t)l * 16 * 128 * 128, (bf16*)(wb + WB_KEYS), 16 * 128 * 128, gtid, gthreads);
    }
    convert_f32_bf16(A.in[0], (bf16*)(A.ws + WS_XB), (size_t)TP * D, gtid, gthreads);
    convert_f32_bf16(A.in[1], (bf16*)(A.ws + WS_XB) + (size_t)TP * D, (size_t)TS * D, gtid, gthreads);
}

#ifndef EMU
struct EpiZ {
    static constexpr bool PERM = true, AFTER_DRAIN = false;
    bf16* ZM; bf16* ZG;
    __device__ __forceinline__ void operator()(const pg8::f32x4 (&acc)[2][2][4][2], const pg8::Unit& u, int wr, int wc, int fr, int fq) const {
        const int row0 = u.pm * 256 + wr * 64 + fr; const bool gate = u.pn >= 19;
        bf16* base = gate ? ZG : ZM; const int ldc = gate ? NZG : NZM; const int col0 = (gate ? (u.pn - 19) : u.pn) * 256 + wc * 32 + 8 * fq;
#pragma unroll
        for (int ai = 0; ai < 2; ++ai)
#pragma unroll
            for (int m = 0; m < 4; ++m) { bf16* rowp = base + (size_t)(row0 + ai * 128 + m * 16) * ldc + col0;
#pragma unroll
                for (int bj = 0; bj < 2; ++bj) { f32x4 v0 = acc[ai][bj][m][0], v1 = acc[ai][bj][m][1];
                    if (gate) {
#pragma unroll
                        for (int j = 0; j < 4; ++j) { v0[j] = __builtin_amdgcn_rcpf(1.0f + __expf(-v0[j])); v1[j] = __builtin_amdgcn_rcpf(1.0f + __expf(-v1[j])); } }
                    u32x4 w; w.x = pg8::cvt_pk_bf16(v0[0], v0[1]); w.y = pg8::cvt_pk_bf16(v0[2], v0[3]); w.z = pg8::cvt_pk_bf16(v1[0], v1[1]); w.w = pg8::cvt_pk_bf16(v1[2], v1[3]);
                    *(u32x4*)(rowp + bj * 128) = w; } }
    }
};

#endif
__device__ __forceinline__ void small_gemm(const bf16* __restrict__ XB, const bf16* __restrict__ WsT, float* __restrict__ ZS) {
    const int tx = opaque_tid(), lane = tx & 63, wave = tx >> 6, gw = blockIdx.x * NWAVES + wave, NGW = gridDim.x * NWAVES, fr = lane & 15, fq = lane >> 4;
    for (int rg = gw; rg < T / 16; rg += NGW) {
        f32x4 a0 = {0.f, 0.f, 0.f, 0.f}, a1 = {0.f, 0.f, 0.f, 0.f};
        const bf16* ap = XB + (size_t)(rg * 16 + fr) * D + 8 * fq; const bf16* b0p = WsT + (size_t)fr * D + 8 * fq; const bf16* b1p = WsT + (size_t)(16 + fr) * D + 8 * fq;
#pragma unroll 4
        for (int k0 = 0; k0 < D; k0 += 32) {
            const bf16x8 a = *(const bf16x8*)(ap + k0), b0 = *(const bf16x8*)(b0p + k0), b1 = *(const bf16x8*)(b1p + k0);
            a0 = mfma16(a, b0, a0); a1 = mfma16(a, b1, a1);
        }
#pragma unroll
        for (int r = 0; r < 4; ++r) { float* o = ZS + (size_t)(rg * 16 + fq * 4 + r) * NSM + fr; o[0] = a0[r]; o[16] = a1[r]; }
    }
}

#ifndef EMU
__device__ __forceinline__ void phase_gemm1(ArgP Ap, LAS unsigned char* lds, int l) {
    unsigned char* wb = A.ws + WS_WB + (size_t)l * WB_BYTES;
    pg8::Gemm g{(const bf16*)(A.ws + WS_XB), (const bf16*)(wb + WB_WIN), T, NZ, D};
    pg8::StaticOrder S; S.init(T, NZ, gridDim.x, blockIdx.x);
    EpiZ E{(bf16*)(A.ws + WS_ZM), (bf16*)(A.ws + WS_ZG)};
    pg8::gemm_phase<EpiZ, pg8::StaticOrder>(lds, g, S, E);
    small_gemm((const bf16*)(A.ws + WS_XB), (const bf16*)(wb + WB_WS), (float*)(A.ws + WS_ZS));
}
#endif

#ifndef EMU
#define XB_TMO      128
#define XB_XCNT(j)  (256  + 64 * (j))
#define XB_XSUB(j)  (1280 + 64 * (j))
#define XB_XGEN(j)  (2304 + 64 * (j))
#define XB_TOP      3328
#define XB_TOPGEN   3392
#define XCD_BAR_WORDS 3456
#define XB_SPIN_CAP (1u << 18)

__device__ __forceinline__ unsigned xb_ld(unsigned* p)              { return __hip_atomic_load(p, __ATOMIC_RELAXED, __HIP_MEMORY_SCOPE_AGENT); }
__device__ __forceinline__ unsigned xb_add(unsigned* p, unsigned v) { return __hip_atomic_fetch_add(p, v, __ATOMIC_RELAXED, __HIP_MEMORY_SCOPE_AGENT); }
__device__ __forceinline__ unsigned xb_xcc_id() { return (unsigned)__builtin_amdgcn_s_getreg((3 << 11) | 20) & 0xFu; }
#define XB_SPIN(cond, bar) do { unsigned _sp = 0; while (cond) { __builtin_amdgcn_s_sleep(1); \
    if ((++_sp & 255u) == 0u) { if (xb_ld(&(bar)[XB_TMO])) break; if (_sp > XB_SPIN_CAP) { atomicAdd(&(bar)[XB_TMO], 1u); break; } } } } while (0)

struct XcdBarrier {
    unsigned* bar; unsigned x;
    volatile LAS unsigned* st;
};

__device__ __forceinline__ XcdBarrier xcd_barrier_post(unsigned* bar, volatile LAS unsigned* st) {
    XcdBarrier b; b.bar = bar; b.x = xb_xcc_id(); b.st = st;
    if (threadIdx.x == 0) (void)xb_add(&bar[XB_XCNT(b.x)], 1u);
    return b;
}
__device__ __forceinline__ void xcd_barrier_complete(unsigned* bar, unsigned x, unsigned& nloc, unsigned& nx) {
    const unsigned G = gridDim.x * gridDim.y * gridDim.z;
    unsigned sum, cnt, mine, sp = 0u;
    for (;;) {
        sum = 0u; cnt = 0u; mine = 0u;
#pragma unroll
        for (unsigned j = 0; j < 16; ++j) { const unsigned c = xb_ld(&bar[XB_XCNT(j)]); sum += c; cnt += (c > 0u) ? 1u : 0u; mine = (j == x) ? c : mine; }
        if (sum == G) break;
        __builtin_amdgcn_s_sleep(1);
        if ((++sp & 255u) == 0u) { if (xb_ld(&bar[XB_TMO])) break; if (sp > XB_SPIN_CAP) { atomicAdd(&bar[XB_TMO], 1u); break; } }
    }
    nloc = mine > 0u ? mine : 1u; nx = cnt > 0u ? cnt : 1u;
}

__device__ __forceinline__ void xcd_barrier(const XcdBarrier& b) {
    asm volatile("s_waitcnt vmcnt(0)" ::: "memory");
    __syncthreads();
    if (threadIdx.x == 0) {
        unsigned* bar = b.bar;
        __builtin_amdgcn_s_waitcnt(0);
        unsigned nloc = b.st[0], nx = b.st[1];
        if (nloc == 0u) { xcd_barrier_complete(bar, b.x, nloc, nx); b.st[0] = nloc; b.st[1] = nx; }
        const unsigned old = xb_add(&bar[XB_XSUB(b.x)], 1u);
        const unsigned gen = old / nloc;
        if (old + 1u == (gen + 1u) * nloc) {
            __builtin_amdgcn_fence(__ATOMIC_RELEASE, "agent");
            asm volatile("s_waitcnt vmcnt(0)" ::: "memory");
            const unsigned og = xb_add(&bar[XB_TOP], 1u);
            const unsigned tg = og / nx;
            if (og + 1u == (tg + 1u) * nx) xb_add(&bar[XB_TOPGEN], 1u);
            else XB_SPIN(xb_ld(&bar[XB_TOPGEN]) == tg, bar);
            __builtin_amdgcn_fence(__ATOMIC_ACQUIRE, "agent");
            xb_add(&bar[XB_XGEN(b.x)], 1u);
            asm volatile("s_waitcnt vmcnt(0)" ::: "memory");
        } else {
            XB_SPIN(xb_ld(&bar[XB_XGEN(b.x)]) == gen, bar);
            __builtin_amdgcn_fence(__ATOMIC_ACQUIRE, "agent");
            asm volatile("s_waitcnt vmcnt(0)" ::: "memory");
        }
    }
    __syncthreads();
}

#endif

typedef short s16x4 __attribute__((ext_vector_type(4)));
#ifndef EMU
__device__ __forceinline__ s16x4 tr4(const LAS bf16* p) { return __builtin_amdgcn_ds_read_tr16_b64_v4i16((LAS s16x4*)p); }
#endif
#define FROW(M, ld, rc0, k0) (*(const LAS bf16x8*)((M) + ((rc0) + fr) * (ld) + (k0) + 8 * fq))
__device__ __forceinline__ bf16x8 ftr_(int fr, int fq, const LAS bf16* M, int ld, int k0, int rc0) {
    const LAS bf16* p = M + (k0 + 8 * fq + (fr >> 2)) * ld + rc0 + 4 * (fr & 3);
    const s16x4 lo = tr4(p), hi = tr4(p + 4 * ld);
    return (bf16x8){lo[0], lo[1], lo[2], lo[3], hi[0], hi[1], hi[2], hi[3]};
}
#define FTR(M, ld, k0, rc0) ftr_(fr, fq, M, ld, k0, rc0)
#define MMA_RR(acc, Am, lda, r0, Bm, ldb, c0, K) do { _Pragma("unroll") for (int k0_ = 0; k0_ < (K); k0_ += 32) acc = mfma16(FROW(Am, lda, r0, k0_), FROW(Bm, ldb, c0, k0_), acc); } while (0)
#define MMA_RT(acc, Am, lda, r0, Bk, ldb, c0, K) do { _Pragma("unroll") for (int k0_ = 0; k0_ < (K); k0_ += 32) acc = mfma16(FROW(Am, lda, r0, k0_), FTR(Bk, ldb, k0_, c0), acc); } while (0)
#define MMA_TT(acc, Ak, lda, m0, Bk, ldb, c0, K) do { _Pragma("unroll") for (int k0_ = 0; k0_ < (K); k0_ += 32) acc = mfma16(FTR(Ak, lda, k0_, m0), FTR(Bk, ldb, k0_, c0), acc); } while (0)
#define MMA_RC(acc, Am, lda, r0, cfrag, K) do { _Pragma("unroll") for (int k0_ = 0; k0_ < (K); k0_ += 32) acc = mfma16(FROW(Am, lda, r0, k0_), cfrag, acc); } while (0)
#define MMA_CT(acc, cfrag, Bk, ldb, c0, K) do { _Pragma("unroll") for (int k0_ = 0; k0_ < (K); k0_ += 32) acc = mfma16(cfrag, FTR(Bk, ldb, k0_, c0), acc); } while (0)
__device__ __forceinline__ u32x2 pack4(float a, float b, float c, float d) { u32x2 w; w.x = pk2(a, b); w.y = pk2(c, d); return w; }
__device__ __forceinline__ float scan_sum64(float v, int lane) {
#pragma unroll
    for (int d = 1; d < 64; d <<= 1) { const float t = __shfl_up(v, d); if (lane >= d) v += t; }
    return v;
}
__device__ __forceinline__ float scan_max64(float v, int lane) {
#pragma unroll
    for (int d = 1; d < 64; d <<= 1) { const float t = __shfl_up(v, d); if (lane >= d) v = fmaxf(v, t); }
    return v;
}
__device__ __forceinline__ float wave_max64(float v) {
#pragma unroll
    for (int m = 1; m < 64; m <<= 1) v = fmaxf(v, __shfl_xor(v, m));
    return v;
}
__device__ __forceinline__ float logsig(float x) { return fminf(x, 0.f) - log1pf(__expf(-fabsf(x))); }
__device__ __forceinline__ float softplusf(float x) { return fmaxf(x, 0.f) + log1pf(__expf(-fabsf(x))); }
__device__ __forceinline__ float sigmoidf(float x) { return 1.0f / (1.0f + __expf(-x)); }
__device__ __forceinline__ float siluf(float x) { return x / (1.0f + __expf(-x)); }
constexpr float NEG_INF = -__builtin_huge_valf();
constexpr float EPS_ = 1e-5f;
__device__ __forceinline__ void unpack8(const u32x4 w, float (&f)[8]) {
    f[0] = __uint_as_float(w.x << 16); f[1] = __uint_as_float(w.x & 0xffff0000u); f[2] = __uint_as_float(w.y << 16); f[3] = __uint_as_float(w.y & 0xffff0000u);
    f[4] = __uint_as_float(w.z << 16); f[5] = __uint_as_float(w.z & 0xffff0000u); f[6] = __uint_as_float(w.w << 16); f[7] = __uint_as_float(w.w & 0xffff0000u);
}
__device__ __forceinline__ u32x4 pack8(const float (&f)[8]) { u32x4 w; w.x = pk2(f[0], f[1]); w.y = pk2(f[2], f[3]); w.z = pk2(f[4], f[5]); w.w = pk2(f[6], f[7]); return w; }

__device__ __forceinline__ void mlstm_item(ArgP Ap, LAS unsigned char* lds, int l, int b, int h, bool sample) {
    int tid_o = threadIdx.x; OPQV(tid_o);
    const int tid = tid_o, lane = tid & 63, wave = tid >> 6, fr = lane & 15, fq = lane >> 4;
    LAS bf16* Qs = (LAS bf16*)(lds); LAS bf16* Ks = (LAS bf16*)(lds + 17408); LAS bf16* Kw = (LAS bf16*)(lds + 34816); LAS bf16* Vs = (LAS bf16*)(lds + 52224);
    LAS bf16* Ss = (LAS bf16*)(lds + 69632); LAS bf16* CbT = (LAS bf16*)(lds + 78848); LAS float* Hs = (LAS float*)(lds + 120320); LAS float* MN = (LAS float*)(lds + 117760); LAS float* gb = (LAS float*)(lds + 118272);
    LAS float* b_ = gb; LAS float* mt_ = gb + 64; LAS float* u_ = gb + 128; LAS float* ein_ = gb + 192; LAS float* wg_ = gb + 256; LAS float* den_ = gb + 320; LAS float* sc_ = gb + 384;
    const int L = sample ? LS : LP, tok0 = sample ? TP + b * LS : b * LP, NB = sample ? BS : BP;
    const bf16* ZM = (const bf16*)(A.ws + WS_ZM); const float* ZS = (const float*)(A.ws + WS_ZS); bf16* BR0 = (bf16*)(A.ws + WS_BR);
    const float ib = A.in[9][l * 4 + h], fb = A.in[10][l * 4 + h];
    f32x4 accC[9];
#pragma unroll
    for (int vi = 0; vi < 9; ++vi) accC[vi] = (f32x4){0.f, 0.f, 0.f, 0.f};
    float m_run = 0.f;
    if (sample) {
        const float* C0 = A.in[2] + ((size_t)(l * BS + b) * 4 + h) * 16384; const float* n0 = A.in[3] + ((size_t)(l * BS + b) * 4 + h) * 128;
        const float* cp = C0 + (4 * fq) * 128 + 16 * wave + fr;
#pragma unroll
        for (int vi = 0; vi < 8; ++vi) {
#pragma unroll
            for (int r = 0; r < 4; ++r) accC[vi][r] = cp[r * 128];
            cp += 2048; OPQV(cp); }
        if (fq == 0) accC[8][0] = n0[16 * wave + fr];
        m_run = A.in[4][(l * BS + b) * 4 + h];
    }
#pragma unroll
    for (int vi = 0; vi < 9; ++vi) *(LAS u32x2*)(CbT + (16 * wave + fr) * 152 + 16 * vi + 4 * fq) = pack4(accC[vi][0], accC[vi][1], accC[vi][2], accC[vi][3]);
    if (tid < 128) MN[tid] = A.in[11][l * 512 + h * 128 + tid];
    u32x4 pq[2], pk[2], pv[2], pm[2]; float pli = NEG_INF, plf = 0.f;
#define MLSTM_PREFETCH_MO(T0N) do { const int nvn_ = (L - (T0N)) < 64 ? (L - (T0N)) : 64; const int t = tid >> 3, part = tid & 7; pm[0] = (u32x4){0u, 0u, 0u, 0u}; pm[1] = pm[0]; \
        if (t < nvn_) { const bf16* mo = ZM + (size_t)(tok0 + (T0N) + t) * NZM + 1536 + h * 128 + 16 * part; pm[0] = *(const u32x4*)mo; pm[1] = *(const u32x4*)(mo + 8); } } while (0)
#define MLSTM_PREFETCH(T0N) do { const int nvn_ = (L - (T0N)) < 64 ? (L - (T0N)) : 64; \
        _Pragma("unroll") for (int i = 0; i < 2; ++i) { const int c = tid + 512 * i, t = c >> 4, cc = (c & 15) * 8; pq[i] = (u32x4){0u, 0u, 0u, 0u}; pk[i] = pq[i]; pv[i] = pq[i]; \
            if (t < nvn_) { const bf16* zp = ZM + (size_t)(tok0 + (T0N) + t) * NZM + h * 128 + cc; pq[i] = *(const u32x4*)zp; pk[i] = *(const u32x4*)(zp + 512); pv[i] = *(const u32x4*)(zp + 1024); } } \
        if (wave == 0) { pli = NEG_INF; plf = 0.f; if (lane < nvn_) { const size_t tok = tok0 + (T0N) + lane; pli = ZS[tok * NSM + h]; plf = ZS[tok * NSM + 4 + h]; } } } while (0)
    MLSTM_PREFETCH(0); MLSTM_PREFETCH_MO(0);
    __syncthreads();
    STG_INIT();
    for (int t0 = 0; t0 < L; t0 += 64) {
        const int nv = (L - t0) < 64 ? (L - t0) : 64, nrt = (nv + 15) >> 4;
        if (wave == 0) {
            const float li = (lane < nv) ? pli + ib : NEG_INF, lf = (lane < nv) ? logsig(plf + fb) : 0.f;
            const float bb = scan_sum64(lf, lane), a = bb + m_run, u = li - bb, M = scan_max64(u, lane), mt = fmaxf(a, bb + M);
            const float blast = __shfl(bb, 63), g = blast + u, gmax = wave_max64(g), mnew = fmaxf(blast + m_run, gmax);
            b_[lane] = bb; mt_[lane] = mt; u_[lane] = u; ein_[lane] = __expf(a - mt); wg_[lane] = __expf(g - mnew);
            if (lane == 0) sc_[1] = __expf(blast + m_run - mnew);
            m_run = mnew;
        }
        LDS_BARRIER(); STG(0);
#pragma unroll
        for (int i = 0; i < 2; ++i) { const int c = tid + 512 * i, t = c >> 4, cc = (c & 15) * 8;
            *(LAS u32x4*)(Qs + t * 136 + cc) = pq[i]; *(LAS u32x4*)(Ks + t * 136 + cc) = pk[i]; *(LAS u32x4*)(Vs + t * 136 + cc) = pv[i];
            float f[8]; unpack8(pk[i], f); const float g = wg_[t];
#pragma unroll
            for (int j = 0; j < 8; ++j) f[j] *= g;
            *(LAS u32x4*)(Kw + t * 136 + cc) = pack8(f); }
        MLSTM_PREFETCH(t0 + 64);
        LDS_BARRIER(); STG(1);
#pragma unroll
        for (int j = 0; j < 2; ++j) { const int idx = wave + 8 * j, ti = idx >> 2, si = idx & 3;
            f32x4 acc = {0.f, 0.f, 0.f, 0.f};
            if (ti >= nrt) continue;
            if (si <= ti) MMA_RR(acc, Ks, 136, 16 * si, Qs, 136, 16 * ti, 128);
            const int t = 16 * ti + fr; const float bt = b_[t] - mt_[t]; float v[4];
#pragma unroll
            for (int r = 0; r < 4; ++r) { const int s = 16 * si + 4 * fq + r; v[r] = (s <= t) ? acc[r] * __expf(bt + u_[s]) : 0.f; }
            *(LAS u32x2*)(Ss + t * 72 + 16 * si + 4 * fq) = pack4(v[0], v[1], v[2], v[3]); }
        LDS_BARRIER(); STG(2);
        if (wave < nrt) { const int ti = wave; f32x4 acc = {0.f, 0.f, 0.f, 0.f};
            MMA_RT(acc, Qs, 136, 16 * ti, CbT, 152, 128, 128);
#pragma unroll
            for (int r = 0; r < 4; ++r) acc[r] *= ein_[16 * ti + 4 * fq + r];
            { int fr_ = fr; OPQV(fr_); const short o1 = (fr_ == 0) ? (short)0x3F80 : (short)0; const bf16x8 ones = {o1, o1, o1, o1, o1, o1, o1, o1};
              MMA_RC(acc, Ss, 72, 16 * ti, ones, 64); }
            if (fr == 0) {
#pragma unroll
                for (int r = 0; r < 4; ++r) den_[16 * ti + 4 * fq + r] = acc[r]; } }
        LDS_BARRIER(); STG(3);
#pragma unroll
        for (int j = 0; j < 4; ++j) { const int idx = wave + 8 * j, ti = idx >> 3, vi = idx & 7; f32x4 accn = {0.f, 0.f, 0.f, 0.f};
            if (ti >= nrt) continue;
            MMA_RT(accn, Qs, 136, 16 * ti, CbT, 152, 16 * vi, 128);
#pragma unroll
            for (int r = 0; r < 4; ++r) accn[r] *= ein_[16 * ti + 4 * fq + r];
            MMA_RT(accn, Ss, 72, 16 * ti, Vs, 136, 16 * vi, 64);
#pragma unroll
            for (int r = 0; r < 4; ++r) { const int t = 16 * ti + 4 * fq + r; const float dn = den_[t] * 0.08838834764831845f;
                Hs[t * 132 + 16 * vi + fr] = accn[r] * 0.08838834764831845f / fmaxf(fabsf(dn), __expf(-mt_[t])); }
            asm volatile("" ::: "memory"); }
        LDS_BARRIER(); STG(4);
        { const int t = tid >> 3, part = tid & 7; float x[16]; float s1 = 0.f;
#pragma unroll
            for (int i = 0; i < 16; ++i) { x[i] = Hs[t * 132 + 16 * part + i]; s1 += x[i]; }
            s1 += __shfl_xor(s1, 1); s1 += __shfl_xor(s1, 2); s1 += __shfl_xor(s1, 4);
            const float mu = s1 * (1.0f / 128.0f); float s2 = 0.f;
#pragma unroll
            for (int i = 0; i < 16; ++i) { x[i] -= mu; s2 += x[i] * x[i]; }
            s2 += __shfl_xor(s2, 1); s2 += __shfl_xor(s2, 2); s2 += __shfl_xor(s2, 4);
            const float rstd = 1.0f / sqrtf(s2 * (1.0f / 128.0f) + EPS_);
            if (t < nv) { const size_t tok = tok0 + t0 + t;
                float o0[8], o1[8]; unpack8(pm[0], o0); unpack8(pm[1], o1); float y0[8], y1[8];
#pragma unroll
                for (int i = 0; i < 8; ++i) { y0[i] = x[i] * rstd * MN[16 * part + i] * sigmoidf(o0[i]); y1[i] = x[8 + i] * rstd * MN[16 * part + 8 + i] * sigmoidf(o1[i]); }
                bf16* o = BR0 + tok * 512 + h * 128 + 16 * part; *(u32x4*)o = pack8(y0); *(u32x4*)(o + 8) = pack8(y1); } }
        MLSTM_PREFETCH_MO(t0 + 64);
        { const float ec = sc_[1];
#pragma unroll
            for (int vi = 0; vi < 9; ++vi) {
#pragma unroll
                for (int r = 0; r < 4; ++r) accC[vi][r] *= ec;
                if (vi < 8) MMA_TT(accC[vi], Vs, 136, 16 * vi, Kw, 136, 16 * wave, 64);
                else { int fr_ = fr; OPQV(fr_); const short o1 = (fr_ == 0) ? (short)0x3F80 : (short)0; const bf16x8 ones = {o1, o1, o1, o1, o1, o1, o1, o1}; MMA_CT(accC[vi], ones, Kw, 136, 16 * wave, 64); }
                *(LAS u32x2*)(CbT + (16 * wave + fr) * 152 + 16 * vi + 4 * fq) = pack4(accC[vi][0], accC[vi][1], accC[vi][2], accC[vi][3]);
                asm volatile("" ::: "memory"); } }
        LDS_BARRIER(); STG(5);
    }
#undef MLSTM_PREFETCH
#undef MLSTM_PREFETCH_MO
    float* Co = A.out + (sample ? O_SC : O_PC) + ((size_t)(l * NB + b) * 4 + h) * 16384; float* no = A.out + (sample ? O_SN : O_PN) + ((size_t)(l * NB + b) * 4 + h) * 128;
    { int fq_ = fq, cw_ = 16 * wave + fr; OPQV(fq_); OPQV(cw_);
      float* cp = Co + (4 * fq_) * 128 + cw_;
#pragma unroll
      for (int vi = 0; vi < 8; ++vi) {
#pragma unroll
        for (int r = 0; r < 4; ++r) cp[r * 128] = accC[vi][r];
        cp += 2048; OPQV(cp); }
      if (fq_ == 0) no[cw_] = accC[8][0]; }
    STG_FINI(h == 0 ? 0 : -1);
    if (tid == 0) A.out[(sample ? O_SM : O_PM) + (size_t)(l * NB + b) * 4 + h] = m_run;
    __syncthreads();
}

__device__ __forceinline__ void gla_item(ArgP Ap, LAS unsigned char* lds, int l, int b, int h, bool sample) {
    int tid_o = threadIdx.x; OPQV(tid_o);
    const int tid = tid_o, lane = tid & 63, wave = tid >> 6, fr = lane & 15, fq = lane >> 4;
    LAS bf16* QE = (LAS bf16*)(lds); LAS bf16* KE = (LAS bf16*)(lds + 9216); LAS bf16* KLs = (LAS bf16*)(lds + 18432); LAS bf16* Vs = (LAS bf16*)(lds + 27648);
    LAS bf16* ATT = (LAS bf16*)(lds + 45056); LAS bf16* STbT = (LAS bf16*)(lds + 54272); LAS float* Os = (LAS float*)(lds + 71680); LAS float* LAM = (LAS float*)(lds + 105472);
    LAS float* GA = (LAS float*)(lds + 122112); LAS float* GUP = (LAS float*)(lds + 126208); LAS float* GBI = (LAS float*)(lds + 130304); LAS float* GN = (LAS float*)(lds + 130560);
    const int L = sample ? LS : LP, tok0 = sample ? TP + b * LS : b * LP, NB = sample ? BS : BP;
    const bf16* ZM = (const bf16*)(A.ws + WS_ZM); const float* ZS = (const float*)(A.ws + WS_ZS); bf16* BR1 = (bf16*)(A.ws + WS_BR) + (size_t)T * 512;
    f32x4 accS[4];
#pragma unroll
    for (int ki = 0; ki < 4; ++ki) accS[ki] = (f32x4){0.f, 0.f, 0.f, 0.f};
    if (sample) { const float* S0 = A.in[5] + ((size_t)(l * BS + b) * 4 + h) * 8192;
        const float* sp = S0 + fr * 128 + 16 * wave + 4 * fq;
#pragma unroll
        for (int ki = 0; ki < 4; ++ki) {
#pragma unroll
            for (int r = 0; r < 4; ++r) accS[ki][r] = sp[r];
            sp += 2048; OPQV(sp); } }
#pragma unroll
    for (int ki = 0; ki < 4; ++ki) *(LAS u32x2*)(STbT + (16 * ki + fr) * 136 + 16 * wave + 4 * fq) = pack4(accS[ki][0], accS[ki][1], accS[ki][2], accS[ki][3]);
    for (int e = tid; e < 1024; e += NTHREADS) GUP[e] = A.in[12][(size_t)l * 16 * 256 + (e >> 6) * 256 + h * 64 + (e & 63)];
    if (tid < 64) GBI[tid] = A.in[13][l * 256 + h * 64 + tid];
    if (tid < 128) GN[tid] = A.in[14][l * 512 + h * 128 + tid];
    u32x4 pq, pk, pv[2], pg[2], pgn[2]; float pga[2];
#define GLA_PREFETCH(T0N) do { const int nvn_ = (L - (T0N)) < 64 ? (L - (T0N)) : 64; \
        { const int t = tid >> 3, cc = (tid & 7) * 8; pq = (u32x4){0u, 0u, 0u, 0u}; pk = pq; pgn[0] = pq; pgn[1] = pq; \
            if (t < nvn_) { const bf16* zr = ZM + (size_t)(tok0 + (T0N) + t) * NZM + 2048 + h * 64 + cc; pq = *(const u32x4*)zr; pk = *(const u32x4*)(zr + 256); \
                const bf16* gr = ZM + (size_t)(tok0 + (T0N) + t) * NZM + 3072 + h * 128 + 16 * (tid & 7); pgn[0] = *(const u32x4*)gr; pgn[1] = *(const u32x4*)(gr + 8); } } \
        _Pragma("unroll") for (int i = 0; i < 2; ++i) { const int c = tid + 512 * i, t = c >> 4, cc = (c & 15) * 8; pv[i] = (u32x4){0u, 0u, 0u, 0u}; \
            if (t < nvn_) pv[i] = *(const u32x4*)(ZM + (size_t)(tok0 + (T0N) + t) * NZM + 2560 + h * 128 + cc); \
            const int e = tid + 512 * i, te = e >> 4; pga[i] = (te < nvn_) ? ZS[(size_t)(tok0 + (T0N) + te) * NSM + 8 + (e & 15)] : 0.f; } } while (0)
    GLA_PREFETCH(0);
    __syncthreads();
    for (int t0 = 0; t0 < L; t0 += 64) {
        const int nv = (L - t0) < 64 ? (L - t0) : 64, nrt = (nv + 15) >> 4;
        pg[0] = pgn[0]; pg[1] = pgn[1];
        GA[tid] = pga[0]; GA[tid + 512] = pga[1];
        LDS_BARRIER();
#pragma unroll
        for (int i = 0; i < 8; ++i) { const int e = tid + 512 * i, t = e >> 6, k = e & 63; float x = GBI[k];
#pragma unroll
            for (int r = 0; r < 16; ++r) x += GA[t * 16 + r] * GUP[r * 64 + k];
            LAM[t * 65 + k] = (t < nv) ? logsig(x) * (1.0f / 16.0f) : 0.f; }
        LDS_BARRIER();
#pragma unroll
        for (int c = 0; c < 8; ++c) { const int k = 8 * wave + c; const float v = scan_sum64(LAM[lane * 65 + k], lane); LAM[lane * 65 + k] = v; }
        LDS_BARRIER();
        { const int t = tid >> 3, cc = (tid & 7) * 8; float q[8], k[8], qe[8], ke[8], kl[8]; unpack8(pq, q); unpack8(pk, k);
#pragma unroll
            for (int i = 0; i < 8; ++i) { const float lm = LAM[t * 65 + cc + i], ll = LAM[63 * 65 + cc + i]; qe[i] = q[i] * __expf(lm); ke[i] = k[i] * __expf(-lm); kl[i] = k[i] * __expf(ll - lm); }
            *(LAS u32x4*)(QE + t * 72 + cc) = pack8(qe); *(LAS u32x4*)(KE + t * 72 + cc) = pack8(ke); *(LAS u32x4*)(KLs + t * 72 + cc) = pack8(kl); }
#pragma unroll
        for (int i = 0; i < 2; ++i) { const int c = tid + 512 * i, t = c >> 4, cc = (c & 15) * 8; *(LAS u32x4*)(Vs + t * 136 + cc) = pv[i]; }
        GLA_PREFETCH(t0 + 64);
        LDS_BARRIER();
#pragma unroll
        for (int j = 0; j < 2; ++j) { const int idx = wave + 8 * j, ti = idx >> 2, si = idx & 3; f32x4 acc = {0.f, 0.f, 0.f, 0.f};
            if (ti >= nrt) continue;
            if (si <= ti) MMA_RR(acc, KE, 72, 16 * si, QE, 72, 16 * ti, 64);
            const int t = 16 * ti + fr; float v[4];
#pragma unroll
            for (int r = 0; r < 4; ++r) { const int s = 16 * si + 4 * fq + r; v[r] = (s <= t) ? acc[r] : 0.f; }
            *(LAS u32x2*)(ATT + t * 72 + 16 * si + 4 * fq) = pack4(v[0], v[1], v[2], v[3]); }
        LDS_BARRIER();
#pragma unroll
        for (int j = 0; j < 4; ++j) { const int idx = wave + 8 * j, ti = idx >> 3, vi = idx & 7; f32x4 acc = {0.f, 0.f, 0.f, 0.f};
            if (ti >= nrt) continue;
            MMA_RT(acc, QE, 72, 16 * ti, STbT, 136, 16 * vi, 64); MMA_RT(acc, ATT, 72, 16 * ti, Vs, 136, 16 * vi, 64);
#pragma unroll
            for (int r = 0; r < 4; ++r) Os[(16 * ti + 4 * fq + r) * 132 + 16 * vi + fr] = acc[r] * 0.125f;
            asm volatile("" ::: "memory"); }
        LDS_BARRIER();
        { const int t = tid >> 3, part = tid & 7; float x[16]; float s2 = 0.f;
#pragma unroll
            for (int i = 0; i < 16; ++i) { x[i] = Os[t * 132 + 16 * part + i]; s2 += x[i] * x[i]; }
            s2 += __shfl_xor(s2, 1); s2 += __shfl_xor(s2, 2); s2 += __shfl_xor(s2, 4);
            const float rstd = 1.0f / sqrtf(s2 * (1.0f / 128.0f) + EPS_);
            if (t < nv) { const size_t tok = tok0 + t0 + t;
                float g0[8], g1[8]; unpack8(pg[0], g0); unpack8(pg[1], g1); float y0[8], y1[8];
#pragma unroll
                for (int i = 0; i < 8; ++i) { y0[i] = x[i] * rstd * GN[16 * part + i] * siluf(g0[i]); y1[i] = x[8 + i] * rstd * GN[16 * part + 8 + i] * siluf(g1[i]); }
                bf16* o = BR1 + tok * 512 + h * 128 + 16 * part; *(u32x4*)o = pack8(y0); *(u32x4*)(o + 8) = pack8(y1); } }
#pragma unroll
        for (int ki = 0; ki < 4; ++ki) { const float dec = __expf(LAM[63 * 65 + 16 * ki + fr]);
#pragma unroll
            for (int r = 0; r < 4; ++r) accS[ki][r] *= dec;
            MMA_TT(accS[ki], Vs, 136, 16 * wave, KLs, 72, 16 * ki, 64);
            *(LAS u32x2*)(STbT + (16 * ki + fr) * 136 + 16 * wave + 4 * fq) = pack4(accS[ki][0], accS[ki][1], accS[ki][2], accS[ki][3]);
            asm volatile("" ::: "memory"); }
        LDS_BARRIER();
    }
#undef GLA_PREFETCH
    float* So = A.out + (sample ? O_SG : O_PG) + ((size_t)(l * NB + b) * 4 + h) * 8192;
    { int o_ = fr * 128 + 16 * wave + 4 * fq; OPQV(o_); float* sp = So + o_;
#pragma unroll
      for (int ki = 0; ki < 4; ++ki) {
#pragma unroll
        for (int r = 0; r < 4; ++r) sp[r] = accS[ki][r];
        sp += 2048; OPQV(sp); } }
    __syncthreads();
}

__device__ __forceinline__ int ssd_chmap(int hd, int c) { const int g = hd >> 2; return c < 64 ? hd * 64 + c : (c < 128 ? 512 + g * 64 + (c - 64) : 640 + g * 64 + (c - 128)); }
__device__ __forceinline__ void ssd_item(ArgP Ap, LAS unsigned char* lds, int l, int b, int hd, bool sample) {
    int tid_o = threadIdx.x; OPQV(tid_o);
    const int tid = tid_o, lane = tid & 63, wave = tid >> 6, fr = lane & 15, fq = lane >> 4;
    LAS bf16* RAW = (LAS bf16*)(lds); LAS bf16* Ys = (LAS bf16*)(lds); LAS bf16* W = (LAS bf16*)(lds + 9216); LAS bf16* Bw = (LAS bf16*)(lds + 18432);
    LAS bf16* Xs = (LAS bf16*)(lds + 27648); LAS bf16* Cs = (LAS bf16*)(lds + 36864); LAS bf16* Bs = (LAS bf16*)(lds + 46080); LAS bf16* HbT = (LAS bf16*)(lds + 55296);
    LAS bf16* HIST = (LAS bf16*)(lds + 64512); LAS float* DT = (LAS float*)(lds + 65792); LAS float* LM = (LAS float*)(lds + 66048);
    LAS float* CW = (LAS float*)(lds + 66304); LAS float* CBI = CW + 4 * 192;
    const int L = sample ? LS : LP, tok0 = sample ? TP + b * LS : b * LP, NB = sample ? BS : BP;
    const bf16* ZM = (const bf16*)(A.ws + WS_ZM); const float* ZS = (const float*)(A.ws + WS_ZS); bf16* BR2 = (bf16*)(A.ws + WS_BR) + (size_t)T * 1024;
    const float Dh = A.in[19][l * 8 + hd], dtb = A.in[17][l * 8 + hd], Ah = -__expf(A.in[18][l * 8 + hd]);
    f32x4 accH[2];
#pragma unroll
    for (int j = 0; j < 2; ++j) { const int idx = wave + 8 * j, pi = idx >> 2, ni = idx & 3; accH[j] = (f32x4){0.f, 0.f, 0.f, 0.f};
        if (sample) { const float* h0 = A.in[6] + ((size_t)(l * BS + b) * 8 + hd) * 4096;
            const float* hp = h0 + (16 * pi + 4 * fq) * 64 + 16 * ni + fr; OPQV(hp);
#pragma unroll
            for (int r = 0; r < 4; ++r) accH[j][r] = hp[r * 64]; }
        *(LAS u32x2*)(HbT + (16 * ni + fr) * 72 + 16 * pi + 4 * fq) = pack4(accH[j][0], accH[j][1], accH[j][2], accH[j][3]); }
    for (int e = tid; e < 5 * 192; e += NTHREADS) { const int j = e / 192, c = e % 192, ch = ssd_chmap(hd, c); CW[e] = (j < 4) ? A.in[15][(size_t)l * 4 * 768 + j * 768 + ch] : A.in[16][l * 768 + ch]; }
    for (int e = tid; e < 3 * 200; e += NTHREADS) { const int r = e / 200, c = e % 200; float v = 0.f;
        if (sample && c < 192) v = A.in[7][((size_t)(l * BS + b) * 3 + r) * 768 + ssd_chmap(hd, c)];
        HIST[e] = f2bf(v); }
    u32x4 pr[3], ps; float pdt = 0.f;
#define SSD_PREFETCH(T0N) do { const int nvn_ = (L - (T0N)) < 64 ? (L - (T0N)) : 64; \
        _Pragma("unroll") for (int i = 0; i < 3; ++i) { const int c = tid + 512 * i, t = c / 24, q = c % 24; pr[i] = (u32x4){0u, 0u, 0u, 0u}; \
            if (t < nvn_) pr[i] = *(const u32x4*)(ZM + (size_t)(tok0 + (T0N) + t) * NZM + 4096 + ssd_chmap(hd, 8 * q)); } \
        if (wave == 0) { pdt = 0.f; if (lane < nvn_) pdt = ZS[(size_t)(tok0 + (T0N) + lane) * NSM + 24 + hd]; } } while (0)
#define SSD_PREFETCH_Z(T0N) do { const int nvn_ = (L - (T0N)) < 64 ? (L - (T0N)) : 64; const int t = tid >> 3, part = tid & 7; ps = (u32x4){0u, 0u, 0u, 0u}; \
        if (t < nvn_) ps = *(const u32x4*)(ZM + (size_t)(tok0 + (T0N) + t) * NZM + 3584 + hd * 64 + 8 * part); } while (0)
    SSD_PREFETCH(0); SSD_PREFETCH_Z(0);
    __syncthreads();
    for (int t0 = 0; t0 < L; t0 += 64) {
        const int nv = (L - t0) < 64 ? (L - t0) : 64, nrt = (nv + 15) >> 4;
#pragma unroll
        for (int i = 0; i < 3; ++i) { const int c = tid + 512 * i, t = c / 24, q = c % 24; *(LAS u32x4*)(RAW + (3 + t) * 200 + 8 * q) = pr[i]; }
        if (tid < 3 * 25) { const int r = tid / 25, q = tid % 25; *(LAS u32x4*)(RAW + r * 200 + 8 * q) = *(const LAS u32x4*)(HIST + r * 200 + 8 * q); }
        if (wave == 0) { const float dtv = (lane < nv) ? softplusf(pdt + dtb) : 0.f; const float lam = scan_sum64(dtv * Ah, lane); DT[lane] = dtv; LM[lane] = lam; }
        SSD_PREFETCH(t0 + 64);
        LDS_BARRIER();
#pragma unroll
        for (int i = 0; i < 3; ++i) { const int c = tid + 512 * i, t = c / 24, q = c % 24; float o[8];
#pragma unroll
            for (int e = 0; e < 8; ++e) o[e] = CBI[8 * q + e];
#pragma unroll
            for (int j = 0; j < 4; ++j) { float x[8]; unpack8(*(const LAS u32x4*)(RAW + (t + j) * 200 + 8 * q), x);
#pragma unroll
                for (int e = 0; e < 8; ++e) o[e] += CW[j * 192 + 8 * q + e] * x[e]; }
#pragma unroll
            for (int e = 0; e < 8; ++e) o[e] = (t < nv) ? siluf(o[e]) : 0.f;
            LAS bf16* dst = (q < 8) ? Xs + t * 72 + q * 8 : (q < 16 ? Bs + t * 72 + (q - 8) * 8 : Cs + t * 72 + (q - 16) * 8);
            *(LAS u32x4*)dst = pack8(o); }
        LDS_BARRIER();
        if (tid < 3 * 25) { const int r = tid / 25, q = tid % 25; *(LAS u32x4*)(HIST + r * 200 + 8 * q) = *(const LAS u32x4*)(RAW + (nv + r) * 200 + 8 * q); }
        f32x4 cbT[2];
#pragma unroll
        for (int j = 0; j < 2; ++j) { const int idx = wave + 8 * j, ti = idx >> 2, si = idx & 3; cbT[j] = (f32x4){0.f, 0.f, 0.f, 0.f};
            if (si <= ti && ti < nrt) MMA_RR(cbT[j], Bs, 72, 16 * si, Cs, 72, 16 * ti, 64); }
        LDS_BARRIER();
#pragma unroll
        for (int j = 0; j < 2; ++j) { const int idx = wave + 8 * j, ti = idx >> 2, si = idx & 3; const int t = 16 * ti + fr; const float lt = LM[t]; float v[4];
#pragma unroll
            for (int r = 0; r < 4; ++r) { const int s = 16 * si + 4 * fq + r; v[r] = (s <= t) ? cbT[j][r] * __expf(lt - LM[s]) * DT[s] : 0.f; }
            *(LAS u32x2*)(W + t * 72 + 16 * si + 4 * fq) = pack4(v[0], v[1], v[2], v[3]); }
        { const int s = tid >> 3, n0 = (tid & 7) * 8; float v[8]; unpack8(*(const LAS u32x4*)(Bs + s * 72 + n0), v); const float ws = __expf(LM[63] - LM[s]) * DT[s];
#pragma unroll
            for (int i = 0; i < 8; ++i) v[i] *= ws;
            *(LAS u32x4*)(Bw + s * 72 + n0) = pack8(v); }
        LDS_BARRIER();
#pragma unroll
        for (int j = 0; j < 2; ++j) { const int idx = wave + 8 * j, ti = idx >> 2, pi = idx & 3; f32x4 acc = {0.f, 0.f, 0.f, 0.f};
            if (ti >= nrt) continue;
            MMA_RT(acc, Cs, 72, 16 * ti, HbT, 72, 16 * pi, 64);
#pragma unroll
            for (int r = 0; r < 4; ++r) acc[r] *= __expf(LM[16 * ti + 4 * fq + r]);
            MMA_RT(acc, W, 72, 16 * ti, Xs, 72, 16 * pi, 64);
#pragma unroll
            for (int r = 0; r < 4; ++r) { const int t = 16 * ti + 4 * fq + r, p = 16 * pi + fr; Ys[t * 72 + p] = f2bf(acc[r] + Dh * bf2f(Xs[t * 72 + p])); } }
        { const float dec = __expf(LM[63]);
#pragma unroll
            for (int j = 0; j < 2; ++j) { const int idx = wave + 8 * j, pi = idx >> 2, ni = idx & 3;
#pragma unroll
                for (int r = 0; r < 4; ++r) accH[j][r] *= dec;
                MMA_TT(accH[j], Xs, 72, 16 * pi, Bw, 72, 16 * ni, 64); } }
        LDS_BARRIER();
#pragma unroll
        for (int j = 0; j < 2; ++j) { const int idx = wave + 8 * j, pi = idx >> 2, ni = idx & 3;
            *(LAS u32x2*)(HbT + (16 * ni + fr) * 72 + 16 * pi + 4 * fq) = pack4(accH[j][0], accH[j][1], accH[j][2], accH[j][3]); }
        { const int t = tid >> 3, part = tid & 7; float f[8], z[8]; unpack8(*(const LAS u32x4*)(Ys + t * 72 + 8 * part), f); unpack8(ps, z);
#pragma unroll
            for (int i = 0; i < 8; ++i) f[i] *= siluf(z[i]);
            if (t < nv) *(u32x4*)(BR2 + (size_t)(tok0 + t0 + t) * 512 + hd * 64 + 8 * part) = pack8(f); }
        SSD_PREFETCH_Z(t0 + 64);
        LDS_BARRIER();
    }
#undef SSD_PREFETCH_Z
#undef SSD_PREFETCH
    { float* ho = A.out + (sample ? O_SH : O_PH) + ((size_t)(l * NB + b) * 8 + hd) * 4096;
#pragma unroll
        for (int j = 0; j < 2; ++j) { const int idx = wave + 8 * j, pi = idx >> 2, ni = idx & 3;
            float* hp = ho + (16 * pi + 4 * fq) * 64 + 16 * ni + fr; OPQV(hp);
#pragma unroll
            for (int r = 0; r < 4; ++r) hp[r * 64] = accH[j][r]; } }
    for (int e = tid; e < 3 * 192; e += NTHREADS) { const int r = e / 192, c = e % 192;
        if (c < 64 || (hd & 3) == 0) A.out[(sample ? O_SV : O_PV) + ((size_t)(l * NB + b) * 3 + r) * 768 + ssd_chmap(hd, c)] = bf2f(HIST[r * 200 + c]); }
    __syncthreads();
}

__device__ __forceinline__ void phase_ssdnorm(ArgP Ap, int l) {
    const int tx = opaque_tid(), lane = tx & 63, wave = tx >> 6, gw = blockIdx.x * NWAVES + wave, NGW = gridDim.x * NWAVES;
    bf16* BR2 = (bf16*)(A.ws + WS_BR) + (size_t)T * 1024; const float* sn = A.in[20] + l * 512 + 8 * lane;
    for (int tok = gw; tok < T; tok += NGW) { float f[8]; unpack8(*(const u32x4*)(BR2 + (size_t)tok * 512 + 8 * lane), f); float s2 = 0.f;
#pragma unroll
        for (int i = 0; i < 8; ++i) s2 += f[i] * f[i];
#pragma unroll
        for (int m = 1; m < 32; m <<= 1) s2 += __shfl_xor(s2, m);
        const float rstd = 1.0f / sqrtf(s2 * (1.0f / 256.0f) + EPS_);
#pragma unroll
        for (int i = 0; i < 8; ++i) f[i] *= rstd * sn[i];
        *(u32x4*)(BR2 + (size_t)tok * 512 + 8 * lane) = pack8(f); }
}

__device__ __forceinline__ void mixer_item(ArgP Ap, LAS unsigned char* lds, int l, int it) {
    constexpr int NL0 = BP * 4, NL1 = NL0 + BP * 4, NL2 = NL1 + BP * 8, NS0 = NL2 + BS * 4, NS1 = NS0 + BS * 4;
    int kind, r; bool sample;
    if (it < NL0) { kind = 0; r = it; sample = false; } else if (it < NL1) { kind = 1; r = it - NL0; sample = false; } else if (it < NL2) { kind = 2; r = it - NL1; sample = false; }
    else if (it < NS0) { kind = 0; r = it - NL2; sample = true; } else if (it < NS1) { kind = 1; r = it - NS0; sample = true; } else { kind = 2; r = it - NS1; sample = true; }
#ifndef ONLYK
#define ONLYK -1
#endif
#ifndef EMU
#define OPQ() ArgP Ap_ = Ap; int l_ = __builtin_amdgcn_readfirstlane(l), r_ = __builtin_amdgcn_readfirstlane(r); LAS unsigned char* lds_ = lds; asm volatile("" : "+s"(Ap_), "+s"(l_), "+s"(r_), "+s"(lds_) :: "memory")
#else
#define OPQ() ArgP Ap_ = Ap; int l_ = l, r_ = r; LAS unsigned char* lds_ = lds
#endif
    if ((ONLYK < 0 || ONLYK == 0) && kind == 0) { OPQ(); mlstm_item(Ap_, lds_, l_, r_ >> 2, r_ & 3, sample); }
    else if ((ONLYK < 0 || ONLYK == 1) && kind == 1) { OPQ(); gla_item(Ap_, lds_, l_, r_ >> 2, r_ & 3, sample); }
    else if ((ONLYK < 0 || ONLYK == 2) && kind == 2) { OPQ(); ssd_item(Ap_, lds_, l_, r_ >> 3, r_ & 7, sample); }
#undef OPQ
}
__device__ __forceinline__ void phase_mixers(ArgP Ap, LAS unsigned char* lds, int l) {
    constexpr int NLONG = BP * 16, NSHORT = BS * 16; int G = gridDim.x, bid = blockIdx.x; OPQS(G); OPQS(bid);
#ifdef MIX_NOSPLIT
    const bool split = false;
#else
    const bool split = G > NLONG;
#endif
#ifndef MIX_IDLE
#define MIX_IDLE 0
#endif
    const int step = split ? (bid < NLONG ? (1 << 28) : G - NLONG - MIX_IDLE) : G;
    if (split && MIX_IDLE && bid >= G - MIX_IDLE) return;
#ifndef MIXREP
#define MIXREP 0
#endif
#pragma unroll 1
    for (int it = bid; it < NLONG + NSHORT; it += step) {
        const int reps = ((MIXREP == 1 && it < NLONG) || (MIXREP == 2 && it >= NLONG) || (MIXREP == 3 && it < BP * 4) || (MIXREP == 4 && it >= BP * 4 && it < BP * 8) || (MIXREP == 5 && it >= BP * 8 && it < NLONG)) ? 2 : 1;
#pragma unroll 1
        for (int rp = 0; rp < reps; ++rp) mixer_item(Ap, lds, l, it);
    }
}

__device__ __forceinline__ float wave_sum64(float v) {
#pragma unroll
    for (int m = 1; m < 64; m <<= 1) v += __shfl_xor(v, m);
    return v;
}
constexpr float DN_ALPHA_ = 1.4142135623730951f;

__device__ __forceinline__ void phase_ln1(ArgP Ap, int l) {
    const int tx = opaque_tid(), lane = tx & 63, wave = tx >> 6, gw = blockIdx.x * NWAVES + wave, NGW = gridDim.x * NWAVES;
    const float* Y = (const float*)(A.ws + WS_ZG); float* H = (float*)(A.ws + WS_H); bf16* H1B = (bf16*)(A.ws + WS_BR);
    const float* lg = A.in[23] + l * D + 16 * lane; const float* lb = A.in[24] + l * D + 16 * lane;
    for (int tok = gw; tok < T; tok += NGW) {
        const float* xr = (l == 0) ? (tok < TP ? A.in[0] + (size_t)tok * D : A.in[1] + (size_t)(tok - TP) * D) : H + (size_t)tok * D;
        float y[16]; float s1 = 0.f;
#pragma unroll
        for (int q = 0; q < 4; ++q) { const float4 a = *(const float4*)(xr + 16 * lane + 4 * q), b = *(const float4*)(Y + (size_t)tok * D + 16 * lane + 4 * q);
            y[4 * q] = DN_ALPHA_ * a.x + b.x; y[4 * q + 1] = DN_ALPHA_ * a.y + b.y; y[4 * q + 2] = DN_ALPHA_ * a.z + b.z; y[4 * q + 3] = DN_ALPHA_ * a.w + b.w; }
#pragma unroll
        for (int i = 0; i < 16; ++i) s1 += y[i];
        const float mu = wave_sum64(s1) * (1.0f / D); float s2 = 0.f;
#pragma unroll
        for (int i = 0; i < 16; ++i) { y[i] -= mu; s2 += y[i] * y[i]; }
        const float rstd = 1.0f / sqrtf(wave_sum64(s2) * (1.0f / D) + EPS_);
#pragma unroll
        for (int i = 0; i < 16; ++i) y[i] = y[i] * rstd * lg[i] + lb[i];
#pragma unroll
        for (int q = 0; q < 4; ++q) *(float4*)(H + (size_t)tok * D + 16 * lane + 4 * q) = make_float4(y[4 * q], y[4 * q + 1], y[4 * q + 2], y[4 * q + 3]);
        float y0[8], y1[8];
#pragma unroll
        for (int i = 0; i < 8; ++i) { y0[i] = y[i]; y1[i] = y[8 + i]; }
        *(u32x4*)(H1B + (size_t)tok * D + 16 * lane) = pack8(y0); *(u32x4*)(H1B + (size_t)tok * D + 16 * lane + 8) = pack8(y1);
    }
    for (int r2 = gw; r2 < 2 * NEXP; r2 += NGW) { const int tab = r2 >= NEXP, row = r2 - tab * NEXP;
        const float* src = A.in[27 + tab] + ((size_t)l * NEXP + row) * D + 16 * lane; float v[16]; float mx = 0.f;
#pragma unroll
        for (int q = 0; q < 4; ++q) { const float4 a = *(const float4*)(src + 4 * q); v[4 * q] = a.x; v[4 * q + 1] = a.y; v[4 * q + 2] = a.z; v[4 * q + 3] = a.w; }
#pragma unroll
        for (int i = 0; i < 16; ++i) mx = fmaxf(mx, fabsf(v[i]));
#pragma unroll
        for (int m = 1; m < 64; m <<= 1) mx = fmaxf(mx, __shfl_xor(mx, m));
        const float sc = (mx > 0.f) ? exp2f(floorf(log2f(224.0f / mx))) : 1.0f;
        u32x4 w; w.x = pk_fp8x4(v[0] * sc, v[1] * sc, v[2] * sc, v[3] * sc); w.y = pk_fp8x4(v[4] * sc, v[5] * sc, v[6] * sc, v[7] * sc);
        w.z = pk_fp8x4(v[8] * sc, v[9] * sc, v[10] * sc, v[11] * sc); w.w = pk_fp8x4(v[12] * sc, v[13] * sc, v[14] * sc, v[15] * sc);
        *(u32x4*)(A.ws + (tab ? WS_PV : WS_PU) + (size_t)row * D + 16 * lane) = w;
        if (lane == 0) ((float*)(A.ws + (tab ? WS_PVS : WS_PUS)))[row] = 1.0f / sc; }
}

__device__ __forceinline__ unsigned ord_of(float f) { const unsigned u = __float_as_uint(f); return (u & 0x80000000u) ? ~u : (u | 0x80000000u); }
__device__ __forceinline__ float dec_ord(unsigned o) { const unsigned u = (o & 0x80000000u) ? (o & 0x7fffffffu) : ~o; return __uint_as_float(u); }
__device__ __forceinline__ unsigned umax_(unsigned a, unsigned b) { return a > b ? a : b; }
__device__ __forceinline__ unsigned umin_(unsigned a, unsigned b) { return a < b ? a : b; }
__device__ __forceinline__ void ins16(unsigned (&L)[16], unsigned x) {
#pragma unroll
    for (int p = 0; p < 16; ++p) { const unsigned hi = umax_(L[p], x); x = umin_(L[p], x); L[p] = hi; }
}
__device__ __forceinline__ unsigned sel16(const unsigned (&L)[16], int a) { unsigned r = L[0];
#pragma unroll
    for (int p = 1; p < 16; ++p) r = (a == p) ? L[p] : r;
    return r; }

__device__ __forceinline__ void route_topk(const bf16* __restrict__ Q, const LAS bf16* KEYS, int tokb, int h, int j, int fr, int fq, unsigned (&Lt)[16]) {
    f32x4 acc[8];
#pragma unroll
    for (int ki = 0; ki < 8; ++ki) acc[ki] = (f32x4){0.f, 0.f, 0.f, 0.f};
#pragma unroll
    for (int kk = 0; kk < 4; ++kk) { const bf16x8 bq = *(const bf16x8*)(Q + (size_t)(tokb + fr) * 2048 + h * 256 + j * 128 + 32 * kk + 8 * fq);
#pragma unroll
        for (int ki = 0; ki < 8; ++ki) { const bf16x8 ak = *(const LAS bf16x8*)(KEYS + (j * 128 + 16 * ki + fr) * 136 + 32 * kk + 8 * fq); acc[ki] = mfma16(ak, bq, acc[ki]); } }
#pragma unroll
    for (int p = 0; p < 16; ++p) Lt[p] = 0u;
#pragma unroll
    for (int ki = 0; ki < 8; ++ki)
#pragma unroll
        for (int r = 0; r < 4; ++r) ins16(Lt, (ord_of(acc[ki][r]) & ~127u) | (unsigned)(127 - (16 * ki + 4 * fq + r)));
#pragma unroll
    for (int m = 16; m < 64; m <<= 1) { unsigned R[16];
#pragma unroll
        for (int p = 0; p < 16; ++p) R[p] = __shfl_xor(Lt[p], m);
#pragma unroll
        for (int p = 0; p < 16; ++p) ins16(Lt, R[p]); }
}

__device__ __forceinline__ void phase_route(ArgP Ap, LAS unsigned char* lds, int l) {
    const int tid = opaque_tid(), lane = tid & 63, wave = tid >> 6, fr = lane & 15, fq = lane >> 4;
    LAS bf16* KEYS = (LAS bf16*)lds;
    LAS unsigned* LST = (LAS unsigned*)(lds + 69632);
    const bf16* Q = (const bf16*)(A.ws + WS_Q); int* IDX = (int*)(A.ws + WS_IDX); float* GT = (float*)(A.ws + WS_GT);
    const bf16* kg = (const bf16*)(A.ws + WS_WB + (size_t)l * WB_BYTES + WB_KEYS);
    constexpr int NG = T / 16, NCH = (NG + 7) / 8, NITEMS = NCH * 8;
    int last_h = -1;
    for (int it = blockIdx.x; it < NITEMS; it += gridDim.x) {
        const int h = it & 7, ch = it >> 3;
        if (h != last_h) { __syncthreads();
            for (int c = tid; c < 2 * 128 * 16; c += NTHREADS) { const int row = c >> 4, cc = (c & 15) * 8; *(LAS u32x4*)(KEYS + row * 136 + cc) = *(const u32x4*)(kg + ((size_t)h * 256 + row) * 128 + cc); }
            __syncthreads(); last_h = h; }
        const int grp = ch * 8 + wave;
        if (grp < NG) {
            const int tokb = grp * 16; unsigned L1[16], L2[16];
            route_topk(Q, KEYS, tokb, h, 0, fr, fq, L1); route_topk(Q, KEYS, tokb, h, 1, fr, fq, L2);
            unsigned C[16];
#pragma unroll
            for (int p = 0; p < 16; ++p) C[p] = 0u;
#pragma unroll
            for (int a = 0; a < 16; ++a)
#pragma unroll
                for (int b = 0; b < 16; ++b) if ((a + 1) * (b + 1) <= 16) {
                    const float s = dec_ord(L1[a] & ~127u) + dec_ord(L2[b] & ~127u); ins16(C, (ord_of(s) & ~255u) | (unsigned)(255 - (a * 16 + b))); }
            const float s0 = dec_ord(C[0] & ~255u); float e[16]; float sum = 0.f;
#pragma unroll
            for (int p = 0; p < 16; ++p) { e[p] = __expf(dec_ord(C[p] & ~255u) - s0); sum += e[p]; }
            const float inv = 1.0f / sum; const size_t ob = (size_t)(tokb + fr) * 128 + h * 16;
#pragma unroll
            for (int p = 0; p < 16; ++p) { LST[(wave * 32 + p) * 64 + lane] = L1[p]; LST[(wave * 32 + 16 + p) * 64 + lane] = L2[p]; }
#pragma unroll
            for (int p = 0; p < 16; ++p) { const int cid = 255 - (int)(C[p] & 255u); const int a = cid >> 4, b = cid & 15;
                const int e1 = 127 - (int)(LST[(wave * 32 + a) * 64 + lane] & 127u), e2 = 127 - (int)(LST[(wave * 32 + 16 + b) * 64 + lane] & 127u);
                if ((p >> 2) == fq) { IDX[ob + p] = e1 * 128 + e2; GT[ob + p] = e[p] * inv; } }
        }
    }
}

__device__ __forceinline__ void phase_gather(ArgP Ap, int l) {
    const int tx = opaque_tid(), lane = tx & 63, wave = tx >> 6, gw = blockIdx.x * NWAVES + wave, NGW = gridDim.x * NWAVES;
    float* H = (float*)(A.ws + WS_H); bf16* XB = (bf16*)(A.ws + WS_XB); const int* IDX = (const int*)(A.ws + WS_IDX); const float* GT = (const float*)(A.ws + WS_GT);
    const unsigned char* PU = A.ws + WS_PU; const unsigned char* PV = A.ws + WS_PV; const float* PUS = (const float*)(A.ws + WS_PUS); const float* PVS = (const float*)(A.ws + WS_PVS);
    const float* lg = A.in[29] + l * D + 16 * lane; const float* lb = A.in[30] + l * D + 16 * lane;
    for (int tok = gw; tok < T; tok += NGW) {
        float x[16];
#pragma unroll
        for (int q = 0; q < 4; ++q) { const float4 a = *(const float4*)(H + (size_t)tok * D + 16 * lane + 4 * q); x[4 * q] = a.x; x[4 * q + 1] = a.y; x[4 * q + 2] = a.z; x[4 * q + 3] = a.w; }
        const int i0 = IDX[(size_t)tok * 128 + lane], i1 = IDX[(size_t)tok * 128 + 64 + lane];
        const float su0 = PUS[i0], su1 = PUS[i1];
        const float gv0 = GT[(size_t)tok * 128 + lane] * PVS[i0], gv1 = GT[(size_t)tok * 128 + 64 + lane] * PVS[i1];
        float o[16];
#pragma unroll
        for (int i = 0; i < 16; ++i) o[i] = 0.f;
#pragma unroll 1
        for (int kb = 0; kb < 128; kb += 16) {
            u32x4 uu[16], vv[16];
#pragma unroll
            for (int kk = 0; kk < 16; ++kk) { const int k = kb + kk; const int e = __shfl(kb < 64 ? i0 : i1, k & 63);
                uu[kk] = *(const u32x4*)(PU + (size_t)e * D + 16 * lane); vv[kk] = *(const u32x4*)(PV + (size_t)e * D + 16 * lane); }
#pragma unroll
            for (int kk = 0; kk < 16; ++kk) { float f[16]; unpk_fp8x4(uu[kk].x, f); unpk_fp8x4(uu[kk].y, f + 4); unpk_fp8x4(uu[kk].z, f + 8); unpk_fp8x4(uu[kk].w, f + 12); float p = 0.f;
#pragma unroll
                for (int i = 0; i < 16; ++i) p += f[i] * x[i];
                p = wave_sum64(p) * __shfl(kb < 64 ? su0 : su1, (kb + kk) & 63);
                const float act = 0.5f * p * (1.0f + erff(p * 0.70710678118654752f)) * __shfl(kb < 64 ? gv0 : gv1, (kb + kk) & 63);
                unpk_fp8x4(vv[kk].x, f); unpk_fp8x4(vv[kk].y, f + 4); unpk_fp8x4(vv[kk].z, f + 8); unpk_fp8x4(vv[kk].w, f + 12);
#pragma unroll
                for (int i = 0; i < 16; ++i) o[i] += act * f[i]; }
        }
        float s1 = 0.f;
#pragma unroll
        for (int i = 0; i < 16; ++i) { o[i] += DN_ALPHA_ * x[i]; s1 += o[i]; }
        const float mu = wave_sum64(s1) * (1.0f / D); float s2 = 0.f;
#pragma unroll
        for (int i = 0; i < 16; ++i) { o[i] -= mu; s2 += o[i] * o[i]; }
        const float rstd = 1.0f / sqrtf(wave_sum64(s2) * (1.0f / D) + EPS_);
#pragma unroll
        for (int i = 0; i < 16; ++i) o[i] = o[i] * rstd * lg[i] + lb[i];
        float* dst = (l == 1) ? A.out + (size_t)tok * D + 16 * lane : H + (size_t)tok * D + 16 * lane;
#pragma unroll
        for (int q = 0; q < 4; ++q) *(float4*)(dst + 4 * q) = make_float4(o[4 * q], o[4 * q + 1], o[4 * q + 2], o[4 * q + 3]);
        if (l == 0) { float y0[8], y1[8];
#pragma unroll
            for (int i = 0; i < 8; ++i) { y0[i] = o[i]; y1[i] = o[8 + i]; }
            *(u32x4*)(XB + (size_t)tok * D + 16 * lane) = pack8(y0); *(u32x4*)(XB + (size_t)tok * D + 16 * lane + 8) = pack8(y1); }
    }
}

#ifndef EMU
struct MergeOrder {
    pg8::StaticOrder S;
    __device__ bool next(int i, pg8::Unit& u) const { pg8::Unit t; if (!S.next(i, t)) return false; const int n = t.pm / (T / 256); u.pm = t.pm; u.pn = n * 4 + t.pn; return true; }
    __device__ __forceinline__ void a_ready(const pg8::Unit&) const {}
    __device__ __forceinline__ void done(const pg8::Unit&) const {}
};
struct EpiP {
    static constexpr bool PERM = true, AFTER_DRAIN = false;
    bf16* P;
    __device__ __forceinline__ void operator()(const pg8::f32x4 (&acc)[2][2][4][2], const pg8::Unit& u, int wr, int wc, int fr, int fq) const {
        const int row0 = u.pm * 256 + wr * 64 + fr, col0 = (u.pn & 3) * 256 + wc * 32 + 8 * fq;
#pragma unroll
        for (int ai = 0; ai < 2; ++ai)
#pragma unroll
            for (int m = 0; m < 4; ++m) { bf16* rowp = P + (size_t)(row0 + ai * 128 + m * 16) * D + col0;
#pragma unroll
                for (int bj = 0; bj < 2; ++bj) { const pg8::f32x4 v0 = acc[ai][bj][m][0], v1 = acc[ai][bj][m][1];
                    u32x4 w; w.x = pg8::cvt_pk_bf16(v0[0], v0[1]); w.y = pg8::cvt_pk_bf16(v0[2], v0[3]); w.z = pg8::cvt_pk_bf16(v1[0], v1[1]); w.w = pg8::cvt_pk_bf16(v1[2], v1[3]);
                    *(u32x4*)(rowp + bj * 128) = w; } }
    }
};
__device__ __forceinline__ void phase_merge(ArgP Ap, LAS unsigned char* lds, int l) {
    pg8::Gemm g{(const bf16*)(A.ws + WS_BR), (const bf16*)(A.ws + WS_WB + (size_t)l * WB_BYTES + WB_WBR), 3 * T, 3 * D, 512};
    MergeOrder S; S.S.init(3 * T, D, gridDim.x, blockIdx.x);
    EpiP E{(bf16*)(A.ws + WS_ZM)};
    pg8::gemm_phase<EpiP, MergeOrder>(lds, g, S, E);
}
#endif
__device__ __forceinline__ void phase_combine(ArgP Ap) {
    const size_t gtid = (size_t)blockIdx.x * NTHREADS + opaque_tid(), gthreads = (size_t)gridDim.x * NTHREADS;
    const bf16* P = (const bf16*)(A.ws + WS_ZM); const bf16* ZG = (const bf16*)(A.ws + WS_ZG); bf16* MIXED = (bf16*)(A.ws + WS_XB);
    for (size_t i = gtid; i < (size_t)T * (D / 8); i += gthreads) { const size_t t = i >> 7, c = (i & 127) * 8; float v[8];
#pragma unroll
        for (int j = 0; j < 8; ++j) v[j] = 0.f;
#pragma unroll
        for (int n = 0; n < 3; ++n) { float p[8], g[8]; unpack8(*(const u32x4*)(P + ((size_t)n * T + t) * D + c), p); unpack8(*(const u32x4*)(ZG + t * NZG + n * D + c), g);
#pragma unroll
            for (int j = 0; j < 8; ++j) v[j] += p[j] * g[j]; }
        *(u32x4*)(MIXED + t * D + c) = pack8(v); }
}
#ifndef EMU
struct EpiF32 {
    static constexpr bool PERM = false, AFTER_DRAIN = false;
    float* C; int ldc;
    __device__ __forceinline__ void operator()(const pg8::f32x4 (&acc)[2][2][4][2], const pg8::Unit& u, int wr, int wc, int fr, int fq) const {
        const int row0 = u.pm * 256 + wr * 64 + fr, col0 = u.pn * 256 + wc * 32 + 4 * fq;
#pragma unroll
        for (int ai = 0; ai < 2; ++ai)
#pragma unroll
            for (int m = 0; m < 4; ++m) { float* rowp = C + (size_t)(row0 + ai * 128 + m * 16) * ldc + col0;
#pragma unroll
                for (int bj = 0; bj < 2; ++bj)
#pragma unroll
                    for (int n = 0; n < 2; ++n) *(pg8::f32x4*)(rowp + bj * 128 + n * 16) = acc[ai][bj][m][n]; }
    }
};
struct EpiB16 {
    static constexpr bool PERM = true, AFTER_DRAIN = false;
    bf16* O; int ldc;
    __device__ __forceinline__ void operator()(const pg8::f32x4 (&acc)[2][2][4][2], const pg8::Unit& u, int wr, int wc, int fr, int fq) const {
        const int row0 = u.pm * 256 + wr * 64 + fr, col0 = u.pn * 256 + wc * 32 + 8 * fq;
#pragma unroll
        for (int ai = 0; ai < 2; ++ai)
#pragma unroll
            for (int m = 0; m < 4; ++m) { bf16* rowp = O + (size_t)(row0 + ai * 128 + m * 16) * ldc + col0;
#pragma unroll
                for (int bj = 0; bj < 2; ++bj) { const pg8::f32x4 v0 = acc[ai][bj][m][0], v1 = acc[ai][bj][m][1];
                    u32x4 w; w.x = pg8::cvt_pk_bf16(v0[0], v0[1]); w.y = pg8::cvt_pk_bf16(v0[2], v0[3]); w.z = pg8::cvt_pk_bf16(v1[0], v1[1]); w.w = pg8::cvt_pk_bf16(v1[2], v1[3]);
                    *(u32x4*)(rowp + bj * 128) = w; } }
    }
};
__device__ __forceinline__ void phase_outproj(ArgP Ap, LAS unsigned char* lds, int l) {
    pg8::Gemm g{(const bf16*)(A.ws + WS_XB), (const bf16*)(A.ws + WS_WB + (size_t)l * WB_BYTES + WB_WO), T, D, D};
    pg8::StaticOrder S; S.init(T, D, gridDim.x, blockIdx.x);
    EpiF32 E{(float*)(A.ws + WS_ZG), D};
    pg8::gemm_phase<EpiF32, pg8::StaticOrder>(lds, g, S, E);
}
__device__ __forceinline__ void phase_qproj(ArgP Ap, LAS unsigned char* lds, int l) {
    pg8::Gemm g{(const bf16*)(A.ws + WS_BR), (const bf16*)(A.ws + WS_WB + (size_t)l * WB_BYTES + WB_WQ), T, 2048, D};
    pg8::StaticOrder S; S.init(T, 2048, gridDim.x, blockIdx.x);
    EpiB16 E{(bf16*)(A.ws + WS_Q), 2048};
    pg8::gemm_phase<EpiB16, pg8::StaticOrder>(lds, g, S, E);
}

__global__ void __launch_bounds__(NTHREADS, 2) mega_fwd(Args kargs) {
    extern __shared__ __attribute__((aligned(16))) unsigned char lds_raw[];
    LAS unsigned char* lds = (LAS unsigned char*)lds_raw;
    volatile LAS unsigned* xst = (volatile LAS unsigned*)(lds + LDS_BYTES - 16);
    unsigned* xbar = (unsigned*)(kargs.ws + WS_CTL);
    if (threadIdx.x < 4) xst[threadIdx.x] = 0u;
    if (blockIdx.x == 0) for (int i = threadIdx.x; i < XCD_BAR_WORDS; i += NTHREADS) xbar[i] = 0u;
#ifdef STAGE_AMP
    if (blockIdx.x == 0 && threadIdx.x < 128) ((unsigned long long*)(kargs.ws + WS_CTL + 40960))[threadIdx.x] = 0ull;
#endif
    __syncthreads();
    XcdBarrier xb; xb.bar = xbar; xb.x = 0; xb.st = xst;
    ArgP Ap = (ArgP)__builtin_amdgcn_kernarg_segment_ptr();
#define RUN(call) do { ArgP Ap_ = Ap; int l_ = l; LAS unsigned char* lds_ = lds; asm volatile("" : "+s"(Ap_), "+s"(l_), "+s"(lds_) :: "memory"); { ArgP Ap = Ap_; const int l = l_; LAS unsigned char* lds = lds_; (void)lds; call; } asm volatile("" ::: "memory"); } while (0)
#ifndef ONLYP
#define ONLYP -1
#endif
#ifndef SKIPP
#define SKIPP -2
#endif
#define PSEL(q) ((ONLYP < 0 || ONLYP == (q)) && SKIPP != (q))
#ifndef REPMASK
#define REPMASK 0
#endif
#define REP(q, l) (((REPMASK >> (q)) & 1) && ((q) != 5 || (l) == 0) && ((q) != 8 || (l) == 1))
#define IN(k) true
#ifdef AMP_PHASE
#define TSTAMP(k) do { if (blockIdx.x == 0 && threadIdx.x == 0) ((unsigned long long*)(kargs.ws + WS_CTL + 32768))[(k)] = __builtin_amdgcn_s_memrealtime(); } while (0)
#else
#define TSTAMP(k) do {} while (0)
#endif
#define SEAM(k) do { if ((k) == 0) { cg::this_grid().sync(); xb = xcd_barrier_post(xbar, xst); } else xcd_barrier(xb); TSTAMP((k) + 1); } while (0)
#pragma unroll 1
    TSTAMP(0);
    {
    { const int l = 0; if (PSEL(0) && IN(0)) { RUN(phase_convert(Ap, lds)); if (REP(0, l)) RUN(phase_convert(Ap, lds)); } (void)l; }
    SEAM(0);
    for (int l = 0; l < 2; ++l) {
        const int p = 1 + 10 * l;
        if (PSEL(1) && IN(p + 0)) { RUN(phase_gemm1(Ap, lds, l)); if (REP(1, l)) RUN(phase_gemm1(Ap, lds, l)); }
        SEAM(p);
        if (PSEL(2) && IN(p + 1)) { RUN(phase_mixers(Ap, lds, l)); if (REP(2, l)) RUN(phase_mixers(Ap, lds, l)); }
        SEAM(p + 1);
#ifdef XBAR_EXTRA
        for (int xe = 0; xe < XBAR_EXTRA; ++xe) xcd_barrier(xb);
#endif
        if (PSEL(9) && IN(p + 2)) RUN(phase_ssdnorm(Ap, l));
        SEAM(p + 2);
        if (PSEL(3) && IN(p + 3)) { RUN(phase_merge(Ap, lds, l)); if (REP(3, l)) RUN(phase_merge(Ap, lds, l)); }
        SEAM(p + 3);
        if (PSEL(10) && IN(p + 4)) RUN(phase_combine(Ap));
        SEAM(p + 4);
        if (PSEL(4) && IN(p + 5)) { RUN(phase_outproj(Ap, lds, l)); if (REP(4, l)) RUN(phase_outproj(Ap, lds, l)); }
        SEAM(p + 5);
        if (PSEL(5) && IN(p + 6)) { RUN(phase_ln1(Ap, l)); if (REP(5, l)) RUN(phase_ln1(Ap, l)); }
        SEAM(p + 6);
        if (PSEL(6) && IN(p + 7)) { RUN(phase_qproj(Ap, lds, l)); if (REP(6, l)) RUN(phase_qproj(Ap, lds, l)); }
        SEAM(p + 7);
        if (PSEL(7) && IN(p + 8)) { RUN(phase_route(Ap, lds, l)); if (REP(7, l)) RUN(phase_route(Ap, lds, l)); }
        SEAM(p + 8);
        if (PSEL(8) && IN(p + 9)) { RUN(phase_gather(Ap, l)); if (REP(8, l)) RUN(phase_gather(Ap, l)); }
        SEAM(p + 9);
    }
    }
#ifdef AMP_PHASE
    if (blockIdx.x == 0 && threadIdx.x == 0) { const unsigned long long* ts = (const unsigned long long*)(kargs.ws + WS_CTL + 32768);
        const unsigned long long dt = (ts[AMP_PHASE + 1] - ts[AMP_PHASE]) * 8ull, t0 = __builtin_amdgcn_s_memrealtime();
        while (__builtin_amdgcn_s_memrealtime() - t0 < dt) __builtin_amdgcn_s_sleep(8); }
#endif
#ifdef STAGE_AMP
    if (blockIdx.x == 0 && threadIdx.x == 0) { const unsigned long long dt = ((const unsigned long long*)(kargs.ws + WS_CTL + 40960))[STAGE_AMP] * 8ull, t0 = __builtin_amdgcn_s_memrealtime();
        while (__builtin_amdgcn_s_memrealtime() - t0 < dt) __builtin_amdgcn_s_sleep(8); }
#endif
#undef IN
#undef RUN
#undef SEAM
}

extern "C" void kernel_launch(void* const* d_in, const int* in_sizes, int n_in, void* d_out, int out_size, void* d_ws, size_t ws_size, hipStream_t stream) {
    static int grid_blocks = 0;
    if (grid_blocks == 0) {
        if (n_in != 31 || (size_t)out_size != O_END || ws_size < WS_END) {
            fprintf(stderr, "kernel_launch: unexpected problem: n_in %d out %d (want %zu) ws %zu (want >= %zu)\n", n_in, out_size, (size_t)O_END, ws_size, (size_t)WS_END); grid_blocks = -1; return; }
        int dev = 0, cus = 0, per_cu = 0;
        (void)hipGetDevice(&dev); (void)hipDeviceGetAttribute(&cus, hipDeviceAttributeMultiprocessorCount, dev);
        if (hipFuncSetAttribute((const void*)mega_fwd, hipFuncAttributeMaxDynamicSharedMemorySize, LDS_BYTES) != hipSuccess) { fprintf(stderr, "kernel_launch: hipFuncSetAttribute failed\n"); grid_blocks = -1; return; }
        if (hipOccupancyMaxActiveBlocksPerMultiprocessor(&per_cu, (const void*)mega_fwd, NTHREADS, LDS_BYTES) != hipSuccess || per_cu < 1) { fprintf(stderr, "kernel_launch: occupancy query failed (%d)\n", per_cu); grid_blocks = -1; return; }
        grid_blocks = cus * per_cu;
        fprintf(stderr, "kernel_launch: %d CUs x %d = %d workgroups\n", cus, per_cu, grid_blocks);
    }
    if (grid_blocks < 0) return;
    Args a{};
    for (int i = 0; i < 31; ++i) a.in[i] = (const float*)d_in[i];
    a.out = (float*)d_out; a.ws = (unsigned char*)d_ws; a.ph_lo = 0; a.ph_hi = 64;
    void* args[] = {&a};
    hipError_t e = hipLaunchCooperativeKernel((const void*)mega_fwd, dim3(grid_blocks), dim3(NTHREADS), args, LDS_BYTES, stream);
    if (e != hipSuccess) fprintf(stderr, "kernel_launch: cooperative launch failed: %s (grid %d)\n", hipGetErrorString(e), grid_blocks);
}
#endif
```

```cpp
#ifndef EMU
#include <hip/hip_runtime.h>
#include <hip/hip_cooperative_groups.h>
#include <cstdio>
#include <cstdint>
namespace cg = cooperative_groups;
namespace pg8 {
#define PG8_LAS __attribute__((address_space(3)))
typedef unsigned short bf16_t;
typedef short bf16x8 __attribute__((ext_vector_type(8)));
typedef float f32x4 __attribute__((ext_vector_type(4)));
typedef unsigned u32x4 __attribute__((ext_vector_type(4)));
constexpr int BM = 256, BK = 64, HALF = 128, HTB = HALF * BK * 2  , STAGE_BYTES = 8 * HTB, NXCD = 8, WGM = 8;

__host__ __device__ __forceinline__ int lds_byte(int r, int c) { const int st = (r >> 4) * 2 + (c >> 5), rr = r & 15, cc = c & 31, ob = rr * 64 + cc * 2; return st * 1024 + (ob ^ (((ob >> 9) & 1) << 5)); }
__host__ __device__ __forceinline__ void stage_rc(int b, int& R, int& C) { const int st = b / 1024, sb = b % 1024, swz = sb ^ (((sb >> 9) & 1) << 5); R = (st >> 1) * 16 + swz / 64; C = (st & 1) * 32 + (swz % 64) / 2; }
__host__ __device__ __forceinline__ int perm32(int rho) { const int n = rho >> 4, i = rho & 15; return 8 * (i >> 2) + 4 * n + (i & 3); }

struct Unit { int pm, pn; };
struct Gemm { const bf16_t* A; const bf16_t* Bt; int M, N, K; };

struct StaticOrder {
    int nM, nN, nwg, G, c;
    __host__ __device__ void init(int M, int N, int G_, int c_) { nM = M / BM; nN = N / BM; nwg = nM * nN; G = G_; c = c_; }
    __host__ __device__ bool next(int i, Unit& u) const {
        const long L = (long)i * G + c; if (L >= nwg) return false;
        int wgid = (int)L; { const int q = nwg / NXCD, r = nwg % NXCD, xcd = wgid % NXCD, off = wgid / NXCD; wgid = (xcd < r ? xcd * (q + 1) : r * (q + 1) + (xcd - r) * q) + off; }
        const int nig = WGM * nN, gid = wgid / nig, fm = gid * WGM, gsz = (nM - fm) < WGM ? (nM - fm) : WGM;
        u.pm = fm + ((wgid % nig) % gsz); u.pn = (wgid % nig) / gsz; return true;
    }
    __device__ __forceinline__ void a_ready(const Unit&) const {}
    __device__ __forceinline__ void done(const Unit&) const {}
};

__device__ __forceinline__ unsigned cvt_pk_bf16(float lo, float hi) { unsigned r; asm volatile("v_cvt_pk_bf16_f32 %0, %1, %2" : "=v"(r) : "v"(lo), "v"(hi)); return r; }
typedef float f32x2 __attribute__((ext_vector_type(2)));
__device__ __forceinline__ f32x2 gelu_pk(f32x2 v) {
    const f32x2 av = __builtin_elementwise_abs(v), d = av * 0.2316418882f + 1.0f;
    f32x2 t; t.x = __builtin_amdgcn_rcpf(d.x); t.y = __builtin_amdgcn_rcpf(d.y);
    f32x2 q = t * 0.5307027145f + (-0.7265760135f); q = q * t + 0.7107068705f; q = q * t + (-0.142248368f); q = q * t + 0.127414796f; q = q * t;
    const f32x2 s = (v * v) * (-0.72134752044f);
    f32x2 e; e.x = __builtin_amdgcn_exp2f(s.x); e.y = __builtin_amdgcn_exp2f(s.y);
    const f32x2 m = v * (q * e), r = v - m;
    f32x2 o; o.x = v.x < 0.f ? m.x : r.x; o.y = v.y < 0.f ? m.y : r.y; return o;
}

template <class Epi, class Sched>
__device__ __forceinline__ void gemm_phase(PG8_LAS unsigned char* lds, const Gemm g, const Sched& S, const Epi& E) {
    int tid_o = threadIdx.x; asm volatile("" : "+v"(tid_o));
    const int tid = tid_o, wid = __builtin_amdgcn_readfirstlane(tid >> 6), lane = tid & 63, wr = wid >> 2, wc = wid & 3, fr = lane & 15, fq = lane >> 4;
    const int K = g.K, nt = K / BK;
    unsigned voffA[2], voffB[2];
#pragma unroll
    for (int i = 0; i < 2; ++i) { int R, C; stage_rc(tid * 16 + i * 8192, R, C); const int Rb = Epi::PERM ? ((R & ~31) + perm32(R & 31)) : R;
        voffA[i] = (unsigned)(R * K + C) * 2u; voffB[i] = (unsigned)(Rb * K + C) * 2u; }
    const size_t kstep = (size_t)(BK * 2);
    const size_t hstep = (size_t)HALF * K * 2;
    const size_t tstep = 2 * hstep;
    const unsigned ldsw = (unsigned)wid * 1024u;
    const int aoff = lds_byte(wr * 64 + fr, fq * 8), boff = lds_byte(wc * 32 + fr, fq * 8);
#define PG8_SA(b, h) (((b) * 2 + (h)) * HTB)
#define PG8_SB(b, h) ((4 + (b) * 2 + (h)) * HTB)
#define PG8_STAGE(bufoff, gbase, voff) do { _Pragma("unroll") for (int _i = 0; _i < 2; ++_i) \
        __builtin_amdgcn_global_load_lds((const unsigned*)((const char*)(gbase) + (voff)[_i]), (PG8_LAS unsigned*)(lds + (bufoff) + ldsw + _i * 8192), 16, 0, 0); } while (0)
#define PG8_LDA(dst, b, h) do { _Pragma("unroll") for (int m = 0; m < 4; ++m) _Pragma("unroll") for (int k = 0; k < 2; ++k) dst[m][k] = *(const PG8_LAS bf16x8*)(lds + PG8_SA(b, h) + aoff + m * 2048 + k * 1024); } while (0)
#define PG8_LDB(dst, b, h) do { _Pragma("unroll") for (int n = 0; n < 2; ++n) _Pragma("unroll") for (int k = 0; k < 2; ++k) dst[n][k] = *(const PG8_LAS bf16x8*)(lds + PG8_SB(b, h) + boff + n * 2048 + k * 1024); } while (0)
#define PG8_MMA(ai, bj, At, Bt) do { __builtin_amdgcn_s_setprio(1); _Pragma("unroll") for (int m = 0; m < 4; ++m) _Pragma("unroll") for (int n = 0; n < 2; ++n) _Pragma("unroll") for (int k = 0; k < 2; ++k) \
        acc[ai][bj][m][n] = __builtin_amdgcn_mfma_f32_16x16x32_bf16(Bt[n][k], At[m][k], acc[ai][bj][m][n], 0, 0, 0); __builtin_amdgcn_s_setprio(0); } while (0)
#define PG8_WAIT_V(n) asm volatile("s_waitcnt vmcnt(" #n ")" ::: "memory")
#define PG8_WAIT_L(n) asm volatile("s_waitcnt lgkmcnt(" #n ")" ::: "memory")
#define PG8_BAR __builtin_amdgcn_s_barrier()
#define PG8_SCHED __builtin_amdgcn_sched_barrier(0)
    Unit cur, nxt; int ui = 0;
    if (!S.next(0, cur)) return;
    f32x4 acc[2][2][4][2];
#pragma unroll
    for (int a = 0; a < 2; ++a)
#pragma unroll
        for (int b = 0; b < 2; ++b)
#pragma unroll
            for (int m = 0; m < 4; ++m)
#pragma unroll
                for (int n = 0; n < 2; ++n) acc[a][b][m][n] = (f32x4){0.f, 0.f, 0.f, 0.f};
    bf16x8 At[4][2], B0[2][2], B1[2][2];
    const char* cA = (const char*)g.A + (size_t)cur.pm * tstep; const char* cB = (const char*)g.Bt + (size_t)cur.pn * tstep;
    S.a_ready(cur);
    PG8_STAGE(PG8_SB(0, 0), cB, voffB); PG8_STAGE(PG8_SA(0, 0), cA, voffA); PG8_STAGE(PG8_SB(0, 1), cB + hstep, voffB); PG8_STAGE(PG8_SA(0, 1), cA + hstep, voffA);
    if (wr == 1) PG8_BAR;
    PG8_WAIT_V(4); PG8_BAR;
    PG8_STAGE(PG8_SB(1, 0), cB + kstep, voffB); PG8_STAGE(PG8_SA(1, 0), cA + kstep, voffA); PG8_STAGE(PG8_SB(1, 1), cB + hstep + kstep, voffB);
    PG8_WAIT_V(6); PG8_BAR;
    for (;;) {
        const bool has_next = S.next(ui + 1, nxt);
        const char* nA = has_next ? (const char*)g.A + (size_t)nxt.pm * tstep : cA; const char* nB = has_next ? (const char*)g.Bt + (size_t)nxt.pn * tstep : cB;
        for (int t = 0; t < nt; t += 2) {
            const bool last = (t == nt - 2);
            const char* a1 = cA + (size_t)(t + 1) * kstep;
            const char* a2 = last ? nA : cA + (size_t)(t + 2) * kstep; const char* b2 = last ? nB : cB + (size_t)(t + 2) * kstep;
            const char* a3 = a2 + kstep; const char* b3 = b2 + kstep;
            if (last && has_next) S.a_ready(nxt);
            PG8_LDB(B0, 0, 0); PG8_SCHED; PG8_LDA(At, 0, 0); PG8_STAGE(PG8_SA(1, 1), a1 + hstep, voffA);
            PG8_WAIT_L(8); PG8_BAR; PG8_WAIT_L(0); PG8_MMA(0, 0, At, B0); PG8_BAR; PG8_SCHED;
            PG8_LDB(B1, 0, 1); PG8_STAGE(PG8_SB(0, 0), b2, voffB);
            PG8_BAR; PG8_WAIT_L(0); PG8_MMA(0, 1, At, B1); PG8_BAR;
            PG8_LDA(At, 0, 1); PG8_STAGE(PG8_SA(0, 0), a2, voffA);
            PG8_BAR; PG8_WAIT_L(0); PG8_MMA(1, 0, At, B0); PG8_BAR; PG8_SCHED;
            PG8_STAGE(PG8_SB(0, 1), b2 + hstep, voffB);
            PG8_WAIT_V(6); PG8_BAR; PG8_MMA(1, 1, At, B1); PG8_BAR;
            PG8_LDB(B0, 1, 0); PG8_SCHED; PG8_LDA(At, 1, 0); PG8_STAGE(PG8_SA(0, 1), a2 + hstep, voffA);
            PG8_WAIT_L(8); PG8_BAR; PG8_WAIT_L(0); PG8_MMA(0, 0, At, B0); PG8_BAR; PG8_SCHED;
            PG8_LDB(B1, 1, 1); PG8_STAGE(PG8_SB(1, 0), b3, voffB);
            PG8_BAR; PG8_WAIT_L(0); PG8_MMA(0, 1, At, B1); PG8_BAR;
            PG8_LDA(At, 1, 1); PG8_STAGE(PG8_SA(1, 0), a3, voffA);
            PG8_BAR; PG8_WAIT_L(0); PG8_MMA(1, 0, At, B0); PG8_BAR; PG8_SCHED;
            PG8_STAGE(PG8_SB(1, 1), b3 + hstep, voffB);
            PG8_WAIT_V(6); PG8_BAR; PG8_MMA(1, 1, At, B1); PG8_BAR;
        }
        if constexpr (!Epi::AFTER_DRAIN) { E(acc, cur, wr, wc, fr, fq); S.done(cur); }
        if (!has_next) break;
#pragma unroll
        for (int a = 0; a < 2; ++a)
#pragma unroll
            for (int b = 0; b < 2; ++b)
#pragma unroll
                for (int m = 0; m < 4; ++m)
#pragma unroll
                    for (int n = 0; n < 2; ++n) acc[a][b][m][n] = (f32x4){0.f, 0.f, 0.f, 0.f};
        cur = nxt; cA = nA; cB = nB; ++ui;
    }
    PG8_WAIT_V(0);
    if (wr == 0) PG8_BAR;
    PG8_BAR;
    if constexpr (Epi::AFTER_DRAIN) { E.fused(acc, cur, wr, wc, fr, fq, lds, wid, lane); S.done(cur); }
#undef PG8_SA
#undef PG8_SB
#undef PG8_STAGE
#undef PG8_LDA
#undef PG8_LDB
#undef PG8_MMA
#undef PG8_WAIT_V
#undef PG8_WAIT_L
#undef PG8_BAR
#undef PG8_SCHED
}
}

#endif

typedef unsigned short bf16;
#ifndef EMU
#define LAS __attribute__((address_space(3)))
#else
#define LAS
#endif
typedef short bf16x8 __attribute__((ext_vector_type(8)));
typedef float f32x4 __attribute__((ext_vector_type(4)));
typedef unsigned u32x4 __attribute__((ext_vector_type(4)));
typedef unsigned u32x2 __attribute__((ext_vector_type(2)));

#ifdef EMU
constexpr int BP = EMU_BP, LP = EMU_LP, BS = EMU_BS;
#else
constexpr int BP = 8, LP = 2048, BS = 128;
#endif
constexpr int D = 1024, LS = 4, TP = BP * LP, TS = BS * LS, T = TP + TS;
constexpr int INW = 7968, NZM = 4864, NZG = 3072, NZ = NZM + NZG, NSM = 32;
constexpr int NEXP = 16384;
constexpr int NTHREADS = 512, NWAVES = 8;
constexpr int LDS_BYTES = 160 * 1024;

constexpr size_t O_YP = 0, O_YS = O_YP + (size_t)TP * D, O_PC = O_YS + (size_t)TS * D, O_PN = O_PC + 2ull * BP * 4 * 128 * 128, O_PM = O_PN + 2ull * BP * 4 * 128,
    O_PG = O_PM + 2ull * BP * 4, O_PH = O_PG + 2ull * BP * 4 * 64 * 128, O_PV = O_PH + 2ull * BP * 8 * 64 * 64, O_SC = O_PV + 2ull * BP * 3 * 768,
    O_SN = O_SC + 2ull * BS * 4 * 128 * 128, O_SM = O_SN + 2ull * BS * 4 * 128, O_SG = O_SM + 2ull * BS * 4, O_SH = O_SG + 2ull * BS * 4 * 64 * 128,
    O_SV = O_SH + 2ull * BS * 8 * 64 * 64, O_END = O_SV + 2ull * BS * 3 * 768;

constexpr size_t al256(size_t x) { return (x + 255) & ~(size_t)255; }
constexpr size_t WS_CTL = 0, WS_CTL_BYTES = 65536;
constexpr size_t WB_WIN = 0, WB_WS = WB_WIN + (size_t)NZ * D * 2, WB_WBR = WB_WS + (size_t)NSM * D * 2, WB_WO = WB_WBR + 3ull * D * 512 * 2, WB_WQ = WB_WO + (size_t)D * D * 2,
    WB_KEYS = WB_WQ + 2048ull * D * 2, WB_BYTES = WB_KEYS + 16ull * 128 * 128 * 2;
constexpr size_t WS_WB = WS_CTL + WS_CTL_BYTES;
constexpr size_t WS_XB = WS_WB + 2 * WB_BYTES;
constexpr size_t WS_H = WS_XB + (size_t)T * D * 2;
constexpr size_t WS_ZS = WS_H + (size_t)T * D * 4;
constexpr size_t WS_BR = WS_ZS + (size_t)T * NSM * 4;
constexpr size_t WS_ZM = WS_BR + 3ull * T * 512 * 2;
constexpr size_t WS_ZG = WS_ZM + (size_t)T * NZM * 2;
constexpr size_t WS_END0 = WS_ZG + (size_t)T * NZG * 2;
constexpr size_t WS_Q = WS_ZM, WS_IDX = WS_Q + (size_t)T * 2048 * 2, WS_GT = WS_IDX + (size_t)T * 128 * 4;
#ifdef EMU
constexpr size_t WS_PU = WS_END0;
#else
constexpr size_t WS_PU = WS_GT + (size_t)T * 128 * 4;
#endif
constexpr size_t WS_PV = WS_PU + (size_t)NEXP * D, WS_PUS = WS_PV + (size_t)NEXP * D, WS_PVS = WS_PUS + (size_t)NEXP * 4, WS_PEND = WS_PVS + (size_t)NEXP * 4;
#ifdef EMU
constexpr size_t WS_END = WS_PEND;
#else
constexpr size_t WS_END = WS_END0;
static_assert(WS_PEND <= WS_ZG, "ZM alias overflow");
#endif
static_assert((size_t)T * D * 4 <= (size_t)T * NZG * 2, "Y alias overflow");

#ifndef EMU
__device__ __forceinline__ f32x4 mfma16(bf16x8 a, bf16x8 b, f32x4 c) { return __builtin_amdgcn_mfma_f32_16x16x32_bf16(a, b, c, 0, 0, 0); }
#endif
struct Args { const float* in[31]; float* out; unsigned char* ws; int ph_lo, ph_hi; };
#ifndef EMU
typedef const __attribute__((address_space(4))) Args* ArgP;
#else
typedef const Args* ArgP;
#endif
#define A (*Ap)
#ifdef STAGE_AMP
#define STG_INIT() LAS unsigned long long* stg_acc_ = (LAS unsigned long long*)(lds + LDS_BYTES - 256); if (tid == 0) { for (int i_ = 0; i_ < 16; ++i_) stg_acc_[i_] = 0; stg_acc_[15] = __builtin_amdgcn_s_memrealtime(); }
#define STG(k) do { if (tid == 0) { const unsigned long long n_ = __builtin_amdgcn_s_memrealtime(); stg_acc_[k] += n_ - stg_acc_[15]; stg_acc_[15] = n_; } } while (0)
#define STG_FINI(slot) do { if (tid == 0 && !sample && b == 0 && (slot) >= 0) { unsigned long long* g_ = (unsigned long long*)(A.ws + WS_CTL + 40960) + (slot) * 16; for (int i_ = 0; i_ < 15; ++i_) g_[i_] += stg_acc_[i_]; } } while (0)
#else
#define STG_INIT() do {} while (0)
#define STG(k) do {} while (0)
#define STG_FINI(slot) do {} while (0)
#endif
#ifndef EMU
#define OPQV(x) asm volatile("" : "+v"(x))
#define OPQS(x) asm volatile("" : "+s"(x))
#define SCHED_FENCE() __builtin_amdgcn_sched_barrier(0)
#define LDS_BARRIER() asm volatile("s_waitcnt lgkmcnt(0)\n\ts_barrier" ::: "memory")
#else
#define OPQV(x) (void)(x)
#define OPQS(x) (void)(x)
#define SCHED_FENCE() do {} while (0)
#define LDS_BARRIER() __syncthreads()
#endif
#ifndef EMU
__device__ __forceinline__ int opaque_tid() { int t = threadIdx.x; asm volatile("" : "+v"(t)); return t; }
#else
static inline int opaque_tid() { return threadIdx.x; }
#endif

#ifndef EMU
__device__ __forceinline__ unsigned pk_fp8x4(float a, float b, float c, float d) { int w = __builtin_amdgcn_cvt_pk_fp8_f32(a, b, 0, false); w = __builtin_amdgcn_cvt_pk_fp8_f32(c, d, w, true); return (unsigned)w; }
__device__ __forceinline__ void unpk_fp8x4(unsigned w, float* f) { typedef float f32x2_ __attribute__((ext_vector_type(2)));
    const f32x2_ lo = __builtin_amdgcn_cvt_pk_f32_fp8((int)w, false), hi = __builtin_amdgcn_cvt_pk_f32_fp8((int)w, true); f[0] = lo.x; f[1] = lo.y; f[2] = hi.x; f[3] = hi.y; }
#endif
#ifndef EMU
__device__ __forceinline__ float swap32_add(float a, float b) { const auto r = __builtin_amdgcn_permlane32_swap(__float_as_uint(a), __float_as_uint(b), false, false); return __uint_as_float(r[0]) + __uint_as_float(r[1]); }
__device__ __forceinline__ float swap16_add(float a, float b) { const auto r = __builtin_amdgcn_permlane16_swap(__float_as_uint(a), __float_as_uint(b), false, false); return __uint_as_float(r[0]) + __uint_as_float(r[1]); }
__device__ __forceinline__ float row_allsum(float x) {
    x += __uint_as_float(__builtin_amdgcn_update_dpp(0, __float_as_uint(x), 0x128, 0xf, 0xf, false)); x += __uint_as_float(__builtin_amdgcn_update_dpp(0, __float_as_uint(x), 0x124, 0xf, 0xf, false));
    x += __uint_as_float(__builtin_amdgcn_update_dpp(0, __float_as_uint(x), 0x122, 0xf, 0xf, false)); x += __uint_as_float(__builtin_amdgcn_update_dpp(0, __float_as_uint(x), 0x121, 0xf, 0xf, false)); return x; }
#define RDLANE(x, k) __uint_as_float(__builtin_amdgcn_readlane(__float_as_uint(x), (k)))
#endif
__device__ __forceinline__ bf16 f2bf(float f) { unsigned u = __float_as_uint(f); u += 0x7FFFu + ((u >> 16) & 1u); return (bf16)(u >> 16); }
__device__ __forceinline__ float bf2f(bf16 b) { return __uint_as_float(((unsigned)b) << 16); }
__device__ __forceinline__ unsigned pk2(float lo, float hi) { return (unsigned)f2bf(lo) | ((unsigned)f2bf(hi) << 16); }

__device__ __forceinline__ void tconv_tile(const float* __restrict__ src, int ldsrc, int k0, int c0, bf16* __restrict__ dst, int ldd, int n0, LAS float* tile) {
    const int t = opaque_tid(), i = t >> 3, jg = (t & 7) * 8;
    const float4 a = *(const float4*)(src + (size_t)(k0 + i) * ldsrc + c0 + jg), b = *(const float4*)(src + (size_t)(k0 + i) * ldsrc + c0 + jg + 4);
    LAS float* r = tile + i * 65 + jg;
    r[0] = a.x; r[1] = a.y; r[2] = a.z; r[3] = a.w; r[4] = b.x; r[5] = b.y; r[6] = b.z; r[7] = b.w;
    __syncthreads();
    const int j = t >> 3, ig = (t & 7) * 8;
    u32x4 w;
    w.x = pk2(tile[(ig + 0) * 65 + j], tile[(ig + 1) * 65 + j]); w.y = pk2(tile[(ig + 2) * 65 + j], tile[(ig + 3) * 65 + j]);
    w.z = pk2(tile[(ig + 4) * 65 + j], tile[(ig + 5) * 65 + j]); w.w = pk2(tile[(ig + 6) * 65 + j], tile[(ig + 7) * 65 + j]);
    *(u32x4*)(dst + (size_t)(n0 + j) * ldd + k0 + ig) = w;
    __syncthreads();
}
__device__ __forceinline__ int zcol_to_src(int zc) { return zc < 2048 ? zc : (zc < 3584 ? zc + 8 : (zc < 4864 ? zc + 24 : zc + 32)); }
__device__ __forceinline__ int scol_to_src(int sc) { return sc < 8 ? 2048 + sc : (sc < 24 ? 3592 + (sc - 8) : 4888 + (sc - 24)); }

__device__ __forceinline__ void convert_f32_bf16(const float* __restrict__ src, bf16* __restrict__ dst, size_t n, int gtid, int gthreads) {
    for (size_t i = (size_t)gtid * 8; i < n; i += (size_t)gthreads * 8) {
        const float4 a = *(const float4*)(src + i), b = *(const float4*)(src + i + 4);
        u32x4 w; w.x = pk2(a.x, a.y); w.y = pk2(a.z, a.w); w.z = pk2(b.x, b.y); w.w = pk2(b.z, b.w);
        *(u32x4*)(dst + i) = w;
    }
}

__device__ __forceinline__ void phase_convert(ArgP Ap, LAS unsigned char* lds) {
    LAS float* tile = (LAS float*)lds;
    const int G = gridDim.x, bid = blockIdx.x;
    constexpr int I_WIN = (NZ / 64) * (D / 64), I_WBR = 3 * (D / 64) * (512 / 64), I_WO = (D / 64) * (D / 64), I_WQ = (2048 / 64) * (D / 64), I_L = I_WIN + I_WBR + I_WO + I_WQ;
    for (int it = bid; it < 2 * I_L; it += G) {
        const int l = it / I_L; int r = it % I_L;
        unsigned char* wb = A.ws + WS_WB + (size_t)l * WB_BYTES;
        if (r < I_WIN) { const int nt = r / (D / 64), kt = r % (D / 64);
            tconv_tile(A.in[8] + (size_t)l * D * INW, INW, kt * 64, zcol_to_src(nt * 64), (bf16*)(wb + WB_WIN), D, nt * 64, tile); continue; }
        r -= I_WIN;
        if (r < I_WBR) { const int n = r / ((D / 64) * 8), rr = r % ((D / 64) * 8), nt = rr / 8, kt = rr % 8;
            tconv_tile(A.in[21] + ((size_t)l * 3 + n) * 512 * D, D, kt * 64, nt * 64, (bf16*)(wb + WB_WBR) + (size_t)n * D * 512, 512, nt * 64, tile); continue; }
        r -= I_WBR;
        if (r < I_WO) { const int nt = r / (D / 64), kt = r % (D / 64);
            tconv_tile(A.in[22] + (size_t)l * D * D, D, kt * 64, nt * 64, (bf16*)(wb + WB_WO), D, nt * 64, tile); continue; }
        r -= I_WO;
        { const int nt = r / (D / 64), kt = r % (D / 64);
            tconv_tile(A.in[25] + (size_t)l * D * 2048, 2048, kt * 64, nt * 64, (bf16*)(wb + WB_WQ), D, nt * 64, tile); }
    }
    const int gtid = bid * NTHREADS + opaque_tid(), gthreads = G * NTHREADS;
    for (int l = 0; l < 2; ++l) {
        unsigned char* wb = A.ws + WS_WB + (size_t)l * WB_BYTES;
        for (int e = gtid; e < NSM * D; e += gthreads) { const int n = e / D, k = e % D; ((bf16*)(wb + WB_WS))[e] = f2bf(A.in[8][(size_t)l * D * INW + (size_t)k * INW + scol_to_src(n)]); }
        convert_f32_bf16(A.in[26] + (size_t)l * 16 * 128 * 128, (bf16*)(wb + WB_KEYS), 16 * 128 * 128, gtid, gthreads);
    }
    convert_f32_bf16(A.in[0], (bf16*)(A.ws + WS_XB), (size_t)TP * D, gtid, gthreads);
    convert_f32_bf16(A.in[1], (bf16*)(A.ws + WS_XB) + (size_t)TP * D, (size_t)TS * D, gtid, gthreads);
}

#ifndef EMU
struct EpiZ {
    static constexpr bool PERM = true, AFTER_DRAIN = false;
    bf16* ZM; bf16* ZG;
    __device__ __forceinline__ void operator()(const pg8::f32x4 (&acc)[2][2][4][2], const pg8::Unit& u, int wr, int wc, int fr, int fq) const {
        const int row0 = u.pm * 256 + wr * 64 + fr; const bool gate = u.pn >= 19;
        bf16* base = gate ? ZG : ZM; const int ldc = gate ? NZG : NZM; const int col0 = (gate ? (u.pn - 19) : u.pn) * 256 + wc * 32 + 8 * fq;
#pragma unroll
        for (int ai = 0; ai < 2; ++ai)
#pragma unroll
            for (int m = 0; m < 4; ++m) { bf16* rowp = base + (size_t)(row0 + ai * 128 + m * 16) * ldc + col0;
#pragma unroll
                for (int bj = 0; bj < 2; ++bj) { f32x4 v0 = acc[ai][bj][m][0], v1 = acc[ai][bj][m][1];
                    if (gate) {
#pragma unroll
                        for (int j = 0; j < 4; ++j) { v0[j] = __builtin_amdgcn_rcpf(1.0f + __expf(-v0[j])); v1[j] = __builtin_amdgcn_rcpf(1.0f + __expf(-v1[j])); } }
                    u32x4 w; w.x = pg8::cvt_pk_bf16(v0[0], v0[1]); w.y = pg8::cvt_pk_bf16(v0[2], v0[3]); w.z = pg8::cvt_pk_bf16(v1[0], v1[1]); w.w = pg8::cvt_pk_bf16(v1[2], v1[3]);
                    *(u32x4*)(rowp + bj * 128) = w; } }
    }
};

#endif
__device__ __forceinline__ void small_gemm(const bf16* __restrict__ XB, const bf16* __restrict__ WsT, float* __restrict__ ZS) {
    const int tx = opaque_tid(), lane = tx & 63, wave = tx >> 6, gw = blockIdx.x * NWAVES + wave, NGW = gridDim.x * NWAVES, fr = lane & 15, fq = lane >> 4;
    for (int rg = gw; rg < T / 16; rg += NGW) {
        f32x4 a0 = {0.f, 0.f, 0.f, 0.f}, a1 = {0.f, 0.f, 0.f, 0.f};
        const bf16* ap = XB + (size_t)(rg * 16 + fr) * D + 8 * fq; const bf16* b0p = WsT + (size_t)fr * D + 8 * fq; const bf16* b1p = WsT + (size_t)(16 + fr) * D + 8 * fq;
#pragma unroll 4
        for (int k0 = 0; k0 < D; k0 += 32) {
            const bf16x8 a = *(const bf16x8*)(ap + k0), b0 = *(const bf16x8*)(b0p + k0), b1 = *(const bf16x8*)(b1p + k0);
            a0 = mfma16(a, b0, a0); a1 = mfma16(a, b1, a1);
        }
#pragma unroll
        for (int r = 0; r < 4; ++r) { float* o = ZS + (size_t)(rg * 16 + fq * 4 + r) * NSM + fr; o[0] = a0[r]; o[16] = a1[r]; }
    }
}

#ifndef EMU
__device__ __forceinline__ void phase_gemm1(ArgP Ap, LAS unsigned char* lds, int l) {
    unsigned char* wb = A.ws + WS_WB + (size_t)l * WB_BYTES;
    pg8::Gemm g{(const bf16*)(A.ws + WS_XB), (const bf16*)(wb + WB_WIN), T, NZ, D};
    pg8::StaticOrder S; S.init(T, NZ, gridDim.x, blockIdx.x);
    EpiZ E{(bf16*)(A.ws + WS_ZM), (bf16*)(A.ws + WS_ZG)};
    pg8::gemm_phase<EpiZ, pg8::StaticOrder>(lds, g, S, E);
    small_gemm((const bf16*)(A.ws + WS_XB), (const bf16*)(wb + WB_WS), (float*)(A.ws + WS_ZS));
}
#endif

#ifndef EMU
#define XB_TMO      128
#define XB_XCNT(j)  (256  + 64 * (j))
#define XB_XSUB(j)  (1280 + 64 * (j))
#define XB_XGEN(j)  (2304 + 64 * (j))
#define XB_TOP      3328
#define XB_TOPGEN   3392
#define XCD_BAR_WORDS 3456
#define XB_SPIN_CAP (1u << 18)

__device__ __forceinline__ unsigned xb_ld(unsigned* p)              { return __hip_atomic_load(p, __ATOMIC_RELAXED, __HIP_MEMORY_SCOPE_AGENT); }
__device__ __forceinline__ unsigned xb_add(unsigned* p, unsigned v) { return __hip_atomic_fetch_add(p, v, __ATOMIC_RELAXED, __HIP_MEMORY_SCOPE_AGENT); }
__device__ __forceinline__ unsigned xb_xcc_id() { return (unsigned)__builtin_amdgcn_s_getreg((3 << 11) | 20) & 0xFu; }
#define XB_SPIN(cond, bar) do { unsigned _sp = 0; while (cond) { __builtin_amdgcn_s_sleep(1); \
    if ((++_sp & 255u) == 0u) { if (xb_ld(&(bar)[XB_TMO])) break; if (_sp > XB_SPIN_CAP) { atomicAdd(&(bar)[XB_TMO], 1u); break; } } } } while (0)

struct XcdBarrier {
    unsigned* bar; unsigned x;
    volatile LAS unsigned* st;
};

__device__ __forceinline__ XcdBarrier xcd_barrier_post(unsigned* bar, volatile LAS unsigned* st) {
    XcdBarrier b; b.bar = bar; b.x = xb_xcc_id(); b.st = st;
    if (threadIdx.x == 0) (void)xb_add(&bar[XB_XCNT(b.x)], 1u);
    return b;
}
__device__ __forceinline__ void xcd_barrier_complete(unsigned* bar, unsigned x, unsigned& nloc, unsigned& nx) {
    const unsigned G = gridDim.x * gridDim.y * gridDim.z;
    unsigned sum, cnt, mine, sp = 0u;
    for (;;) {
        sum = 0u; cnt = 0u; mine = 0u;
#pragma unroll
        for (unsigned j = 0; j < 16; ++j) { const unsigned c = xb_ld(&bar[XB_XCNT(j)]); sum += c; cnt += (c > 0u) ? 1u : 0u; mine = (j == x) ? c : mine; }
        if (sum == G) break;
        __builtin_amdgcn_s_sleep(1);
        if ((++sp & 255u) == 0u) { if (xb_ld(&bar[XB_TMO])) break; if (sp > XB_SPIN_CAP) { atomicAdd(&bar[XB_TMO], 1u); break; } }
    }
    nloc = mine > 0u ? mine : 1u; nx = cnt > 0u ? cnt : 1u;
}

__device__ __forceinline__ void xcd_barrier(const XcdBarrier& b) {
    asm volatile("s_waitcnt vmcnt(0)" ::: "memory");
    __syncthreads();
    if (threadIdx.x == 0) {
        unsigned* bar = b.bar;
        __builtin_amdgcn_s_waitcnt(0);
        unsigned nloc = b.st[0], nx = b.st[1];
        if (nloc == 0u) { xcd_barrier_complete(bar, b.x, nloc, nx); b.st[0] = nloc; b.st[1] = nx; }
        const unsigned old = xb_add(&bar[XB_XSUB(b.x)], 1u);
        const unsigned gen = old / nloc;
        if (old + 1u == (gen + 1u) * nloc) {
            __builtin_amdgcn_fence(__ATOMIC_RELEASE, "agent");
            asm volatile("s_waitcnt vmcnt(0)" ::: "memory");
            const unsigned og = xb_add(&bar[XB_TOP], 1u);
            const unsigned tg = og / nx;
            if (og + 1u == (tg + 1u) * nx) xb_add(&bar[XB_TOPGEN], 1u);
            else XB_SPIN(xb_ld(&bar[XB_TOPGEN]) == tg, bar);
            __builtin_amdgcn_fence(__ATOMIC_ACQUIRE, "agent");
            xb_add(&bar[XB_XGEN(b.x)], 1u);
            asm volatile("s_waitcnt vmcnt(0)" ::: "memory");
        } else {
            XB_SPIN(xb_ld(&bar[XB_XGEN(b.x)]) == gen, bar);
            __builtin_amdgcn_fence(__ATOMIC_ACQUIRE, "agent");
            asm volatile("s_waitcnt vmcnt(0)" ::: "memory");
        }
    }
    __syncthreads();
}

#endif

typedef short s16x4 __attribute__((ext_vector_type(4)));
#ifndef EMU
__device__ __forceinline__ s16x4 tr4(const LAS bf16* p) { return __builtin_amdgcn_ds_read_tr16_b64_v4i16((LAS s16x4*)p); }
#endif
#define FROW(M, ld, rc0, k0) (*(const LAS bf16x8*)((M) + ((rc0) + fr) * (ld) + (k0) + 8 * fq))
__device__ __forceinline__ bf16x8 ftr_(int fr, int fq, const LAS bf16* M, int ld, int k0, int rc0) {
    const LAS bf16* p = M + (k0 + 8 * fq + (fr >> 2)) * ld + rc0 + 4 * (fr & 3);
    const s16x4 lo = tr4(p), hi = tr4(p + 4 * ld);
    return (bf16x8){lo[0], lo[1], lo[2], lo[3], hi[0], hi[1], hi[2], hi[3]};
}
#define FTR(M, ld, k0, rc0) ftr_(fr, fq, M, ld, k0, rc0)
#define MMA_RR(acc, Am, lda, r0, Bm, ldb, c0, K) do { _Pragma("unroll") for (int k0_ = 0; k0_ < (K); k0_ += 32) acc = mfma16(FROW(Am, lda, r0, k0_), FROW(Bm, ldb, c0, k0_), acc); } while (0)
#define MMA_RT(acc, Am, lda, r0, Bk, ldb, c0, K) do { _Pragma("unroll") for (int k0_ = 0; k0_ < (K); k0_ += 32) acc = mfma16(FROW(Am, lda, r0, k0_), FTR(Bk, ldb, k0_, c0), acc); } while (0)
#define MMA_TT(acc, Ak, lda, m0, Bk, ldb, c0, K) do { _Pragma("unroll") for (int k0_ = 0; k0_ < (K); k0_ += 32) acc = mfma16(FTR(Ak, lda, k0_, m0), FTR(Bk, ldb, k0_, c0), acc); } while (0)
#define MMA_RC(acc, Am, lda, r0, cfrag, K) do { _Pragma("unroll") for (int k0_ = 0; k0_ < (K); k0_ += 32) acc = mfma16(FROW(Am, lda, r0, k0_), cfrag, acc); } while (0)
#define MMA_CT(acc, cfrag, Bk, ldb, c0, K) do { _Pragma("unroll") for (int k0_ = 0; k0_ < (K); k0_ += 32) acc = mfma16(cfrag, FTR(Bk, ldb, k0_, c0), acc); } while (0)
__device__ __forceinline__ u32x2 pack4(float a, float b, float c, float d) { u32x2 w; w.x = pk2(a, b); w.y = pk2(c, d); return w; }
__device__ __forceinline__ float scan_sum64(float v, int lane) {
#pragma unroll
    for (int d = 1; d < 64; d <<= 1) { const float t = __shfl_up(v, d); if (lane >= d) v += t; }
    return v;
}
__device__ __forceinline__ float scan_max64(float v, int lane) {
#pragma unroll
    for (int d = 1; d < 64; d <<= 1) { const float t = __shfl_up(v, d); if (lane >= d) v = fmaxf(v, t); }
    return v;
}
__device__ __forceinline__ float wave_max64(float v) {
#pragma unroll
    for (int m = 1; m < 64; m <<= 1) v = fmaxf(v, __shfl_xor(v, m));
    return v;
}
__device__ __forceinline__ float logsig(float x) { return fminf(x, 0.f) - log1pf(__expf(-fabsf(x))); }
__device__ __forceinline__ float softplusf(float x) { return fmaxf(x, 0.f) + log1pf(__expf(-fabsf(x))); }
__device__ __forceinline__ float sigmoidf(float x) { return 1.0f / (1.0f + __expf(-x)); }
__device__ __forceinline__ float siluf(float x) { return x / (1.0f + __expf(-x)); }
constexpr float NEG_INF = -__builtin_huge_valf();
constexpr float EPS_ = 1e-5f;
__device__ __forceinline__ void unpack8(const u32x4 w, float (&f)[8]) {
    f[0] = __uint_as_float(w.x << 16); f[1] = __uint_as_float(w.x & 0xffff0000u); f[2] = __uint_as_float(w.y << 16); f[3] = __uint_as_float(w.y & 0xffff0000u);
    f[4] = __uint_as_float(w.z << 16); f[5] = __uint_as_float(w.z & 0xffff0000u); f[6] = __uint_as_float(w.w << 16); f[7] = __uint_as_float(w.w & 0xffff0000u);
}
__device__ __forceinline__ u32x4 pack8(const float (&f)[8]) { u32x4 w; w.x = pk2(f[0], f[1]); w.y = pk2(f[2], f[3]); w.z = pk2(f[4], f[5]); w.w = pk2(f[6], f[7]); return w; }

__device__ __forceinline__ void mlstm_item(ArgP Ap, LAS unsigned char* lds, int l, int b, int h, bool sample) {
    int tid_o = threadIdx.x; OPQV(tid_o);
    const int tid = tid_o, lane = tid & 63, wave = tid >> 6, fr = lane & 15, fq = lane >> 4;
    LAS bf16* Qs = (LAS bf16*)(lds); LAS bf16* Ks = (LAS bf16*)(lds + 17408); LAS bf16* Kw = (LAS bf16*)(lds + 34816); LAS bf16* Vs = (LAS bf16*)(lds + 52224);
    LAS bf16* Ss = (LAS bf16*)(lds + 69632); LAS bf16* CbT = (LAS bf16*)(lds + 78848); LAS float* Hs = (LAS float*)(lds + 120320); LAS float* MN = (LAS float*)(lds + 117760); LAS float* gb = (LAS float*)(lds + 118272);
    LAS float* b_ = gb; LAS float* mt_ = gb + 64; LAS float* u_ = gb + 128; LAS float* ein_ = gb + 192; LAS float* wg_ = gb + 256; LAS float* den_ = gb + 320; LAS float* sc_ = gb + 384;
    const int L = sample ? LS : LP, tok0 = sample ? TP + b * LS : b * LP, NB = sample ? BS : BP;
    const bf16* ZM = (const bf16*)(A.ws + WS_ZM); const float* ZS = (const float*)(A.ws + WS_ZS); bf16* BR0 = (bf16*)(A.ws + WS_BR);
    const float ib = A.in[9][l * 4 + h], fb = A.in[10][l * 4 + h];
    f32x4 accC[9];
#pragma unroll
    for (int vi = 0; vi < 9; ++vi) accC[vi] = (f32x4){0.f, 0.f, 0.f, 0.f};
    float m_run = 0.f;
    if (sample) {
        const float* C0 = A.in[2] + ((size_t)(l * BS + b) * 4 + h) * 16384; const float* n0 = A.in[3] + ((size_t)(l * BS + b) * 4 + h) * 128;
        const float* cp = C0 + (4 * fq) * 128 + 16 * wave + fr;
#pragma unroll
        for (int vi = 0; vi < 8; ++vi) {
#pragma unroll
            for (int r = 0; r < 4; ++r) accC[vi][r] = cp[r * 128];
            cp += 2048; OPQV(cp); }
        if (fq == 0) accC[8][0] = n0[16 * wave + fr];
        m_run = A.in[4][(l * BS + b) * 4 + h];
    }
#pragma unroll
    for (int vi = 0; vi < 9; ++vi) *(LAS u32x2*)(CbT + (16 * wave + fr) * 152 + 16 * vi + 4 * fq) = pack4(accC[vi][0], accC[vi][1], accC[vi][2], accC[vi][3]);
    if (tid < 128) MN[tid] = A.in[11][l * 512 + h * 128 + tid];
    u32x4 pq[2], pk[2], pv[2], pm[2]; float pli = NEG_INF, plf = 0.f;
#define MLSTM_PREFETCH_MO(T0N) do { const int nvn_ = (L - (T0N)) < 64 ? (L - (T0N)) : 64; const int t = tid >> 3, part = tid & 7; pm[0] = (u32x4){0u, 0u, 0u, 0u}; pm[1] = pm[0]; \
        if (t < nvn_) { const bf16* mo = ZM + (size_t)(tok0 + (T0N) + t) * NZM + 1536 + h * 128 + 16 * part; pm[0] = *(const u32x4*)mo; pm[1] = *(const u32x4*)(mo + 8); } } while (0)
#define MLSTM_PREFETCH(T0N) do { const int nvn_ = (L - (T0N)) < 64 ? (L - (T0N)) : 64; \
        _Pragma("unroll") for (int i = 0; i < 2; ++i) { const int c = tid + 512 * i, t = c >> 4, cc = (c & 15) * 8; pq[i] = (u32x4){0u, 0u, 0u, 0u}; pk[i] = pq[i]; pv[i] = pq[i]; \
            if (t < nvn_) { const bf16* zp = ZM + (size_t)(tok0 + (T0N) + t) * NZM + h * 128 + cc; pq[i] = *(const u32x4*)zp; pk[i] = *(const u32x4*)(zp + 512); pv[i] = *(const u32x4*)(zp + 1024); } } \
        if (wave == 0) { pli = NEG_INF; plf = 0.f; if (lane < nvn_) { const size_t tok = tok0 + (T0N) + lane; pli = ZS[tok * NSM + h]; plf = ZS[tok * NSM + 4 + h]; } } } while (0)
    MLSTM_PREFETCH(0); MLSTM_PREFETCH_MO(0);
    __syncthreads();
    STG_INIT();
    for (int t0 = 0; t0 < L; t0 += 64) {
        const int nv = (L - t0) < 64 ? (L - t0) : 64, nrt = (nv + 15) >> 4;
        if (wave == 0) {
            const float li = (lane < nv) ? pli + ib : NEG_INF, lf = (lane < nv) ? logsig(plf + fb) : 0.f;
            const float bb = scan_sum64(lf, lane), a = bb + m_run, u = li - bb, M = scan_max64(u, lane), mt = fmaxf(a, bb + M);
            const float blast = __shfl(bb, 63), g = blast + u, gmax = wave_max64(g), mnew = fmaxf(blast + m_run, gmax);
            b_[lane] = bb; mt_[lane] = mt; u_[lane] = u; ein_[lane] = __expf(a - mt); wg_[lane] = __expf(g - mnew);
            if (lane == 0) sc_[1] = __expf(blast + m_run - mnew);
            m_run = mnew;
        }
        LDS_BARRIER(); STG(0);
#pragma unroll
        for (int i = 0; i < 2; ++i) { const int c = tid + 512 * i, t = c >> 4, cc = (c & 15) * 8;
            *(LAS u32x4*)(Qs + t * 136 + cc) = pq[i]; *(LAS u32x4*)(Ks + t * 136 + cc) = pk[i]; *(LAS u32x4*)(Vs + t * 136 + cc) = pv[i];
            float f[8]; unpack8(pk[i], f); const float g = wg_[t];
#pragma unroll
            for (int j = 0; j < 8; ++j) f[j] *= g;
            *(LAS u32x4*)(Kw + t * 136 + cc) = pack8(f); }
        MLSTM_PREFETCH(t0 + 64);
        LDS_BARRIER(); STG(1);
#pragma unroll
        for (int j = 0; j < 2; ++j) { const int idx = wave + 8 * j, ti = idx >> 2, si = idx & 3;
            f32x4 acc = {0.f, 0.f, 0.f, 0.f};
            if (ti >= nrt) continue;
            if (si <= ti) MMA_RR(acc, Ks, 136, 16 * si, Qs, 136, 16 * ti, 128);
            const int t = 16 * ti + fr; const float bt = b_[t] - mt_[t]; float v[4];
#pragma unroll
            for (int r = 0; r < 4; ++r) { const int s = 16 * si + 4 * fq + r; v[r] = (s <= t) ? acc[r] * __expf(bt + u_[s]) : 0.f; }
            *(LAS u32x2*)(Ss + t * 72 + 16 * si + 4 * fq) = pack4(v[0], v[1], v[2], v[3]); }
        LDS_BARRIER(); STG(2);
        if (wave < nrt) { const int ti = wave; f32x4 acc = {0.f, 0.f, 0.f, 0.f};
            MMA_RT(acc, Qs, 136, 16 * ti, CbT, 152, 128, 128);
#pragma unroll
            for (int r = 0; r < 4; ++r) acc[r] *= ein_[16 * ti + 4 * fq + r];
            { int fr_ = fr; OPQV(fr_); const short o1 = (fr_ == 0) ? (short)0x3F80 : (short)0; const bf16x8 ones = {o1, o1, o1, o1, o1, o1, o1, o1};
              MMA_RC(acc, Ss, 72, 16 * ti, ones, 64); }
            if (fr == 0) {
#pragma unroll
                for (int r = 0; r < 4; ++r) den_[16 * ti + 4 * fq + r] = acc[r]; } }
        LDS_BARRIER(); STG(3);
        { bf16x8 bC[4], bV[2];
#pragma unroll
          for (int kk = 0; kk < 4; ++kk) bC[kk] = FTR(CbT, 152, 32 * kk, 16 * wave);
#pragma unroll
          for (int kk = 0; kk < 2; ++kk) bV[kk] = FTR(Vs, 136, 32 * kk, 16 * wave);
#pragma unroll
          for (int ti = 0; ti < 4; ++ti) { if (ti >= nrt) continue; f32x4 accn = {0.f, 0.f, 0.f, 0.f};
#pragma unroll
            for (int kk = 0; kk < 4; ++kk) accn = mfma16(FROW(Qs, 136, 16 * ti, 32 * kk), bC[kk], accn);
#pragma unroll
            for (int r = 0; r < 4; ++r) accn[r] *= ein_[16 * ti + 4 * fq + r];
#pragma unroll
            for (int kk = 0; kk < 2; ++kk) accn = mfma16(FROW(Ss, 72, 16 * ti, 32 * kk), bV[kk], accn);
#pragma unroll
            for (int r = 0; r < 4; ++r) { const int t = 16 * ti + 4 * fq + r; const float dn = den_[t] * 0.08838834764831845f;
                Hs[t * 132 + 16 * wave + fr] = accn[r] * 0.08838834764831845f / fmaxf(fabsf(dn), __expf(-mt_[t])); } } }
        LDS_BARRIER(); STG(4);
        { const int t = tid >> 3, part = tid & 7; float x[16]; float s1 = 0.f;
#pragma unroll
            for (int i = 0; i < 16; ++i) { x[i] = Hs[t * 132 + 16 * part + i]; s1 += x[i]; }
            s1 += __shfl_xor(s1, 1); s1 += __shfl_xor(s1, 2); s1 += __shfl_xor(s1, 4);
            const float mu = s1 * (1.0f / 128.0f); float s2 = 0.f;
#pragma unroll
            for (int i = 0; i < 16; ++i) { x[i] -= mu; s2 += x[i] * x[i]; }
            s2 += __shfl_xor(s2, 1); s2 += __shfl_xor(s2, 2); s2 += __shfl_xor(s2, 4);
            const float rstd = 1.0f / sqrtf(s2 * (1.0f / 128.0f) + EPS_);
            if (t < nv) { const size_t tok = tok0 + t0 + t;
                float o0[8], o1[8]; unpack8(pm[0], o0); unpack8(pm[1], o1); float y0[8], y1[8];
#pragma unroll
                for (int i = 0; i < 8; ++i) { y0[i] = x[i] * rstd * MN[16 * part + i] * sigmoidf(o0[i]); y1[i] = x[8 + i] * rstd * MN[16 * part + 8 + i] * sigmoidf(o1[i]); }
                bf16* o = BR0 + tok * 512 + h * 128 + 16 * part; *(u32x4*)o = pack8(y0); *(u32x4*)(o + 8) = pack8(y1); } }
        MLSTM_PREFETCH_MO(t0 + 64);
        { const float ec = sc_[1]; bf16x8 bK[2];
#pragma unroll
            for (int kk = 0; kk < 2; ++kk) bK[kk] = FTR(Kw, 136, 32 * kk, 16 * wave);
#pragma unroll
            for (int vi = 0; vi < 9; ++vi) {
#pragma unroll
                for (int r = 0; r < 4; ++r) accC[vi][r] *= ec;
                if (vi < 8) {
#pragma unroll
                    for (int kk = 0; kk < 2; ++kk) accC[vi] = mfma16(FTR(Vs, 136, 32 * kk, 16 * vi), bK[kk], accC[vi]); }
                else { int fr_ = fr; OPQV(fr_); const short o1 = (fr_ == 0) ? (short)0x3F80 : (short)0; const bf16x8 ones = {o1, o1, o1, o1, o1, o1, o1, o1};
#pragma unroll
                    for (int kk = 0; kk < 2; ++kk) accC[vi] = mfma16(ones, bK[kk], accC[vi]); }
                *(LAS u32x2*)(CbT + (16 * wave + fr) * 152 + 16 * vi + 4 * fq) = pack4(accC[vi][0], accC[vi][1], accC[vi][2], accC[vi][3]); } }
        LDS_BARRIER(); STG(5);
    }
#undef MLSTM_PREFETCH
#undef MLSTM_PREFETCH_MO
    float* Co = A.out + (sample ? O_SC : O_PC) + ((size_t)(l * NB + b) * 4 + h) * 16384; float* no = A.out + (sample ? O_SN : O_PN) + ((size_t)(l * NB + b) * 4 + h) * 128;
    { int fq_ = fq, cw_ = 16 * wave + fr; OPQV(fq_); OPQV(cw_);
      float* cp = Co + (4 * fq_) * 128 + cw_;
#pragma unroll
      for (int vi = 0; vi < 8; ++vi) {
#pragma unroll
        for (int r = 0; r < 4; ++r) cp[r * 128] = accC[vi][r];
        cp += 2048; OPQV(cp); }
      if (fq_ == 0) no[cw_] = accC[8][0]; }
    STG_FINI(h == 0 ? 0 : -1);
    if (tid == 0) A.out[(sample ? O_SM : O_PM) + (size_t)(l * NB + b) * 4 + h] = m_run;
    __syncthreads();
}

__device__ __forceinline__ void gla_item(ArgP Ap, LAS unsigned char* lds, int l, int b, int h, bool sample) {
    int tid_o = threadIdx.x; OPQV(tid_o);
    const int tid = tid_o, lane = tid & 63, wave = tid >> 6, fr = lane & 15, fq = lane >> 4;
    LAS bf16* QE = (LAS bf16*)(lds); LAS bf16* KE = (LAS bf16*)(lds + 9216); LAS bf16* KLs = (LAS bf16*)(lds + 18432); LAS bf16* Vs = (LAS bf16*)(lds + 27648);
    LAS bf16* ATT = (LAS bf16*)(lds + 45056); LAS bf16* STbT = (LAS bf16*)(lds + 54272); LAS float* Os = (LAS float*)(lds + 71680); LAS float* LAM = (LAS float*)(lds + 105472);
    LAS float* GA = (LAS float*)(lds + 122112); LAS float* GUP = (LAS float*)(lds + 126208); LAS float* GBI = (LAS float*)(lds + 130304); LAS float* GN = (LAS float*)(lds + 130560);
    const int L = sample ? LS : LP, tok0 = sample ? TP + b * LS : b * LP, NB = sample ? BS : BP;
    const bf16* ZM = (const bf16*)(A.ws + WS_ZM); const float* ZS = (const float*)(A.ws + WS_ZS); bf16* BR1 = (bf16*)(A.ws + WS_BR) + (size_t)T * 512;
    f32x4 accS[4];
#pragma unroll
    for (int ki = 0; ki < 4; ++ki) accS[ki] = (f32x4){0.f, 0.f, 0.f, 0.f};
    if (sample) { const float* S0 = A.in[5] + ((size_t)(l * BS + b) * 4 + h) * 8192;
        const float* sp = S0 + fr * 128 + 16 * wave + 4 * fq;
#pragma unroll
        for (int ki = 0; ki < 4; ++ki) {
#pragma unroll
            for (int r = 0; r < 4; ++r) accS[ki][r] = sp[r];
            sp += 2048; OPQV(sp); } }
#pragma unroll
    for (int ki = 0; ki < 4; ++ki) *(LAS u32x2*)(STbT + (16 * ki + fr) * 136 + 16 * wave + 4 * fq) = pack4(accS[ki][0], accS[ki][1], accS[ki][2], accS[ki][3]);
    for (int e = tid; e < 1024; e += NTHREADS) GUP[e] = A.in[12][(size_t)l * 16 * 256 + (e >> 6) * 256 + h * 64 + (e & 63)];
    if (tid < 64) GBI[tid] = A.in[13][l * 256 + h * 64 + tid];
    if (tid < 128) GN[tid] = A.in[14][l * 512 + h * 128 + tid];
    u32x4 pq, pk, pv[2], pg[2], pgn[2]; float pga[2];
#define GLA_PREFETCH(T0N) do { const int nvn_ = (L - (T0N)) < 64 ? (L - (T0N)) : 64; \
        { const int t = tid >> 3, cc = (tid & 7) * 8; pq = (u32x4){0u, 0u, 0u, 0u}; pk = pq; pgn[0] = pq; pgn[1] = pq; \
            if (t < nvn_) { const bf16* zr = ZM + (size_t)(tok0 + (T0N) + t) * NZM + 2048 + h * 64 + cc; pq = *(const u32x4*)zr; pk = *(const u32x4*)(zr + 256); \
                const bf16* gr = ZM + (size_t)(tok0 + (T0N) + t) * NZM + 3072 + h * 128 + 16 * (tid & 7); pgn[0] = *(const u32x4*)gr; pgn[1] = *(const u32x4*)(gr + 8); } } \
        _Pragma("unroll") for (int i = 0; i < 2; ++i) { const int c = tid + 512 * i, t = c >> 4, cc = (c & 15) * 8; pv[i] = (u32x4){0u, 0u, 0u, 0u}; \
            if (t < nvn_) pv[i] = *(const u32x4*)(ZM + (size_t)(tok0 + (T0N) + t) * NZM + 2560 + h * 128 + cc); \
            const int e = tid + 512 * i, te = e >> 4; pga[i] = (te < nvn_) ? ZS[(size_t)(tok0 + (T0N) + te) * NSM + 8 + (e & 15)] : 0.f; } } while (0)
    GLA_PREFETCH(0);
    __syncthreads();
    for (int t0 = 0; t0 < L; t0 += 64) {
        const int nv = (L - t0) < 64 ? (L - t0) : 64, nrt = (nv + 15) >> 4;
        pg[0] = pgn[0]; pg[1] = pgn[1];
        GA[tid] = pga[0]; GA[tid + 512] = pga[1];
        LDS_BARRIER();
#pragma unroll
        for (int i = 0; i < 8; ++i) { const int e = tid + 512 * i, t = e >> 6, k = e & 63; float x = GBI[k];
#pragma unroll
            for (int r = 0; r < 16; ++r) x += GA[t * 16 + r] * GUP[r * 64 + k];
            LAM[t * 65 + k] = (t < nv) ? logsig(x) * (1.0f / 16.0f) : 0.f; }
        LDS_BARRIER();
#pragma unroll
        for (int c = 0; c < 8; ++c) { const int k = 8 * wave + c; const float v = scan_sum64(LAM[lane * 65 + k], lane); LAM[lane * 65 + k] = v; }
        LDS_BARRIER();
        { const int t = tid >> 3, cc = (tid & 7) * 8; float q[8], k[8], qe[8], ke[8], kl[8]; unpack8(pq, q); unpack8(pk, k);
#pragma unroll
            for (int i = 0; i < 8; ++i) { const float lm = LAM[t * 65 + cc + i], ll = LAM[63 * 65 + cc + i]; qe[i] = q[i] * __expf(lm); ke[i] = k[i] * __expf(-lm); kl[i] = k[i] * __expf(ll - lm); }
            *(LAS u32x4*)(QE + t * 72 + cc) = pack8(qe); *(LAS u32x4*)(KE + t * 72 + cc) = pack8(ke); *(LAS u32x4*)(KLs + t * 72 + cc) = pack8(kl); }
#pragma unroll
        for (int i = 0; i < 2; ++i) { const int c = tid + 512 * i, t = c >> 4, cc = (c & 15) * 8; *(LAS u32x4*)(Vs + t * 136 + cc) = pv[i]; }
        GLA_PREFETCH(t0 + 64);
        LDS_BARRIER();
#pragma unroll
        for (int j = 0; j < 2; ++j) { const int idx = wave + 8 * j, ti = idx >> 2, si = idx & 3; f32x4 acc = {0.f, 0.f, 0.f, 0.f};
            if (ti >= nrt) continue;
            if (si <= ti) MMA_RR(acc, KE, 72, 16 * si, QE, 72, 16 * ti, 64);
            const int t = 16 * ti + fr; float v[4];
#pragma unroll
            for (int r = 0; r < 4; ++r) { const int s = 16 * si + 4 * fq + r; v[r] = (s <= t) ? acc[r] : 0.f; }
            *(LAS u32x2*)(ATT + t * 72 + 16 * si + 4 * fq) = pack4(v[0], v[1], v[2], v[3]); }
        LDS_BARRIER();
        { bf16x8 bS[2], bV[2];
#pragma unroll
          for (int kk = 0; kk < 2; ++kk) { bS[kk] = FTR(STbT, 136, 32 * kk, 16 * wave); bV[kk] = FTR(Vs, 136, 32 * kk, 16 * wave); }
#pragma unroll
          for (int ti = 0; ti < 4; ++ti) { if (ti >= nrt) continue; f32x4 acc = {0.f, 0.f, 0.f, 0.f};
#pragma unroll
            for (int kk = 0; kk < 2; ++kk) acc = mfma16(FROW(QE, 72, 16 * ti, 32 * kk), bS[kk], acc);
#pragma unroll
            for (int kk = 0; kk < 2; ++kk) acc = mfma16(FROW(ATT, 72, 16 * ti, 32 * kk), bV[kk], acc);
#pragma unroll
            for (int r = 0; r < 4; ++r) Os[(16 * ti + 4 * fq + r) * 132 + 16 * wave + fr] = acc[r] * 0.125f; } }
        LDS_BARRIER();
        { const int t = tid >> 3, part = tid & 7; float x[16]; float s2 = 0.f;
#pragma unroll
            for (int i = 0; i < 16; ++i) { x[i] = Os[t * 132 + 16 * part + i]; s2 += x[i] * x[i]; }
            s2 += __shfl_xor(s2, 1); s2 += __shfl_xor(s2, 2); s2 += __shfl_xor(s2, 4);
            const float rstd = 1.0f / sqrtf(s2 * (1.0f / 128.0f) + EPS_);
            if (t < nv) { const size_t tok = tok0 + t0 + t;
                float g0[8], g1[8]; unpack8(pg[0], g0); unpack8(pg[1], g1); float y0[8], y1[8];
#pragma unroll
                for (int i = 0; i < 8; ++i) { y0[i] = x[i] * rstd * GN[16 * part + i] * siluf(g0[i]); y1[i] = x[8 + i] * rstd * GN[16 * part + 8 + i] * siluf(g1[i]); }
                bf16* o = BR1 + tok * 512 + h * 128 + 16 * part; *(u32x4*)o = pack8(y0); *(u32x4*)(o + 8) = pack8(y1); } }
        { bf16x8 aV[2];
#pragma unroll
          for (int kk = 0; kk < 2; ++kk) aV[kk] = FTR(Vs, 136, 32 * kk, 16 * wave);
#pragma unroll
          for (int ki = 0; ki < 4; ++ki) { const float dec = __expf(LAM[63 * 65 + 16 * ki + fr]);
#pragma unroll
            for (int r = 0; r < 4; ++r) accS[ki][r] *= dec;
#pragma unroll
            for (int kk = 0; kk < 2; ++kk) accS[ki] = mfma16(aV[kk], FTR(KLs, 72, 32 * kk, 16 * ki), accS[ki]);
            *(LAS u32x2*)(STbT + (16 * ki + fr) * 136 + 16 * wave + 4 * fq) = pack4(accS[ki][0], accS[ki][1], accS[ki][2], accS[ki][3]); } }
        LDS_BARRIER();
    }
#undef GLA_PREFETCH
    float* So = A.out + (sample ? O_SG : O_PG) + ((size_t)(l * NB + b) * 4 + h) * 8192;
    { int o_ = fr * 128 + 16 * wave + 4 * fq; OPQV(o_); float* sp = So + o_;
#pragma unroll
      for (int ki = 0; ki < 4; ++ki) {
#pragma unroll
        for (int r = 0; r < 4; ++r) sp[r] = accS[ki][r];
        sp += 2048; OPQV(sp); } }
    __syncthreads();
}

__device__ __forceinline__ int ssd_chmap(int hd, int c) { const int g = hd >> 2; return c < 64 ? hd * 64 + c : (c < 128 ? 512 + g * 64 + (c - 64) : 640 + g * 64 + (c - 128)); }
__device__ __forceinline__ void ssd_item(ArgP Ap, LAS unsigned char* lds, int l, int b, int hd, bool sample) {
    int tid_o = threadIdx.x; OPQV(tid_o);
    const int tid = tid_o, lane = tid & 63, wave = tid >> 6, fr = lane & 15, fq = lane >> 4;
    LAS bf16* RAW = (LAS bf16*)(lds); LAS bf16* Ys = (LAS bf16*)(lds); LAS bf16* W = (LAS bf16*)(lds + 9216); LAS bf16* Bw = (LAS bf16*)(lds + 18432);
    LAS bf16* Xs = (LAS bf16*)(lds + 27648); LAS bf16* Cs = (LAS bf16*)(lds + 36864); LAS bf16* Bs = (LAS bf16*)(lds + 46080); LAS bf16* HbT = (LAS bf16*)(lds + 55296);
    LAS bf16* HIST = (LAS bf16*)(lds + 64512); LAS float* DT = (LAS float*)(lds + 65792); LAS float* LM = (LAS float*)(lds + 66048);
    LAS float* CW = (LAS float*)(lds + 66304); LAS float* CBI = CW + 4 * 192;
    const int L = sample ? LS : LP, tok0 = sample ? TP + b * LS : b * LP, NB = sample ? BS : BP;
    const bf16* ZM = (const bf16*)(A.ws + WS_ZM); const float* ZS = (const float*)(A.ws + WS_ZS); bf16* BR2 = (bf16*)(A.ws + WS_BR) + (size_t)T * 1024;
    const float Dh = A.in[19][l * 8 + hd], dtb = A.in[17][l * 8 + hd], Ah = -__expf(A.in[18][l * 8 + hd]);
    f32x4 accH[2];
#pragma unroll
    for (int j = 0; j < 2; ++j) { const int idx = wave + 8 * j, pi = idx >> 2, ni = idx & 3; accH[j] = (f32x4){0.f, 0.f, 0.f, 0.f};
        if (sample) { const float* h0 = A.in[6] + ((size_t)(l * BS + b) * 8 + hd) * 4096;
            const float* hp = h0 + (16 * pi + 4 * fq) * 64 + 16 * ni + fr; OPQV(hp);
#pragma unroll
            for (int r = 0; r < 4; ++r) accH[j][r] = hp[r * 64]; }
        *(LAS u32x2*)(HbT + (16 * ni + fr) * 72 + 16 * pi + 4 * fq) = pack4(accH[j][0], accH[j][1], accH[j][2], accH[j][3]); }
    for (int e = tid; e < 5 * 192; e += NTHREADS) { const int j = e / 192, c = e % 192, ch = ssd_chmap(hd, c); CW[e] = (j < 4) ? A.in[15][(size_t)l * 4 * 768 + j * 768 + ch] : A.in[16][l * 768 + ch]; }
    for (int e = tid; e < 3 * 200; e += NTHREADS) { const int r = e / 200, c = e % 200; float v = 0.f;
        if (sample && c < 192) v = A.in[7][((size_t)(l * BS + b) * 3 + r) * 768 + ssd_chmap(hd, c)];
        HIST[e] = f2bf(v); }
    u32x4 pr[3], ps; float pdt = 0.f;
#define SSD_PREFETCH(T0N) do { const int nvn_ = (L - (T0N)) < 64 ? (L - (T0N)) : 64; \
        _Pragma("unroll") for (int i = 0; i < 3; ++i) { const int c = tid + 512 * i, t = c / 24, q = c % 24; pr[i] = (u32x4){0u, 0u, 0u, 0u}; \
            if (t < nvn_) pr[i] = *(const u32x4*)(ZM + (size_t)(tok0 + (T0N) + t) * NZM + 4096 + ssd_chmap(hd, 8 * q)); } \
        if (wave == 0) { pdt = 0.f; if (lane < nvn_) pdt = ZS[(size_t)(tok0 + (T0N) + lane) * NSM + 24 + hd]; } } while (0)
#define SSD_PREFETCH_Z(T0N) do { const int nvn_ = (L - (T0N)) < 64 ? (L - (T0N)) : 64; const int t = tid >> 3, part = tid & 7; ps = (u32x4){0u, 0u, 0u, 0u}; \
        if (t < nvn_) ps = *(const u32x4*)(ZM + (size_t)(tok0 + (T0N) + t) * NZM + 3584 + hd * 64 + 8 * part); } while (0)
    SSD_PREFETCH(0); SSD_PREFETCH_Z(0);
    __syncthreads();
    for (int t0 = 0; t0 < L; t0 += 64) {
        const int nv = (L - t0) < 64 ? (L - t0) : 64, nrt = (nv + 15) >> 4;
#pragma unroll
        for (int i = 0; i < 3; ++i) { const int c = tid + 512 * i, t = c / 24, q = c % 24; *(LAS u32x4*)(RAW + (3 + t) * 200 + 8 * q) = pr[i]; }
        if (tid < 3 * 25) { const int r = tid / 25, q = tid % 25; *(LAS u32x4*)(RAW + r * 200 + 8 * q) = *(const LAS u32x4*)(HIST + r * 200 + 8 * q); }
        if (wave == 0) { const float dtv = (lane < nv) ? softplusf(pdt + dtb) : 0.f; const float lam = scan_sum64(dtv * Ah, lane); DT[lane] = dtv; LM[lane] = lam; }
        SSD_PREFETCH(t0 + 64);
        LDS_BARRIER();
#pragma unroll
        for (int i = 0; i < 3; ++i) { const int c = tid + 512 * i, t = c / 24, q = c % 24; float o[8];
#pragma unroll
            for (int e = 0; e < 8; ++e) o[e] = CBI[8 * q + e];
#pragma unroll
            for (int j = 0; j < 4; ++j) { float x[8]; unpack8(*(const LAS u32x4*)(RAW + (t + j) * 200 + 8 * q), x);
#pragma unroll
                for (int e = 0; e < 8; ++e) o[e] += CW[j * 192 + 8 * q + e] * x[e]; }
#pragma unroll
            for (int e = 0; e < 8; ++e) o[e] = (t < nv) ? siluf(o[e]) : 0.f;
            LAS bf16* dst = (q < 8) ? Xs + t * 72 + q * 8 : (q < 16 ? Bs + t * 72 + (q - 8) * 8 : Cs + t * 72 + (q - 16) * 8);
            *(LAS u32x4*)dst = pack8(o); }
        LDS_BARRIER();
        if (tid < 3 * 25) { const int r = tid / 25, q = tid % 25; *(LAS u32x4*)(HIST + r * 200 + 8 * q) = *(const LAS u32x4*)(RAW + (nv + r) * 200 + 8 * q); }
        f32x4 cbT[2];
#pragma unroll
        for (int j = 0; j < 2; ++j) { const int idx = wave + 8 * j, ti = idx >> 2, si = idx & 3; cbT[j] = (f32x4){0.f, 0.f, 0.f, 0.f};
            if (si <= ti && ti < nrt) MMA_RR(cbT[j], Bs, 72, 16 * si, Cs, 72, 16 * ti, 64); }
        LDS_BARRIER();
#pragma unroll
        for (int j = 0; j < 2; ++j) { const int idx = wave + 8 * j, ti = idx >> 2, si = idx & 3; const int t = 16 * ti + fr; const float lt = LM[t]; float v[4];
#pragma unroll
            for (int r = 0; r < 4; ++r) { const int s = 16 * si + 4 * fq + r; v[r] = (s <= t) ? cbT[j][r] * __expf(lt - LM[s]) * DT[s] : 0.f; }
            *(LAS u32x2*)(W + t * 72 + 16 * si + 4 * fq) = pack4(v[0], v[1], v[2], v[3]); }
        { const int s = tid >> 3, n0 = (tid & 7) * 8; float v[8]; unpack8(*(const LAS u32x4*)(Bs + s * 72 + n0), v); const float ws = __expf(LM[63] - LM[s]) * DT[s];
#pragma unroll
            for (int i = 0; i < 8; ++i) v[i] *= ws;
            *(LAS u32x4*)(Bw + s * 72 + n0) = pack8(v); }
        LDS_BARRIER();
        { const int pi = wave & 3; bf16x8 bH[2], bX[2];
#pragma unroll
          for (int kk = 0; kk < 2; ++kk) { bH[kk] = FTR(HbT, 72, 32 * kk, 16 * pi); bX[kk] = FTR(Xs, 72, 32 * kk, 16 * pi); }
#pragma unroll
          for (int j = 0; j < 2; ++j) { const int ti = (wave >> 2) + 2 * j; if (ti >= nrt) continue; f32x4 acc = {0.f, 0.f, 0.f, 0.f};
#pragma unroll
            for (int kk = 0; kk < 2; ++kk) acc = mfma16(FROW(Cs, 72, 16 * ti, 32 * kk), bH[kk], acc);
#pragma unroll
            for (int r = 0; r < 4; ++r) acc[r] *= __expf(LM[16 * ti + 4 * fq + r]);
#pragma unroll
            for (int kk = 0; kk < 2; ++kk) acc = mfma16(FROW(W, 72, 16 * ti, 32 * kk), bX[kk], acc);
#pragma unroll
            for (int r = 0; r < 4; ++r) { const int t = 16 * ti + 4 * fq + r, p = 16 * pi + fr; Ys[t * 72 + p] = f2bf(acc[r] + Dh * bf2f(Xs[t * 72 + p])); } } }
        { const float dec = __expf(LM[63]); const int ni = wave & 3; bf16x8 bB[2];
#pragma unroll
          for (int kk = 0; kk < 2; ++kk) bB[kk] = FTR(Bw, 72, 32 * kk, 16 * ni);
#pragma unroll
          for (int j = 0; j < 2; ++j) { const int pi = (wave >> 2) + 2 * j;
#pragma unroll
            for (int r = 0; r < 4; ++r) accH[j][r] *= dec;
#pragma unroll
            for (int kk = 0; kk < 2; ++kk) accH[j] = mfma16(FTR(Xs, 72, 32 * kk, 16 * pi), bB[kk], accH[j]); } }
        LDS_BARRIER();
#pragma unroll
        for (int j = 0; j < 2; ++j) { const int idx = wave + 8 * j, pi = idx >> 2, ni = idx & 3;
            *(LAS u32x2*)(HbT + (16 * ni + fr) * 72 + 16 * pi + 4 * fq) = pack4(accH[j][0], accH[j][1], accH[j][2], accH[j][3]); }
        { const int t = tid >> 3, part = tid & 7; float f[8], z[8]; unpack8(*(const LAS u32x4*)(Ys + t * 72 + 8 * part), f); unpack8(ps, z);
#pragma unroll
            for (int i = 0; i < 8; ++i) f[i] *= siluf(z[i]);
            if (t < nv) *(u32x4*)(BR2 + (size_t)(tok0 + t0 + t) * 512 + hd * 64 + 8 * part) = pack8(f); }
        SSD_PREFETCH_Z(t0 + 64);
        LDS_BARRIER();
    }
#undef SSD_PREFETCH_Z
#undef SSD_PREFETCH
    { float* ho = A.out + (sample ? O_SH : O_PH) + ((size_t)(l * NB + b) * 8 + hd) * 4096;
#pragma unroll
        for (int j = 0; j < 2; ++j) { const int idx = wave + 8 * j, pi = idx >> 2, ni = idx & 3;
            float* hp = ho + (16 * pi + 4 * fq) * 64 + 16 * ni + fr; OPQV(hp);
#pragma unroll
            for (int r = 0; r < 4; ++r) hp[r * 64] = accH[j][r]; } }
    for (int e = tid; e < 3 * 192; e += NTHREADS) { const int r = e / 192, c = e % 192;
        if (c < 64 || (hd & 3) == 0) A.out[(sample ? O_SV : O_PV) + ((size_t)(l * NB + b) * 3 + r) * 768 + ssd_chmap(hd, c)] = bf2f(HIST[r * 200 + c]); }
    __syncthreads();
}

__device__ __forceinline__ void phase_ssdnorm(ArgP Ap, int l) {
    const int tx = opaque_tid(), lane = tx & 63, wave = tx >> 6, gw = blockIdx.x * NWAVES + wave, NGW = gridDim.x * NWAVES;
    bf16* BR2 = (bf16*)(A.ws + WS_BR) + (size_t)T * 1024; const float* sn = A.in[20] + l * 512 + 8 * lane;
    for (int tok = gw; tok < T; tok += NGW) { float f[8]; unpack8(*(const u32x4*)(BR2 + (size_t)tok * 512 + 8 * lane), f); float s2 = 0.f;
#pragma unroll
        for (int i = 0; i < 8; ++i) s2 += f[i] * f[i];
#pragma unroll
        for (int m = 1; m < 32; m <<= 1) s2 += __shfl_xor(s2, m);
        const float rstd = 1.0f / sqrtf(s2 * (1.0f / 256.0f) + EPS_);
#pragma unroll
        for (int i = 0; i < 8; ++i) f[i] *= rstd * sn[i];
        *(u32x4*)(BR2 + (size_t)tok * 512 + 8 * lane) = pack8(f); }
}

__device__ __forceinline__ void mixer_item(ArgP Ap, LAS unsigned char* lds, int l, int it) {
    constexpr int NL0 = BP * 4, NL1 = NL0 + BP * 4, NL2 = NL1 + BP * 8, NS0 = NL2 + BS * 4, NS1 = NS0 + BS * 4;
    int kind, r; bool sample;
    if (it < NL0) { kind = 0; r = it; sample = false; } else if (it < NL1) { kind = 1; r = it - NL0; sample = false; } else if (it < NL2) { kind = 2; r = it - NL1; sample = false; }
    else if (it < NS0) { kind = 0; r = it - NL2; sample = true; } else if (it < NS1) { kind = 1; r = it - NS0; sample = true; } else { kind = 2; r = it - NS1; sample = true; }
#ifndef ONLYK
#define ONLYK -1
#endif
#ifndef EMU
#define OPQ() ArgP Ap_ = Ap; int l_ = __builtin_amdgcn_readfirstlane(l), r_ = __builtin_amdgcn_readfirstlane(r); LAS unsigned char* lds_ = lds; asm volatile("" : "+s"(Ap_), "+s"(l_), "+s"(r_), "+s"(lds_) :: "memory")
#else
#define OPQ() ArgP Ap_ = Ap; int l_ = l, r_ = r; LAS unsigned char* lds_ = lds
#endif
    if ((ONLYK < 0 || ONLYK == 0) && kind == 0) { OPQ(); mlstm_item(Ap_, lds_, l_, r_ >> 2, r_ & 3, sample); }
    else if ((ONLYK < 0 || ONLYK == 1) && kind == 1) { OPQ(); gla_item(Ap_, lds_, l_, r_ >> 2, r_ & 3, sample); }
    else if ((ONLYK < 0 || ONLYK == 2) && kind == 2) { OPQ(); ssd_item(Ap_, lds_, l_, r_ >> 3, r_ & 7, sample); }
#undef OPQ
}
__device__ __forceinline__ void phase_mixers(ArgP Ap, LAS unsigned char* lds, int l) {
    constexpr int NLONG = BP * 16, NSHORT = BS * 16; int G = gridDim.x, bid = blockIdx.x; OPQS(G); OPQS(bid);
#ifdef MIX_NOSPLIT
    const bool split = false;
#else
    const bool split = G > NLONG;
#endif
#ifndef MIX_IDLE
#define MIX_IDLE 0
#endif
    const int step = split ? (bid < NLONG ? (1 << 28) : G - NLONG - MIX_IDLE) : G;
    if (split && MIX_IDLE && bid >= G - MIX_IDLE) return;
#ifndef MIXREP
#define MIXREP 0
#endif
#pragma unroll 1
    for (int it = bid; it < NLONG + NSHORT; it += step) {
        const int reps = ((MIXREP == 1 && it < NLONG) || (MIXREP == 2 && it >= NLONG) || (MIXREP == 3 && it < BP * 4) || (MIXREP == 4 && it >= BP * 4 && it < BP * 8) || (MIXREP == 5 && it >= BP * 8 && it < NLONG)) ? 2 : 1;
#pragma unroll 1
        for (int rp = 0; rp < reps; ++rp) mixer_item(Ap, lds, l, it);
    }
}

__device__ __forceinline__ float wave_sum64(float v) {
#pragma unroll
    for (int m = 1; m < 64; m <<= 1) v += __shfl_xor(v, m);
    return v;
}
constexpr float DN_ALPHA_ = 1.4142135623730951f;

__device__ __forceinline__ void phase_ln1(ArgP Ap, int l) {
    const int tx = opaque_tid(), lane = tx & 63, wave = tx >> 6, gw = blockIdx.x * NWAVES + wave, NGW = gridDim.x * NWAVES;
    const float* Y = (const float*)(A.ws + WS_ZG); float* H = (float*)(A.ws + WS_H); bf16* H1B = (bf16*)(A.ws + WS_BR);
    const float* lg = A.in[23] + l * D + 16 * lane; const float* lb = A.in[24] + l * D + 16 * lane;
    for (int tok = gw; tok < T; tok += NGW) {
        const float* xr = (l == 0) ? (tok < TP ? A.in[0] + (size_t)tok * D : A.in[1] + (size_t)(tok - TP) * D) : H + (size_t)tok * D;
        float y[16]; float s1 = 0.f;
#pragma unroll
        for (int q = 0; q < 4; ++q) { const float4 a = *(const float4*)(xr + 16 * lane + 4 * q), b = *(const float4*)(Y + (size_t)tok * D + 16 * lane + 4 * q);
            y[4 * q] = DN_ALPHA_ * a.x + b.x; y[4 * q + 1] = DN_ALPHA_ * a.y + b.y; y[4 * q + 2] = DN_ALPHA_ * a.z + b.z; y[4 * q + 3] = DN_ALPHA_ * a.w + b.w; }
#pragma unroll
        for (int i = 0; i < 16; ++i) s1 += y[i];
        const float mu = wave_sum64(s1) * (1.0f / D); float s2 = 0.f;
#pragma unroll
        for (int i = 0; i < 16; ++i) { y[i] -= mu; s2 += y[i] * y[i]; }
        const float rstd = 1.0f / sqrtf(wave_sum64(s2) * (1.0f / D) + EPS_);
#pragma unroll
        for (int i = 0; i < 16; ++i) y[i] = y[i] * rstd * lg[i] + lb[i];
#pragma unroll
        for (int q = 0; q < 4; ++q) *(float4*)(H + (size_t)tok * D + 16 * lane + 4 * q) = make_float4(y[4 * q], y[4 * q + 1], y[4 * q + 2], y[4 * q + 3]);
        float y0[8], y1[8];
#pragma unroll
        for (int i = 0; i < 8; ++i) { y0[i] = y[i]; y1[i] = y[8 + i]; }
        *(u32x4*)(H1B + (size_t)tok * D + 16 * lane) = pack8(y0); *(u32x4*)(H1B + (size_t)tok * D + 16 * lane + 8) = pack8(y1);
    }
    for (int r2 = gw; r2 < 2 * NEXP; r2 += NGW) { const int tab = r2 >= NEXP, row = r2 - tab * NEXP;
        const float* src = A.in[27 + tab] + ((size_t)l * NEXP + row) * D + 16 * lane; float v[16]; float mx = 0.f;
#pragma unroll
        for (int q = 0; q < 4; ++q) { const float4 a = *(const float4*)(src + 4 * q); v[4 * q] = a.x; v[4 * q + 1] = a.y; v[4 * q + 2] = a.z; v[4 * q + 3] = a.w; }
#pragma unroll
        for (int i = 0; i < 16; ++i) mx = fmaxf(mx, fabsf(v[i]));
#pragma unroll
        for (int m = 1; m < 64; m <<= 1) mx = fmaxf(mx, __shfl_xor(mx, m));
        const float sc = (mx > 0.f) ? exp2f(floorf(log2f(224.0f / mx))) : 1.0f;
        u32x4 w; w.x = pk_fp8x4(v[0] * sc, v[1] * sc, v[2] * sc, v[3] * sc); w.y = pk_fp8x4(v[4] * sc, v[5] * sc, v[6] * sc, v[7] * sc);
        w.z = pk_fp8x4(v[8] * sc, v[9] * sc, v[10] * sc, v[11] * sc); w.w = pk_fp8x4(v[12] * sc, v[13] * sc, v[14] * sc, v[15] * sc);
        *(u32x4*)(A.ws + (tab ? WS_PV : WS_PU) + (size_t)row * D + 16 * lane) = w;
        if (lane == 0) ((float*)(A.ws + (tab ? WS_PVS : WS_PUS)))[row] = 1.0f / sc; }
}

__device__ __forceinline__ unsigned ord_of(float f) { const unsigned u = __float_as_uint(f); return (u & 0x80000000u) ? ~u : (u | 0x80000000u); }
__device__ __forceinline__ float dec_ord(unsigned o) { const unsigned u = (o & 0x80000000u) ? (o & 0x7fffffffu) : ~o; return __uint_as_float(u); }
__device__ __forceinline__ unsigned umax_(unsigned a, unsigned b) { return a > b ? a : b; }
__device__ __forceinline__ unsigned umin_(unsigned a, unsigned b) { return a < b ? a : b; }
__device__ __forceinline__ void ins16(unsigned (&L)[16], unsigned x) {
#pragma unroll
    for (int p = 0; p < 16; ++p) { const unsigned hi = umax_(L[p], x); x = umin_(L[p], x); L[p] = hi; }
}
__device__ __forceinline__ unsigned sel16(const unsigned (&L)[16], int a) { unsigned r = L[0];
#pragma unroll
    for (int p = 1; p < 16; ++p) r = (a == p) ? L[p] : r;
    return r; }

__device__ __forceinline__ void route_topk(const bf16* __restrict__ Q, const LAS bf16* KEYS, int tokb, int h, int j, int fr, int fq, unsigned (&Lt)[16]) {
    f32x4 acc[8];
#pragma unroll
    for (int ki = 0; ki < 8; ++ki) acc[ki] = (f32x4){0.f, 0.f, 0.f, 0.f};
#pragma unroll
    for (int kk = 0; kk < 4; ++kk) { const bf16x8 bq = *(const bf16x8*)(Q + (size_t)(tokb + fr) * 2048 + h * 256 + j * 128 + 32 * kk + 8 * fq);
#pragma unroll
        for (int ki = 0; ki < 8; ++ki) { const bf16x8 ak = *(const LAS bf16x8*)(KEYS + (j * 128 + 16 * ki + fr) * 136 + 32 * kk + 8 * fq); acc[ki] = mfma16(ak, bq, acc[ki]); } }
#pragma unroll
    for (int p = 0; p < 16; ++p) Lt[p] = 0u;
#pragma unroll
    for (int ki = 0; ki < 8; ++ki)
#pragma unroll
        for (int r = 0; r < 4; ++r) ins16(Lt, (ord_of(acc[ki][r]) & ~127u) | (unsigned)(127 - (16 * ki + 4 * fq + r)));
#pragma unroll
    for (int m = 16; m < 64; m <<= 1) { unsigned R[16];
#pragma unroll
        for (int p = 0; p < 16; ++p) R[p] = __shfl_xor(Lt[p], m);
#pragma unroll
        for (int p = 0; p < 16; ++p) ins16(Lt, R[p]); }
}

__device__ __forceinline__ void phase_route(ArgP Ap, LAS unsigned char* lds, int l) {
    const int tid = opaque_tid(), lane = tid & 63, wave = tid >> 6, fr = lane & 15, fq = lane >> 4;
    LAS bf16* KEYS = (LAS bf16*)lds;
    LAS unsigned* LST = (LAS unsigned*)(lds + 69632);
    const bf16* Q = (const bf16*)(A.ws + WS_Q); int* IDX = (int*)(A.ws + WS_IDX); float* GT = (float*)(A.ws + WS_GT);
    const bf16* kg = (const bf16*)(A.ws + WS_WB + (size_t)l * WB_BYTES + WB_KEYS);
    constexpr int NG = T / 16, NCH = (NG + 7) / 8, NITEMS = NCH * 8;
    int last_h = -1;
    for (int it = blockIdx.x; it < NITEMS; it += gridDim.x) {
        const int h = it & 7, ch = it >> 3;
        if (h != last_h) { __syncthreads();
            for (int c = tid; c < 2 * 128 * 16; c += NTHREADS) { const int row = c >> 4, cc = (c & 15) * 8; *(LAS u32x4*)(KEYS + row * 136 + cc) = *(const u32x4*)(kg + ((size_t)h * 256 + row) * 128 + cc); }
            __syncthreads(); last_h = h; }
        const int grp = ch * 8 + wave;
        if (grp < NG) {
            const int tokb = grp * 16; unsigned L1[16], L2[16];
            route_topk(Q, KEYS, tokb, h, 0, fr, fq, L1); route_topk(Q, KEYS, tokb, h, 1, fr, fq, L2);
            unsigned C[16];
#pragma unroll
            for (int p = 0; p < 16; ++p) C[p] = 0u;
#pragma unroll
            for (int a = 0; a < 16; ++a)
#pragma unroll
                for (int b = 0; b < 16; ++b) if ((a + 1) * (b + 1) <= 16) {
                    const float s = dec_ord(L1[a] & ~127u) + dec_ord(L2[b] & ~127u); ins16(C, (ord_of(s) & ~255u) | (unsigned)(255 - (a * 16 + b))); }
            const float s0 = dec_ord(C[0] & ~255u); float e[16]; float sum = 0.f;
#pragma unroll
            for (int p = 0; p < 16; ++p) { e[p] = __expf(dec_ord(C[p] & ~255u) - s0); sum += e[p]; }
            const float inv = 1.0f / sum; const size_t ob = (size_t)(tokb + fr) * 128 + h * 16;
#pragma unroll
            for (int p = 0; p < 16; ++p) { LST[(wave * 32 + p) * 64 + lane] = L1[p]; LST[(wave * 32 + 16 + p) * 64 + lane] = L2[p]; }
#pragma unroll
            for (int p = 0; p < 16; ++p) { const int cid = 255 - (int)(C[p] & 255u); const int a = cid >> 4, b = cid & 15;
                const int e1 = 127 - (int)(LST[(wave * 32 + a) * 64 + lane] & 127u), e2 = 127 - (int)(LST[(wave * 32 + 16 + b) * 64 + lane] & 127u);
                if ((p >> 2) == fq) { IDX[ob + p] = e1 * 128 + e2; GT[ob + p] = e[p] * inv; } }
        }
    }
}

__device__ __forceinline__ void phase_gather(ArgP Ap, int l) {
    const int tx = opaque_tid(), lane = tx & 63, wave = tx >> 6, gw = blockIdx.x * NWAVES + wave, NGW = gridDim.x * NWAVES, rho = lane >> 4;
    float* H = (float*)(A.ws + WS_H); bf16* XB = (bf16*)(A.ws + WS_XB); const int* IDX = (const int*)(A.ws + WS_IDX); const float* GT = (const float*)(A.ws + WS_GT);
    const unsigned char* PU = A.ws + WS_PU; const unsigned char* PV = A.ws + WS_PV; const float* PUS = (const float*)(A.ws + WS_PUS); const float* PVS = (const float*)(A.ws + WS_PVS);
    const float* lgb = A.in[29] + l * D; const float* lbb = A.in[30] + l * D; const int l16 = 16 * lane;
    const int kofs = 2 * (rho & 1) + (rho >> 1);
    for (int tok = gw; tok < T; tok += NGW) {
        const int i0 = IDX[(size_t)tok * 128 + lane], i1 = IDX[(size_t)tok * 128 + 64 + lane];
        float x[16];
#pragma unroll
        for (int q = 0; q < 4; ++q) { const float4 a = *(const float4*)(H + (unsigned)tok * D + l16 + 4 * q); x[4 * q] = a.x; x[4 * q + 1] = a.y; x[4 * q + 2] = a.z; x[4 * q + 3] = a.w; }
        const float su0 = PUS[i0], su1 = PUS[i1];
        const float gv0 = GT[(size_t)tok * 128 + lane] * PVS[i0], gv1 = GT[(size_t)tok * 128 + 64 + lane] * PVS[i1];
        float o[16];
#pragma unroll
        for (int i = 0; i < 16; ++i) o[i] = 0.f;
#pragma unroll 1
        for (int kb = 0; kb < 128; kb += 8) {
            u32x4 uu[8], vv[8];
#pragma unroll
            for (int kk = 0; kk < 8; ++kk) { const int e = __shfl(kb < 64 ? i0 : i1, (kb + kk) & 63);
                const unsigned off = (unsigned)e * D + l16; uu[kk] = *(const u32x4*)(PU + off); vv[kk] = *(const u32x4*)(PV + off); }
            float r[2];
#pragma unroll
            for (int i = 0; i < 2; ++i) { float p[4];
#pragma unroll
                for (int c = 0; c < 4; ++c) { const int kk = 4 * i + c; float f[16]; unpk_fp8x4(uu[kk].x, f); unpk_fp8x4(uu[kk].y, f + 4); unpk_fp8x4(uu[kk].z, f + 8); unpk_fp8x4(uu[kk].w, f + 12); float s = 0.f;
#pragma unroll
                    for (int j = 0; j < 16; ++j) s += f[j] * x[j];
                    p[c] = s; SCHED_FENCE(); }
                float t = row_allsum(swap16_add(swap32_add(p[0], p[1]), swap32_add(p[2], p[3])));
                const int kq = kb + 4 * i + kofs;
                t *= __shfl(kb < 64 ? su0 : su1, kq & 63);
                r[i] = 0.5f * t * (1.0f + erff(t * 0.70710678118654752f)) * __shfl(kb < 64 ? gv0 : gv1, kq & 63); SCHED_FENCE(); }
#pragma unroll
            for (int kk = 0; kk < 8; ++kk) { const int c = kk & 3; const float act = RDLANE(r[kk >> 2], 16 * (((c & 1) << 1) | ((c >> 1) & 1)));
                float f[16]; unpk_fp8x4(vv[kk].x, f); unpk_fp8x4(vv[kk].y, f + 4); unpk_fp8x4(vv[kk].z, f + 8); unpk_fp8x4(vv[kk].w, f + 12);
#pragma unroll
                for (int j = 0; j < 16; ++j) o[j] += act * f[j];
                SCHED_FENCE(); }
        }
        float s1 = 0.f;
#pragma unroll
        for (int i = 0; i < 16; ++i) { o[i] += DN_ALPHA_ * x[i]; s1 += o[i]; }
        const float mu = wave_sum64(s1) * (1.0f / D); float s2 = 0.f;
#pragma unroll
        for (int i = 0; i < 16; ++i) { o[i] -= mu; s2 += o[i] * o[i]; }
        const float rstd = 1.0f / sqrtf(wave_sum64(s2) * (1.0f / D) + EPS_);
#pragma unroll
        for (int i = 0; i < 16; ++i) o[i] = o[i] * rstd * lgb[l16 + i] + lbb[l16 + i];
        float* dst = ((l == 1) ? A.out : H) + (unsigned)tok * D + l16;
#pragma unroll
        for (int q = 0; q < 4; ++q) *(float4*)(dst + 4 * q) = make_float4(o[4 * q], o[4 * q + 1], o[4 * q + 2], o[4 * q + 3]);
        if (l == 0) { float y0[8], y1[8];
#pragma unroll
            for (int i = 0; i < 8; ++i) { y0[i] = o[i]; y1[i] = o[8 + i]; }
            *(u32x4*)(XB + (unsigned)tok * D + l16) = pack8(y0); *(u32x4*)(XB + (unsigned)tok * D + l16 + 8) = pack8(y1); }
    }
}

#ifndef EMU
struct MergeOrder {
    pg8::StaticOrder S;
    __device__ bool next(int i, pg8::Unit& u) const { pg8::Unit t; if (!S.next(i, t)) return false; const int n = t.pm / (T / 256); u.pm = t.pm; u.pn = n * 4 + t.pn; return true; }
    __device__ __forceinline__ void a_ready(const pg8::Unit&) const {}
    __device__ __forceinline__ void done(const pg8::Unit&) const {}
};
struct EpiP {
    static constexpr bool PERM = true, AFTER_DRAIN = false;
    bf16* P;
    __device__ __forceinline__ void operator()(const pg8::f32x4 (&acc)[2][2][4][2], const pg8::Unit& u, int wr, int wc, int fr, int fq) const {
        const int row0 = u.pm * 256 + wr * 64 + fr, col0 = (u.pn & 3) * 256 + wc * 32 + 8 * fq;
#pragma unroll
        for (int ai = 0; ai < 2; ++ai)
#pragma unroll
            for (int m = 0; m < 4; ++m) { bf16* rowp = P + (size_t)(row0 + ai * 128 + m * 16) * D + col0;
#pragma unroll
                for (int bj = 0; bj < 2; ++bj) { const pg8::f32x4 v0 = acc[ai][bj][m][0], v1 = acc[ai][bj][m][1];
                    u32x4 w; w.x = pg8::cvt_pk_bf16(v0[0], v0[1]); w.y = pg8::cvt_pk_bf16(v0[2], v0[3]); w.z = pg8::cvt_pk_bf16(v1[0], v1[1]); w.w = pg8::cvt_pk_bf16(v1[2], v1[3]);
                    *(u32x4*)(rowp + bj * 128) = w; } }
    }
};
__device__ __forceinline__ void phase_merge(ArgP Ap, LAS unsigned char* lds, int l) {
    pg8::Gemm g{(const bf16*)(A.ws + WS_BR), (const bf16*)(A.ws + WS_WB + (size_t)l * WB_BYTES + WB_WBR), 3 * T, 3 * D, 512};
    MergeOrder S; S.S.init(3 * T, D, gridDim.x, blockIdx.x);
    EpiP E{(bf16*)(A.ws + WS_ZM)};
    pg8::gemm_phase<EpiP, MergeOrder>(lds, g, S, E);
}
#endif
__device__ __forceinline__ void phase_combine(ArgP Ap) {
    const size_t gtid = (size_t)blockIdx.x * NTHREADS + opaque_tid(), gthreads = (size_t)gridDim.x * NTHREADS;
    const bf16* P = (const bf16*)(A.ws + WS_ZM); const bf16* ZG = (const bf16*)(A.ws + WS_ZG); bf16* MIXED = (bf16*)(A.ws + WS_XB);
    for (size_t i = gtid; i < (size_t)T * (D / 8); i += gthreads) { const size_t t = i >> 7, c = (i & 127) * 8; float v[8];
#pragma unroll
        for (int j = 0; j < 8; ++j) v[j] = 0.f;
#pragma unroll
        for (int n = 0; n < 3; ++n) { float p[8], g[8]; unpack8(*(const u32x4*)(P + ((size_t)n * T + t) * D + c), p); unpack8(*(const u32x4*)(ZG + t * NZG + n * D + c), g);
#pragma unroll
            for (int j = 0; j < 8; ++j) v[j] += p[j] * g[j]; }
        *(u32x4*)(MIXED + t * D + c) = pack8(v); }
}
#ifndef EMU
struct EpiF32 {
    static constexpr bool PERM = false, AFTER_DRAIN = false;
    float* C; int ldc;
    __device__ __forceinline__ void operator()(const pg8::f32x4 (&acc)[2][2][4][2], const pg8::Unit& u, int wr, int wc, int fr, int fq) const {
        const int row0 = u.pm * 256 + wr * 64 + fr, col0 = u.pn * 256 + wc * 32 + 4 * fq;
#pragma unroll
        for (int ai = 0; ai < 2; ++ai)
#pragma unroll
            for (int m = 0; m < 4; ++m) { float* rowp = C + (size_t)(row0 + ai * 128 + m * 16) * ldc + col0;
#pragma unroll
                for (int bj = 0; bj < 2; ++bj)
#pragma unroll
                    for (int n = 0; n < 2; ++n) *(pg8::f32x4*)(rowp + bj * 128 + n * 16) = acc[ai][bj][m][n]; }
    }
};
struct EpiB16 {
    static constexpr bool PERM = true, AFTER_DRAIN = false;
    bf16* O; int ldc;
    __device__ __forceinline__ void operator()(const pg8::f32x4 (&acc)[2][2][4][2], const pg8::Unit& u, int wr, int wc, int fr, int fq) const {
        const int row0 = u.pm * 256 + wr * 64 + fr, col0 = u.pn * 256 + wc * 32 + 8 * fq;
#pragma unroll
        for (int ai = 0; ai < 2; ++ai)
#pragma unroll
            for (int m = 0; m < 4; ++m) { bf16* rowp = O + (size_t)(row0 + ai * 128 + m * 16) * ldc + col0;
#pragma unroll
                for (int bj = 0; bj < 2; ++bj) { const pg8::f32x4 v0 = acc[ai][bj][m][0], v1 = acc[ai][bj][m][1];
                    u32x4 w; w.x = pg8::cvt_pk_bf16(v0[0], v0[1]); w.y = pg8::cvt_pk_bf16(v0[2], v0[3]); w.z = pg8::cvt_pk_bf16(v1[0], v1[1]); w.w = pg8::cvt_pk_bf16(v1[2], v1[3]);
                    *(u32x4*)(rowp + bj * 128) = w; } }
    }
};
__device__ __forceinline__ void phase_outproj(ArgP Ap, LAS unsigned char* lds, int l) {
    pg8::Gemm g{(const bf16*)(A.ws + WS_XB), (const bf16*)(A.ws + WS_WB + (size_t)l * WB_BYTES + WB_WO), T, D, D};
    pg8::StaticOrder S; S.init(T, D, gridDim.x, blockIdx.x);
    EpiF32 E{(float*)(A.ws + WS_ZG), D};
    pg8::gemm_phase<EpiF32, pg8::StaticOrder>(lds, g, S, E);
}
__device__ __forceinline__ void phase_qproj(ArgP Ap, LAS unsigned char* lds, int l) {
    pg8::Gemm g{(const bf16*)(A.ws + WS_BR), (const bf16*)(A.ws + WS_WB + (size_t)l * WB_BYTES + WB_WQ), T, 2048, D};
    pg8::StaticOrder S; S.init(T, 2048, gridDim.x, blockIdx.x);
    EpiB16 E{(bf16*)(A.ws + WS_Q), 2048};
    pg8::gemm_phase<EpiB16, pg8::StaticOrder>(lds, g, S, E);
}

__global__ void __launch_bounds__(NTHREADS, 2) mega_fwd(Args kargs) {
    extern __shared__ __attribute__((aligned(16))) unsigned char lds_raw[];
    LAS unsigned char* lds = (LAS unsigned char*)lds_raw;
    volatile LAS unsigned* xst = (volatile LAS unsigned*)(lds + LDS_BYTES - 16);
    unsigned* xbar = (unsigned*)(kargs.ws + WS_CTL);
    if (threadIdx.x < 4) xst[threadIdx.x] = 0u;
    if (blockIdx.x == 0) for (int i = threadIdx.x; i < XCD_BAR_WORDS; i += NTHREADS) xbar[i] = 0u;
#ifdef STAGE_AMP
    if (blockIdx.x == 0 && threadIdx.x < 128) ((unsigned long long*)(kargs.ws + WS_CTL + 40960))[threadIdx.x] = 0ull;
#endif
    __syncthreads();
    XcdBarrier xb; xb.bar = xbar; xb.x = 0; xb.st = xst;
    ArgP Ap = (ArgP)__builtin_amdgcn_kernarg_segment_ptr();
#define RUN(call) do { ArgP Ap_ = Ap; int l_ = l; LAS unsigned char* lds_ = lds; asm volatile("" : "+s"(Ap_), "+s"(l_), "+s"(lds_) :: "memory"); { ArgP Ap = Ap_; const int l = l_; LAS unsigned char* lds = lds_; (void)lds; call; } asm volatile("" ::: "memory"); } while (0)
#ifndef ONLYP
#define ONLYP -1
#endif
#ifndef SKIPP
#define SKIPP -2
#endif
#define PSEL(q) ((ONLYP < 0 || ONLYP == (q)) && SKIPP != (q))
#ifndef REPMASK
#define REPMASK 0
#endif
#define REP(q, l) (((REPMASK >> (q)) & 1) && ((q) != 5 || (l) == 0) && ((q) != 8 || (l) == 1))
#define IN(k) true
#ifdef AMP_PHASE
#define TSTAMP(k) do { if (blockIdx.x == 0 && threadIdx.x == 0) ((unsigned long long*)(kargs.ws + WS_CTL + 32768))[(k)] = __builtin_amdgcn_s_memrealtime(); } while (0)
#else
#define TSTAMP(k) do {} while (0)
#endif
#define SEAM(k) do { if ((k) == 0) { cg::this_grid().sync(); xb = xcd_barrier_post(xbar, xst); } else xcd_barrier(xb); TSTAMP((k) + 1); } while (0)
#pragma unroll 1
    TSTAMP(0);
    {
    { const int l = 0; if (PSEL(0) && IN(0)) { RUN(phase_convert(Ap, lds)); if (REP(0, l)) RUN(phase_convert(Ap, lds)); } (void)l; }
    SEAM(0);
    for (int l = 0; l < 2; ++l) {
        const int p = 1 + 10 * l;
        if (PSEL(1) && IN(p + 0)) { RUN(phase_gemm1(Ap, lds, l)); if (REP(1, l)) RUN(phase_gemm1(Ap, lds, l)); }
        SEAM(p);
        if (PSEL(2) && IN(p + 1)) { RUN(phase_mixers(Ap, lds, l)); if (REP(2, l)) RUN(phase_mixers(Ap, lds, l)); }
        SEAM(p + 1);
#ifdef XBAR_EXTRA
        for (int xe = 0; xe < XBAR_EXTRA; ++xe) xcd_barrier(xb);
#endif
        if (PSEL(9) && IN(p + 2)) RUN(phase_ssdnorm(Ap, l));
        SEAM(p + 2);
        if (PSEL(3) && IN(p + 3)) { RUN(phase_merge(Ap, lds, l)); if (REP(3, l)) RUN(phase_merge(Ap, lds, l)); }
        SEAM(p + 3);
        if (PSEL(10) && IN(p + 4)) RUN(phase_combine(Ap));
        SEAM(p + 4);
        if (PSEL(4) && IN(p + 5)) { RUN(phase_outproj(Ap, lds, l)); if (REP(4, l)) RUN(phase_outproj(Ap, lds, l)); }
        SEAM(p + 5);
        if (PSEL(5) && IN(p + 6)) { RUN(phase_ln1(Ap, l)); if (REP(5, l)) RUN(phase_ln1(Ap, l)); }
        SEAM(p + 6);
        if (PSEL(6) && IN(p + 7)) { RUN(phase_qproj(Ap, lds, l)); if (REP(6, l)) RUN(phase_qproj(Ap, lds, l)); }
        SEAM(p + 7);
        if (PSEL(7) && IN(p + 8)) { RUN(phase_route(Ap, lds, l)); if (REP(7, l)) RUN(phase_route(Ap, lds, l)); }
        SEAM(p + 8);
        if (PSEL(8) && IN(p + 9)) { RUN(phase_gather(Ap, l)); if (REP(8, l)) RUN(phase_gather(Ap, l)); }
        SEAM(p + 9);
    }
    }
#ifdef AMP_PHASE
    if (blockIdx.x == 0 && threadIdx.x == 0) { const unsigned long long* ts = (const unsigned long long*)(kargs.ws + WS_CTL + 32768);
        const unsigned long long dt = (ts[AMP_PHASE + 1] - ts[AMP_PHASE]) * 8ull, t0 = __builtin_amdgcn_s_memrealtime();
        while (__builtin_amdgcn_s_memrealtime() - t0 < dt) __builtin_amdgcn_s_sleep(8); }
#endif
#ifdef STAGE_AMP
    if (blockIdx.x == 0 && threadIdx.x == 0) { const unsigned long long dt = ((const unsigned long long*)(kargs.ws + WS_CTL + 40960))[STAGE_AMP] * 8ull, t0 = __builtin_amdgcn_s_memrealtime();
        while (__builtin_amdgcn_s_memrealtime() - t0 < dt) __builtin_amdgcn_s_sleep(8); }
#endif
#undef IN
#undef RUN
#undef SEAM
}

extern "C" void kernel_launch(void* const* d_in, const int* in_sizes, int n_in, void* d_out, int out_size, void* d_ws, size_t ws_size, hipStream_t stream) {
    static int grid_blocks = 0;
    if (grid_blocks == 0) {
        if (n_in != 31 || (size_t)out_size != O_END || ws_size < WS_END) {
            fprintf(stderr, "kernel_launch: unexpected problem: n_in %d out %d (want %zu) ws %zu (want >= %zu)\n", n_in, out_size, (size_t)O_END, ws_size, (size_t)WS_END); grid_blocks = -1; return; }
        int dev = 0, cus = 0, per_cu = 0;
        (void)hipGetDevice(&dev); (void)hipDeviceGetAttribute(&cus, hipDeviceAttributeMultiprocessorCount, dev);
        if (hipFuncSetAttribute((const void*)mega_fwd, hipFuncAttributeMaxDynamicSharedMemorySize, LDS_BYTES) != hipSuccess) { fprintf(stderr, "kernel_launch: hipFuncSetAttribute failed\n"); grid_blocks = -1; return; }
        if (hipOccupancyMaxActiveBlocksPerMultiprocessor(&per_cu, (const void*)mega_fwd, NTHREADS, LDS_BYTES) != hipSuccess || per_cu < 1) { fprintf(stderr, "kernel_launch: occupancy query failed (%d)\n", per_cu); grid_blocks = -1; return; }
        grid_blocks = cus * per_cu;
        fprintf(stderr, "kernel_launch: %d CUs x %d = %d workgroups\n", cus, per_cu, grid_blocks);
    }
    if (grid_blocks < 0) return;
    Args a{};
    for (int i = 0; i < 31; ++i) a.in[i] = (const float*)d_in[i];
    a.out = (float*)d_out; a.ws = (unsigned char*)d_ws; a.ph_lo = 0; a.ph_hi = 64;
    void* args[] = {&a};
    hipError_t e = hipLaunchCooperativeKernel((const void*)mega_fwd, dim3(grid_blocks), dim3(NTHREADS), args, LDS_BYTES, stream);
    if (e != hipSuccess) fprintf(stderr, "kernel_launch: cooperative launch failed: %s (grid %d)\n", hipGetErrorString(e), grid_blocks);
}
#endif
```

```cpp
#ifndef EMU
#include <hip/hip_runtime.h>
#include <hip/hip_cooperative_groups.h>
#include <cstdio>
#include <cstdint>
namespace cg = cooperative_groups;
namespace pg8 {
#define PG8_LAS __attribute__((address_space(3)))
typedef unsigned short bf16_t;
typedef short bf16x8 __attribute__((ext_vector_type(8)));
typedef float f32x4 __attribute__((ext_vector_type(4)));
typedef unsigned u32x4 __attribute__((ext_vector_type(4)));
constexpr int BM = 256, BK = 64, HALF = 128, HTB = HALF * BK * 2  , STAGE_BYTES = 8 * HTB, NXCD = 8, WGM = 8;

__host__ __device__ __forceinline__ int lds_byte(int r, int c) { const int st = (r >> 4) * 2 + (c >> 5), rr = r & 15, cc = c & 31, ob = rr * 64 + cc * 2; return st * 1024 + (ob ^ (((ob >> 9) & 1) << 5)); }
__host__ __device__ __forceinline__ void stage_rc(int b, int& R, int& C) { const int st = b / 1024, sb = b % 1024, swz = sb ^ (((sb >> 9) & 1) << 5); R = (st >> 1) * 16 + swz / 64; C = (st & 1) * 32 + (swz % 64) / 2; }
__host__ __device__ __forceinline__ int perm32(int rho) { const int n = rho >> 4, i = rho & 15; return 8 * (i >> 2) + 4 * n + (i & 3); }

struct Unit { int pm, pn; };
struct Gemm { const bf16_t* A; const bf16_t* Bt; int M, N, K; };

struct StaticOrder {
    int nM, nN, nwg, G, c;
    __host__ __device__ void init(int M, int N, int G_, int c_) { nM = M / BM; nN = N / BM; nwg = nM * nN; G = G_; c = c_; }
    __host__ __device__ bool next(int i, Unit& u) const {
        const long L = (long)i * G + c; if (L >= nwg) return false;
        int wgid = (int)L; { const int q = nwg / NXCD, r = nwg % NXCD, xcd = wgid % NXCD, off = wgid / NXCD; wgid = (xcd < r ? xcd * (q + 1) : r * (q + 1) + (xcd - r) * q) + off; }
        const int nig = WGM * nN, gid = wgid / nig, fm = gid * WGM, gsz = (nM - fm) < WGM ? (nM - fm) : WGM;
        u.pm = fm + ((wgid % nig) % gsz); u.pn = (wgid % nig) / gsz; return true;
    }
    __device__ __forceinline__ void a_ready(const Unit&) const {}
    __device__ __forceinline__ void done(const Unit&) const {}
};

__device__ __forceinline__ unsigned cvt_pk_bf16(float lo, float hi) { unsigned r; asm volatile("v_cvt_pk_bf16_f32 %0, %1, %2" : "=v"(r) : "v"(lo), "v"(hi)); return r; }
typedef float f32x2 __attribute__((ext_vector_type(2)));
__device__ __forceinline__ f32x2 gelu_pk(f32x2 v) {
    const f32x2 av = __builtin_elementwise_abs(v), d = av * 0.2316418882f + 1.0f;
    f32x2 t; t.x = __builtin_amdgcn_rcpf(d.x); t.y = __builtin_amdgcn_rcpf(d.y);
    f32x2 q = t * 0.5307027145f + (-0.7265760135f); q = q * t + 0.7107068705f; q = q * t + (-0.142248368f); q = q * t + 0.127414796f; q = q * t;
    const f32x2 s = (v * v) * (-0.72134752044f);
    f32x2 e; e.x = __builtin_amdgcn_exp2f(s.x); e.y = __builtin_amdgcn_exp2f(s.y);
    const f32x2 m = v * (q * e), r = v - m;
    f32x2 o; o.x = v.x < 0.f ? m.x : r.x; o.y = v.y < 0.f ? m.y : r.y; return o;
}

template <class Epi, class Sched>
__device__ __forceinline__ void gemm_phase(PG8_LAS unsigned char* lds, const Gemm g, const Sched& S, const Epi& E) {
    int tid_o = threadIdx.x; asm volatile("" : "+v"(tid_o));
    const int tid = tid_o, wid = __builtin_amdgcn_readfirstlane(tid >> 6), lane = tid & 63, wr = wid >> 2, wc = wid & 3, fr = lane & 15, fq = lane >> 4;
    const int K = g.K, nt = K / BK;
    unsigned voffA[2], voffB[2];
#pragma unroll
    for (int i = 0; i < 2; ++i) { int R, C; stage_rc(tid * 16 + i * 8192, R, C); const int Rb = Epi::PERM ? ((R & ~31) + perm32(R & 31)) : R;
        voffA[i] = (unsigned)(R * K + C) * 2u; voffB[i] = (unsigned)(Rb * K + C) * 2u; }
    const size_t kstep = (size_t)(BK * 2);
    const size_t hstep = (size_t)HALF * K * 2;
    const size_t tstep = 2 * hstep;
    const unsigned ldsw = (unsigned)wid * 1024u;
    const int aoff = lds_byte(wr * 64 + fr, fq * 8), boff = lds_byte(wc * 32 + fr, fq * 8);
#define PG8_SA(b, h) (((b) * 2 + (h)) * HTB)
#define PG8_SB(b, h) ((4 + (b) * 2 + (h)) * HTB)
#define PG8_STAGE(bufoff, gbase, voff) do { _Pragma("unroll") for (int _i = 0; _i < 2; ++_i) \
        __builtin_amdgcn_global_load_lds((const unsigned*)((const char*)(gbase) + (voff)[_i]), (PG8_LAS unsigned*)(lds + (bufoff) + ldsw + _i * 8192), 16, 0, 0); } while (0)
#define PG8_LDA(dst, b, h) do { _Pragma("unroll") for (int m = 0; m < 4; ++m) _Pragma("unroll") for (int k = 0; k < 2; ++k) dst[m][k] = *(const PG8_LAS bf16x8*)(lds + PG8_SA(b, h) + aoff + m * 2048 + k * 1024); } while (0)
#define PG8_LDB(dst, b, h) do { _Pragma("unroll") for (int n = 0; n < 2; ++n) _Pragma("unroll") for (int k = 0; k < 2; ++k) dst[n][k] = *(const PG8_LAS bf16x8*)(lds + PG8_SB(b, h) + boff + n * 2048 + k * 1024); } while (0)
#define PG8_MMA(ai, bj, At, Bt) do { __builtin_amdgcn_s_setprio(1); _Pragma("unroll") for (int m = 0; m < 4; ++m) _Pragma("unroll") for (int n = 0; n < 2; ++n) _Pragma("unroll") for (int k = 0; k < 2; ++k) \
        acc[ai][bj][m][n] = __builtin_amdgcn_mfma_f32_16x16x32_bf16(Bt[n][k], At[m][k], acc[ai][bj][m][n], 0, 0, 0); __builtin_amdgcn_s_setprio(0); } while (0)
#define PG8_WAIT_V(n) asm volatile("s_waitcnt vmcnt(" #n ")" ::: "memory")
#define PG8_WAIT_L(n) asm volatile("s_waitcnt lgkmcnt(" #n ")" ::: "memory")
#define PG8_BAR __builtin_amdgcn_s_barrier()
#define PG8_SCHED __builtin_amdgcn_sched_barrier(0)
    Unit cur, nxt; int ui = 0;
    if (!S.next(0, cur)) return;
    f32x4 acc[2][2][4][2];
#pragma unroll
    for (int a = 0; a < 2; ++a)
#pragma unroll
        for (int b = 0; b < 2; ++b)
#pragma unroll
            for (int m = 0; m < 4; ++m)
#pragma unroll
                for (int n = 0; n < 2; ++n) acc[a][b][m][n] = (f32x4){0.f, 0.f, 0.f, 0.f};
    bf16x8 At[4][2], B0[2][2], B1[2][2];
    const char* cA = (const char*)g.A + (size_t)cur.pm * tstep; const char* cB = (const char*)g.Bt + (size_t)cur.pn * tstep;
    S.a_ready(cur);
    PG8_STAGE(PG8_SB(0, 0), cB, voffB); PG8_STAGE(PG8_SA(0, 0), cA, voffA); PG8_STAGE(PG8_SB(0, 1), cB + hstep, voffB); PG8_STAGE(PG8_SA(0, 1), cA + hstep, voffA);
    if (wr == 1) PG8_BAR;
    PG8_WAIT_V(4); PG8_BAR;
    PG8_STAGE(PG8_SB(1, 0), cB + kstep, voffB); PG8_STAGE(PG8_SA(1, 0), cA + kstep, voffA); PG8_STAGE(PG8_SB(1, 1), cB + hstep + kstep, voffB);
    PG8_WAIT_V(6); PG8_BAR;
    for (;;) {
        const bool has_next = S.next(ui + 1, nxt);
        const char* nA = has_next ? (const char*)g.A + (size_t)nxt.pm * tstep : cA; const char* nB = has_next ? (const char*)g.Bt + (size_t)nxt.pn * tstep : cB;
        for (int t = 0; t < nt; t += 2) {
            const bool last = (t == nt - 2);
            const char* a1 = cA + (size_t)(t + 1) * kstep;
            const char* a2 = last ? nA : cA + (size_t)(t + 2) * kstep; const char* b2 = last ? nB : cB + (size_t)(t + 2) * kstep;
            const char* a3 = a2 + kstep; const char* b3 = b2 + kstep;
            if (last && has_next) S.a_ready(nxt);
            PG8_LDB(B0, 0, 0); PG8_SCHED; PG8_LDA(At, 0, 0); PG8_STAGE(PG8_SA(1, 1), a1 + hstep, voffA);
            PG8_WAIT_L(8); PG8_BAR; PG8_WAIT_L(0); PG8_MMA(0, 0, At, B0); PG8_BAR; PG8_SCHED;
            PG8_LDB(B1, 0, 1); PG8_STAGE(PG8_SB(0, 0), b2, voffB);
            PG8_BAR; PG8_WAIT_L(0); PG8_MMA(0, 1, At, B1); PG8_BAR;
            PG8_LDA(At, 0, 1); PG8_STAGE(PG8_SA(0, 0), a2, voffA);
            PG8_BAR; PG8_WAIT_L(0); PG8_MMA(1, 0, At, B0); PG8_BAR; PG8_SCHED;
            PG8_STAGE(PG8_SB(0, 1), b2 + hstep, voffB);
            PG8_WAIT_V(6); PG8_BAR; PG8_MMA(1, 1, At, B1); PG8_BAR;
            PG8_LDB(B0, 1, 0); PG8_SCHED; PG8_LDA(At, 1, 0); PG8_STAGE(PG8_SA(0, 1), a2 + hstep, voffA);
            PG8_WAIT_L(8); PG8_BAR; PG8_WAIT_L(0); PG8_MMA(0, 0, At, B0); PG8_BAR; PG8_SCHED;
            PG8_LDB(B1, 1, 1); PG8_STAGE(PG8_SB(1, 0), b3, voffB);
            PG8_BAR; PG8_WAIT_L(0); PG8_MMA(0, 1, At, B1); PG8_BAR;
            PG8_LDA(At, 1, 1); PG8_STAGE(PG8_SA(1, 0), a3, voffA);
            PG8_BAR; PG8_WAIT_L(0); PG8_MMA(1, 0, At, B0); PG8_BAR; PG8_SCHED;
            PG8_STAGE(PG8_SB(1, 1), b3 + hstep, voffB);
            PG8_WAIT_V(6); PG8_BAR; PG8_MMA(1, 1, At, B1); PG8_BAR;
        }
        if constexpr (!Epi::AFTER_DRAIN) { E(acc, cur, wr, wc, fr, fq); S.done(cur); }
        if (!has_next) break;
#pragma unroll
        for (int a = 0; a < 2; ++a)
#pragma unroll
            for (int b = 0; b < 2; ++b)
#pragma unroll
                for (int m = 0; m < 4; ++m)
#pragma unroll
                    for (int n = 0; n < 2; ++n) acc[a][b][m][n] = (f32x4){0.f, 0.f, 0.f, 0.f};
        cur = nxt; cA = nA; cB = nB; ++ui;
    }
    PG8_WAIT_V(0);
    if (wr == 0) PG8_BAR;
    PG8_BAR;
    if constexpr (Epi::AFTER_DRAIN) { E.fused(acc, cur, wr, wc, fr, fq, lds, wid, lane); S.done(cur); }
#undef PG8_SA
#undef PG8_SB
#undef PG8_STAGE
#undef PG8_LDA
#undef PG8_LDB
#undef PG8_MMA
#undef PG8_WAIT_V
#undef PG8_WAIT_L
#undef PG8_BAR
#undef PG8_SCHED
}
}

#endif

typedef unsigned short bf16;
#ifndef EMU
#define LAS __attribute__((address_space(3)))
#else
#define LAS
#endif
typedef short bf16x8 __attribute__((ext_vector_type(8)));
typedef float f32x4 __attribute__((ext_vector_type(4)));
typedef unsigned u32x4 __attribute__((ext_vector_type(4)));
typedef unsigned u32x2 __attribute__((ext_vector_type(2)));

#ifdef EMU
constexpr int BP = EMU_BP, LP = EMU_LP, BS = EMU_BS;
#else
constexpr int BP = 8, LP = 2048, BS = 128;
#endif
constexpr int D = 1024, LS = 4, TP = BP * LP, TS = BS * LS, T = TP + TS;
constexpr int INW = 7968, NZM = 4864, NZG = 3072, NZ = NZM + NZG, NSM = 32;
constexpr int NEXP = 16384;
constexpr int SPLIT_T = 64 * (((LP / 64) * 5) / 8);
constexpr int NTHREADS = 512, NWAVES = 8;
constexpr int LDS_BYTES = 160 * 1024;

constexpr size_t O_YP = 0, O_YS = O_YP + (size_t)TP * D, O_PC = O_YS + (size_t)TS * D, O_PN = O_PC + 2ull * BP * 4 * 128 * 128, O_PM = O_PN + 2ull * BP * 4 * 128,
    O_PG = O_PM + 2ull * BP * 4, O_PH = O_PG + 2ull * BP * 4 * 64 * 128, O_PV = O_PH + 2ull * BP * 8 * 64 * 64, O_SC = O_PV + 2ull * BP * 3 * 768,
    O_SN = O_SC + 2ull * BS * 4 * 128 * 128, O_SM = O_SN + 2ull * BS * 4 * 128, O_SG = O_SM + 2ull * BS * 4, O_SH = O_SG + 2ull * BS * 4 * 64 * 128,
    O_SV = O_SH + 2ull * BS * 8 * 64 * 64, O_END = O_SV + 2ull * BS * 3 * 768;

constexpr size_t al256(size_t x) { return (x + 255) & ~(size_t)255; }
constexpr size_t WS_CTL = 0, WS_CTL_BYTES = 65536;
constexpr size_t WB_WIN = 0, WB_WS = WB_WIN + (size_t)NZ * D * 2, WB_WBR = WB_WS + (size_t)NSM * D * 2, WB_WO = WB_WBR + 3ull * D * 512 * 2, WB_WQ = WB_WO + (size_t)D * D * 2,
    WB_KEYS = WB_WQ + 2048ull * D * 2, WB_BYTES = WB_KEYS + 16ull * 128 * 128 * 2;
constexpr size_t WS_WB = WS_CTL + WS_CTL_BYTES;
constexpr size_t WS_XB = WS_WB + 2 * WB_BYTES;
constexpr size_t WS_H = WS_XB + (size_t)T * D * 2;
constexpr size_t WS_ZS = WS_H + (size_t)T * D * 4;
constexpr size_t WS_BR = WS_ZS + (size_t)T * NSM * 4;
constexpr size_t WS_ZM = WS_BR + 3ull * T * 512 * 2;
constexpr size_t WS_ZG = WS_ZM + (size_t)T * NZM * 2;
constexpr size_t WS_END0 = WS_ZG + (size_t)T * NZG * 2;
constexpr size_t WS_Q = WS_ZM, WS_IDX = WS_Q + (size_t)T * 2048 * 2, WS_GT = WS_IDX + (size_t)T * 128 * 4;
constexpr size_t WS_PU = WS_END0, WS_PV = WS_PU + (size_t)NEXP * D, WS_PUS = WS_PV + (size_t)NEXP * D, WS_PVS = WS_PUS + (size_t)NEXP * 4, WS_END = WS_PVS + (size_t)NEXP * 4;
#ifndef EMU
__device__ __forceinline__ f32x4 mfma16(bf16x8 a, bf16x8 b, f32x4 c) { return __builtin_amdgcn_mfma_f32_16x16x32_bf16(a, b, c, 0, 0, 0); }
#endif
struct Args { const float* in[31]; float* out; unsigned char* ws; int ph_lo, ph_hi; };
#ifndef EMU
typedef const __attribute__((address_space(4))) Args* ArgP;
#else
typedef const Args* ArgP;
#endif
#define A (*Ap)
#ifdef STAGE_AMP
#define STG_INIT() LAS unsigned long long* stg_acc_ = (LAS unsigned long long*)(lds + LDS_BYTES - 256); if (tid == 0) { for (int i_ = 0; i_ < 16; ++i_) stg_acc_[i_] = 0; stg_acc_[15] = __builtin_amdgcn_s_memrealtime(); }
#define STG(k) do { if (tid == 0) { const unsigned long long n_ = __builtin_amdgcn_s_memrealtime(); stg_acc_[k] += n_ - stg_acc_[15]; stg_acc_[15] = n_; } } while (0)
#define STG_FINI(slot) do { if (tid == 0 && !sample && b == 0 && (slot) >= 0) { unsigned long long* g_ = (unsigned long long*)(A.ws + WS_CTL + 40960) + (slot) * 16; for (int i_ = 0; i_ < 15; ++i_) g_[i_] += stg_acc_[i_]; } } while (0)
#else
#define STG_INIT() do {} while (0)
#define STG(k) do {} while (0)
#define STG_FINI(slot) do {} while (0)
#endif
#ifndef EMU
#define OPQV(x) asm volatile("" : "+v"(x))
#define OPQS(x) asm volatile("" : "+s"(x))
#define SCHED_FENCE() __builtin_amdgcn_sched_barrier(0)
#define LDS_BARRIER() asm volatile("s_waitcnt lgkmcnt(0)\n\ts_barrier" ::: "memory")
#else
#define OPQV(x) (void)(x)
#define OPQS(x) (void)(x)
#define SCHED_FENCE() do {} while (0)
#define LDS_BARRIER() __syncthreads()
#endif
#ifndef EMU
__device__ __forceinline__ int obid() { int b = blockIdx.x; asm volatile("" : "+s"(b)); return b; }
__device__ __forceinline__ int ogrid() { int g = gridDim.x; asm volatile("" : "+s"(g)); return g; }
__device__ __forceinline__ int opaque_tid() { int t = threadIdx.x; asm volatile("" : "+v"(t)); return t; }
#else
static inline int opaque_tid() { return threadIdx.x; }
static inline int obid() { return blockIdx.x; }
static inline int ogrid() { return gridDim.x; }
#endif

#ifndef EMU
__device__ __forceinline__ unsigned pk_fp8x4(float a, float b, float c, float d) { int w = __builtin_amdgcn_cvt_pk_fp8_f32(a, b, 0, false); w = __builtin_amdgcn_cvt_pk_fp8_f32(c, d, w, true); return (unsigned)w; }
__device__ __forceinline__ void unpk_fp8x4(unsigned w, float* f) { typedef float f32x2_ __attribute__((ext_vector_type(2)));
    const f32x2_ lo = __builtin_amdgcn_cvt_pk_f32_fp8((int)w, false), hi = __builtin_amdgcn_cvt_pk_f32_fp8((int)w, true); f[0] = lo.x; f[1] = lo.y; f[2] = hi.x; f[3] = hi.y; }
#endif
#ifndef EMU
__device__ __forceinline__ float swap32_add(float a, float b) { const auto r = __builtin_amdgcn_permlane32_swap(__float_as_uint(a), __float_as_uint(b), false, false); return __uint_as_float(r[0]) + __uint_as_float(r[1]); }
__device__ __forceinline__ float swap16_add(float a, float b) { const auto r = __builtin_amdgcn_permlane16_swap(__float_as_uint(a), __float_as_uint(b), false, false); return __uint_as_float(r[0]) + __uint_as_float(r[1]); }
__device__ __forceinline__ float row_allsum(float x) {
    x += __uint_as_float(__builtin_amdgcn_update_dpp(0, __float_as_uint(x), 0x128, 0xf, 0xf, false)); x += __uint_as_float(__builtin_amdgcn_update_dpp(0, __float_as_uint(x), 0x124, 0xf, 0xf, false));
    x += __uint_as_float(__builtin_amdgcn_update_dpp(0, __float_as_uint(x), 0x122, 0xf, 0xf, false)); x += __uint_as_float(__builtin_amdgcn_update_dpp(0, __float_as_uint(x), 0x121, 0xf, 0xf, false)); return x; }
#define RDLANE(x, k) __uint_as_float(__builtin_amdgcn_readlane(__float_as_uint(x), (k)))
#endif
__device__ __forceinline__ bf16 f2bf(float f) { unsigned u = __float_as_uint(f); u += 0x7FFFu + ((u >> 16) & 1u); return (bf16)(u >> 16); }
__device__ __forceinline__ float bf2f(bf16 b) { return __uint_as_float(((unsigned)b) << 16); }
__device__ __forceinline__ unsigned pk2(float lo, float hi) { return (unsigned)f2bf(lo) | ((unsigned)f2bf(hi) << 16); }

__device__ __forceinline__ void tconv_tile(const float* __restrict__ src, int ldsrc, int k0, int c0, bf16* __restrict__ dst, int ldd, int n0, LAS float* tile) {
    const int t = opaque_tid(), i = t >> 3, jg = (t & 7) * 8;
    const float4 a = *(const float4*)(src + (size_t)(k0 + i) * ldsrc + c0 + jg), b = *(const float4*)(src + (size_t)(k0 + i) * ldsrc + c0 + jg + 4);
    LAS float* r = tile + i * 65 + jg;
    r[0] = a.x; r[1] = a.y; r[2] = a.z; r[3] = a.w; r[4] = b.x; r[5] = b.y; r[6] = b.z; r[7] = b.w;
    __syncthreads();
    const int j = t >> 3, ig = (t & 7) * 8;
    u32x4 w;
    w.x = pk2(tile[(ig + 0) * 65 + j], tile[(ig + 1) * 65 + j]); w.y = pk2(tile[(ig + 2) * 65 + j], tile[(ig + 3) * 65 + j]);
    w.z = pk2(tile[(ig + 4) * 65 + j], tile[(ig + 5) * 65 + j]); w.w = pk2(tile[(ig + 6) * 65 + j], tile[(ig + 7) * 65 + j]);
    *(u32x4*)(dst + (size_t)(n0 + j) * ldd + k0 + ig) = w;
    __syncthreads();
}
__device__ __forceinline__ int zcol_to_src(int zc) { return zc < 2048 ? zc : (zc < 3584 ? zc + 8 : (zc < 4864 ? zc + 24 : zc + 32)); }
__device__ __forceinline__ int scol_to_src(int sc) { return sc < 8 ? 2048 + sc : (sc < 24 ? 3592 + (sc - 8) : 4888 + (sc - 24)); }

__device__ __forceinline__ void convert_f32_bf16(const float* __restrict__ src, bf16* __restrict__ dst, size_t n, int gtid, int gthreads) {
    for (size_t i = (size_t)gtid * 8; i < n; i += (size_t)gthreads * 8) {
        const float4 a = *(const float4*)(src + i), b = *(const float4*)(src + i + 4);
        u32x4 w; w.x = pk2(a.x, a.y); w.y = pk2(a.z, a.w); w.z = pk2(b.x, b.y); w.w = pk2(b.z, b.w);
        *(u32x4*)(dst + i) = w;
    }
}

__device__ __forceinline__ void convert_weights(ArgP Ap, LAS unsigned char* lds, int l, int part, int nparts) {
    LAS float* tile = (LAS float*)lds;
    constexpr int I_WIN = (NZ / 64) * (D / 64), I_WBR = 3 * (D / 64) * (512 / 64), I_WO = (D / 64) * (D / 64), I_WQ = (2048 / 64) * (D / 64), I_L = I_WIN + I_WBR + I_WO + I_WQ;
    unsigned char* wb = A.ws + WS_WB + (size_t)l * WB_BYTES;
    for (int it = part; it < I_L; it += nparts) {
        int r = it;
        if (r < I_WIN) { const int nt = r / (D / 64), kt = r % (D / 64);
            tconv_tile(A.in[8] + (size_t)l * D * INW, INW, kt * 64, zcol_to_src(nt * 64), (bf16*)(wb + WB_WIN), D, nt * 64, tile); continue; }
        r -= I_WIN;
        if (r < I_WBR) { const int n = r / ((D / 64) * 8), rr = r % ((D / 64) * 8), nt = rr / 8, kt = rr % 8;
            tconv_tile(A.in[21] + ((size_t)l * 3 + n) * 512 * D, D, kt * 64, nt * 64, (bf16*)(wb + WB_WBR) + (size_t)n * D * 512, 512, nt * 64, tile); continue; }
        r -= I_WBR;
        if (r < I_WO) { const int nt = r / (D / 64), kt = r % (D / 64);
            tconv_tile(A.in[22] + (size_t)l * D * D, D, kt * 64, nt * 64, (bf16*)(wb + WB_WO), D, nt * 64, tile); continue; }
        r -= I_WO;
        { const int nt = r / (D / 64), kt = r % (D / 64);
            tconv_tile(A.in[25] + (size_t)l * D * 2048, 2048, kt * 64, nt * 64, (bf16*)(wb + WB_WQ), D, nt * 64, tile); }
    }
    const int gtid = part * NTHREADS + opaque_tid(), gthreads = nparts * NTHREADS;
    for (int e = gtid; e < NSM * D; e += gthreads) { const int n = e / D, k = e % D; ((bf16*)(wb + WB_WS))[e] = f2bf(A.in[8][(size_t)l * D * INW + (size_t)k * INW + scol_to_src(n)]); }
    convert_f32_bf16(A.in[26] + (size_t)l * 16 * 128 * 128, (bf16*)(wb + WB_KEYS), 16 * 128 * 128, gtid, gthreads);
}
__device__ __forceinline__ void convert_tables(ArgP Ap, int l, int part, int nparts) {
    const int tx = opaque_tid(), lane = tx & 63, wave = tx >> 6;
    for (int r2 = part * NWAVES + wave; r2 < 2 * NEXP; r2 += nparts * NWAVES) { const int tab = r2 >= NEXP, row = r2 - tab * NEXP;
        const float* src = A.in[27 + tab] + ((size_t)l * NEXP + row) * D + 16 * lane; float v[16]; float mx = 0.f;
#pragma unroll
        for (int q = 0; q < 4; ++q) { const float4 a = *(const float4*)(src + 4 * q); v[4 * q] = a.x; v[4 * q + 1] = a.y; v[4 * q + 2] = a.z; v[4 * q + 3] = a.w; }
#pragma unroll
        for (int i = 0; i < 16; ++i) mx = fmaxf(mx, fabsf(v[i]));
#pragma unroll
        for (int m = 1; m < 64; m <<= 1) mx = fmaxf(mx, __shfl_xor(mx, m));
        const float sc = (mx > 0.f) ? exp2f(floorf(log2f(224.0f / mx))) : 1.0f;
        u32x4 w; w.x = pk_fp8x4(v[0] * sc, v[1] * sc, v[2] * sc, v[3] * sc); w.y = pk_fp8x4(v[4] * sc, v[5] * sc, v[6] * sc, v[7] * sc);
        w.z = pk_fp8x4(v[8] * sc, v[9] * sc, v[10] * sc, v[11] * sc); w.w = pk_fp8x4(v[12] * sc, v[13] * sc, v[14] * sc, v[15] * sc);
        *(u32x4*)(A.ws + (tab ? WS_PV : WS_PU) + (size_t)row * D + 16 * lane) = w;
        if (lane == 0) ((float*)(A.ws + (tab ? WS_PVS : WS_PUS)))[row] = 1.0f / sc; }
}
__device__ __forceinline__ void phase_convert(ArgP Ap, LAS unsigned char* lds) {
    const int G = ogrid(), bid = obid();
    convert_weights(Ap, lds, 0, bid, G);
    const int gtid = bid * NTHREADS + opaque_tid(), gthreads = G * NTHREADS;
    convert_f32_bf16(A.in[0], (bf16*)(A.ws + WS_XB), (size_t)TP * D, gtid, gthreads);
    convert_f32_bf16(A.in[1], (bf16*)(A.ws + WS_XB) + (size_t)TP * D, (size_t)TS * D, gtid, gthreads);
}

#ifndef EMU
struct EpiZ {
    static constexpr bool PERM = true, AFTER_DRAIN = false;
    bf16* ZM; bf16* ZG;
    __device__ __forceinline__ void operator()(const pg8::f32x4 (&acc)[2][2][4][2], const pg8::Unit& u, int wr, int wc, int fr, int fq) const {
        const int row0 = u.pm * 256 + wr * 64 + fr; const bool gate = u.pn >= 19;
        bf16* base = gate ? ZG : ZM; const int ldc = gate ? NZG : NZM; const int col0 = (gate ? (u.pn - 19) : u.pn) * 256 + wc * 32 + 8 * fq;
#pragma unroll
        for (int ai = 0; ai < 2; ++ai)
#pragma unroll
            for (int m = 0; m < 4; ++m) { bf16* rowp = base + (size_t)(row0 + ai * 128 + m * 16) * ldc + col0;
#pragma unroll
                for (int bj = 0; bj < 2; ++bj) { f32x4 v0 = acc[ai][bj][m][0], v1 = acc[ai][bj][m][1];
                    if (gate) {
#pragma unroll
                        for (int j = 0; j < 4; ++j) { v0[j] = __builtin_amdgcn_rcpf(1.0f + __expf(-v0[j])); v1[j] = __builtin_amdgcn_rcpf(1.0f + __expf(-v1[j])); } }
                    u32x4 w; w.x = pg8::cvt_pk_bf16(v0[0], v0[1]); w.y = pg8::cvt_pk_bf16(v0[2], v0[3]); w.z = pg8::cvt_pk_bf16(v1[0], v1[1]); w.w = pg8::cvt_pk_bf16(v1[2], v1[3]);
                    *(u32x4*)(rowp + bj * 128) = w; } }
    }
};

#endif
__device__ __forceinline__ void small_gemm(const bf16* __restrict__ XB, const bf16* __restrict__ WsT, float* __restrict__ ZS) {
    const int tx = opaque_tid(), lane = tx & 63, wave = tx >> 6, gw = obid() * NWAVES + wave, NGW = ogrid() * NWAVES, fr = lane & 15, fq = lane >> 4;
    for (int rg = gw; rg < T / 16; rg += NGW) {
        f32x4 a0 = {0.f, 0.f, 0.f, 0.f}, a1 = {0.f, 0.f, 0.f, 0.f};
        const bf16* ap = XB + (size_t)(rg * 16 + fr) * D + 8 * fq; const bf16* b0p = WsT + (size_t)fr * D + 8 * fq; const bf16* b1p = WsT + (size_t)(16 + fr) * D + 8 * fq;
#pragma unroll 4
        for (int k0 = 0; k0 < D; k0 += 32) {
            const bf16x8 a = *(const bf16x8*)(ap + k0), b0 = *(const bf16x8*)(b0p + k0), b1 = *(const bf16x8*)(b1p + k0);
            a0 = mfma16(a, b0, a0); a1 = mfma16(a, b1, a1);
        }
#pragma unroll
        for (int r = 0; r < 4; ++r) { float* o = ZS + (size_t)(rg * 16 + fq * 4 + r) * NSM + fr; o[0] = a0[r]; o[16] = a1[r]; }
    }
}

#ifndef EMU
__device__ __forceinline__ void phase_gemm1(ArgP Ap, LAS unsigned char* lds, int l) {
    unsigned char* wb = A.ws + WS_WB + (size_t)l * WB_BYTES;
    pg8::Gemm g{(const bf16*)(A.ws + WS_XB), (const bf16*)(wb + WB_WIN), T, NZ, D};
    pg8::StaticOrder S; S.init(T, NZ, ogrid(), obid());
    EpiZ E{(bf16*)(A.ws + WS_ZM), (bf16*)(A.ws + WS_ZG)};
    pg8::gemm_phase<EpiZ, pg8::StaticOrder>(lds, g, S, E);
    small_gemm((const bf16*)(A.ws + WS_XB), (const bf16*)(wb + WB_WS), (float*)(A.ws + WS_ZS));
}
#endif

#ifndef EMU
#define XB_TMO      128
#define XB_XCNT(j)  (256  + 64 * (j))
#define XB_XSUB(j)  (1280 + 64 * (j))
#define XB_XGEN(j)  (2304 + 64 * (j))
#define XB_TOP      3328
#define XB_TOPGEN   3392
#define XCD_BAR_WORDS 3456
#define XB_SPIN_CAP (1u << 18)

__device__ __forceinline__ unsigned xb_ld(unsigned* p)              { return __hip_atomic_load(p, __ATOMIC_RELAXED, __HIP_MEMORY_SCOPE_AGENT); }
__device__ __forceinline__ unsigned xb_add(unsigned* p, unsigned v) { return __hip_atomic_fetch_add(p, v, __ATOMIC_RELAXED, __HIP_MEMORY_SCOPE_AGENT); }
__device__ __forceinline__ unsigned xb_xcc_id() { return (unsigned)__builtin_amdgcn_s_getreg((3 << 11) | 20) & 0xFu; }
#define XB_SPIN(cond, bar) do { unsigned _sp = 0; while (cond) { __builtin_amdgcn_s_sleep(1); \
    if ((++_sp & 255u) == 0u) { if (xb_ld(&(bar)[XB_TMO])) break; if (_sp > XB_SPIN_CAP) { atomicAdd(&(bar)[XB_TMO], 1u); break; } } } } while (0)

struct XcdBarrier {
    unsigned* bar; unsigned x;
    volatile LAS unsigned* st;
};

__device__ __forceinline__ XcdBarrier xcd_barrier_post(unsigned* bar, volatile LAS unsigned* st) {
    XcdBarrier b; b.bar = bar; b.x = xb_xcc_id(); b.st = st;
    if (threadIdx.x == 0) (void)xb_add(&bar[XB_XCNT(b.x)], 1u);
    return b;
}
__device__ __forceinline__ void xcd_barrier_complete(unsigned* bar, unsigned x, unsigned& nloc, unsigned& nx) {
    const unsigned G = gridDim.x * gridDim.y * gridDim.z;
    unsigned sum, cnt, mine, sp = 0u;
    for (;;) {
        sum = 0u; cnt = 0u; mine = 0u;
#pragma unroll
        for (unsigned j = 0; j < 16; ++j) { const unsigned c = xb_ld(&bar[XB_XCNT(j)]); sum += c; cnt += (c > 0u) ? 1u : 0u; mine = (j == x) ? c : mine; }
        if (sum == G) break;
        __builtin_amdgcn_s_sleep(1);
        if ((++sp & 255u) == 0u) { if (xb_ld(&bar[XB_TMO])) break; if (sp > XB_SPIN_CAP) { atomicAdd(&bar[XB_TMO], 1u); break; } }
    }
    nloc = mine > 0u ? mine : 1u; nx = cnt > 0u ? cnt : 1u;
}

__device__ __forceinline__ void xcd_barrier(const XcdBarrier& b) {
    asm volatile("s_waitcnt vmcnt(0)" ::: "memory");
    __syncthreads();
    if (threadIdx.x == 0) {
        unsigned* bar = b.bar;
        __builtin_amdgcn_s_waitcnt(0);
        unsigned nloc = b.st[0], nx = b.st[1];
        if (nloc == 0u) { xcd_barrier_complete(bar, b.x, nloc, nx); b.st[0] = nloc; b.st[1] = nx; }
        const unsigned old = xb_add(&bar[XB_XSUB(b.x)], 1u);
        const unsigned gen = old / nloc;
        if (old + 1u == (gen + 1u) * nloc) {
            __builtin_amdgcn_fence(__ATOMIC_RELEASE, "agent");
            asm volatile("s_waitcnt vmcnt(0)" ::: "memory");
            const unsigned og = xb_add(&bar[XB_TOP], 1u);
            const unsigned tg = og / nx;
            if (og + 1u == (tg + 1u) * nx) xb_add(&bar[XB_TOPGEN], 1u);
            else XB_SPIN(xb_ld(&bar[XB_TOPGEN]) == tg, bar);
            __builtin_amdgcn_fence(__ATOMIC_ACQUIRE, "agent");
            xb_add(&bar[XB_XGEN(b.x)], 1u);
            asm volatile("s_waitcnt vmcnt(0)" ::: "memory");
        } else {
            XB_SPIN(xb_ld(&bar[XB_XGEN(b.x)]) == gen, bar);
            __builtin_amdgcn_fence(__ATOMIC_ACQUIRE, "agent");
            asm volatile("s_waitcnt vmcnt(0)" ::: "memory");
        }
    }
    __syncthreads();
}

#endif

typedef short s16x4 __attribute__((ext_vector_type(4)));
#ifndef EMU
__device__ __forceinline__ s16x4 tr4(const LAS bf16* p) { return __builtin_amdgcn_ds_read_tr16_b64_v4i16((LAS s16x4*)p); }
#endif
#define FROW(M, ld, rc0, k0) (*(const LAS bf16x8*)((M) + ((rc0) + fr) * (ld) + (k0) + 8 * fq))
__device__ __forceinline__ bf16x8 ftr_(int fr, int fq, const LAS bf16* M, int ld, int k0, int rc0) {
    const LAS bf16* p = M + (k0 + 8 * fq + (fr >> 2)) * ld + rc0 + 4 * (fr & 3);
    const s16x4 lo = tr4(p), hi = tr4(p + 4 * ld);
    return (bf16x8){lo[0], lo[1], lo[2], lo[3], hi[0], hi[1], hi[2], hi[3]};
}
#define FTR(M, ld, k0, rc0) ftr_(fr, fq, M, ld, k0, rc0)
#define MMA_RR(acc, Am, lda, r0, Bm, ldb, c0, K) do { _Pragma("unroll") for (int k0_ = 0; k0_ < (K); k0_ += 32) acc = mfma16(FROW(Am, lda, r0, k0_), FROW(Bm, ldb, c0, k0_), acc); } while (0)
#define MMA_RT(acc, Am, lda, r0, Bk, ldb, c0, K) do { _Pragma("unroll") for (int k0_ = 0; k0_ < (K); k0_ += 32) acc = mfma16(FROW(Am, lda, r0, k0_), FTR(Bk, ldb, k0_, c0), acc); } while (0)
#define MMA_TT(acc, Ak, lda, m0, Bk, ldb, c0, K) do { _Pragma("unroll") for (int k0_ = 0; k0_ < (K); k0_ += 32) acc = mfma16(FTR(Ak, lda, k0_, m0), FTR(Bk, ldb, k0_, c0), acc); } while (0)
#define MMA_RC(acc, Am, lda, r0, cfrag, K) do { _Pragma("unroll") for (int k0_ = 0; k0_ < (K); k0_ += 32) acc = mfma16(FROW(Am, lda, r0, k0_), cfrag, acc); } while (0)
#define MMA_CT(acc, cfrag, Bk, ldb, c0, K) do { _Pragma("unroll") for (int k0_ = 0; k0_ < (K); k0_ += 32) acc = mfma16(cfrag, FTR(Bk, ldb, k0_, c0), acc); } while (0)
__device__ __forceinline__ u32x2 pack4(float a, float b, float c, float d) { u32x2 w; w.x = pk2(a, b); w.y = pk2(c, d); return w; }
__device__ __forceinline__ float scan_sum64(float v, int lane) {
#pragma unroll
    for (int d = 1; d < 64; d <<= 1) { const float t = __shfl_up(v, d); if (lane >= d) v += t; }
    return v;
}
__device__ __forceinline__ float scan_max64(float v, int lane) {
#pragma unroll
    for (int d = 1; d < 64; d <<= 1) { const float t = __shfl_up(v, d); if (lane >= d) v = fmaxf(v, t); }
    return v;
}
__device__ __forceinline__ float wave_max64(float v) {
#pragma unroll
    for (int m = 1; m < 64; m <<= 1) v = fmaxf(v, __shfl_xor(v, m));
    return v;
}
__device__ __forceinline__ float logsig(float x) { return fminf(x, 0.f) - log1pf(__expf(-fabsf(x))); }
__device__ __forceinline__ float softplusf(float x) { return fmaxf(x, 0.f) + log1pf(__expf(-fabsf(x))); }
__device__ __forceinline__ float sigmoidf(float x) { return 1.0f / (1.0f + __expf(-x)); }
__device__ __forceinline__ float siluf(float x) { return x / (1.0f + __expf(-x)); }
constexpr float NEG_INF = -__builtin_huge_valf();
constexpr float EPS_ = 1e-5f;
__device__ __forceinline__ void unpack8(const u32x4 w, float (&f)[8]) {
    f[0] = __uint_as_float(w.x << 16); f[1] = __uint_as_float(w.x & 0xffff0000u); f[2] = __uint_as_float(w.y << 16); f[3] = __uint_as_float(w.y & 0xffff0000u);
    f[4] = __uint_as_float(w.z << 16); f[5] = __uint_as_float(w.z & 0xffff0000u); f[6] = __uint_as_float(w.w << 16); f[7] = __uint_as_float(w.w & 0xffff0000u);
}
__device__ __forceinline__ u32x4 pack8(const float (&f)[8]) { u32x4 w; w.x = pk2(f[0], f[1]); w.y = pk2(f[2], f[3]); w.z = pk2(f[4], f[5]); w.w = pk2(f[6], f[7]); return w; }

__device__ __forceinline__ void mlstm_item(ArgP Ap, LAS unsigned char* lds, int l, int b, int h, bool sample) {
    int tid_o = threadIdx.x; OPQV(tid_o);
    const int tid = tid_o, lane = tid & 63, wave = tid >> 6, fr = lane & 15, fq = lane >> 4;
    LAS bf16* Qs = (LAS bf16*)(lds); LAS bf16* Ks = (LAS bf16*)(lds + 17408); LAS bf16* Kw = (LAS bf16*)(lds + 34816); LAS bf16* Vs = (LAS bf16*)(lds + 52224);
    LAS bf16* Ss = (LAS bf16*)(lds + 69632); LAS bf16* CbT = (LAS bf16*)(lds + 78848); LAS float* Hs = (LAS float*)(lds + 120320); LAS float* MN = (LAS float*)(lds + 117760); LAS float* gb = (LAS float*)(lds + 118272);
    LAS float* b_ = gb; LAS float* mt_ = gb + 64; LAS float* u_ = gb + 128; LAS float* ein_ = gb + 192; LAS float* wg_ = gb + 256; LAS float* den_ = gb + 320; LAS float* sc_ = gb + 384;
    const int L = sample ? LS : LP, tok0 = sample ? TP + b * LS : b * LP, NB = sample ? BS : BP;
    const bf16* ZM = (const bf16*)(A.ws + WS_ZM); const float* ZS = (const float*)(A.ws + WS_ZS); bf16* BR0 = (bf16*)(A.ws + WS_BR);
    const float ib = A.in[9][l * 4 + h], fb = A.in[10][l * 4 + h];
    f32x4 accC[9];
#pragma unroll
    for (int vi = 0; vi < 9; ++vi) accC[vi] = (f32x4){0.f, 0.f, 0.f, 0.f};
    float m_run = 0.f;
    if (sample) {
        const float* C0 = A.in[2] + ((size_t)(l * BS + b) * 4 + h) * 16384; const float* n0 = A.in[3] + ((size_t)(l * BS + b) * 4 + h) * 128;
        const float* cp = C0 + (4 * fq) * 128 + 16 * wave + fr;
#pragma unroll
        for (int vi = 0; vi < 8; ++vi) {
#pragma unroll
            for (int r = 0; r < 4; ++r) accC[vi][r] = cp[r * 128];
            cp += 2048; OPQV(cp); }
        if (fq == 0) accC[8][0] = n0[16 * wave + fr];
        m_run = A.in[4][(l * BS + b) * 4 + h];
    }
#pragma unroll
    for (int vi = 0; vi < 9; ++vi) *(LAS u32x2*)(CbT + (16 * wave + fr) * 152 + 16 * vi + 4 * fq) = pack4(accC[vi][0], accC[vi][1], accC[vi][2], accC[vi][3]);
    if (tid < 128) MN[tid] = A.in[11][l * 512 + h * 128 + tid];
    u32x4 pq[2], pk[2], pv[2], pm[2]; float pli = NEG_INF, plf = 0.f;
#define MLSTM_PREFETCH_MO(T0N) do { const int nvn_ = (L - (T0N)) < 64 ? (L - (T0N)) : 64; const int t = tid >> 3, part = tid & 7; pm[0] = (u32x4){0u, 0u, 0u, 0u}; pm[1] = pm[0]; \
        if (t < nvn_) { const bf16* mo = ZM + (size_t)(tok0 + (T0N) + t) * NZM + 1536 + h * 128 + 16 * part; pm[0] = *(const u32x4*)mo; pm[1] = *(const u32x4*)(mo + 8); } } while (0)
#define MLSTM_PREFETCH(T0N) do { const int nvn_ = (L - (T0N)) < 64 ? (L - (T0N)) : 64; \
        _Pragma("unroll") for (int i = 0; i < 2; ++i) { const int c = tid + 512 * i, t = c >> 4, cc = (c & 15) * 8; pq[i] = (u32x4){0u, 0u, 0u, 0u}; pk[i] = pq[i]; pv[i] = pq[i]; \
            if (t < nvn_) { const bf16* zp = ZM + (size_t)(tok0 + (T0N) + t) * NZM + h * 128 + cc; pq[i] = *(const u32x4*)zp; pk[i] = *(const u32x4*)(zp + 512); pv[i] = *(const u32x4*)(zp + 1024); } } \
        if (wave == 0) { pli = NEG_INF; plf = 0.f; if (lane < nvn_) { const size_t tok = tok0 + (T0N) + lane; pli = ZS[tok * NSM + h]; plf = ZS[tok * NSM + 4 + h]; } } } while (0)
    MLSTM_PREFETCH(0); MLSTM_PREFETCH_MO(0);
    __syncthreads();
    STG_INIT();
    for (int t0 = 0; t0 < L; t0 += 64) {
        const int nv = (L - t0) < 64 ? (L - t0) : 64, nrt = (nv + 15) >> 4;
        if (wave == 0) {
            const float li = (lane < nv) ? pli + ib : NEG_INF, lf = (lane < nv) ? logsig(plf + fb) : 0.f;
            const float bb = scan_sum64(lf, lane), a = bb + m_run, u = li - bb, M = scan_max64(u, lane), mt = fmaxf(a, bb + M);
            const float blast = __shfl(bb, 63), g = blast + u, gmax = wave_max64(g), mnew = fmaxf(blast + m_run, gmax);
            b_[lane] = bb; mt_[lane] = mt; u_[lane] = u; ein_[lane] = __expf(a - mt); wg_[lane] = __expf(g - mnew);
            if (lane == 0) sc_[1] = __expf(blast + m_run - mnew);
            m_run = mnew;
        }
        LDS_BARRIER(); STG(0);
#pragma unroll
        for (int i = 0; i < 2; ++i) { const int c = tid + 512 * i, t = c >> 4, cc = (c & 15) * 8;
            *(LAS u32x4*)(Qs + t * 136 + cc) = pq[i]; *(LAS u32x4*)(Ks + t * 136 + cc) = pk[i]; *(LAS u32x4*)(Vs + t * 136 + cc) = pv[i];
            float f[8]; unpack8(pk[i], f); const float g = wg_[t];
#pragma unroll
            for (int j = 0; j < 8; ++j) f[j] *= g;
            *(LAS u32x4*)(Kw + t * 136 + cc) = pack8(f); }
        MLSTM_PREFETCH(t0 + 64);
        LDS_BARRIER(); STG(1);
#pragma unroll
        for (int j = 0; j < 2; ++j) { const int idx = wave + 8 * j, ti = idx >> 2, si = idx & 3;
            f32x4 acc = {0.f, 0.f, 0.f, 0.f};
            if (ti >= nrt) continue;
            if (si <= ti) MMA_RR(acc, Ks, 136, 16 * si, Qs, 136, 16 * ti, 128);
            const int t = 16 * ti + fr; const float bt = b_[t] - mt_[t]; float v[4];
#pragma unroll
            for (int r = 0; r < 4; ++r) { const int s = 16 * si + 4 * fq + r; v[r] = (s <= t) ? acc[r] * __expf(bt + u_[s]) : 0.f; }
            *(LAS u32x2*)(Ss + t * 72 + 16 * si + 4 * fq) = pack4(v[0], v[1], v[2], v[3]); }
        LDS_BARRIER(); STG(2);
        if (wave < nrt) { const int ti = wave; f32x4 acc = {0.f, 0.f, 0.f, 0.f};
            MMA_RT(acc, Qs, 136, 16 * ti, CbT, 152, 128, 128);
#pragma unroll
            for (int r = 0; r < 4; ++r) acc[r] *= ein_[16 * ti + 4 * fq + r];
            { int fr_ = fr; OPQV(fr_); const short o1 = (fr_ == 0) ? (short)0x3F80 : (short)0; const bf16x8 ones = {o1, o1, o1, o1, o1, o1, o1, o1};
              MMA_RC(acc, Ss, 72, 16 * ti, ones, 64); }
            if (fr == 0) {
#pragma unroll
                for (int r = 0; r < 4; ++r) den_[16 * ti + 4 * fq + r] = acc[r]; } }
        LDS_BARRIER(); STG(3);
        { bf16x8 bC[4], bV[2];
#pragma unroll
          for (int kk = 0; kk < 4; ++kk) bC[kk] = FTR(CbT, 152, 32 * kk, 16 * wave);
#pragma unroll
          for (int kk = 0; kk < 2; ++kk) bV[kk] = FTR(Vs, 136, 32 * kk, 16 * wave);
#pragma unroll
          for (int ti = 0; ti < 4; ++ti) { if (ti >= nrt) continue; f32x4 accn = {0.f, 0.f, 0.f, 0.f};
#pragma unroll
            for (int kk = 0; kk < 4; ++kk) accn = mfma16(FROW(Qs, 136, 16 * ti, 32 * kk), bC[kk], accn);
#pragma unroll
            for (int r = 0; r < 4; ++r) accn[r] *= ein_[16 * ti + 4 * fq + r];
#pragma unroll
            for (int kk = 0; kk < 2; ++kk) accn = mfma16(FROW(Ss, 72, 16 * ti, 32 * kk), bV[kk], accn);
#pragma unroll
            for (int r = 0; r < 4; ++r) { const int t = 16 * ti + 4 * fq + r; const float dn = den_[t] * 0.08838834764831845f;
                Hs[t * 132 + 16 * wave + fr] = accn[r] * 0.08838834764831845f / fmaxf(fabsf(dn), __expf(-mt_[t])); } } }
        LDS_BARRIER(); STG(4);
        { const int t = tid >> 3, part = tid & 7; float x[16]; float s1 = 0.f;
#pragma unroll
            for (int i = 0; i < 16; ++i) { x[i] = Hs[t * 132 + 16 * part + i]; s1 += x[i]; }
            s1 += __shfl_xor(s1, 1); s1 += __shfl_xor(s1, 2); s1 += __shfl_xor(s1, 4);
            const float mu = s1 * (1.0f / 128.0f); float s2 = 0.f;
#pragma unroll
            for (int i = 0; i < 16; ++i) { x[i] -= mu; s2 += x[i] * x[i]; }
            s2 += __shfl_xor(s2, 1); s2 += __shfl_xor(s2, 2); s2 += __shfl_xor(s2, 4);
            const float rstd = 1.0f / sqrtf(s2 * (1.0f / 128.0f) + EPS_);
            if (t < nv) { const size_t tok = tok0 + t0 + t;
                float o0[8], o1[8]; unpack8(pm[0], o0); unpack8(pm[1], o1); float y0[8], y1[8];
#pragma unroll
                for (int i = 0; i < 8; ++i) { y0[i] = x[i] * rstd * MN[16 * part + i] * sigmoidf(o0[i]); y1[i] = x[8 + i] * rstd * MN[16 * part + 8 + i] * sigmoidf(o1[i]); }
                bf16* o = BR0 + tok * 512 + h * 128 + 16 * part; *(u32x4*)o = pack8(y0); *(u32x4*)(o + 8) = pack8(y1); } }
        MLSTM_PREFETCH_MO(t0 + 64);
        { const float ec = sc_[1]; bf16x8 bK[2];
#pragma unroll
            for (int kk = 0; kk < 2; ++kk) bK[kk] = FTR(Kw, 136, 32 * kk, 16 * wave);
#pragma unroll
            for (int vi = 0; vi < 9; ++vi) {
#pragma unroll
                for (int r = 0; r < 4; ++r) accC[vi][r] *= ec;
                if (vi < 8) {
#pragma unroll
                    for (int kk = 0; kk < 2; ++kk) accC[vi] = mfma16(FTR(Vs, 136, 32 * kk, 16 * vi), bK[kk], accC[vi]); }
                else { int fr_ = fr; OPQV(fr_); const short o1 = (fr_ == 0) ? (short)0x3F80 : (short)0; const bf16x8 ones = {o1, o1, o1, o1, o1, o1, o1, o1};
#pragma unroll
                    for (int kk = 0; kk < 2; ++kk) accC[vi] = mfma16(ones, bK[kk], accC[vi]); }
                *(LAS u32x2*)(CbT + (16 * wave + fr) * 152 + 16 * vi + 4 * fq) = pack4(accC[vi][0], accC[vi][1], accC[vi][2], accC[vi][3]); } }
        LDS_BARRIER(); STG(5);
    }
#undef MLSTM_PREFETCH
#undef MLSTM_PREFETCH_MO
    float* Co = A.out + (sample ? O_SC : O_PC) + ((size_t)(l * NB + b) * 4 + h) * 16384; float* no = A.out + (sample ? O_SN : O_PN) + ((size_t)(l * NB + b) * 4 + h) * 128;
    { int fq_ = fq, cw_ = 16 * wave + fr; OPQV(fq_); OPQV(cw_);
      float* cp = Co + (4 * fq_) * 128 + cw_;
#pragma unroll
      for (int vi = 0; vi < 8; ++vi) {
#pragma unroll
        for (int r = 0; r < 4; ++r) cp[r * 128] = accC[vi][r];
        cp += 2048; OPQV(cp); }
      if (fq_ == 0) no[cw_] = accC[8][0]; }
    STG_FINI(h == 0 ? 0 : -1);
    if (tid == 0) A.out[(sample ? O_SM : O_PM) + (size_t)(l * NB + b) * 4 + h] = m_run;
    __syncthreads();
}

__device__ __forceinline__ void gla_item(ArgP Ap, LAS unsigned char* lds, int l, int b, int h, bool sample) {
    int tid_o = threadIdx.x; OPQV(tid_o);
    const int tid = tid_o, lane = tid & 63, wave = tid >> 6, fr = lane & 15, fq = lane >> 4;
    LAS bf16* QE = (LAS bf16*)(lds); LAS bf16* KE = (LAS bf16*)(lds + 9216); LAS bf16* KLs = (LAS bf16*)(lds + 18432); LAS bf16* Vs = (LAS bf16*)(lds + 27648);
    LAS bf16* ATT = (LAS bf16*)(lds + 45056); LAS bf16* STbT = (LAS bf16*)(lds + 54272); LAS float* Os = (LAS float*)(lds + 71680); LAS float* LAM = (LAS float*)(lds + 105472);
    LAS float* GA = (LAS float*)(lds + 122112); LAS float* GUP = (LAS float*)(lds + 126208); LAS float* GBI = (LAS float*)(lds + 130304); LAS float* GN = (LAS float*)(lds + 130560);
    const int L = sample ? LS : LP, tok0 = sample ? TP + b * LS : b * LP, NB = sample ? BS : BP;
    const bf16* ZM = (const bf16*)(A.ws + WS_ZM); const float* ZS = (const float*)(A.ws + WS_ZS); bf16* BR1 = (bf16*)(A.ws + WS_BR) + (size_t)T * 512;
    f32x4 accS[4];
#pragma unroll
    for (int ki = 0; ki < 4; ++ki) accS[ki] = (f32x4){0.f, 0.f, 0.f, 0.f};
    if (sample) { const float* S0 = A.in[5] + ((size_t)(l * BS + b) * 4 + h) * 8192;
        const float* sp = S0 + fr * 128 + 16 * wave + 4 * fq;
#pragma unroll
        for (int ki = 0; ki < 4; ++ki) {
#pragma unroll
            for (int r = 0; r < 4; ++r) accS[ki][r] = sp[r];
            sp += 2048; OPQV(sp); } }
#pragma unroll
    for (int ki = 0; ki < 4; ++ki) *(LAS u32x2*)(STbT + (16 * ki + fr) * 136 + 16 * wave + 4 * fq) = pack4(accS[ki][0], accS[ki][1], accS[ki][2], accS[ki][3]);
    for (int e = tid; e < 1024; e += NTHREADS) GUP[e] = A.in[12][(size_t)l * 16 * 256 + (e >> 6) * 256 + h * 64 + (e & 63)];
    if (tid < 64) GBI[tid] = A.in[13][l * 256 + h * 64 + tid];
    if (tid < 128) GN[tid] = A.in[14][l * 512 + h * 128 + tid];
    u32x4 pq, pk, pv[2], pg[2], pgn[2]; float pga[2];
#define GLA_PREFETCH(T0N) do { const int nvn_ = (L - (T0N)) < 64 ? (L - (T0N)) : 64; \
        { const int t = tid >> 3, cc = (tid & 7) * 8; pq = (u32x4){0u, 0u, 0u, 0u}; pk = pq; pgn[0] = pq; pgn[1] = pq; \
            if (t < nvn_) { const bf16* zr = ZM + (size_t)(tok0 + (T0N) + t) * NZM + 2048 + h * 64 + cc; pq = *(const u32x4*)zr; pk = *(const u32x4*)(zr + 256); \
                const bf16* gr = ZM + (size_t)(tok0 + (T0N) + t) * NZM + 3072 + h * 128 + 16 * (tid & 7); pgn[0] = *(const u32x4*)gr; pgn[1] = *(const u32x4*)(gr + 8); } } \
        _Pragma("unroll") for (int i = 0; i < 2; ++i) { const int c = tid + 512 * i, t = c >> 4, cc = (c & 15) * 8; pv[i] = (u32x4){0u, 0u, 0u, 0u}; \
            if (t < nvn_) pv[i] = *(const u32x4*)(ZM + (size_t)(tok0 + (T0N) + t) * NZM + 2560 + h * 128 + cc); \
            const int e = tid + 512 * i, te = e >> 4; pga[i] = (te < nvn_) ? ZS[(size_t)(tok0 + (T0N) + te) * NSM + 8 + (e & 15)] : 0.f; } } while (0)
    GLA_PREFETCH(0);
    __syncthreads();
    for (int t0 = 0; t0 < L; t0 += 64) {
        const int nv = (L - t0) < 64 ? (L - t0) : 64, nrt = (nv + 15) >> 4;
        pg[0] = pgn[0]; pg[1] = pgn[1];
        GA[tid] = pga[0]; GA[tid + 512] = pga[1];
        LDS_BARRIER();
#pragma unroll
        for (int i = 0; i < 8; ++i) { const int e = tid + 512 * i, t = e >> 6, k = e & 63; float x = GBI[k];
#pragma unroll
            for (int r = 0; r < 16; ++r) x += GA[t * 16 + r] * GUP[r * 64 + k];
            LAM[t * 65 + k] = (t < nv) ? logsig(x) * (1.0f / 16.0f) : 0.f; }
        LDS_BARRIER();
#pragma unroll
        for (int c = 0; c < 8; ++c) { const int k = 8 * wave + c; const float v = scan_sum64(LAM[lane * 65 + k], lane); LAM[lane * 65 + k] = v; }
        LDS_BARRIER();
        { const int t = tid >> 3, cc = (tid & 7) * 8; float q[8], k[8], qe[8], ke[8], kl[8]; unpack8(pq, q); unpack8(pk, k);
#pragma unroll
            for (int i = 0; i < 8; ++i) { const float lm = LAM[t * 65 + cc + i], ll = LAM[63 * 65 + cc + i]; qe[i] = q[i] * __expf(lm); ke[i] = k[i] * __expf(-lm); kl[i] = k[i] * __expf(ll - lm); }
            *(LAS u32x4*)(QE + t * 72 + cc) = pack8(qe); *(LAS u32x4*)(KE + t * 72 + cc) = pack8(ke); *(LAS u32x4*)(KLs + t * 72 + cc) = pack8(kl); }
#pragma unroll
        for (int i = 0; i < 2; ++i) { const int c = tid + 512 * i, t = c >> 4, cc = (c & 15) * 8; *(LAS u32x4*)(Vs + t * 136 + cc) = pv[i]; }
        GLA_PREFETCH(t0 + 64);
        LDS_BARRIER();
#pragma unroll
        for (int j = 0; j < 2; ++j) { const int idx = wave + 8 * j, ti = idx >> 2, si = idx & 3; f32x4 acc = {0.f, 0.f, 0.f, 0.f};
            if (ti >= nrt) continue;
            if (si <= ti) MMA_RR(acc, KE, 72, 16 * si, QE, 72, 16 * ti, 64);
            const int t = 16 * ti + fr; float v[4];
#pragma unroll
            for (int r = 0; r < 4; ++r) { const int s = 16 * si + 4 * fq + r; v[r] = (s <= t) ? acc[r] : 0.f; }
            *(LAS u32x2*)(ATT + t * 72 + 16 * si + 4 * fq) = pack4(v[0], v[1], v[2], v[3]); }
        LDS_BARRIER();
        { bf16x8 bS[2], bV[2];
#pragma unroll
          for (int kk = 0; kk < 2; ++kk) { bS[kk] = FTR(STbT, 136, 32 * kk, 16 * wave); bV[kk] = FTR(Vs, 136, 32 * kk, 16 * wave); }
#pragma unroll
          for (int ti = 0; ti < 4; ++ti) { if (ti >= nrt) continue; f32x4 acc = {0.f, 0.f, 0.f, 0.f};
#pragma unroll
            for (int kk = 0; kk < 2; ++kk) acc = mfma16(FROW(QE, 72, 16 * ti, 32 * kk), bS[kk], acc);
#pragma unroll
            for (int kk = 0; kk < 2; ++kk) acc = mfma16(FROW(ATT, 72, 16 * ti, 32 * kk), bV[kk], acc);
#pragma unroll
            for (int r = 0; r < 4; ++r) Os[(16 * ti + 4 * fq + r) * 132 + 16 * wave + fr] = acc[r] * 0.125f; } }
        LDS_BARRIER();
        { const int t = tid >> 3, part = tid & 7; float x[16]; float s2 = 0.f;
#pragma unroll
            for (int i = 0; i < 16; ++i) { x[i] = Os[t * 132 + 16 * part + i]; s2 += x[i] * x[i]; }
            s2 += __shfl_xor(s2, 1); s2 += __shfl_xor(s2, 2); s2 += __shfl_xor(s2, 4);
            const float rstd = 1.0f / sqrtf(s2 * (1.0f / 128.0f) + EPS_);
            if (t < nv) { const size_t tok = tok0 + t0 + t;
                float g0[8], g1[8]; unpack8(pg[0], g0); unpack8(pg[1], g1); float y0[8], y1[8];
#pragma unroll
                for (int i = 0; i < 8; ++i) { y0[i] = x[i] * rstd * GN[16 * part + i] * siluf(g0[i]); y1[i] = x[8 + i] * rstd * GN[16 * part + 8 + i] * siluf(g1[i]); }
                bf16* o = BR1 + tok * 512 + h * 128 + 16 * part; *(u32x4*)o = pack8(y0); *(u32x4*)(o + 8) = pack8(y1); } }
        { bf16x8 aV[2];
#pragma unroll
          for (int kk = 0; kk < 2; ++kk) aV[kk] = FTR(Vs, 136, 32 * kk, 16 * wave);
#pragma unroll
          for (int ki = 0; ki < 4; ++ki) { const float dec = __expf(LAM[63 * 65 + 16 * ki + fr]);
#pragma unroll
            for (int r = 0; r < 4; ++r) accS[ki][r] *= dec;
#pragma unroll
            for (int kk = 0; kk < 2; ++kk) accS[ki] = mfma16(aV[kk], FTR(KLs, 72, 32 * kk, 16 * ki), accS[ki]);
            *(LAS u32x2*)(STbT + (16 * ki + fr) * 136 + 16 * wave + 4 * fq) = pack4(accS[ki][0], accS[ki][1], accS[ki][2], accS[ki][3]); } }
        LDS_BARRIER();
    }
#undef GLA_PREFETCH
    float* So = A.out + (sample ? O_SG : O_PG) + ((size_t)(l * NB + b) * 4 + h) * 8192;
    { int o_ = fr * 128 + 16 * wave + 4 * fq; OPQV(o_); float* sp = So + o_;
#pragma unroll
      for (int ki = 0; ki < 4; ++ki) {
#pragma unroll
        for (int r = 0; r < 4; ++r) sp[r] = accS[ki][r];
        sp += 2048; OPQV(sp); } }
    __syncthreads();
}

__device__ __forceinline__ int ssd_chmap(int hd, int c) { const int g = hd >> 2; return c < 64 ? hd * 64 + c : (c < 128 ? 512 + g * 64 + (c - 64) : 640 + g * 64 + (c - 128)); }
__device__ __forceinline__ void ssd_item(ArgP Ap, LAS unsigned char* lds, int l, int b, int hd, bool sample) {
    int tid_o = threadIdx.x; OPQV(tid_o);
    const int tid = tid_o, lane = tid & 63, wave = tid >> 6, fr = lane & 15, fq = lane >> 4;
    LAS bf16* RAW = (LAS bf16*)(lds); LAS bf16* Ys = (LAS bf16*)(lds); LAS bf16* W = (LAS bf16*)(lds + 9216); LAS bf16* Bw = (LAS bf16*)(lds + 18432);
    LAS bf16* Xs = (LAS bf16*)(lds + 27648); LAS bf16* Cs = (LAS bf16*)(lds + 36864); LAS bf16* Bs = (LAS bf16*)(lds + 46080); LAS bf16* HbT = (LAS bf16*)(lds + 55296);
    LAS bf16* HIST = (LAS bf16*)(lds + 64512); LAS float* DT = (LAS float*)(lds + 65792); LAS float* LM = (LAS float*)(lds + 66048);
    LAS float* CW = (LAS float*)(lds + 66304); LAS float* CBI = CW + 4 * 192;
    const int L = sample ? LS : LP, tok0 = sample ? TP + b * LS : b * LP, NB = sample ? BS : BP;
    const bf16* ZM = (const bf16*)(A.ws + WS_ZM); const float* ZS = (const float*)(A.ws + WS_ZS); bf16* BR2 = (bf16*)(A.ws + WS_BR) + (size_t)T * 1024;
    const float Dh = A.in[19][l * 8 + hd], dtb = A.in[17][l * 8 + hd], Ah = -__expf(A.in[18][l * 8 + hd]);
    f32x4 accH[2];
#pragma unroll
    for (int j = 0; j < 2; ++j) { const int idx = wave + 8 * j, pi = idx >> 2, ni = idx & 3; accH[j] = (f32x4){0.f, 0.f, 0.f, 0.f};
        if (sample) { const float* h0 = A.in[6] + ((size_t)(l * BS + b) * 8 + hd) * 4096;
            const float* hp = h0 + (16 * pi + 4 * fq) * 64 + 16 * ni + fr; OPQV(hp);
#pragma unroll
            for (int r = 0; r < 4; ++r) accH[j][r] = hp[r * 64]; }
        *(LAS u32x2*)(HbT + (16 * ni + fr) * 72 + 16 * pi + 4 * fq) = pack4(accH[j][0], accH[j][1], accH[j][2], accH[j][3]); }
    for (int e = tid; e < 5 * 192; e += NTHREADS) { const int j = e / 192, c = e % 192, ch = ssd_chmap(hd, c); CW[e] = (j < 4) ? A.in[15][(size_t)l * 4 * 768 + j * 768 + ch] : A.in[16][l * 768 + ch]; }
    for (int e = tid; e < 3 * 200; e += NTHREADS) { const int r = e / 200, c = e % 200; float v = 0.f;
        if (sample && c < 192) v = A.in[7][((size_t)(l * BS + b) * 3 + r) * 768 + ssd_chmap(hd, c)];
        HIST[e] = f2bf(v); }
    u32x4 pr[3], ps; float pdt = 0.f;
#define SSD_PREFETCH(T0N) do { const int nvn_ = (L - (T0N)) < 64 ? (L - (T0N)) : 64; \
        _Pragma("unroll") for (int i = 0; i < 3; ++i) { const int c = tid + 512 * i, t = c / 24, q = c % 24; pr[i] = (u32x4){0u, 0u, 0u, 0u}; \
            if (t < nvn_) pr[i] = *(const u32x4*)(ZM + (size_t)(tok0 + (T0N) + t) * NZM + 4096 + ssd_chmap(hd, 8 * q)); } \
        if (wave == 0) { pdt = 0.f; if (lane < nvn_) pdt = ZS[(size_t)(tok0 + (T0N) + lane) * NSM + 24 + hd]; } } while (0)
#define SSD_PREFETCH_Z(T0N) do { const int nvn_ = (L - (T0N)) < 64 ? (L - (T0N)) : 64; const int t = tid >> 3, part = tid & 7; ps = (u32x4){0u, 0u, 0u, 0u}; \
        if (t < nvn_) ps = *(const u32x4*)(ZM + (size_t)(tok0 + (T0N) + t) * NZM + 3584 + hd * 64 + 8 * part); } while (0)
    SSD_PREFETCH(0); SSD_PREFETCH_Z(0);
    __syncthreads();
    for (int t0 = 0; t0 < L; t0 += 64) {
        const int nv = (L - t0) < 64 ? (L - t0) : 64, nrt = (nv + 15) >> 4;
#pragma unroll
        for (int i = 0; i < 3; ++i) { const int c = tid + 512 * i, t = c / 24, q = c % 24; *(LAS u32x4*)(RAW + (3 + t) * 200 + 8 * q) = pr[i]; }
        if (tid < 3 * 25) { const int r = tid / 25, q = tid % 25; *(LAS u32x4*)(RAW + r * 200 + 8 * q) = *(const LAS u32x4*)(HIST + r * 200 + 8 * q); }
        if (wave == 0) { const float dtv = (lane < nv) ? softplusf(pdt + dtb) : 0.f; const float lam = scan_sum64(dtv * Ah, lane); DT[lane] = dtv; LM[lane] = lam; }
        SSD_PREFETCH(t0 + 64);
        LDS_BARRIER();
#pragma unroll
        for (int i = 0; i < 3; ++i) { const int c = tid + 512 * i, t = c / 24, q = c % 24; float o[8];
#pragma unroll
            for (int e = 0; e < 8; ++e) o[e] = CBI[8 * q + e];
#pragma unroll
            for (int j = 0; j < 4; ++j) { float x[8]; unpack8(*(const LAS u32x4*)(RAW + (t + j) * 200 + 8 * q), x);
#pragma unroll
                for (int e = 0; e < 8; ++e) o[e] += CW[j * 192 + 8 * q + e] * x[e]; }
#pragma unroll
            for (int e = 0; e < 8; ++e) o[e] = (t < nv) ? siluf(o[e]) : 0.f;
            LAS bf16* dst = (q < 8) ? Xs + t * 72 + q * 8 : (q < 16 ? Bs + t * 72 + (q - 8) * 8 : Cs + t * 72 + (q - 16) * 8);
            *(LAS u32x4*)dst = pack8(o); }
        LDS_BARRIER();
        if (tid < 3 * 25) { const int r = tid / 25, q = tid % 25; *(LAS u32x4*)(HIST + r * 200 + 8 * q) = *(const LAS u32x4*)(RAW + (nv + r) * 200 + 8 * q); }
        f32x4 cbT[2];
#pragma unroll
        for (int j = 0; j < 2; ++j) { const int idx = wave + 8 * j, ti = idx >> 2, si = idx & 3; cbT[j] = (f32x4){0.f, 0.f, 0.f, 0.f};
            if (si <= ti && ti < nrt) MMA_RR(cbT[j], Bs, 72, 16 * si, Cs, 72, 16 * ti, 64); }
        LDS_BARRIER();
#pragma unroll
        for (int j = 0; j < 2; ++j) { const int idx = wave + 8 * j, ti = idx >> 2, si = idx & 3; const int t = 16 * ti + fr; const float lt = LM[t]; float v[4];
#pragma unroll
            for (int r = 0; r < 4; ++r) { const int s = 16 * si + 4 * fq + r; v[r] = (s <= t) ? cbT[j][r] * __expf(lt - LM[s]) * DT[s] : 0.f; }
            *(LAS u32x2*)(W + t * 72 + 16 * si + 4 * fq) = pack4(v[0], v[1], v[2], v[3]); }
        { const int s = tid >> 3, n0 = (tid & 7) * 8; float v[8]; unpack8(*(const LAS u32x4*)(Bs + s * 72 + n0), v); const float ws = __expf(LM[63] - LM[s]) * DT[s];
#pragma unroll
            for (int i = 0; i < 8; ++i) v[i] *= ws;
            *(LAS u32x4*)(Bw + s * 72 + n0) = pack8(v); }
        LDS_BARRIER();
        { const int pi = wave & 3; bf16x8 bH[2], bX[2];
#pragma unroll
          for (int kk = 0; kk < 2; ++kk) { bH[kk] = FTR(HbT, 72, 32 * kk, 16 * pi); bX[kk] = FTR(Xs, 72, 32 * kk, 16 * pi); }
#pragma unroll
          for (int j = 0; j < 2; ++j) { const int ti = (wave >> 2) + 2 * j; if (ti >= nrt) continue; f32x4 acc = {0.f, 0.f, 0.f, 0.f};
#pragma unroll
            for (int kk = 0; kk < 2; ++kk) acc = mfma16(FROW(Cs, 72, 16 * ti, 32 * kk), bH[kk], acc);
#pragma unroll
            for (int r = 0; r < 4; ++r) acc[r] *= __expf(LM[16 * ti + 4 * fq + r]);
#pragma unroll
            for (int kk = 0; kk < 2; ++kk) acc = mfma16(FROW(W, 72, 16 * ti, 32 * kk), bX[kk], acc);
#pragma unroll
            for (int r = 0; r < 4; ++r) { const int t = 16 * ti + 4 * fq + r, p = 16 * pi + fr; Ys[t * 72 + p] = f2bf(acc[r] + Dh * bf2f(Xs[t * 72 + p])); } } }
        { const float dec = __expf(LM[63]); const int ni = wave & 3; bf16x8 bB[2];
#pragma unroll
          for (int kk = 0; kk < 2; ++kk) bB[kk] = FTR(Bw, 72, 32 * kk, 16 * ni);
#pragma unroll
          for (int j = 0; j < 2; ++j) { const int pi = (wave >> 2) + 2 * j;
#pragma unroll
            for (int r = 0; r < 4; ++r) accH[j][r] *= dec;
#pragma unroll
            for (int kk = 0; kk < 2; ++kk) accH[j] = mfma16(FTR(Xs, 72, 32 * kk, 16 * pi), bB[kk], accH[j]); } }
        LDS_BARRIER();
#pragma unroll
        for (int j = 0; j < 2; ++j) { const int idx = wave + 8 * j, pi = idx >> 2, ni = idx & 3;
            *(LAS u32x2*)(HbT + (16 * ni + fr) * 72 + 16 * pi + 4 * fq) = pack4(accH[j][0], accH[j][1], accH[j][2], accH[j][3]); }
        { const int t = tid >> 3, part = tid & 7; float f[8], z[8]; unpack8(*(const LAS u32x4*)(Ys + t * 72 + 8 * part), f); unpack8(ps, z);
#pragma unroll
            for (int i = 0; i < 8; ++i) f[i] *= siluf(z[i]);
            if (t < nv) *(u32x4*)(BR2 + (size_t)(tok0 + t0 + t) * 512 + hd * 64 + 8 * part) = pack8(f); }
        SSD_PREFETCH_Z(t0 + 64);
        LDS_BARRIER();
    }
#undef SSD_PREFETCH_Z
#undef SSD_PREFETCH
    { float* ho = A.out + (sample ? O_SH : O_PH) + ((size_t)(l * NB + b) * 8 + hd) * 4096;
#pragma unroll
        for (int j = 0; j < 2; ++j) { const int idx = wave + 8 * j, pi = idx >> 2, ni = idx & 3;
            float* hp = ho + (16 * pi + 4 * fq) * 64 + 16 * ni + fr; OPQV(hp);
#pragma unroll
            for (int r = 0; r < 4; ++r) hp[r * 64] = accH[j][r]; } }
    for (int e = tid; e < 3 * 192; e += NTHREADS) { const int r = e / 192, c = e % 192;
        if (c < 64 || (hd & 3) == 0) A.out[(sample ? O_SV : O_PV) + ((size_t)(l * NB + b) * 3 + r) * 768 + ssd_chmap(hd, c)] = bf2f(HIST[r * 200 + c]); }
    __syncthreads();
}

__device__ __forceinline__ void phase_ssdnorm(ArgP Ap, int l) {
    const int tx = opaque_tid(), lane = tx & 63, wave = tx >> 6, gw = obid() * NWAVES + wave, NGW = ogrid() * NWAVES;
    bf16* BR2 = (bf16*)(A.ws + WS_BR) + (size_t)T * 1024; const float* sn = A.in[20] + l * 512 + 8 * lane;
    for (int tok = gw; tok < T; tok += NGW) { float f[8]; unpack8(*(const u32x4*)(BR2 + (size_t)tok * 512 + 8 * lane), f); float s2 = 0.f;
#pragma unroll
        for (int i = 0; i < 8; ++i) s2 += f[i] * f[i];
#pragma unroll
        for (int m = 1; m < 32; m <<= 1) s2 += __shfl_xor(s2, m);
        const float rstd = 1.0f / sqrtf(s2 * (1.0f / 256.0f) + EPS_);
#pragma unroll
        for (int i = 0; i < 8; ++i) f[i] *= rstd * sn[i];
        *(u32x4*)(BR2 + (size_t)tok * 512 + 8 * lane) = pack8(f); }
}

__device__ __forceinline__ void mixer_item(ArgP Ap, LAS unsigned char* lds, int l, int it) {
    constexpr int NL0 = BP * 4, NL1 = NL0 + BP * 4, NL2 = NL1 + BP * 8, NS0 = NL2 + BS * 4, NS1 = NS0 + BS * 4;
    int kind, r; bool sample;
    if (it < NL0) { kind = 0; r = it; sample = false; } else if (it < NL1) { kind = 1; r = it - NL0; sample = false; } else if (it < NL2) { kind = 2; r = it - NL1; sample = false; }
    else if (it < NS0) { kind = 0; r = it - NL2; sample = true; } else if (it < NS1) { kind = 1; r = it - NS0; sample = true; } else { kind = 2; r = it - NS1; sample = true; }
#ifndef ONLYK
#define ONLYK -1
#endif
#ifndef EMU
#define OPQ() ArgP Ap_ = Ap; int l_ = __builtin_amdgcn_readfirstlane(l), r_ = __builtin_amdgcn_readfirstlane(r); LAS unsigned char* lds_ = lds; asm volatile("" : "+s"(Ap_), "+s"(l_), "+s"(r_), "+s"(lds_) :: "memory")
#else
#define OPQ() ArgP Ap_ = Ap; int l_ = l, r_ = r; LAS unsigned char* lds_ = lds
#endif
    if ((ONLYK < 0 || ONLYK == 0) && kind == 0) { OPQ(); mlstm_item(Ap_, lds_, l_, r_ >> 2, r_ & 3, sample); }
    else if ((ONLYK < 0 || ONLYK == 1) && kind == 1) { OPQ(); gla_item(Ap_, lds_, l_, r_ >> 2, r_ & 3, sample); }
    else if ((ONLYK < 0 || ONLYK == 2) && kind == 2) { OPQ(); ssd_item(Ap_, lds_, l_, r_ >> 3, r_ & 7, sample); }
#undef OPQ
}
__device__ __forceinline__ void phase_mixers(ArgP Ap, LAS unsigned char* lds, int l) {
    constexpr int NLONG = BP * 16, NSHORT = BS * 16; int G = ogrid(), bid = obid(); OPQS(G); OPQS(bid);
#ifdef MIX_NOSPLIT
    const bool split = false;
#else
    const bool split = G > NLONG;
#endif
#ifndef MIX_IDLE
#define MIX_IDLE 0
#endif
    const int step = split ? (bid < NLONG ? (1 << 28) : G - NLONG - MIX_IDLE) : G;
    if (split && MIX_IDLE && bid >= G - MIX_IDLE) return;
#ifndef MIXREP
#define MIXREP 0
#endif
#pragma unroll 1
    for (int it = bid; it < NLONG + NSHORT; it += step) {
        const int reps = ((MIXREP == 1 && it < NLONG) || (MIXREP == 2 && it >= NLONG) || (MIXREP == 3 && it < BP * 4) || (MIXREP == 4 && it >= BP * 4 && it < BP * 8) || (MIXREP == 5 && it >= BP * 8 && it < NLONG)) ? 2 : 1;
#pragma unroll 1
        for (int rp = 0; rp < reps; ++rp) mixer_item(Ap, lds, l, it);
    }
    if (!split || bid >= NLONG) { const int part = split ? bid - NLONG : bid, nparts = split ? G - NLONG : G;
        __syncthreads();
        convert_tables(Ap, l, part, nparts);
        if (l == 0) convert_weights(Ap, lds, 1, part, nparts); }
}

__device__ __forceinline__ float wave_sum64(float v) {
#pragma unroll
    for (int m = 1; m < 64; m <<= 1) v += __shfl_xor(v, m);
    return v;
}
constexpr float DN_ALPHA_ = 1.4142135623730951f;

__device__ __forceinline__ void phase_ln1(ArgP Ap, int l) {
    const int tx = opaque_tid(), lane = tx & 63, wave = tx >> 6, gw = obid() * NWAVES + wave, NGW = ogrid() * NWAVES;
    const float* Y = (const float*)(A.ws + WS_ZG); float* H = (float*)(A.ws + WS_H); bf16* H1B = (bf16*)(A.ws + WS_BR);
    const float* lg = A.in[23] + l * D + 16 * lane; const float* lb = A.in[24] + l * D + 16 * lane;
    for (int tok = gw; tok < T; tok += NGW) {
        const float* xr = (l == 0) ? (tok < TP ? A.in[0] + (size_t)tok * D : A.in[1] + (size_t)(tok - TP) * D) : H + (size_t)tok * D;
        float y[16]; float s1 = 0.f;
#pragma unroll
        for (int q = 0; q < 4; ++q) { const float4 a = *(const float4*)(xr + 16 * lane + 4 * q), b = *(const float4*)(Y + (size_t)tok * D + 16 * lane + 4 * q);
            y[4 * q] = DN_ALPHA_ * a.x + b.x; y[4 * q + 1] = DN_ALPHA_ * a.y + b.y; y[4 * q + 2] = DN_ALPHA_ * a.z + b.z; y[4 * q + 3] = DN_ALPHA_ * a.w + b.w; }
#pragma unroll
        for (int i = 0; i < 16; ++i) s1 += y[i];
        const float mu = wave_sum64(s1) * (1.0f / D); float s2 = 0.f;
#pragma unroll
        for (int i = 0; i < 16; ++i) { y[i] -= mu; s2 += y[i] * y[i]; }
        const float rstd = 1.0f / sqrtf(wave_sum64(s2) * (1.0f / D) + EPS_);
#pragma unroll
        for (int i = 0; i < 16; ++i) y[i] = y[i] * rstd * lg[i] + lb[i];
#pragma unroll
        for (int q = 0; q < 4; ++q) *(float4*)(H + (size_t)tok * D + 16 * lane + 4 * q) = make_float4(y[4 * q], y[4 * q + 1], y[4 * q + 2], y[4 * q + 3]);
        float y0[8], y1[8];
#pragma unroll
        for (int i = 0; i < 8; ++i) { y0[i] = y[i]; y1[i] = y[8 + i]; }
        *(u32x4*)(H1B + (size_t)tok * D + 16 * lane) = pack8(y0); *(u32x4*)(H1B + (size_t)tok * D + 16 * lane + 8) = pack8(y1);
    }
}

__device__ __forceinline__ unsigned ord_of(float f) { const unsigned u = __float_as_uint(f); return (u & 0x80000000u) ? ~u : (u | 0x80000000u); }
__device__ __forceinline__ float dec_ord(unsigned o) { const unsigned u = (o & 0x80000000u) ? (o & 0x7fffffffu) : ~o; return __uint_as_float(u); }
__device__ __forceinline__ unsigned umax_(unsigned a, unsigned b) { return a > b ? a : b; }
__device__ __forceinline__ unsigned umin_(unsigned a, unsigned b) { return a < b ? a : b; }
__device__ __forceinline__ void ins16(unsigned (&L)[16], unsigned x) {
#pragma unroll
    for (int p = 0; p < 16; ++p) { const unsigned hi = umax_(L[p], x); x = umin_(L[p], x); L[p] = hi; }
}
__device__ __forceinline__ unsigned sel16(const unsigned (&L)[16], int a) { unsigned r = L[0];
#pragma unroll
    for (int p = 1; p < 16; ++p) r = (a == p) ? L[p] : r;
    return r; }

__device__ __forceinline__ void route_topk(const bf16* __restrict__ Q, const LAS bf16* KEYS, int tokb, int h, int j, int fr, int fq, unsigned (&Lt)[16]) {
    f32x4 acc[8];
#pragma unroll
    for (int ki = 0; ki < 8; ++ki) acc[ki] = (f32x4){0.f, 0.f, 0.f, 0.f};
#pragma unroll
    for (int kk = 0; kk < 4; ++kk) { const bf16x8 bq = *(const bf16x8*)(Q + (size_t)(tokb + fr) * 2048 + h * 256 + j * 128 + 32 * kk + 8 * fq);
#pragma unroll
        for (int ki = 0; ki < 8; ++ki) { const bf16x8 ak = *(const LAS bf16x8*)(KEYS + (j * 128 + 16 * ki + fr) * 136 + 32 * kk + 8 * fq); acc[ki] = mfma16(ak, bq, acc[ki]); } }
#pragma unroll
    for (int p = 0; p < 16; ++p) Lt[p] = 0u;
#pragma unroll
    for (int ki = 0; ki < 8; ++ki)
#pragma unroll
        for (int r = 0; r < 4; ++r) ins16(Lt, (ord_of(acc[ki][r]) & ~127u) | (unsigned)(127 - (16 * ki + 4 * fq + r)));
#pragma unroll
    for (int m = 16; m < 64; m <<= 1) { unsigned R[16];
#pragma unroll
        for (int p = 0; p < 16; ++p) R[p] = __shfl_xor(Lt[p], m);
#pragma unroll
        for (int p = 0; p < 16; ++p) ins16(Lt, R[p]); }
}

__device__ __forceinline__ void phase_route(ArgP Ap, LAS unsigned char* lds, int l) {
    const int tid = opaque_tid(), lane = tid & 63, wave = tid >> 6, fr = lane & 15, fq = lane >> 4;
    LAS bf16* KEYS = (LAS bf16*)lds;
    LAS unsigned* LST = (LAS unsigned*)(lds + 69632);
    const bf16* Q = (const bf16*)(A.ws + WS_Q); int* IDX = (int*)(A.ws + WS_IDX); float* GT = (float*)(A.ws + WS_GT);
    const bf16* kg = (const bf16*)(A.ws + WS_WB + (size_t)l * WB_BYTES + WB_KEYS);
    constexpr int NG = T / 16, NCH = (NG + 7) / 8, NITEMS = NCH * 8;
    int last_h = -1;
    for (int it = obid(); it < NITEMS; it += ogrid()) {
        const int h = it & 7, ch = it >> 3;
        if (h != last_h) { __syncthreads();
            for (int c = tid; c < 2 * 128 * 16; c += NTHREADS) { const int row = c >> 4, cc = (c & 15) * 8; *(LAS u32x4*)(KEYS + row * 136 + cc) = *(const u32x4*)(kg + ((size_t)h * 256 + row) * 128 + cc); }
            __syncthreads(); last_h = h; }
        const int grp = ch * 8 + wave;
        if (grp < NG) {
            const int tokb = grp * 16; unsigned L1[16], L2[16];
            route_topk(Q, KEYS, tokb, h, 0, fr, fq, L1); route_topk(Q, KEYS, tokb, h, 1, fr, fq, L2);
            unsigned C[16];
#pragma unroll
            for (int p = 0; p < 16; ++p) C[p] = 0u;
#pragma unroll
            for (int a = 0; a < 16; ++a)
#pragma unroll
                for (int b = 0; b < 16; ++b) if ((a + 1) * (b + 1) <= 16) {
                    const float s = dec_ord(L1[a] & ~127u) + dec_ord(L2[b] & ~127u); ins16(C, (ord_of(s) & ~255u) | (unsigned)(255 - (a * 16 + b))); }
            const float s0 = dec_ord(C[0] & ~255u); float e[16]; float sum = 0.f;
#pragma unroll
            for (int p = 0; p < 16; ++p) { e[p] = __expf(dec_ord(C[p] & ~255u) - s0); sum += e[p]; }
            const float inv = 1.0f / sum; const size_t ob = (size_t)(tokb + fr) * 128 + h * 16;
#pragma unroll
            for (int p = 0; p < 16; ++p) { LST[(wave * 32 + p) * 64 + lane] = L1[p]; LST[(wave * 32 + 16 + p) * 64 + lane] = L2[p]; }
#pragma unroll
            for (int p = 0; p < 16; ++p) { const int cid = 255 - (int)(C[p] & 255u); const int a = cid >> 4, b = cid & 15;
                const int e1 = 127 - (int)(LST[(wave * 32 + a) * 64 + lane] & 127u), e2 = 127 - (int)(LST[(wave * 32 + 16 + b) * 64 + lane] & 127u);
                if ((p >> 2) == fq) { IDX[ob + p] = e1 * 128 + e2; GT[ob + p] = e[p] * inv; } }
        }
    }
}

__device__ __forceinline__ void phase_gather(ArgP Ap, int l) {
    const int tx = opaque_tid(), lane = tx & 63, wave = tx >> 6, gw = obid() * NWAVES + wave, NGW = ogrid() * NWAVES, rho = lane >> 4;
    float* H = (float*)(A.ws + WS_H); bf16* XB = (bf16*)(A.ws + WS_XB); const int* IDX = (const int*)(A.ws + WS_IDX); const float* GT = (const float*)(A.ws + WS_GT);
    const unsigned char* PU = A.ws + WS_PU; const unsigned char* PV = A.ws + WS_PV; const float* PUS = (const float*)(A.ws + WS_PUS); const float* PVS = (const float*)(A.ws + WS_PVS);
    const float* lgb = A.in[29] + l * D; const float* lbb = A.in[30] + l * D; const int l16 = 16 * lane;
    const int kofs = 2 * (rho & 1) + (rho >> 1);
    for (int tok = gw; tok < T; tok += NGW) {
        const int i0 = IDX[(size_t)tok * 128 + lane], i1 = IDX[(size_t)tok * 128 + 64 + lane];
        float x[16];
#pragma unroll
        for (int q = 0; q < 4; ++q) { const float4 a = *(const float4*)(H + (unsigned)tok * D + l16 + 4 * q); x[4 * q] = a.x; x[4 * q + 1] = a.y; x[4 * q + 2] = a.z; x[4 * q + 3] = a.w; }
        const float su0 = PUS[i0], su1 = PUS[i1];
        const float gv0 = GT[(size_t)tok * 128 + lane] * PVS[i0], gv1 = GT[(size_t)tok * 128 + 64 + lane] * PVS[i1];
        float o[16];
#pragma unroll
        for (int i = 0; i < 16; ++i) o[i] = 0.f;
#pragma unroll 1
        for (int kb = 0; kb < 128; kb += 8) {
            u32x4 uu[8], vv[8];
#pragma unroll
            for (int kk = 0; kk < 8; ++kk) { const int e = __shfl(kb < 64 ? i0 : i1, (kb + kk) & 63);
                const unsigned off = (unsigned)e * D + l16; uu[kk] = *(const u32x4*)(PU + off); vv[kk] = *(const u32x4*)(PV + off); }
            float r[2];
#pragma unroll
            for (int i = 0; i < 2; ++i) { float p[4];
#pragma unroll
                for (int c = 0; c < 4; ++c) { const int kk = 4 * i + c; float f[16]; unpk_fp8x4(uu[kk].x, f); unpk_fp8x4(uu[kk].y, f + 4); unpk_fp8x4(uu[kk].z, f + 8); unpk_fp8x4(uu[kk].w, f + 12); float s = 0.f;
#pragma unroll
                    for (int j = 0; j < 16; ++j) s += f[j] * x[j];
                    p[c] = s; SCHED_FENCE(); }
                float t = row_allsum(swap16_add(swap32_add(p[0], p[1]), swap32_add(p[2], p[3])));
                const int kq = kb + 4 * i + kofs;
                t *= __shfl(kb < 64 ? su0 : su1, kq & 63);
                r[i] = 0.5f * t * (1.0f + erff(t * 0.70710678118654752f)) * __shfl(kb < 64 ? gv0 : gv1, kq & 63); SCHED_FENCE(); }
#pragma unroll
            for (int kk = 0; kk < 8; ++kk) { const int c = kk & 3; const float act = RDLANE(r[kk >> 2], 16 * (((c & 1) << 1) | ((c >> 1) & 1)));
                float f[16]; unpk_fp8x4(vv[kk].x, f); unpk_fp8x4(vv[kk].y, f + 4); unpk_fp8x4(vv[kk].z, f + 8); unpk_fp8x4(vv[kk].w, f + 12);
#pragma unroll
                for (int j = 0; j < 16; ++j) o[j] += act * f[j];
                SCHED_FENCE(); }
        }
        float s1 = 0.f;
#pragma unroll
        for (int i = 0; i < 16; ++i) { o[i] += DN_ALPHA_ * x[i]; s1 += o[i]; }
        const float mu = wave_sum64(s1) * (1.0f / D); float s2 = 0.f;
#pragma unroll
        for (int i = 0; i < 16; ++i) { o[i] -= mu; s2 += o[i] * o[i]; }
        const float rstd = 1.0f / sqrtf(wave_sum64(s2) * (1.0f / D) + EPS_);
#pragma unroll
        for (int i = 0; i < 16; ++i) o[i] = o[i] * rstd * lgb[l16 + i] + lbb[l16 + i];
        float* dst = ((l == 1) ? A.out : H) + (unsigned)tok * D + l16;
#pragma unroll
        for (int q = 0; q < 4; ++q) *(float4*)(dst + 4 * q) = make_float4(o[4 * q], o[4 * q + 1], o[4 * q + 2], o[4 * q + 3]);
        if (l == 0) { float y0[8], y1[8];
#pragma unroll
            for (int i = 0; i < 8; ++i) { y0[i] = o[i]; y1[i] = o[8 + i]; }
            *(u32x4*)(XB + (unsigned)tok * D + l16) = pack8(y0); *(u32x4*)(XB + (unsigned)tok * D + l16 + 8) = pack8(y1); }
    }
}


#ifndef EMU
struct MergeOrder {
    pg8::StaticOrder S;
    __device__ bool next(int i, pg8::Unit& u) const { pg8::Unit t; if (!S.next(i, t)) return false; const int n = t.pm / (T / 256); u.pm = t.pm; u.pn = n * 4 + t.pn; return true; }
    __device__ __forceinline__ void a_ready(const pg8::Unit&) const {}
    __device__ __forceinline__ void done(const pg8::Unit&) const {}
};
struct EpiP {
    static constexpr bool PERM = true, AFTER_DRAIN = false;
    bf16* P;
    __device__ __forceinline__ void operator()(const pg8::f32x4 (&acc)[2][2][4][2], const pg8::Unit& u, int wr, int wc, int fr, int fq) const {
        const int row0 = u.pm * 256 + wr * 64 + fr, col0 = (u.pn & 3) * 256 + wc * 32 + 8 * fq;
#pragma unroll
        for (int ai = 0; ai < 2; ++ai)
#pragma unroll
            for (int m = 0; m < 4; ++m) { bf16* rowp = P + (size_t)(row0 + ai * 128 + m * 16) * D + col0;
#pragma unroll
                for (int bj = 0; bj < 2; ++bj) { const pg8::f32x4 v0 = acc[ai][bj][m][0], v1 = acc[ai][bj][m][1];
                    u32x4 w; w.x = pg8::cvt_pk_bf16(v0[0], v0[1]); w.y = pg8::cvt_pk_bf16(v0[2], v0[3]); w.z = pg8::cvt_pk_bf16(v1[0], v1[1]); w.w = pg8::cvt_pk_bf16(v1[2], v1[3]);
                    *(u32x4*)(rowp + bj * 128) = w; } }
    }
};
__device__ __forceinline__ void phase_merge(ArgP Ap, LAS unsigned char* lds, int l) {
    pg8::Gemm g{(const bf16*)(A.ws + WS_BR), (const bf16*)(A.ws + WS_WB + (size_t)l * WB_BYTES + WB_WBR), 3 * T, 3 * D, 512};
    MergeOrder S; S.S.init(3 * T, D, ogrid(), obid());
    EpiP E{(bf16*)(A.ws + WS_ZM)};
    pg8::gemm_phase<EpiP, MergeOrder>(lds, g, S, E);
}
#endif
__device__ __forceinline__ void phase_combine(ArgP Ap) {
    const size_t gtid = (size_t)obid() * NTHREADS + opaque_tid(), gthreads = (size_t)ogrid() * NTHREADS;
    const bf16* P = (const bf16*)(A.ws + WS_ZM); const bf16* ZG = (const bf16*)(A.ws + WS_ZG); bf16* MIXED = (bf16*)(A.ws + WS_XB);
    for (size_t i = gtid; i < (size_t)T * (D / 8); i += gthreads) { const size_t t = i >> 7, c = (i & 127) * 8; float v[8];
#pragma unroll
        for (int j = 0; j < 8; ++j) v[j] = 0.f;
#pragma unroll
        for (int n = 0; n < 3; ++n) { float p[8], g[8]; unpack8(*(const u32x4*)(P + ((size_t)n * T + t) * D + c), p); unpack8(*(const u32x4*)(ZG + t * NZG + n * D + c), g);
#pragma unroll
            for (int j = 0; j < 8; ++j) v[j] += p[j] * g[j]; }
        *(u32x4*)(MIXED + t * D + c) = pack8(v); }
}
#ifndef EMU
struct EpiF32 {
    static constexpr bool PERM = false, AFTER_DRAIN = false;
    float* C; int ldc;
    __device__ __forceinline__ void operator()(const pg8::f32x4 (&acc)[2][2][4][2], const pg8::Unit& u, int wr, int wc, int fr, int fq) const {
        const int row0 = u.pm * 256 + wr * 64 + fr, col0 = u.pn * 256 + wc * 32 + 4 * fq;
#pragma unroll
        for (int ai = 0; ai < 2; ++ai)
#pragma unroll
            for (int m = 0; m < 4; ++m) { float* rowp = C + (size_t)(row0 + ai * 128 + m * 16) * ldc + col0;
#pragma unroll
                for (int bj = 0; bj < 2; ++bj)
#pragma unroll
                    for (int n = 0; n < 2; ++n) *(pg8::f32x4*)(rowp + bj * 128 + n * 16) = acc[ai][bj][m][n]; }
    }
};
struct EpiB16 {
    static constexpr bool PERM = true, AFTER_DRAIN = false;
    bf16* O; int ldc;
    __device__ __forceinline__ void operator()(const pg8::f32x4 (&acc)[2][2][4][2], const pg8::Unit& u, int wr, int wc, int fr, int fq) const {
        const int row0 = u.pm * 256 + wr * 64 + fr, col0 = u.pn * 256 + wc * 32 + 8 * fq;
#pragma unroll
        for (int ai = 0; ai < 2; ++ai)
#pragma unroll
            for (int m = 0; m < 4; ++m) { bf16* rowp = O + (size_t)(row0 + ai * 128 + m * 16) * ldc + col0;
#pragma unroll
                for (int bj = 0; bj < 2; ++bj) { const pg8::f32x4 v0 = acc[ai][bj][m][0], v1 = acc[ai][bj][m][1];
                    u32x4 w; w.x = pg8::cvt_pk_bf16(v0[0], v0[1]); w.y = pg8::cvt_pk_bf16(v0[2], v0[3]); w.z = pg8::cvt_pk_bf16(v1[0], v1[1]); w.w = pg8::cvt_pk_bf16(v1[2], v1[3]);
                    *(u32x4*)(rowp + bj * 128) = w; } }
    }
};
__device__ __forceinline__ void phase_outproj(ArgP Ap, LAS unsigned char* lds, int l) {
    pg8::Gemm g{(const bf16*)(A.ws + WS_XB), (const bf16*)(A.ws + WS_WB + (size_t)l * WB_BYTES + WB_WO), T, D, D};
    pg8::StaticOrder S; S.init(T, D, ogrid(), obid());
    EpiF32 E{(float*)(A.ws + WS_ZG), D};
    pg8::gemm_phase<EpiF32, pg8::StaticOrder>(lds, g, S, E);
}
__device__ __forceinline__ void phase_qproj(ArgP Ap, LAS unsigned char* lds, int l) {
    pg8::Gemm g{(const bf16*)(A.ws + WS_BR), (const bf16*)(A.ws + WS_WB + (size_t)l * WB_BYTES + WB_WQ), T, 2048, D};
    pg8::StaticOrder S; S.init(T, 2048, ogrid(), obid());
    EpiB16 E{(bf16*)(A.ws + WS_Q), 2048};
    pg8::gemm_phase<EpiB16, pg8::StaticOrder>(lds, g, S, E);
}

__global__ void __launch_bounds__(NTHREADS, 2) mega_fwd(Args kargs) {
    extern __shared__ __attribute__((aligned(16))) unsigned char lds_raw[];
    LAS unsigned char* lds = (LAS unsigned char*)lds_raw;
    volatile LAS unsigned* xst = (volatile LAS unsigned*)(lds + LDS_BYTES - 16);
    unsigned* xbar = (unsigned*)(kargs.ws + WS_CTL);
    if (threadIdx.x < 4) xst[threadIdx.x] = 0u;
    if (blockIdx.x == 0) for (int i = threadIdx.x; i < XCD_BAR_WORDS; i += NTHREADS) xbar[i] = 0u;
#ifdef STAGE_AMP
    if (blockIdx.x == 0 && threadIdx.x < 128) ((unsigned long long*)(kargs.ws + WS_CTL + 40960))[threadIdx.x] = 0ull;
#endif
    __syncthreads();
    XcdBarrier xb; xb.bar = xbar; xb.x = 0; xb.st = xst;
    ArgP Ap = (ArgP)__builtin_amdgcn_kernarg_segment_ptr();
#define RUN(call) do { ArgP Ap_ = Ap; int l_ = l; LAS unsigned char* lds_ = lds; asm volatile("" : "+s"(Ap_), "+s"(l_), "+s"(lds_) :: "memory"); { ArgP Ap = Ap_; const int l = l_; LAS unsigned char* lds = lds_; (void)lds; call; } asm volatile("" ::: "memory"); } while (0)
#ifndef ONLYP
#define ONLYP -1
#endif
#ifndef SKIPP
#define SKIPP -2
#endif
#define PSEL(q) ((ONLYP < 0 || ONLYP == (q)) && SKIPP != (q))
#ifndef REPMASK
#define REPMASK 0
#endif
#define REP(q, l) (((REPMASK >> (q)) & 1) && ((q) != 5 || (l) == 0) && ((q) != 8 || (l) == 1))
#define IN(k) true
#ifdef AMP_PHASE
#define TSTAMP(k) do { if (blockIdx.x == 0 && threadIdx.x == 0) ((unsigned long long*)(kargs.ws + WS_CTL + 32768))[(k)] = __builtin_amdgcn_s_memrealtime(); } while (0)
#else
#define TSTAMP(k) do {} while (0)
#endif
#define SEAM(k) do { if ((k) == 0) { cg::this_grid().sync(); xb = xcd_barrier_post(xbar, xst); } else xcd_barrier(xb); TSTAMP((k) + 1); } while (0)
#pragma unroll 1
    TSTAMP(0);
    {
    { const int l = 0; if (PSEL(0) && IN(0)) { RUN(phase_convert(Ap, lds)); if (REP(0, l)) RUN(phase_convert(Ap, lds)); } (void)l; }
    SEAM(0);
    for (int l = 0; l < 2; ++l) {
        const int p = 1 + 10 * l;
        if (PSEL(1) && IN(p + 0)) { RUN(phase_gemm1(Ap, lds, l)); if (REP(1, l)) RUN(phase_gemm1(Ap, lds, l)); }
        SEAM(p);
        if (PSEL(2) && IN(p + 1)) { RUN(phase_mixers(Ap, lds, l)); if (REP(2, l)) RUN(phase_mixers(Ap, lds, l)); }
        SEAM(p + 1);
#ifdef XBAR_EXTRA
        for (int xe = 0; xe < XBAR_EXTRA; ++xe) xcd_barrier(xb);
#endif
        if (PSEL(9) && IN(p + 2)) RUN(phase_ssdnorm(Ap, l));
        SEAM(p + 2);
        if (PSEL(3) && IN(p + 3)) { RUN(phase_merge(Ap, lds, l)); if (REP(3, l)) RUN(phase_merge(Ap, lds, l)); }
        SEAM(p + 3);
        if (PSEL(10) && IN(p + 4)) RUN(phase_combine(Ap));
        SEAM(p + 4);
        if (PSEL(4) && IN(p + 5)) { RUN(phase_outproj(Ap, lds, l)); if (REP(4, l)) RUN(phase_outproj(Ap, lds, l)); }
        SEAM(p + 5);
        if (PSEL(5) && IN(p + 6)) { RUN(phase_ln1(Ap, l)); if (REP(5, l)) RUN(phase_ln1(Ap, l)); }
        SEAM(p + 6);
        if (PSEL(6) && IN(p + 7)) { RUN(phase_qproj(Ap, lds, l)); if (REP(6, l)) RUN(phase_qproj(Ap, lds, l)); }
        SEAM(p + 7);
        if (PSEL(7) && IN(p + 8)) { RUN(phase_route(Ap, lds, l)); if (REP(7, l)) RUN(phase_route(Ap, lds, l)); }
        SEAM(p + 8);
        if (PSEL(8) && IN(p + 9)) { RUN(phase_gather(Ap, l)); if (REP(8, l)) RUN(phase_gather(Ap, l)); }
        SEAM(p + 9);
    }
    }
#ifdef AMP_PHASE
    if (blockIdx.x == 0 && threadIdx.x == 0) { const unsigned long long* ts = (const unsigned long long*)(kargs.ws + WS_CTL + 32768);
        const unsigned long long dt = (ts[AMP_PHASE + 1] - ts[AMP_PHASE]) * 8ull, t0 = __builtin_amdgcn_s_memrealtime();
        while (__builtin_amdgcn_s_memrealtime() - t0 < dt) __builtin_amdgcn_s_sleep(8); }
#endif
#ifdef STAGE_AMP
    if (blockIdx.x == 0 && threadIdx.x == 0) { const unsigned long long dt = ((const unsigned long long*)(kargs.ws + WS_CTL + 40960))[STAGE_AMP] * 8ull, t0 = __builtin_amdgcn_s_memrealtime();
        while (__builtin_amdgcn_s_memrealtime() - t0 < dt) __builtin_amdgcn_s_sleep(8); }
#endif
#undef IN
#undef RUN
#undef SEAM
}

extern "C" void kernel_launch(void* const* d_in, const int* in_sizes, int n_in, void* d_out, int out_size, void* d_ws, size_t ws_size, hipStream_t stream) {
    static int grid_blocks = 0;
    if (grid_blocks == 0) {
        if (n_in != 31 || (size_t)out_size != O_END || ws_size < WS_END) {
            fprintf(stderr, "kernel_launch: unexpected problem: n_in %d out %d (want %zu) ws %zu (want >= %zu)\n", n_in, out_size, (size_t)O_END, ws_size, (size_t)WS_END); grid_blocks = -1; return; }
        int dev = 0, cus = 0, per_cu = 0;
        (void)hipGetDevice(&dev); (void)hipDeviceGetAttribute(&cus, hipDeviceAttributeMultiprocessorCount, dev);
        if (hipFuncSetAttribute((const void*)mega_fwd, hipFuncAttributeMaxDynamicSharedMemorySize, LDS_BYTES) != hipSuccess) { fprintf(stderr, "kernel_launch: hipFuncSetAttribute failed\n"); grid_blocks = -1; return; }
        if (hipOccupancyMaxActiveBlocksPerMultiprocessor(&per_cu, (const void*)mega_fwd, NTHREADS, LDS_BYTES) != hipSuccess || per_cu < 1) { fprintf(stderr, "kernel_launch: occupancy query failed (%d)\n", per_cu); grid_blocks = -1; return; }
        grid_blocks = cus * per_cu;
        fprintf(stderr, "kernel_launch: %d CUs x %d = %d workgroups\n", cus, per_cu, grid_blocks);
    }
    if (grid_blocks < 0) return;
    Args a{};
    for (int i = 0; i < 31; ++i) a.in[i] = (const float*)d_in[i];
    a.out = (float*)d_out; a.ws = (unsigned char*)d_ws; a.ph_lo = 0; a.ph_hi = 64;
    void* args[] = {&a};
    hipError_t e = hipLaunchCooperativeKernel((const void*)mega_fwd, dim3(grid_blocks), dim3(NTHREADS), args, LDS_BYTES, stream);
    if (e != hipSuccess) fprintf(stderr, "kernel_launch: cooperative launch failed: %s (grid %d)\n", hipGetErrorString(e), grid_blocks);
}
#endif
```

```cpp
#ifndef EMU
#include <hip/hip_runtime.h>
#include <hip/hip_cooperative_groups.h>
#include <cstdio>
#include <cstdint>
namespace cg = cooperative_groups;
namespace pg8 {
#define PG8_LAS __attribute__((address_space(3)))
typedef unsigned short bf16_t;
typedef short bf16x8 __attribute__((ext_vector_type(8)));
typedef float f32x4 __attribute__((ext_vector_type(4)));
typedef unsigned u32x4 __attribute__((ext_vector_type(4)));
constexpr int BM = 256, BK = 64, HALF = 128, HTB = HALF * BK * 2  , STAGE_BYTES = 8 * HTB, NXCD = 8, WGM = 8;

__host__ __device__ __forceinline__ int lds_byte(int r, int c) { const int st = (r >> 4) * 2 + (c >> 5), rr = r & 15, cc = c & 31, ob = rr * 64 + cc * 2; return st * 1024 + (ob ^ (((ob >> 9) & 1) << 5)); }
__host__ __device__ __forceinline__ void stage_rc(int b, int& R, int& C) { const int st = b / 1024, sb = b % 1024, swz = sb ^ (((sb >> 9) & 1) << 5); R = (st >> 1) * 16 + swz / 64; C = (st & 1) * 32 + (swz % 64) / 2; }
__host__ __device__ __forceinline__ int perm32(int rho) { const int n = rho >> 4, i = rho & 15; return 8 * (i >> 2) + 4 * n + (i & 3); }

struct Unit { int pm, pn; };
struct Gemm { const bf16_t* A; const bf16_t* Bt; int M, N, K; };

struct StaticOrder {
    int nM, nN, nwg, G, c;
    __host__ __device__ void init(int M, int N, int G_, int c_) { nM = M / BM; nN = N / BM; nwg = nM * nN; G = G_; c = c_; }
    __host__ __device__ bool next(int i, Unit& u) const {
        const long L = (long)i * G + c; if (L >= nwg) return false;
        int wgid = (int)L; { const int q = nwg / NXCD, r = nwg % NXCD, xcd = wgid % NXCD, off = wgid / NXCD; wgid = (xcd < r ? xcd * (q + 1) : r * (q + 1) + (xcd - r) * q) + off; }
        const int nig = WGM * nN, gid = wgid / nig, fm = gid * WGM, gsz = (nM - fm) < WGM ? (nM - fm) : WGM;
        u.pm = fm + ((wgid % nig) % gsz); u.pn = (wgid % nig) / gsz; return true;
    }
    __device__ __forceinline__ void a_ready(const Unit&) const {}
    __device__ __forceinline__ void done(const Unit&) const {}
};

__device__ __forceinline__ unsigned cvt_pk_bf16(float lo, float hi) { unsigned r; asm volatile("v_cvt_pk_bf16_f32 %0, %1, %2" : "=v"(r) : "v"(lo), "v"(hi)); return r; }
typedef float f32x2 __attribute__((ext_vector_type(2)));
__device__ __forceinline__ f32x2 gelu_pk(f32x2 v) {
    const f32x2 av = __builtin_elementwise_abs(v), d = av * 0.2316418882f + 1.0f;
    f32x2 t; t.x = __builtin_amdgcn_rcpf(d.x); t.y = __builtin_amdgcn_rcpf(d.y);
    f32x2 q = t * 0.5307027145f + (-0.7265760135f); q = q * t + 0.7107068705f; q = q * t + (-0.142248368f); q = q * t + 0.127414796f; q = q * t;
    const f32x2 s = (v * v) * (-0.72134752044f);
    f32x2 e; e.x = __builtin_amdgcn_exp2f(s.x); e.y = __builtin_amdgcn_exp2f(s.y);
    const f32x2 m = v * (q * e), r = v - m;
    f32x2 o; o.x = v.x < 0.f ? m.x : r.x; o.y = v.y < 0.f ? m.y : r.y; return o;
}

template <class Epi, class Sched>
__device__ __forceinline__ void gemm_phase(PG8_LAS unsigned char* lds, const Gemm g, const Sched& S, const Epi& E) {
    int tid_o = threadIdx.x; asm volatile("" : "+v"(tid_o));
    const int tid = tid_o, wid = __builtin_amdgcn_readfirstlane(tid >> 6), lane = tid & 63, wr = wid >> 2, wc = wid & 3, fr = lane & 15, fq = lane >> 4;
    const int K = g.K, nt = K / BK;
    unsigned voffA[2], voffB[2];
#pragma unroll
    for (int i = 0; i < 2; ++i) { int R, C; stage_rc(tid * 16 + i * 8192, R, C); const int Rb = Epi::PERM ? ((R & ~31) + perm32(R & 31)) : R;
        voffA[i] = (unsigned)(R * K + C) * 2u; voffB[i] = (unsigned)(Rb * K + C) * 2u; }
    const size_t kstep = (size_t)(BK * 2);
    const size_t hstep = (size_t)HALF * K * 2;
    const size_t tstep = 2 * hstep;
    const unsigned ldsw = (unsigned)wid * 1024u;
    const int aoff = lds_byte(wr * 64 + fr, fq * 8), boff = lds_byte(wc * 32 + fr, fq * 8);
#define PG8_SA(b, h) (((b) * 2 + (h)) * HTB)
#define PG8_SB(b, h) ((4 + (b) * 2 + (h)) * HTB)
#define PG8_STAGE(bufoff, gbase, voff) do { _Pragma("unroll") for (int _i = 0; _i < 2; ++_i) \
        __builtin_amdgcn_global_load_lds((const unsigned*)((const char*)(gbase) + (voff)[_i]), (PG8_LAS unsigned*)(lds + (bufoff) + ldsw + _i * 8192), 16, 0, 0); } while (0)
#define PG8_LDA(dst, b, h) do { _Pragma("unroll") for (int m = 0; m < 4; ++m) _Pragma("unroll") for (int k = 0; k < 2; ++k) dst[m][k] = *(const PG8_LAS bf16x8*)(lds + PG8_SA(b, h) + aoff + m * 2048 + k * 1024); } while (0)
#define PG8_LDB(dst, b, h) do { _Pragma("unroll") for (int n = 0; n < 2; ++n) _Pragma("unroll") for (int k = 0; k < 2; ++k) dst[n][k] = *(const PG8_LAS bf16x8*)(lds + PG8_SB(b, h) + boff + n * 2048 + k * 1024); } while (0)
#define PG8_MMA(ai, bj, At, Bt) do { __builtin_amdgcn_s_setprio(1); _Pragma("unroll") for (int m = 0; m < 4; ++m) _Pragma("unroll") for (int n = 0; n < 2; ++n) _Pragma("unroll") for (int k = 0; k < 2; ++k) \
        acc[ai][bj][m][n] = __builtin_amdgcn_mfma_f32_16x16x32_bf16(Bt[n][k], At[m][k], acc[ai][bj][m][n], 0, 0, 0); __builtin_amdgcn_s_setprio(0); } while (0)
#define PG8_WAIT_V(n) asm volatile("s_waitcnt vmcnt(" #n ")" ::: "memory")
#define PG8_WAIT_L(n) asm volatile("s_waitcnt lgkmcnt(" #n ")" ::: "memory")
#define PG8_BAR __builtin_amdgcn_s_barrier()
#define PG8_SCHED __builtin_amdgcn_sched_barrier(0)
    Unit cur, nxt; int ui = 0;
    if (!S.next(0, cur)) return;
    f32x4 acc[2][2][4][2];
#pragma unroll
    for (int a = 0; a < 2; ++a)
#pragma unroll
        for (int b = 0; b < 2; ++b)
#pragma unroll
            for (int m = 0; m < 4; ++m)
#pragma unroll
                for (int n = 0; n < 2; ++n) acc[a][b][m][n] = (f32x4){0.f, 0.f, 0.f, 0.f};
    bf16x8 At[4][2], B0[2][2], B1[2][2];
    const char* cA = (const char*)g.A + (size_t)cur.pm * tstep; const char* cB = (const char*)g.Bt + (size_t)cur.pn * tstep;
    S.a_ready(cur);
    PG8_STAGE(PG8_SB(0, 0), cB, voffB); PG8_STAGE(PG8_SA(0, 0), cA, voffA); PG8_STAGE(PG8_SB(0, 1), cB + hstep, voffB); PG8_STAGE(PG8_SA(0, 1), cA + hstep, voffA);
    if (wr == 1) PG8_BAR;
    PG8_WAIT_V(4); PG8_BAR;
    PG8_STAGE(PG8_SB(1, 0), cB + kstep, voffB); PG8_STAGE(PG8_SA(1, 0), cA + kstep, voffA); PG8_STAGE(PG8_SB(1, 1), cB + hstep + kstep, voffB);
    PG8_WAIT_V(6); PG8_BAR;
    for (;;) {
        const bool has_next = S.next(ui + 1, nxt);
        const char* nA = has_next ? (const char*)g.A + (size_t)nxt.pm * tstep : cA; const char* nB = has_next ? (const char*)g.Bt + (size_t)nxt.pn * tstep : cB;
        for (int t = 0; t < nt; t += 2) {
            const bool last = (t == nt - 2);
            const char* a1 = cA + (size_t)(t + 1) * kstep;
            const char* a2 = last ? nA : cA + (size_t)(t + 2) * kstep; const char* b2 = last ? nB : cB + (size_t)(t + 2) * kstep;
            const char* a3 = a2 + kstep; const char* b3 = b2 + kstep;
            if (last && has_next) S.a_ready(nxt);
            PG8_LDB(B0, 0, 0); PG8_SCHED; PG8_LDA(At, 0, 0); PG8_STAGE(PG8_SA(1, 1), a1 + hstep, voffA);
            PG8_WAIT_L(8); PG8_BAR; PG8_WAIT_L(0); PG8_MMA(0, 0, At, B0); PG8_BAR; PG8_SCHED;
            PG8_LDB(B1, 0, 1); PG8_STAGE(PG8_SB(0, 0), b2, voffB);
            PG8_BAR; PG8_WAIT_L(0); PG8_MMA(0, 1, At, B1); PG8_BAR;
            PG8_LDA(At, 0, 1); PG8_STAGE(PG8_SA(0, 0), a2, voffA);
            PG8_BAR; PG8_WAIT_L(0); PG8_MMA(1, 0, At, B0); PG8_BAR; PG8_SCHED;
            PG8_STAGE(PG8_SB(0, 1), b2 + hstep, voffB);
            PG8_WAIT_V(6); PG8_BAR; PG8_MMA(1, 1, At, B1); PG8_BAR;
            PG8_LDB(B0, 1, 0); PG8_SCHED; PG8_LDA(At, 1, 0); PG8_STAGE(PG8_SA(0, 1), a2 + hstep, voffA);
            PG8_WAIT_L(8); PG8_BAR; PG8_WAIT_L(0); PG8_MMA(0, 0, At, B0); PG8_BAR; PG8_SCHED;
            PG8_LDB(B1, 1, 1); PG8_STAGE(PG8_SB(1, 0), b3, voffB);
            PG8_BAR; PG8_WAIT_L(0); PG8_MMA(0, 1, At, B1); PG8_BAR;
            PG8_LDA(At, 1, 1); PG8_STAGE(PG8_SA(1, 0), a3, voffA);
            PG8_BAR; PG8_WAIT_L(0); PG8_MMA(1, 0, At, B0); PG8_BAR; PG8_SCHED;
            PG8_STAGE(PG8_SB(1, 1), b3 + hstep, voffB);
            PG8_WAIT_V(6); PG8_BAR; PG8_MMA(1, 1, At, B1); PG8_BAR;
        }
        if constexpr (!Epi::AFTER_DRAIN) { E(acc, cur, wr, wc, fr, fq); S.done(cur); }
        if (!has_next) break;
#pragma unroll
        for (int a = 0; a < 2; ++a)
#pragma unroll
            for (int b = 0; b < 2; ++b)
#pragma unroll
                for (int m = 0; m < 4; ++m)
#pragma unroll
                    for (int n = 0; n < 2; ++n) acc[a][b][m][n] = (f32x4){0.f, 0.f, 0.f, 0.f};
        cur = nxt; cA = nA; cB = nB; ++ui;
    }
    PG8_WAIT_V(0);
    if (wr == 0) PG8_BAR;
    PG8_BAR;
    if constexpr (Epi::AFTER_DRAIN) { E.fused(acc, cur, wr, wc, fr, fq, lds, wid, lane); S.done(cur); }
#undef PG8_SA
#undef PG8_SB
#undef PG8_STAGE
#undef PG8_LDA
#undef PG8_LDB
#undef PG8_MMA
#undef PG8_WAIT_V
#undef PG8_WAIT_L
#undef PG8_BAR
#undef PG8_SCHED
}
}

#endif

typedef unsigned short bf16;
#ifndef EMU
#define LAS __attribute__((address_space(3)))
#else
#define LAS
#endif
typedef short bf16x8 __attribute__((ext_vector_type(8)));
typedef float f32x4 __attribute__((ext_vector_type(4)));
typedef unsigned u32x4 __attribute__((ext_vector_type(4)));
typedef unsigned u32x2 __attribute__((ext_vector_type(2)));

#ifdef EMU
constexpr int BP = EMU_BP, LP = EMU_LP, BS = EMU_BS;
#else
constexpr int BP = 8, LP = 2048, BS = 128;
#endif
constexpr int D = 1024, LS = 4, TP = BP * LP, TS = BS * LS, T = TP + TS;
constexpr int INW = 7968, NZM = 4864, NZG = 3072, NZ = NZM + NZG, NSM = 32;
constexpr int NEXP = 16384;
constexpr int SPLIT_T = 64 * (((LP / 64) * 5) / 8);
constexpr int NTHREADS = 512, NWAVES = 8;
constexpr int LDS_BYTES = 160 * 1024;

constexpr size_t O_YP = 0, O_YS = O_YP + (size_t)TP * D, O_PC = O_YS + (size_t)TS * D, O_PN = O_PC + 2ull * BP * 4 * 128 * 128, O_PM = O_PN + 2ull * BP * 4 * 128,
    O_PG = O_PM + 2ull * BP * 4, O_PH = O_PG + 2ull * BP * 4 * 64 * 128, O_PV = O_PH + 2ull * BP * 8 * 64 * 64, O_SC = O_PV + 2ull * BP * 3 * 768,
    O_SN = O_SC + 2ull * BS * 4 * 128 * 128, O_SM = O_SN + 2ull * BS * 4 * 128, O_SG = O_SM + 2ull * BS * 4, O_SH = O_SG + 2ull * BS * 4 * 64 * 128,
    O_SV = O_SH + 2ull * BS * 8 * 64 * 64, O_END = O_SV + 2ull * BS * 3 * 768;

constexpr size_t al256(size_t x) { return (x + 255) & ~(size_t)255; }
constexpr size_t WS_CTL = 0, WS_CTL_BYTES = 65536;
constexpr size_t WB_WIN = 0, WB_WS = WB_WIN + (size_t)NZ * D * 2, WB_WBR = WB_WS + (size_t)NSM * D * 2, WB_WO = WB_WBR + 3ull * D * 512 * 2, WB_WQ = WB_WO + (size_t)D * D * 2,
    WB_KEYS = WB_WQ + 2048ull * D * 2, WB_BYTES = WB_KEYS + 16ull * 128 * 128 * 2;
constexpr size_t WS_WB = WS_CTL + WS_CTL_BYTES;
constexpr size_t WS_XB = WS_WB + 2 * WB_BYTES;
constexpr size_t WS_H = WS_XB + (size_t)T * D * 2;
constexpr size_t WS_ZS = WS_H + (size_t)T * D * 4;
constexpr size_t WS_BR = WS_ZS + (size_t)T * NSM * 4;
constexpr size_t WS_ZM = WS_BR + 3ull * T * 512 * 2;
constexpr size_t WS_ZG = WS_ZM + (size_t)T * NZM * 2;
constexpr size_t WS_END0 = WS_ZG + (size_t)T * NZG * 2;
constexpr size_t WS_Q = WS_ZM, WS_IDX = WS_Q + (size_t)T * 2048 * 2, WS_GT = WS_IDX + (size_t)T * 128 * 4;
constexpr size_t WS_PU = WS_END0, WS_PV = WS_PU + (size_t)NEXP * D, WS_PUS = WS_PV + (size_t)NEXP * D, WS_PVS = WS_PUS + (size_t)NEXP * 4, WS_END = WS_PVS + (size_t)NEXP * 4;
#ifndef EMU
__device__ __forceinline__ f32x4 mfma16(bf16x8 a, bf16x8 b, f32x4 c) { return __builtin_amdgcn_mfma_f32_16x16x32_bf16(a, b, c, 0, 0, 0); }
#endif
struct Args { const float* in[31]; float* out; unsigned char* ws; int ph_lo, ph_hi; };
#ifndef EMU
typedef const __attribute__((address_space(4))) Args* ArgP;
#else
typedef const Args* ArgP;
#endif
#define A (*Ap)
#ifdef STAGE_AMP
#define STG_INIT() LAS unsigned long long* stg_acc_ = (LAS unsigned long long*)(lds + LDS_BYTES - 256); if (tid == 0) { for (int i_ = 0; i_ < 16; ++i_) stg_acc_[i_] = 0; stg_acc_[15] = __builtin_amdgcn_s_memrealtime(); stg_acc_[13] = stg_acc_[15]; }
#define STG(k) do { if (tid == 0) { const unsigned long long n_ = __builtin_amdgcn_s_memrealtime(); stg_acc_[k] += n_ - stg_acc_[15]; stg_acc_[15] = n_; } } while (0)
#define STG_TOTAL() do { if (tid == 0) stg_acc_[14] = __builtin_amdgcn_s_memrealtime() - stg_acc_[13]; } while (0)
#define STG_FINI(slot) do { if (tid == 0 && !sample && b == 0 && (slot) >= 0) { unsigned long long* g_ = (unsigned long long*)(A.ws + WS_CTL + 40960) + (slot) * 16; for (int i_ = 0; i_ < 15; ++i_) g_[i_] += stg_acc_[i_]; } } while (0)
#else
#define STG_INIT() do {} while (0)
#define STG(k) do {} while (0)
#define STG_FINI(slot) do {} while (0)
#define STG_TOTAL() do {} while (0)
#endif
#ifndef EMU
#define OPQV(x) asm volatile("" : "+v"(x))
#define OPQS(x) asm volatile("" : "+s"(x))
#define SCHED_FENCE() __builtin_amdgcn_sched_barrier(0)
#define LDS_BARRIER() asm volatile("s_waitcnt lgkmcnt(0)\n\ts_barrier" ::: "memory")
#else
#define OPQV(x) (void)(x)
#define OPQS(x) (void)(x)
#define SCHED_FENCE() do {} while (0)
#define LDS_BARRIER() __syncthreads()
#endif
#ifndef EMU
__device__ __forceinline__ int obid() { int b = blockIdx.x; asm volatile("" : "+s"(b)); return b; }
__device__ __forceinline__ int ogrid() { int g = gridDim.x; asm volatile("" : "+s"(g)); return g; }
__device__ __forceinline__ int opaque_tid() { int t = threadIdx.x; asm volatile("" : "+v"(t)); return t; }
#else
static inline int opaque_tid() { return threadIdx.x; }
static inline int obid() { return blockIdx.x; }
static inline int ogrid() { return gridDim.x; }
#endif

#ifndef EMU
__device__ __forceinline__ unsigned pk_fp8x4(float a, float b, float c, float d) { int w = __builtin_amdgcn_cvt_pk_fp8_f32(a, b, 0, false); w = __builtin_amdgcn_cvt_pk_fp8_f32(c, d, w, true); return (unsigned)w; }
__device__ __forceinline__ void unpk_fp8x4(unsigned w, float* f) { typedef float f32x2_ __attribute__((ext_vector_type(2)));
    const f32x2_ lo = __builtin_amdgcn_cvt_pk_f32_fp8((int)w, false), hi = __builtin_amdgcn_cvt_pk_f32_fp8((int)w, true); f[0] = lo.x; f[1] = lo.y; f[2] = hi.x; f[3] = hi.y; }
#endif
#ifndef EMU
__device__ __forceinline__ float swap32_add(float a, float b) { const auto r = __builtin_amdgcn_permlane32_swap(__float_as_uint(a), __float_as_uint(b), false, false); return __uint_as_float(r[0]) + __uint_as_float(r[1]); }
__device__ __forceinline__ float swap16_add(float a, float b) { const auto r = __builtin_amdgcn_permlane16_swap(__float_as_uint(a), __float_as_uint(b), false, false); return __uint_as_float(r[0]) + __uint_as_float(r[1]); }
__device__ __forceinline__ float row_allsum(float x) {
    x += __uint_as_float(__builtin_amdgcn_update_dpp(0, __float_as_uint(x), 0x128, 0xf, 0xf, false)); x += __uint_as_float(__builtin_amdgcn_update_dpp(0, __float_as_uint(x), 0x124, 0xf, 0xf, false));
    x += __uint_as_float(__builtin_amdgcn_update_dpp(0, __float_as_uint(x), 0x122, 0xf, 0xf, false)); x += __uint_as_float(__builtin_amdgcn_update_dpp(0, __float_as_uint(x), 0x121, 0xf, 0xf, false)); return x; }
#define RDLANE(x, k) __uint_as_float(__builtin_amdgcn_readlane(__float_as_uint(x), (k)))
#endif
#ifndef EMU
__device__ __forceinline__ float frcp(float x) { return __builtin_amdgcn_rcpf(x); }
__device__ __forceinline__ float frsq(float x) { return __builtin_amdgcn_rsqf(x); }
#else
static inline float frcp(float x) { return 1.0f / x; }
static inline float frsq(float x) { return 1.0f / sqrtf(x); }
#endif
__device__ __forceinline__ float gelu_fast(float v) {
    const float av = fabsf(v), t = frcp(av * 0.2316418882f + 1.0f);
    float q = t * 0.5307027145f + (-0.7265760135f); q = q * t + 0.7107068705f; q = q * t + (-0.142248368f); q = q * t + 0.127414796f; q = q * t;
    const float m = v * (q * __expf(v * v * -0.5f));
    return v < 0.f ? m : v - m;
}
__device__ __forceinline__ bf16 f2bf(float f) { unsigned u = __float_as_uint(f); u += 0x7FFFu + ((u >> 16) & 1u); return (bf16)(u >> 16); }
__device__ __forceinline__ float bf2f(bf16 b) { return __uint_as_float(((unsigned)b) << 16); }
__device__ __forceinline__ unsigned pk2(float lo, float hi) { return (unsigned)f2bf(lo) | ((unsigned)f2bf(hi) << 16); }

__device__ __forceinline__ void tconv_tile(const float* __restrict__ src, int ldsrc, int k0, int c0, bf16* __restrict__ dst, int ldd, int n0, LAS float* tile) {
    const int t = opaque_tid(), i = t >> 3, jg = (t & 7) * 8;
    const float4 a = *(const float4*)(src + (size_t)(k0 + i) * ldsrc + c0 + jg), b = *(const float4*)(src + (size_t)(k0 + i) * ldsrc + c0 + jg + 4);
    LAS float* r = tile + i * 65 + jg;
    r[0] = a.x; r[1] = a.y; r[2] = a.z; r[3] = a.w; r[4] = b.x; r[5] = b.y; r[6] = b.z; r[7] = b.w;
    __syncthreads();
    const int j = t >> 3, ig = (t & 7) * 8;
    u32x4 w;
    w.x = pk2(tile[(ig + 0) * 65 + j], tile[(ig + 1) * 65 + j]); w.y = pk2(tile[(ig + 2) * 65 + j], tile[(ig + 3) * 65 + j]);
    w.z = pk2(tile[(ig + 4) * 65 + j], tile[(ig + 5) * 65 + j]); w.w = pk2(tile[(ig + 6) * 65 + j], tile[(ig + 7) * 65 + j]);
    *(u32x4*)(dst + (size_t)(n0 + j) * ldd + k0 + ig) = w;
    __syncthreads();
}
__device__ __forceinline__ int zcol_to_src(int zc) { return zc < 2048 ? zc : (zc < 3584 ? zc + 8 : (zc < 4864 ? zc + 24 : zc + 32)); }
__device__ __forceinline__ int scol_to_src(int sc) { return sc < 8 ? 2048 + sc : (sc < 24 ? 3592 + (sc - 8) : 4888 + (sc - 24)); }

__device__ __forceinline__ void convert_f32_bf16(const float* __restrict__ src, bf16* __restrict__ dst, size_t n, int gtid, int gthreads) {
    for (size_t i = (size_t)gtid * 8; i < n; i += (size_t)gthreads * 8) {
        const float4 a = *(const float4*)(src + i), b = *(const float4*)(src + i + 4);
        u32x4 w; w.x = pk2(a.x, a.y); w.y = pk2(a.z, a.w); w.z = pk2(b.x, b.y); w.w = pk2(b.z, b.w);
        *(u32x4*)(dst + i) = w;
    }
}

__device__ __forceinline__ void convert_weights(ArgP Ap, LAS unsigned char* lds, int l, int part, int nparts) {
    LAS float* tile = (LAS float*)lds;
    constexpr int I_WIN = (NZ / 64) * (D / 64), I_WBR = 3 * (D / 64) * (512 / 64), I_WO = (D / 64) * (D / 64), I_WQ = (2048 / 64) * (D / 64), I_L = I_WIN + I_WBR + I_WO + I_WQ;
    unsigned char* wb = A.ws + WS_WB + (size_t)l * WB_BYTES;
    for (int it = part; it < I_L; it += nparts) {
        int r = it;
        if (r < I_WIN) { const int nt = r / (D / 64), kt = r % (D / 64);
            tconv_tile(A.in[8] + (size_t)l * D * INW, INW, kt * 64, zcol_to_src(nt * 64), (bf16*)(wb + WB_WIN), D, nt * 64, tile); continue; }
        r -= I_WIN;
        if (r < I_WBR) { const int n = r / ((D / 64) * 8), rr = r % ((D / 64) * 8), nt = rr / 8, kt = rr % 8;
            tconv_tile(A.in[21] + ((size_t)l * 3 + n) * 512 * D, D, kt * 64, nt * 64, (bf16*)(wb + WB_WBR) + (size_t)n * D * 512, 512, nt * 64, tile); continue; }
        r -= I_WBR;
        if (r < I_WO) { const int nt = r / (D / 64), kt = r % (D / 64);
            tconv_tile(A.in[22] + (size_t)l * D * D, D, kt * 64, nt * 64, (bf16*)(wb + WB_WO), D, nt * 64, tile); continue; }
        r -= I_WO;
        { const int nt = r / (D / 64), kt = r % (D / 64);
            tconv_tile(A.in[25] + (size_t)l * D * 2048, 2048, kt * 64, nt * 64, (bf16*)(wb + WB_WQ), D, nt * 64, tile); }
    }
    const int gtid = part * NTHREADS + opaque_tid(), gthreads = nparts * NTHREADS;
    for (int e = gtid; e < NSM * D; e += gthreads) { const int n = e / D, k = e % D; ((bf16*)(wb + WB_WS))[e] = f2bf(A.in[8][(size_t)l * D * INW + (size_t)k * INW + scol_to_src(n)]); }
    convert_f32_bf16(A.in[26] + (size_t)l * 16 * 128 * 128, (bf16*)(wb + WB_KEYS), 16 * 128 * 128, gtid, gthreads);
}
__device__ __forceinline__ void convert_tables(ArgP Ap, int l, int part, int nparts) {
    const int tx = opaque_tid(), lane = tx & 63, wave = tx >> 6;
    for (int r2 = part * NWAVES + wave; r2 < 2 * NEXP; r2 += nparts * NWAVES) { const int tab = r2 >= NEXP, row = r2 - tab * NEXP;
        const float* src = A.in[27 + tab] + ((size_t)l * NEXP + row) * D + 16 * lane; float v[16]; float mx = 0.f;
#pragma unroll
        for (int q = 0; q < 4; ++q) { const float4 a = *(const float4*)(src + 4 * q); v[4 * q] = a.x; v[4 * q + 1] = a.y; v[4 * q + 2] = a.z; v[4 * q + 3] = a.w; }
#pragma unroll
        for (int i = 0; i < 16; ++i) mx = fmaxf(mx, fabsf(v[i]));
#pragma unroll
        for (int m = 1; m < 64; m <<= 1) mx = fmaxf(mx, __shfl_xor(mx, m));
        const float sc = (mx > 0.f) ? exp2f(floorf(log2f(224.0f / mx))) : 1.0f;
        u32x4 w; w.x = pk_fp8x4(v[0] * sc, v[1] * sc, v[2] * sc, v[3] * sc); w.y = pk_fp8x4(v[4] * sc, v[5] * sc, v[6] * sc, v[7] * sc);
        w.z = pk_fp8x4(v[8] * sc, v[9] * sc, v[10] * sc, v[11] * sc); w.w = pk_fp8x4(v[12] * sc, v[13] * sc, v[14] * sc, v[15] * sc);
        *(u32x4*)(A.ws + (tab ? WS_PV : WS_PU) + (size_t)row * D + 16 * lane) = w;
        if (lane == 0) ((float*)(A.ws + (tab ? WS_PVS : WS_PUS)))[row] = 1.0f / sc; }
}
__device__ __forceinline__ void phase_convert(ArgP Ap, LAS unsigned char* lds) {
    const int G = ogrid(), bid = obid();
    convert_weights(Ap, lds, 0, bid, G);
    const int gtid = bid * NTHREADS + opaque_tid(), gthreads = G * NTHREADS;
    convert_f32_bf16(A.in[0], (bf16*)(A.ws + WS_XB), (size_t)TP * D, gtid, gthreads);
    convert_f32_bf16(A.in[1], (bf16*)(A.ws + WS_XB) + (size_t)TP * D, (size_t)TS * D, gtid, gthreads);
}

#ifndef EMU
struct EpiZ {
    static constexpr bool PERM = true, AFTER_DRAIN = false;
    bf16* ZM; bf16* ZG;
    __device__ __forceinline__ void operator()(const pg8::f32x4 (&acc)[2][2][4][2], const pg8::Unit& u, int wr, int wc, int fr, int fq) const {
        const int row0 = u.pm * 256 + wr * 64 + fr; const bool gate = u.pn >= 19;
        bf16* base = gate ? ZG : ZM; const int ldc = gate ? NZG : NZM; const int col0 = (gate ? (u.pn - 19) : u.pn) * 256 + wc * 32 + 8 * fq;
#pragma unroll
        for (int ai = 0; ai < 2; ++ai)
#pragma unroll
            for (int m = 0; m < 4; ++m) { bf16* rowp = base + (size_t)(row0 + ai * 128 + m * 16) * ldc + col0;
#pragma unroll
                for (int bj = 0; bj < 2; ++bj) { f32x4 v0 = acc[ai][bj][m][0], v1 = acc[ai][bj][m][1];
                    if (gate) {
#pragma unroll
                        for (int j = 0; j < 4; ++j) { v0[j] = __builtin_amdgcn_rcpf(1.0f + __expf(-v0[j])); v1[j] = __builtin_amdgcn_rcpf(1.0f + __expf(-v1[j])); } }
                    u32x4 w; w.x = pg8::cvt_pk_bf16(v0[0], v0[1]); w.y = pg8::cvt_pk_bf16(v0[2], v0[3]); w.z = pg8::cvt_pk_bf16(v1[0], v1[1]); w.w = pg8::cvt_pk_bf16(v1[2], v1[3]);
                    *(u32x4*)(rowp + bj * 128) = w; } }
    }
};

#endif
__device__ __forceinline__ void small_gemm(const bf16* __restrict__ XB, const bf16* __restrict__ WsT, float* __restrict__ ZS) {
    const int tx = opaque_tid(), lane = tx & 63, wave = tx >> 6, gw = obid() * NWAVES + wave, NGW = ogrid() * NWAVES, fr = lane & 15, fq = lane >> 4;
    for (int rg = gw; rg < T / 16; rg += NGW) {
        f32x4 a0 = {0.f, 0.f, 0.f, 0.f}, a1 = {0.f, 0.f, 0.f, 0.f};
        const bf16* ap = XB + (size_t)(rg * 16 + fr) * D + 8 * fq; const bf16* b0p = WsT + (size_t)fr * D + 8 * fq; const bf16* b1p = WsT + (size_t)(16 + fr) * D + 8 * fq;
#pragma unroll 4
        for (int k0 = 0; k0 < D; k0 += 32) {
            const bf16x8 a = *(const bf16x8*)(ap + k0), b0 = *(const bf16x8*)(b0p + k0), b1 = *(const bf16x8*)(b1p + k0);
            a0 = mfma16(a, b0, a0); a1 = mfma16(a, b1, a1);
        }
#pragma unroll
        for (int r = 0; r < 4; ++r) { float* o = ZS + (size_t)(rg * 16 + fq * 4 + r) * NSM + fr; o[0] = a0[r]; o[16] = a1[r]; }
    }
}

#ifndef EMU
__device__ __forceinline__ void phase_gemm1(ArgP Ap, LAS unsigned char* lds, int l) {
    unsigned char* wb = A.ws + WS_WB + (size_t)l * WB_BYTES;
    pg8::Gemm g{(const bf16*)(A.ws + WS_XB), (const bf16*)(wb + WB_WIN), T, NZ, D};
    pg8::StaticOrder S; S.init(T, NZ, ogrid(), obid());
    EpiZ E{(bf16*)(A.ws + WS_ZM), (bf16*)(A.ws + WS_ZG)};
    pg8::gemm_phase<EpiZ, pg8::StaticOrder>(lds, g, S, E);
    small_gemm((const bf16*)(A.ws + WS_XB), (const bf16*)(wb + WB_WS), (float*)(A.ws + WS_ZS));
}
#endif

#ifndef EMU
#define XB_TMO      128
#define XB_XCNT(j)  (256  + 64 * (j))
#define XB_XSUB(j)  (1280 + 64 * (j))
#define XB_XGEN(j)  (2304 + 64 * (j))
#define XB_TOP      3328
#define XB_TOPGEN   3392
#define XCD_BAR_WORDS 3456
#define XB_SPIN_CAP (1u << 18)

__device__ __forceinline__ unsigned xb_ld(unsigned* p)              { return __hip_atomic_load(p, __ATOMIC_RELAXED, __HIP_MEMORY_SCOPE_AGENT); }
__device__ __forceinline__ unsigned xb_add(unsigned* p, unsigned v) { return __hip_atomic_fetch_add(p, v, __ATOMIC_RELAXED, __HIP_MEMORY_SCOPE_AGENT); }
__device__ __forceinline__ unsigned xb_xcc_id() { return (unsigned)__builtin_amdgcn_s_getreg((3 << 11) | 20) & 0xFu; }
#define XB_SPIN(cond, bar) do { unsigned _sp = 0; while (cond) { __builtin_amdgcn_s_sleep(1); \
    if ((++_sp & 255u) == 0u) { if (xb_ld(&(bar)[XB_TMO])) break; if (_sp > XB_SPIN_CAP) { atomicAdd(&(bar)[XB_TMO], 1u); break; } } } } while (0)

struct XcdBarrier {
    unsigned* bar; unsigned x;
    volatile LAS unsigned* st;
};

__device__ __forceinline__ XcdBarrier xcd_barrier_post(unsigned* bar, volatile LAS unsigned* st) {
    XcdBarrier b; b.bar = bar; b.x = xb_xcc_id(); b.st = st;
    if (threadIdx.x == 0) (void)xb_add(&bar[XB_XCNT(b.x)], 1u);
    return b;
}
__device__ __forceinline__ void xcd_barrier_complete(unsigned* bar, unsigned x, unsigned& nloc, unsigned& nx) {
    const unsigned G = gridDim.x * gridDim.y * gridDim.z;
    unsigned sum, cnt, mine, sp = 0u;
    for (;;) {
        sum = 0u; cnt = 0u; mine = 0u;
#pragma unroll
        for (unsigned j = 0; j < 16; ++j) { const unsigned c = xb_ld(&bar[XB_XCNT(j)]); sum += c; cnt += (c > 0u) ? 1u : 0u; mine = (j == x) ? c : mine; }
        if (sum == G) break;
        __builtin_amdgcn_s_sleep(1);
        if ((++sp & 255u) == 0u) { if (xb_ld(&bar[XB_TMO])) break; if (sp > XB_SPIN_CAP) { atomicAdd(&bar[XB_TMO], 1u); break; } }
    }
    nloc = mine > 0u ? mine : 1u; nx = cnt > 0u ? cnt : 1u;
}

__device__ __forceinline__ void xcd_barrier(const XcdBarrier& b) {
    asm volatile("s_waitcnt vmcnt(0)" ::: "memory");
    __syncthreads();
    if (threadIdx.x == 0) {
        unsigned* bar = b.bar;
        __builtin_amdgcn_s_waitcnt(0);
        unsigned nloc = b.st[0], nx = b.st[1];
        if (nloc == 0u) { xcd_barrier_complete(bar, b.x, nloc, nx); b.st[0] = nloc; b.st[1] = nx; }
        const unsigned old = xb_add(&bar[XB_XSUB(b.x)], 1u);
        const unsigned gen = old / nloc;
        if (old + 1u == (gen + 1u) * nloc) {
            __builtin_amdgcn_fence(__ATOMIC_RELEASE, "agent");
            asm volatile("s_waitcnt vmcnt(0)" ::: "memory");
            const unsigned og = xb_add(&bar[XB_TOP], 1u);
            const unsigned tg = og / nx;
            if (og + 1u == (tg + 1u) * nx) xb_add(&bar[XB_TOPGEN], 1u);
            else XB_SPIN(xb_ld(&bar[XB_TOPGEN]) == tg, bar);
            __builtin_amdgcn_fence(__ATOMIC_ACQUIRE, "agent");
            xb_add(&bar[XB_XGEN(b.x)], 1u);
            asm volatile("s_waitcnt vmcnt(0)" ::: "memory");
        } else {
            XB_SPIN(xb_ld(&bar[XB_XGEN(b.x)]) == gen, bar);
            __builtin_amdgcn_fence(__ATOMIC_ACQUIRE, "agent");
            asm volatile("s_waitcnt vmcnt(0)" ::: "memory");
        }
    }
    __syncthreads();
}

#endif

typedef short s16x4 __attribute__((ext_vector_type(4)));
#ifndef EMU
__device__ __forceinline__ s16x4 tr4(const LAS bf16* p) { return __builtin_amdgcn_ds_read_tr16_b64_v4i16((LAS s16x4*)p); }
#endif
#define FROW(M, ld, rc0, k0) (*(const LAS bf16x8*)((M) + ((rc0) + fr) * (ld) + (k0) + 8 * fq))
__device__ __forceinline__ bf16x8 ftr_(int fr, int fq, const LAS bf16* M, int ld, int k0, int rc0) {
    const LAS bf16* p = M + (k0 + 8 * fq + (fr >> 2)) * ld + rc0 + 4 * (fr & 3);
    const s16x4 lo = tr4(p), hi = tr4(p + 4 * ld);
    return (bf16x8){lo[0], lo[1], lo[2], lo[3], hi[0], hi[1], hi[2], hi[3]};
}
#define FTR(M, ld, k0, rc0) ftr_(fr, fq, M, ld, k0, rc0)
#define MMA_RR(acc, Am, lda, r0, Bm, ldb, c0, K) do { _Pragma("unroll") for (int k0_ = 0; k0_ < (K); k0_ += 32) acc = mfma16(FROW(Am, lda, r0, k0_), FROW(Bm, ldb, c0, k0_), acc); } while (0)
#define MMA_RT(acc, Am, lda, r0, Bk, ldb, c0, K) do { _Pragma("unroll") for (int k0_ = 0; k0_ < (K); k0_ += 32) acc = mfma16(FROW(Am, lda, r0, k0_), FTR(Bk, ldb, k0_, c0), acc); } while (0)
#define MMA_TT(acc, Ak, lda, m0, Bk, ldb, c0, K) do { _Pragma("unroll") for (int k0_ = 0; k0_ < (K); k0_ += 32) acc = mfma16(FTR(Ak, lda, k0_, m0), FTR(Bk, ldb, k0_, c0), acc); } while (0)
#define MMA_RC(acc, Am, lda, r0, cfrag, K) do { _Pragma("unroll") for (int k0_ = 0; k0_ < (K); k0_ += 32) acc = mfma16(FROW(Am, lda, r0, k0_), cfrag, acc); } while (0)
#define MMA_CT(acc, cfrag, Bk, ldb, c0, K) do { _Pragma("unroll") for (int k0_ = 0; k0_ < (K); k0_ += 32) acc = mfma16(cfrag, FTR(Bk, ldb, k0_, c0), acc); } while (0)
__device__ __forceinline__ u32x2 pack4(float a, float b, float c, float d) { u32x2 w; w.x = pk2(a, b); w.y = pk2(c, d); return w; }
constexpr float NEG_INF = -__builtin_huge_valf();
#ifndef EMU
#define DPP_F(old, x, ctrl, rmask, bc) __uint_as_float(__builtin_amdgcn_update_dpp(__float_as_uint(old), __float_as_uint(x), ctrl, rmask, 0xf, bc))
__device__ __forceinline__ float scan_sum64(float v, int) {
    v += DPP_F(0.f, v, 0x111, 0xf, true); v += DPP_F(0.f, v, 0x112, 0xf, true); v += DPP_F(0.f, v, 0x114, 0xf, true); v += DPP_F(0.f, v, 0x118, 0xf, true);
    v += DPP_F(0.f, v, 0x142, 0xa, false); v += DPP_F(0.f, v, 0x143, 0xc, false); return v; }
__device__ __forceinline__ float scan_max64(float v, int) {
    v = fmaxf(v, DPP_F(NEG_INF, v, 0x111, 0xf, false)); v = fmaxf(v, DPP_F(NEG_INF, v, 0x112, 0xf, false)); v = fmaxf(v, DPP_F(NEG_INF, v, 0x114, 0xf, false)); v = fmaxf(v, DPP_F(NEG_INF, v, 0x118, 0xf, false));
    v = fmaxf(v, DPP_F(NEG_INF, v, 0x142, 0xa, false)); v = fmaxf(v, DPP_F(NEG_INF, v, 0x143, 0xc, false)); return v; }
__device__ __forceinline__ float lane63(float v) { return __uint_as_float(__builtin_amdgcn_readlane(__float_as_uint(v), 63)); }
#else
static inline float scan_sum64(float v, int lane) { for (int d = 1; d < 64; d <<= 1) { const float t = __shfl_up(v, d); if (lane >= d) v += t; } return v; }
static inline float scan_max64(float v, int lane) { for (int d = 1; d < 64; d <<= 1) { const float t = __shfl_up(v, d); if (lane >= d) v = fmaxf(v, t); } return v; }
static inline float lane63(float v) { return __shfl(v, 63); }
#endif
__device__ __forceinline__ float wave_max64(float v) { return lane63(scan_max64(v, threadIdx.x & 63)); }
__device__ __forceinline__ float logsig(float x) { return fminf(x, 0.f) - __logf(1.0f + __expf(-fabsf(x))); }
__device__ __forceinline__ float softplusf(float x) { return fmaxf(x, 0.f) + __logf(1.0f + __expf(-fabsf(x))); }
__device__ __forceinline__ float sigmoidf(float x) { return frcp(1.0f + __expf(-x)); }
__device__ __forceinline__ float siluf(float x) { return x * frcp(1.0f + __expf(-x)); }
constexpr float EPS_ = 1e-5f;
__device__ __forceinline__ void unpack8(const u32x4 w, float (&f)[8]) {
    f[0] = __uint_as_float(w.x << 16); f[1] = __uint_as_float(w.x & 0xffff0000u); f[2] = __uint_as_float(w.y << 16); f[3] = __uint_as_float(w.y & 0xffff0000u);
    f[4] = __uint_as_float(w.z << 16); f[5] = __uint_as_float(w.z & 0xffff0000u); f[6] = __uint_as_float(w.w << 16); f[7] = __uint_as_float(w.w & 0xffff0000u);
}
__device__ __forceinline__ u32x4 pack8(const float (&f)[8]) { u32x4 w; w.x = pk2(f[0], f[1]); w.y = pk2(f[2], f[3]); w.z = pk2(f[4], f[5]); w.w = pk2(f[6], f[7]); return w; }

__device__ __forceinline__ void mlstm_item(ArgP Ap, LAS unsigned char* lds, int l, int b, int h, bool sample) {
    int tid_o = threadIdx.x; OPQV(tid_o);
    const int tid = tid_o, lane = tid & 63, wave = tid >> 6, fr = lane & 15, fq = lane >> 4;
    LAS bf16* Qs = (LAS bf16*)(lds); LAS bf16* Ks = (LAS bf16*)(lds + 17408); LAS bf16* Kw = (LAS bf16*)(lds + 34816); LAS bf16* Vs = (LAS bf16*)(lds + 52224);
    LAS bf16* Ss = (LAS bf16*)(lds + 69632); LAS bf16* CbT = (LAS bf16*)(lds + 78848); LAS float* Hs = (LAS float*)(lds + 120320); LAS float* MN = (LAS float*)(lds + 117760); LAS float* gb = (LAS float*)(lds + 118272);
    LAS float* b_ = gb; LAS float* mt_ = gb + 64; LAS float* u_ = gb + 128; LAS float* ein_ = gb + 192; LAS float* wg_ = gb + 256; LAS float* den_ = gb + 320; LAS float* sc_ = gb + 384;
    const int L = sample ? LS : LP, tok0 = sample ? TP + b * LS : b * LP, NB = sample ? BS : BP;
    const bf16* ZM = (const bf16*)(A.ws + WS_ZM); const float* ZS = (const float*)(A.ws + WS_ZS); bf16* BR0 = (bf16*)(A.ws + WS_BR);
    const float ib = A.in[9][l * 4 + h], fb = A.in[10][l * 4 + h];
    f32x4 accC[9];
#pragma unroll
    for (int vi = 0; vi < 9; ++vi) accC[vi] = (f32x4){0.f, 0.f, 0.f, 0.f};
    float m_run = 0.f;
    if (sample) {
        const float* C0 = A.in[2] + ((size_t)(l * BS + b) * 4 + h) * 16384; const float* n0 = A.in[3] + ((size_t)(l * BS + b) * 4 + h) * 128;
        const float* cp = C0 + (4 * fq) * 128 + 16 * wave + fr;
#pragma unroll
        for (int vi = 0; vi < 8; ++vi) {
#pragma unroll
            for (int r = 0; r < 4; ++r) accC[vi][r] = cp[r * 128];
            cp += 2048; OPQV(cp); }
        if (fq == 0) accC[8][0] = n0[16 * wave + fr];
        m_run = A.in[4][(l * BS + b) * 4 + h];
    }
#pragma unroll
    for (int vi = 0; vi < 9; ++vi) *(LAS u32x2*)(CbT + (16 * wave + fr) * 152 + 16 * vi + 4 * fq) = pack4(accC[vi][0], accC[vi][1], accC[vi][2], accC[vi][3]);
    if (tid < 128) MN[tid] = A.in[11][l * 512 + h * 128 + tid];
    u32x4 pq[2], pk[2], pv[2], pm[2]; float pli = NEG_INF, plf = 0.f;
#define MLSTM_PREFETCH_MO(T0N) do { const int nvn_ = (L - (T0N)) < 64 ? (L - (T0N)) : 64; const int t = tid >> 3, part = tid & 7; pm[0] = (u32x4){0u, 0u, 0u, 0u}; pm[1] = pm[0]; \
        if (t < nvn_) { const bf16* mo = ZM + (size_t)(tok0 + (T0N) + t) * NZM + 1536 + h * 128 + 16 * part; pm[0] = *(const u32x4*)mo; pm[1] = *(const u32x4*)(mo + 8); } } while (0)
#define MLSTM_PREFETCH(T0N) do { const int nvn_ = (L - (T0N)) < 64 ? (L - (T0N)) : 64; \
        _Pragma("unroll") for (int i = 0; i < 2; ++i) { const int c = tid + 512 * i, t = c >> 4, cc = (c & 15) * 8; pq[i] = (u32x4){0u, 0u, 0u, 0u}; pk[i] = pq[i]; pv[i] = pq[i]; \
            if (t < nvn_) { const bf16* zp = ZM + (size_t)(tok0 + (T0N) + t) * NZM + h * 128 + cc; pq[i] = *(const u32x4*)zp; pk[i] = *(const u32x4*)(zp + 512); pv[i] = *(const u32x4*)(zp + 1024); } } \
        if (wave == 0) { pli = NEG_INF; plf = 0.f; if (lane < nvn_) { const size_t tok = tok0 + (T0N) + lane; pli = ZS[tok * NSM + h]; plf = ZS[tok * NSM + 4 + h]; } } } while (0)
    MLSTM_PREFETCH(0); MLSTM_PREFETCH_MO(0);
    __syncthreads();
    STG_INIT();
    for (int t0 = 0; t0 < L; t0 += 64) {
        const int nv = (L - t0) < 64 ? (L - t0) : 64, nrt = (nv + 15) >> 4;
        if (wave == 0) {
            const float li = (lane < nv) ? pli + ib : NEG_INF, lf = (lane < nv) ? logsig(plf + fb) : 0.f;
            const float bb = scan_sum64(lf, lane), a = bb + m_run, u = li - bb, M = scan_max64(u, lane), mt = fmaxf(a, bb + M);
            const float blast = lane63(bb), g = blast + u, gmax = wave_max64(g), mnew = fmaxf(blast + m_run, gmax);
            b_[lane] = bb; mt_[lane] = mt; u_[lane] = u; ein_[lane] = __expf(a - mt); wg_[lane] = __expf(g - mnew);
            if (lane == 0) sc_[1] = __expf(blast + m_run - mnew);
            m_run = mnew;
        }
        LDS_BARRIER(); STG(0);
#pragma unroll
        for (int i = 0; i < 2; ++i) { const int c = tid + 512 * i, t = c >> 4, cc = (c & 15) * 8;
            *(LAS u32x4*)(Qs + t * 136 + cc) = pq[i]; *(LAS u32x4*)(Ks + t * 136 + cc) = pk[i]; *(LAS u32x4*)(Vs + t * 136 + cc) = pv[i];
            float f[8]; unpack8(pk[i], f); const float g = wg_[t];
#pragma unroll
            for (int j = 0; j < 8; ++j) f[j] *= g;
            *(LAS u32x4*)(Kw + t * 136 + cc) = pack8(f); }
        MLSTM_PREFETCH(t0 + 64);
        LDS_BARRIER(); STG(1);
#pragma unroll
        for (int j = 0; j < 2; ++j) { const int idx = wave + 8 * j, ti = idx >> 2, si = idx & 3;
            f32x4 acc = {0.f, 0.f, 0.f, 0.f};
            if (ti >= nrt) continue;
            if (si <= ti) MMA_RR(acc, Ks, 136, 16 * si, Qs, 136, 16 * ti, 128);
            const int t = 16 * ti + fr; const float bt = b_[t] - mt_[t]; float v[4];
#pragma unroll
            for (int r = 0; r < 4; ++r) { const int s = 16 * si + 4 * fq + r; v[r] = (s <= t) ? acc[r] * __expf(bt + u_[s]) : 0.f; }
            *(LAS u32x2*)(Ss + t * 72 + 16 * si + 4 * fq) = pack4(v[0], v[1], v[2], v[3]); }
        LDS_BARRIER(); STG(2);
        if (wave < nrt) { const int ti = wave; f32x4 acc = {0.f, 0.f, 0.f, 0.f};
            MMA_RT(acc, Qs, 136, 16 * ti, CbT, 152, 128, 128);
#pragma unroll
            for (int r = 0; r < 4; ++r) acc[r] *= ein_[16 * ti + 4 * fq + r];
            { int fr_ = fr; OPQV(fr_); const short o1 = (fr_ == 0) ? (short)0x3F80 : (short)0; const bf16x8 ones = {o1, o1, o1, o1, o1, o1, o1, o1};
              MMA_RC(acc, Ss, 72, 16 * ti, ones, 64); }
            if (fr == 0) {
#pragma unroll
                for (int r = 0; r < 4; ++r) { const int t = 16 * ti + 4 * fq + r; den_[t] = 0.08838834764831845f * frcp(fmaxf(fabsf(acc[r] * 0.08838834764831845f), __expf(-mt_[t]))); } } }
        LDS_BARRIER(); STG(3);
        { bf16x8 bC[4], bV[2];
#pragma unroll
          for (int kk = 0; kk < 4; ++kk) bC[kk] = FTR(CbT, 152, 32 * kk, 16 * wave);
#pragma unroll
          for (int kk = 0; kk < 2; ++kk) bV[kk] = FTR(Vs, 136, 32 * kk, 16 * wave);
#pragma unroll
          for (int ti = 0; ti < 4; ++ti) { if (ti >= nrt) continue; f32x4 accn = {0.f, 0.f, 0.f, 0.f};
#pragma unroll
            for (int kk = 0; kk < 4; ++kk) accn = mfma16(FROW(Qs, 136, 16 * ti, 32 * kk), bC[kk], accn);
#pragma unroll
            for (int r = 0; r < 4; ++r) accn[r] *= ein_[16 * ti + 4 * fq + r];
#pragma unroll
            for (int kk = 0; kk < 2; ++kk) accn = mfma16(FROW(Ss, 72, 16 * ti, 32 * kk), bV[kk], accn);
#pragma unroll
            for (int r = 0; r < 4; ++r) { const int t = 16 * ti + 4 * fq + r; Hs[t * 132 + 16 * wave + fr] = accn[r] * den_[t]; } } }
        LDS_BARRIER(); STG(4);
        { const int t = tid >> 3, part = tid & 7; float x[16]; float s1 = 0.f;
#pragma unroll
            for (int i = 0; i < 16; ++i) { x[i] = Hs[t * 132 + 16 * part + i]; s1 += x[i]; }
            s1 += __shfl_xor(s1, 1); s1 += __shfl_xor(s1, 2); s1 += __shfl_xor(s1, 4);
            const float mu = s1 * (1.0f / 128.0f); float s2 = 0.f;
#pragma unroll
            for (int i = 0; i < 16; ++i) { x[i] -= mu; s2 += x[i] * x[i]; }
            s2 += __shfl_xor(s2, 1); s2 += __shfl_xor(s2, 2); s2 += __shfl_xor(s2, 4);
            const float rstd = frsq(s2 * (1.0f / 128.0f) + EPS_);
            if (t < nv) { const size_t tok = tok0 + t0 + t;
                float o0[8], o1[8]; unpack8(pm[0], o0); unpack8(pm[1], o1); float y0[8], y1[8];
#pragma unroll
                for (int i = 0; i < 8; ++i) { y0[i] = x[i] * rstd * MN[16 * part + i] * sigmoidf(o0[i]); y1[i] = x[8 + i] * rstd * MN[16 * part + 8 + i] * sigmoidf(o1[i]); }
                bf16* o = BR0 + tok * 512 + h * 128 + 16 * part; *(u32x4*)o = pack8(y0); *(u32x4*)(o + 8) = pack8(y1); } }
        MLSTM_PREFETCH_MO(t0 + 64);
        { const float ec = sc_[1]; bf16x8 bK[2];
#pragma unroll
            for (int kk = 0; kk < 2; ++kk) bK[kk] = FTR(Kw, 136, 32 * kk, 16 * wave);
#pragma unroll
            for (int vi = 0; vi < 9; ++vi) {
#pragma unroll
                for (int r = 0; r < 4; ++r) accC[vi][r] *= ec;
                if (vi < 8) {
#pragma unroll
                    for (int kk = 0; kk < 2; ++kk) accC[vi] = mfma16(FTR(Vs, 136, 32 * kk, 16 * vi), bK[kk], accC[vi]); }
                else { int fr_ = fr; OPQV(fr_); const short o1 = (fr_ == 0) ? (short)0x3F80 : (short)0; const bf16x8 ones = {o1, o1, o1, o1, o1, o1, o1, o1};
#pragma unroll
                    for (int kk = 0; kk < 2; ++kk) accC[vi] = mfma16(ones, bK[kk], accC[vi]); }
                *(LAS u32x2*)(CbT + (16 * wave + fr) * 152 + 16 * vi + 4 * fq) = pack4(accC[vi][0], accC[vi][1], accC[vi][2], accC[vi][3]); } }
        LDS_BARRIER(); STG(5);
    }
#undef MLSTM_PREFETCH
#undef MLSTM_PREFETCH_MO
    float* Co = A.out + (sample ? O_SC : O_PC) + ((size_t)(l * NB + b) * 4 + h) * 16384; float* no = A.out + (sample ? O_SN : O_PN) + ((size_t)(l * NB + b) * 4 + h) * 128;
    { int fq_ = fq, cw_ = 16 * wave + fr; OPQV(fq_); OPQV(cw_);
      float* cp = Co + (4 * fq_) * 128 + cw_;
#pragma unroll
      for (int vi = 0; vi < 8; ++vi) {
#pragma unroll
        for (int r = 0; r < 4; ++r) cp[r * 128] = accC[vi][r];
        cp += 2048; OPQV(cp); }
      if (fq_ == 0) no[cw_] = accC[8][0]; }
    STG_TOTAL(); STG_FINI(h == 0 ? 0 : -1);
    if (tid == 0) A.out[(sample ? O_SM : O_PM) + (size_t)(l * NB + b) * 4 + h] = m_run;
    __syncthreads();
}

__device__ __forceinline__ void gla_item(ArgP Ap, LAS unsigned char* lds, int l, int b, int h, bool sample) {
    int tid_o = threadIdx.x; OPQV(tid_o);
    const int tid = tid_o, lane = tid & 63, wave = tid >> 6, fr = lane & 15, fq = lane >> 4;
    LAS bf16* QE = (LAS bf16*)(lds); LAS bf16* KE = (LAS bf16*)(lds + 9216); LAS bf16* KLs = (LAS bf16*)(lds + 18432); LAS bf16* Vs = (LAS bf16*)(lds + 27648);
    LAS bf16* ATT = (LAS bf16*)(lds + 45056); LAS bf16* STbT = (LAS bf16*)(lds + 54272); LAS float* Os = (LAS float*)(lds + 71680); LAS float* LAM = (LAS float*)(lds + 105472);
    LAS float* GA = (LAS float*)(lds + 122112); LAS float* GUP = (LAS float*)(lds + 126208); LAS float* GBI = (LAS float*)(lds + 130304); LAS float* GN = (LAS float*)(lds + 130560);
    const int L = sample ? LS : LP, tok0 = sample ? TP + b * LS : b * LP, NB = sample ? BS : BP;
    const bf16* ZM = (const bf16*)(A.ws + WS_ZM); const float* ZS = (const float*)(A.ws + WS_ZS); bf16* BR1 = (bf16*)(A.ws + WS_BR) + (size_t)T * 512;
    f32x4 accS[4];
#pragma unroll
    for (int ki = 0; ki < 4; ++ki) accS[ki] = (f32x4){0.f, 0.f, 0.f, 0.f};
    if (sample) { const float* S0 = A.in[5] + ((size_t)(l * BS + b) * 4 + h) * 8192;
        const float* sp = S0 + fr * 128 + 16 * wave + 4 * fq;
#pragma unroll
        for (int ki = 0; ki < 4; ++ki) {
#pragma unroll
            for (int r = 0; r < 4; ++r) accS[ki][r] = sp[r];
            sp += 2048; OPQV(sp); } }
#pragma unroll
    for (int ki = 0; ki < 4; ++ki) *(LAS u32x2*)(STbT + (16 * ki + fr) * 136 + 16 * wave + 4 * fq) = pack4(accS[ki][0], accS[ki][1], accS[ki][2], accS[ki][3]);
    float gup[16];
#pragma unroll
    for (int r = 0; r < 16; ++r) gup[r] = A.in[12][(size_t)l * 16 * 256 + r * 256 + h * 64 + (tid & 63)];
    const float gbi = A.in[13][l * 256 + h * 64 + (tid & 63)];
    if (tid < 128) GN[tid] = A.in[14][l * 512 + h * 128 + tid];
    u32x4 pq, pk, pv[2], pg[2], pgn[2]; float pga[2];
#define GLA_PREFETCH(T0N) do { const int nvn_ = (L - (T0N)) < 64 ? (L - (T0N)) : 64; \
        { const int t = tid >> 3, cc = (tid & 7) * 8; pq = (u32x4){0u, 0u, 0u, 0u}; pk = pq; pgn[0] = pq; pgn[1] = pq; \
            if (t < nvn_) { const bf16* zr = ZM + (size_t)(tok0 + (T0N) + t) * NZM + 2048 + h * 64 + cc; pq = *(const u32x4*)zr; pk = *(const u32x4*)(zr + 256); \
                const bf16* gr = ZM + (size_t)(tok0 + (T0N) + t) * NZM + 3072 + h * 128 + 16 * (tid & 7); pgn[0] = *(const u32x4*)gr; pgn[1] = *(const u32x4*)(gr + 8); } } \
        _Pragma("unroll") for (int i = 0; i < 2; ++i) { const int c = tid + 512 * i, t = c >> 4, cc = (c & 15) * 8; pv[i] = (u32x4){0u, 0u, 0u, 0u}; \
            if (t < nvn_) pv[i] = *(const u32x4*)(ZM + (size_t)(tok0 + (T0N) + t) * NZM + 2560 + h * 128 + cc); \
            const int e = tid + 512 * i, te = e >> 4; pga[i] = (te < nvn_) ? ZS[(size_t)(tok0 + (T0N) + te) * NSM + 8 + (e & 15)] : 0.f; } } while (0)
    GLA_PREFETCH(0);
    __syncthreads();
    STG_INIT();
    for (int t0 = 0; t0 < L; t0 += 64) {
        const int nv = (L - t0) < 64 ? (L - t0) : 64, nrt = (nv + 15) >> 4;
        pg[0] = pgn[0]; pg[1] = pgn[1];
        GA[tid] = pga[0]; GA[tid + 512] = pga[1];
        LDS_BARRIER();
#pragma unroll
        for (int i = 0; i < 8; ++i) { const int t = (tid >> 6) + 8 * i, k = tid & 63; float x = gbi;
#pragma unroll
            for (int q = 0; q < 4; ++q) { const f32x4 ga = *(const LAS f32x4*)(GA + t * 16 + 4 * q); x += ga[0] * gup[4 * q] + ga[1] * gup[4 * q + 1] + ga[2] * gup[4 * q + 2] + ga[3] * gup[4 * q + 3]; }
            LAM[t * 65 + k] = (t < nv) ? logsig(x) * (1.0f / 16.0f) : 0.f; }
        LDS_BARRIER();
#pragma unroll
        for (int c = 0; c < 8; ++c) { const int k = 8 * wave + c; const float v = scan_sum64(LAM[lane * 65 + k], lane); LAM[lane * 65 + k] = v; }
        LDS_BARRIER();
        { const int t = tid >> 3, cc = (tid & 7) * 8; float q[8], k[8], qe[8], ke[8], kl[8]; unpack8(pq, q); unpack8(pk, k);
#pragma unroll
            for (int i = 0; i < 8; ++i) { const float lm = LAM[t * 65 + cc + i], ll = LAM[63 * 65 + cc + i]; qe[i] = q[i] * __expf(lm); ke[i] = k[i] * __expf(-lm); kl[i] = k[i] * __expf(ll - lm); }
            *(LAS u32x4*)(QE + t * 72 + cc) = pack8(qe); *(LAS u32x4*)(KE + t * 72 + cc) = pack8(ke); *(LAS u32x4*)(KLs + t * 72 + cc) = pack8(kl); }
#pragma unroll
        for (int i = 0; i < 2; ++i) { const int c = tid + 512 * i, t = c >> 4, cc = (c & 15) * 8; *(LAS u32x4*)(Vs + t * 136 + cc) = pv[i]; }
        GLA_PREFETCH(t0 + 64);
        LDS_BARRIER();
#pragma unroll
        for (int j = 0; j < 2; ++j) { const int idx = wave + 8 * j, ti = idx >> 2, si = idx & 3; f32x4 acc = {0.f, 0.f, 0.f, 0.f};
            if (ti >= nrt) continue;
            if (si <= ti) MMA_RR(acc, KE, 72, 16 * si, QE, 72, 16 * ti, 64);
            const int t = 16 * ti + fr; float v[4];
#pragma unroll
            for (int r = 0; r < 4; ++r) { const int s = 16 * si + 4 * fq + r; v[r] = (s <= t) ? acc[r] : 0.f; }
            *(LAS u32x2*)(ATT + t * 72 + 16 * si + 4 * fq) = pack4(v[0], v[1], v[2], v[3]); }
        LDS_BARRIER();
        { bf16x8 bS[2], bV[2];
#pragma unroll
          for (int kk = 0; kk < 2; ++kk) { bS[kk] = FTR(STbT, 136, 32 * kk, 16 * wave); bV[kk] = FTR(Vs, 136, 32 * kk, 16 * wave); }
#pragma unroll
          for (int ti = 0; ti < 4; ++ti) { if (ti >= nrt) continue; f32x4 acc = {0.f, 0.f, 0.f, 0.f};
#pragma unroll
            for (int kk = 0; kk < 2; ++kk) acc = mfma16(FROW(QE, 72, 16 * ti, 32 * kk), bS[kk], acc);
#pragma unroll
            for (int kk = 0; kk < 2; ++kk) acc = mfma16(FROW(ATT, 72, 16 * ti, 32 * kk), bV[kk], acc);
#pragma unroll
            for (int r = 0; r < 4; ++r) Os[(16 * ti + 4 * fq + r) * 132 + 16 * wave + fr] = acc[r] * 0.125f; } }
        LDS_BARRIER();
        { const int t = tid >> 3, part = tid & 7; float x[16]; float s2 = 0.f;
#pragma unroll
            for (int i = 0; i < 16; ++i) { x[i] = Os[t * 132 + 16 * part + i]; s2 += x[i] * x[i]; }
            s2 += __shfl_xor(s2, 1); s2 += __shfl_xor(s2, 2); s2 += __shfl_xor(s2, 4);
            const float rstd = frsq(s2 * (1.0f / 128.0f) + EPS_);
            if (t < nv) { const size_t tok = tok0 + t0 + t;
                float g0[8], g1[8]; unpack8(pg[0], g0); unpack8(pg[1], g1); float y0[8], y1[8];
#pragma unroll
                for (int i = 0; i < 8; ++i) { y0[i] = x[i] * rstd * GN[16 * part + i] * siluf(g0[i]); y1[i] = x[8 + i] * rstd * GN[16 * part + 8 + i] * siluf(g1[i]); }
                bf16* o = BR1 + tok * 512 + h * 128 + 16 * part; *(u32x4*)o = pack8(y0); *(u32x4*)(o + 8) = pack8(y1); } }
        { bf16x8 aV[2];
#pragma unroll
          for (int kk = 0; kk < 2; ++kk) aV[kk] = FTR(Vs, 136, 32 * kk, 16 * wave);
#pragma unroll
          for (int ki = 0; ki < 4; ++ki) { const float dec = __expf(LAM[63 * 65 + 16 * ki + fr]);
#pragma unroll
            for (int r = 0; r < 4; ++r) accS[ki][r] *= dec;
#pragma unroll
            for (int kk = 0; kk < 2; ++kk) accS[ki] = mfma16(aV[kk], FTR(KLs, 72, 32 * kk, 16 * ki), accS[ki]);
            *(LAS u32x2*)(STbT + (16 * ki + fr) * 136 + 16 * wave + 4 * fq) = pack4(accS[ki][0], accS[ki][1], accS[ki][2], accS[ki][3]); } }
        LDS_BARRIER();
    }
#undef GLA_PREFETCH
    STG_TOTAL(); STG_FINI(h == 0 ? 1 : -1);
    float* So = A.out + (sample ? O_SG : O_PG) + ((size_t)(l * NB + b) * 4 + h) * 8192;
    { int o_ = fr * 128 + 16 * wave + 4 * fq; OPQV(o_); float* sp = So + o_;
#pragma unroll
      for (int ki = 0; ki < 4; ++ki) {
#pragma unroll
        for (int r = 0; r < 4; ++r) sp[r] = accS[ki][r];
        sp += 2048; OPQV(sp); } }
    __syncthreads();
}

__device__ __forceinline__ int ssd_chmap(int hd, int c) { const int g = hd >> 2; return c < 64 ? hd * 64 + c : (c < 128 ? 512 + g * 64 + (c - 64) : 640 + g * 64 + (c - 128)); }
__device__ __forceinline__ void ssd_item(ArgP Ap, LAS unsigned char* lds, int l, int b, int hd, bool sample) {
    int tid_o = threadIdx.x; OPQV(tid_o);
    const int tid = tid_o, lane = tid & 63, wave = tid >> 6, fr = lane & 15, fq = lane >> 4;
    LAS bf16* RAW = (LAS bf16*)(lds); LAS bf16* Ys = (LAS bf16*)(lds); LAS bf16* W = (LAS bf16*)(lds + 9216); LAS bf16* Bw = (LAS bf16*)(lds + 18432);
    LAS bf16* Xs = (LAS bf16*)(lds + 27648); LAS bf16* Cs = (LAS bf16*)(lds + 36864); LAS bf16* Bs = (LAS bf16*)(lds + 46080); LAS bf16* HbT = (LAS bf16*)(lds + 55296);
    LAS bf16* HIST = (LAS bf16*)(lds + 64512); LAS float* DT = (LAS float*)(lds + 65792); LAS float* LM = (LAS float*)(lds + 66048);
    LAS float* CW = (LAS float*)(lds + 66304); LAS float* CBI = CW + 4 * 192;
    const int L = sample ? LS : LP, tok0 = sample ? TP + b * LS : b * LP, NB = sample ? BS : BP;
    const bf16* ZM = (const bf16*)(A.ws + WS_ZM); const float* ZS = (const float*)(A.ws + WS_ZS); bf16* BR2 = (bf16*)(A.ws + WS_BR) + (size_t)T * 1024;
    const float Dh = A.in[19][l * 8 + hd], dtb = A.in[17][l * 8 + hd], Ah = -__expf(A.in[18][l * 8 + hd]);
    f32x4 accH[2];
#pragma unroll
    for (int j = 0; j < 2; ++j) { const int idx = wave + 8 * j, pi = idx >> 2, ni = idx & 3; accH[j] = (f32x4){0.f, 0.f, 0.f, 0.f};
        if (sample) { const float* h0 = A.in[6] + ((size_t)(l * BS + b) * 8 + hd) * 4096;
            const float* hp = h0 + (16 * pi + 4 * fq) * 64 + 16 * ni + fr; OPQV(hp);
#pragma unroll
            for (int r = 0; r < 4; ++r) accH[j][r] = hp[r * 64]; }
        *(LAS u32x2*)(HbT + (16 * ni + fr) * 72 + 16 * pi + 4 * fq) = pack4(accH[j][0], accH[j][1], accH[j][2], accH[j][3]); }
    for (int e = tid; e < 5 * 192; e += NTHREADS) { const int j = e / 192, c = e % 192, ch = ssd_chmap(hd, c); CW[e] = (j < 4) ? A.in[15][(size_t)l * 4 * 768 + j * 768 + ch] : A.in[16][l * 768 + ch]; }
    for (int e = tid; e < 3 * 200; e += NTHREADS) { const int r = e / 200, c = e % 200; float v = 0.f;
        if (sample && c < 192) v = A.in[7][((size_t)(l * BS + b) * 3 + r) * 768 + ssd_chmap(hd, c)];
        HIST[e] = f2bf(v); }
    u32x4 pr[3], ps; float pdt = 0.f;
#define SSD_PREFETCH(T0N) do { const int nvn_ = (L - (T0N)) < 64 ? (L - (T0N)) : 64; \
        _Pragma("unroll") for (int i = 0; i < 3; ++i) { const int c = tid + 512 * i, t = c / 24, q = c % 24; pr[i] = (u32x4){0u, 0u, 0u, 0u}; \
            if (t < nvn_) pr[i] = *(const u32x4*)(ZM + (size_t)(tok0 + (T0N) + t) * NZM + 4096 + ssd_chmap(hd, 8 * q)); } \
        if (wave == 0) { pdt = 0.f; if (lane < nvn_) pdt = ZS[(size_t)(tok0 + (T0N) + lane) * NSM + 24 + hd]; } } while (0)
#define SSD_PREFETCH_Z(T0N) do { const int nvn_ = (L - (T0N)) < 64 ? (L - (T0N)) : 64; const int t = tid >> 3, part = tid & 7; ps = (u32x4){0u, 0u, 0u, 0u}; \
        if (t < nvn_) ps = *(const u32x4*)(ZM + (size_t)(tok0 + (T0N) + t) * NZM + 3584 + hd * 64 + 8 * part); } while (0)
    SSD_PREFETCH(0); SSD_PREFETCH_Z(0);
    __syncthreads();
    STG_INIT();
    for (int t0 = 0; t0 < L; t0 += 64) {
        const int nv = (L - t0) < 64 ? (L - t0) : 64, nrt = (nv + 15) >> 4;
#pragma unroll
        for (int i = 0; i < 3; ++i) { const int c = tid + 512 * i, t = c / 24, q = c % 24; *(LAS u32x4*)(RAW + (3 + t) * 200 + 8 * q) = pr[i]; }
        if (tid < 3 * 25) { const int r = tid / 25, q = tid % 25; *(LAS u32x4*)(RAW + r * 200 + 8 * q) = *(const LAS u32x4*)(HIST + r * 200 + 8 * q); }
        if (wave == 0) { const float dtv = (lane < nv) ? softplusf(pdt + dtb) : 0.f; const float lam = scan_sum64(dtv * Ah, lane); DT[lane] = dtv; LM[lane] = lam; }
        SSD_PREFETCH(t0 + 64);
        LDS_BARRIER();
#pragma unroll
        for (int i = 0; i < 3; ++i) { const int c = tid + 512 * i, t = c / 24, q = c % 24; float o[8];
            { const f32x4 b0 = *(const LAS f32x4*)(CBI + 8 * q), b1 = *(const LAS f32x4*)(CBI + 8 * q + 4); o[0] = b0[0]; o[1] = b0[1]; o[2] = b0[2]; o[3] = b0[3]; o[4] = b1[0]; o[5] = b1[1]; o[6] = b1[2]; o[7] = b1[3]; }
#pragma unroll
            for (int j = 0; j < 4; ++j) { float x[8]; unpack8(*(const LAS u32x4*)(RAW + (t + j) * 200 + 8 * q), x);
                const f32x4 w0 = *(const LAS f32x4*)(CW + j * 192 + 8 * q), w1 = *(const LAS f32x4*)(CW + j * 192 + 8 * q + 4);
                o[0] += w0[0] * x[0]; o[1] += w0[1] * x[1]; o[2] += w0[2] * x[2]; o[3] += w0[3] * x[3]; o[4] += w1[0] * x[4]; o[5] += w1[1] * x[5]; o[6] += w1[2] * x[6]; o[7] += w1[3] * x[7]; }
#pragma unroll
            for (int e = 0; e < 8; ++e) o[e] = (t < nv) ? siluf(o[e]) : 0.f;
            LAS bf16* dst = (q < 8) ? Xs + t * 72 + q * 8 : (q < 16 ? Bs + t * 72 + (q - 8) * 8 : Cs + t * 72 + (q - 16) * 8);
            *(LAS u32x4*)dst = pack8(o); }
        LDS_BARRIER();
        if (tid < 3 * 25) { const int r = tid / 25, q = tid % 25; *(LAS u32x4*)(HIST + r * 200 + 8 * q) = *(const LAS u32x4*)(RAW + (nv + r) * 200 + 8 * q); }
        f32x4 cbT[2];
#pragma unroll
        for (int j = 0; j < 2; ++j) { const int idx = wave + 8 * j, ti = idx >> 2, si = idx & 3; cbT[j] = (f32x4){0.f, 0.f, 0.f, 0.f};
            if (si <= ti && ti < nrt) MMA_RR(cbT[j], Bs, 72, 16 * si, Cs, 72, 16 * ti, 64); }
        LDS_BARRIER();
#pragma unroll
        for (int j = 0; j < 2; ++j) { const int idx = wave + 8 * j, ti = idx >> 2, si = idx & 3; const int t = 16 * ti + fr; const float lt = LM[t]; float v[4];
#pragma unroll
            for (int r = 0; r < 4; ++r) { const int s = 16 * si + 4 * fq + r; v[r] = (s <= t) ? cbT[j][r] * __expf(lt - LM[s]) * DT[s] : 0.f; }
            *(LAS u32x2*)(W + t * 72 + 16 * si + 4 * fq) = pack4(v[0], v[1], v[2], v[3]); }
        { const int s = tid >> 3, n0 = (tid & 7) * 8; float v[8]; unpack8(*(const LAS u32x4*)(Bs + s * 72 + n0), v); const float ws = __expf(LM[63] - LM[s]) * DT[s];
#pragma unroll
            for (int i = 0; i < 8; ++i) v[i] *= ws;
            *(LAS u32x4*)(Bw + s * 72 + n0) = pack8(v); }
        LDS_BARRIER();
        { const int pi = wave & 3; bf16x8 bH[2], bX[2];
#pragma unroll
          for (int kk = 0; kk < 2; ++kk) { bH[kk] = FTR(HbT, 72, 32 * kk, 16 * pi); bX[kk] = FTR(Xs, 72, 32 * kk, 16 * pi); }
#pragma unroll
          for (int j = 0; j < 2; ++j) { const int ti = (wave >> 2) + 2 * j; if (ti >= nrt) continue; f32x4 acc = {0.f, 0.f, 0.f, 0.f};
#pragma unroll
            for (int kk = 0; kk < 2; ++kk) acc = mfma16(FROW(Cs, 72, 16 * ti, 32 * kk), bH[kk], acc);
#pragma unroll
            for (int r = 0; r < 4; ++r) acc[r] *= __expf(LM[16 * ti + 4 * fq + r]);
#pragma unroll
            for (int kk = 0; kk < 2; ++kk) acc = mfma16(FROW(W, 72, 16 * ti, 32 * kk), bX[kk], acc);
#pragma unroll
            for (int r = 0; r < 4; ++r) { const int t = 16 * ti + 4 * fq + r, p = 16 * pi + fr; Ys[t * 72 + p] = f2bf(acc[r] + Dh * bf2f(Xs[t * 72 + p])); } } }
        { const float dec = __expf(LM[63]); const int ni = wave & 3; bf16x8 bB[2];
#pragma unroll
          for (int kk = 0; kk < 2; ++kk) bB[kk] = FTR(Bw, 72, 32 * kk, 16 * ni);
#pragma unroll
          for (int j = 0; j < 2; ++j) { const int pi = (wave >> 2) + 2 * j;
#pragma unroll
            for (int r = 0; r < 4; ++r) accH[j][r] *= dec;
#pragma unroll
            for (int kk = 0; kk < 2; ++kk) accH[j] = mfma16(FTR(Xs, 72, 32 * kk, 16 * pi), bB[kk], accH[j]); } }
        LDS_BARRIER();
#pragma unroll
        for (int j = 0; j < 2; ++j) { const int idx = wave + 8 * j, pi = idx >> 2, ni = idx & 3;
            *(LAS u32x2*)(HbT + (16 * ni + fr) * 72 + 16 * pi + 4 * fq) = pack4(accH[j][0], accH[j][1], accH[j][2], accH[j][3]); }
        { const int t = tid >> 3, part = tid & 7; float f[8], z[8]; unpack8(*(const LAS u32x4*)(Ys + t * 72 + 8 * part), f); unpack8(ps, z);
#pragma unroll
            for (int i = 0; i < 8; ++i) f[i] *= siluf(z[i]);
            if (t < nv) *(u32x4*)(BR2 + (size_t)(tok0 + t0 + t) * 512 + hd * 64 + 8 * part) = pack8(f); }
        SSD_PREFETCH_Z(t0 + 64);
        LDS_BARRIER();
    }
#undef SSD_PREFETCH_Z
#undef SSD_PREFETCH
    STG_TOTAL(); STG_FINI(hd == 0 ? 2 : -1);
    { float* ho = A.out + (sample ? O_SH : O_PH) + ((size_t)(l * NB + b) * 8 + hd) * 4096;
#pragma unroll
        for (int j = 0; j < 2; ++j) { const int idx = wave + 8 * j, pi = idx >> 2, ni = idx & 3;
            float* hp = ho + (16 * pi + 4 * fq) * 64 + 16 * ni + fr; OPQV(hp);
#pragma unroll
            for (int r = 0; r < 4; ++r) hp[r * 64] = accH[j][r]; } }
    for (int e = tid; e < 3 * 192; e += NTHREADS) { const int r = e / 192, c = e % 192;
        if (c < 64 || (hd & 3) == 0) A.out[(sample ? O_SV : O_PV) + ((size_t)(l * NB + b) * 3 + r) * 768 + ssd_chmap(hd, c)] = bf2f(HIST[r * 200 + c]); }
    __syncthreads();
}

__device__ __forceinline__ void phase_ssdnorm(ArgP Ap, int l) {
    const int tx = opaque_tid(), lane = tx & 63, wave = tx >> 6, gw = obid() * NWAVES + wave, NGW = ogrid() * NWAVES;
    bf16* BR2 = (bf16*)(A.ws + WS_BR) + (size_t)T * 1024; const float* sn = A.in[20] + l * 512 + 8 * lane;
    for (int tok = gw; tok < T; tok += NGW) { float f[8]; unpack8(*(const u32x4*)(BR2 + (size_t)tok * 512 + 8 * lane), f); float s2 = 0.f;
#pragma unroll
        for (int i = 0; i < 8; ++i) s2 += f[i] * f[i];
#pragma unroll
        for (int m = 1; m < 32; m <<= 1) s2 += __shfl_xor(s2, m);
        const float rstd = frsq(s2 * (1.0f / 256.0f) + EPS_);
#pragma unroll
        for (int i = 0; i < 8; ++i) f[i] *= rstd * sn[i];
        *(u32x4*)(BR2 + (size_t)tok * 512 + 8 * lane) = pack8(f); }
}

__device__ __forceinline__ void mixer_item(ArgP Ap, LAS unsigned char* lds, int l, int it) {
    constexpr int NL0 = BP * 4, NL1 = NL0 + BP * 4, NL2 = NL1 + BP * 8, NS0 = NL2 + BS * 4, NS1 = NS0 + BS * 4;
    int kind, r; bool sample;
    if (it < NL0) { kind = 0; r = it; sample = false; } else if (it < NL1) { kind = 1; r = it - NL0; sample = false; } else if (it < NL2) { kind = 2; r = it - NL1; sample = false; }
    else if (it < NS0) { kind = 0; r = it - NL2; sample = true; } else if (it < NS1) { kind = 1; r = it - NS0; sample = true; } else { kind = 2; r = it - NS1; sample = true; }
#ifndef ONLYK
#define ONLYK -1
#endif
#ifndef EMU
#define OPQ() ArgP Ap_ = Ap; int l_ = __builtin_amdgcn_readfirstlane(l), r_ = __builtin_amdgcn_readfirstlane(r); LAS unsigned char* lds_ = lds; asm volatile("" : "+s"(Ap_), "+s"(l_), "+s"(r_), "+s"(lds_) :: "memory")
#else
#define OPQ() ArgP Ap_ = Ap; int l_ = l, r_ = r; LAS unsigned char* lds_ = lds
#endif
    if ((ONLYK < 0 || ONLYK == 0) && kind == 0) { OPQ(); mlstm_item(Ap_, lds_, l_, r_ >> 2, r_ & 3, sample); }
    else if ((ONLYK < 0 || ONLYK == 1) && kind == 1) { OPQ(); gla_item(Ap_, lds_, l_, r_ >> 2, r_ & 3, sample); }
    else if ((ONLYK < 0 || ONLYK == 2) && kind == 2) { OPQ(); ssd_item(Ap_, lds_, l_, r_ >> 3, r_ & 7, sample); }
#undef OPQ
}
__device__ __forceinline__ void phase_mixers(ArgP Ap, LAS unsigned char* lds, int l) {
    constexpr int NLONG = BP * 16, NSHORT = BS * 16; int G = ogrid(), bid = obid(); OPQS(G); OPQS(bid);
#ifdef MIX_NOSPLIT
    const bool split = false;
#else
    const bool split = G > NLONG;
#endif
#ifndef MIX_IDLE
#define MIX_IDLE 0
#endif
    const int step = split ? (bid < NLONG ? (1 << 28) : G - NLONG - MIX_IDLE) : G;
    if (split && MIX_IDLE && bid >= G - MIX_IDLE) return;
#ifndef MIXREP
#define MIXREP 0
#endif
#pragma unroll 1
    for (int it = bid; it < NLONG + NSHORT; it += step) {
        const int reps = ((MIXREP == 1 && it < NLONG) || (MIXREP == 2 && it >= NLONG) || (MIXREP == 3 && it < BP * 4) || (MIXREP == 4 && it >= BP * 4 && it < BP * 8) || (MIXREP == 5 && it >= BP * 8 && it < NLONG)) ? 2 : 1;
#pragma unroll 1
        for (int rp = 0; rp < reps; ++rp) mixer_item(Ap, lds, l, it);
    }
    if (!split || bid >= NLONG) { const int part = split ? bid - NLONG : bid, nparts = split ? G - NLONG : G;
        __syncthreads();
        convert_tables(Ap, l, part, nparts);
        if (l == 0) convert_weights(Ap, lds, 1, part, nparts); }
}

__device__ __forceinline__ float wave_sum64(float v) {
#pragma unroll
    for (int m = 1; m < 64; m <<= 1) v += __shfl_xor(v, m);
    return v;
}
constexpr float DN_ALPHA_ = 1.4142135623730951f;

__device__ __forceinline__ void phase_ln1(ArgP Ap, int l) {
    const int tx = opaque_tid(), lane = tx & 63, wave = tx >> 6, gw = obid() * NWAVES + wave, NGW = ogrid() * NWAVES;
    const float* Y = (const float*)(A.ws + WS_ZG); float* H = (float*)(A.ws + WS_H); bf16* H1B = (bf16*)(A.ws + WS_BR);
    const float* lg = A.in[23] + l * D + 16 * lane; const float* lb = A.in[24] + l * D + 16 * lane;
    for (int tok = gw; tok < T; tok += NGW) {
        const float* xr = (l == 0) ? (tok < TP ? A.in[0] + (size_t)tok * D : A.in[1] + (size_t)(tok - TP) * D) : H + (size_t)tok * D;
        float y[16]; float s1 = 0.f;
#pragma unroll
        for (int q = 0; q < 4; ++q) { const float4 a = *(const float4*)(xr + 16 * lane + 4 * q), b = *(const float4*)(Y + (size_t)tok * D + 16 * lane + 4 * q);
            y[4 * q] = DN_ALPHA_ * a.x + b.x; y[4 * q + 1] = DN_ALPHA_ * a.y + b.y; y[4 * q + 2] = DN_ALPHA_ * a.z + b.z; y[4 * q + 3] = DN_ALPHA_ * a.w + b.w; }
#pragma unroll
        for (int i = 0; i < 16; ++i) s1 += y[i];
        const float mu = wave_sum64(s1) * (1.0f / D); float s2 = 0.f;
#pragma unroll
        for (int i = 0; i < 16; ++i) { y[i] -= mu; s2 += y[i] * y[i]; }
        const float rstd = frsq(wave_sum64(s2) * (1.0f / D) + EPS_);
#pragma unroll
        for (int i = 0; i < 16; ++i) y[i] = y[i] * rstd * lg[i] + lb[i];
#pragma unroll
        for (int q = 0; q < 4; ++q) *(float4*)(H + (size_t)tok * D + 16 * lane + 4 * q) = make_float4(y[4 * q], y[4 * q + 1], y[4 * q + 2], y[4 * q + 3]);
        float y0[8], y1[8];
#pragma unroll
        for (int i = 0; i < 8; ++i) { y0[i] = y[i]; y1[i] = y[8 + i]; }
        *(u32x4*)(H1B + (size_t)tok * D + 16 * lane) = pack8(y0); *(u32x4*)(H1B + (size_t)tok * D + 16 * lane + 8) = pack8(y1);
    }
}

__device__ __forceinline__ unsigned ord_of(float f) { const unsigned u = __float_as_uint(f); return (u & 0x80000000u) ? ~u : (u | 0x80000000u); }
__device__ __forceinline__ float dec_ord(unsigned o) { const unsigned u = (o & 0x80000000u) ? (o & 0x7fffffffu) : ~o; return __uint_as_float(u); }
__device__ __forceinline__ unsigned umax_(unsigned a, unsigned b) { return a > b ? a : b; }
__device__ __forceinline__ unsigned umin_(unsigned a, unsigned b) { return a < b ? a : b; }
__device__ __forceinline__ void ins16(unsigned (&L)[16], unsigned x) {
#pragma unroll
    for (int p = 0; p < 16; ++p) { const unsigned hi = umax_(L[p], x); x = umin_(L[p], x); L[p] = hi; }
}
__device__ __forceinline__ unsigned sel16(const unsigned (&L)[16], int a) { unsigned r = L[0];
#pragma unroll
    for (int p = 1; p < 16; ++p) r = (a == p) ? L[p] : r;
    return r; }

__device__ __forceinline__ void route_topk(const bf16* __restrict__ Q, const LAS bf16* KEYS, int tokb, int h, int j, int fr, int fq, unsigned (&Lt)[16]) {
    f32x4 acc[8];
#pragma unroll
    for (int ki = 0; ki < 8; ++ki) acc[ki] = (f32x4){0.f, 0.f, 0.f, 0.f};
#pragma unroll
    for (int kk = 0; kk < 4; ++kk) { const bf16x8 bq = *(const bf16x8*)(Q + (size_t)(tokb + fr) * 2048 + h * 256 + j * 128 + 32 * kk + 8 * fq);
#pragma unroll
        for (int ki = 0; ki < 8; ++ki) { const bf16x8 ak = *(const LAS bf16x8*)(KEYS + (j * 128 + 16 * ki + fr) * 136 + 32 * kk + 8 * fq); acc[ki] = mfma16(ak, bq, acc[ki]); } }
#pragma unroll
    for (int p = 0; p < 16; ++p) Lt[p] = 0u;
#pragma unroll
    for (int ki = 0; ki < 8; ++ki)
#pragma unroll
        for (int r = 0; r < 4; ++r) ins16(Lt, (ord_of(acc[ki][r]) & ~127u) | (unsigned)(127 - (16 * ki + 4 * fq + r)));
#pragma unroll
    for (int m = 16; m < 64; m <<= 1) { unsigned R[16];
#pragma unroll
        for (int p = 0; p < 16; ++p) R[p] = __shfl_xor(Lt[p], m);
#pragma unroll
        for (int p = 0; p < 16; ++p) ins16(Lt, R[p]); }
}

__device__ __forceinline__ void phase_route(ArgP Ap, LAS unsigned char* lds, int l) {
    const int tid = opaque_tid(), lane = tid & 63, wave = tid >> 6, fr = lane & 15, fq = lane >> 4;
    LAS bf16* KEYS = (LAS bf16*)lds;
    LAS unsigned* LST = (LAS unsigned*)(lds + 69632);
    const bf16* Q = (const bf16*)(A.ws + WS_Q); int* IDX = (int*)(A.ws + WS_IDX); float* GT = (float*)(A.ws + WS_GT);
    const bf16* kg = (const bf16*)(A.ws + WS_WB + (size_t)l * WB_BYTES + WB_KEYS);
    constexpr int NG = T / 16, NCH = (NG + 7) / 8, NITEMS = NCH * 8;
    int last_h = -1;
    for (int it = obid(); it < NITEMS; it += ogrid()) {
        const int h = it & 7, ch = it >> 3;
        if (h != last_h) { __syncthreads();
            for (int c = tid; c < 2 * 128 * 16; c += NTHREADS) { const int row = c >> 4, cc = (c & 15) * 8; *(LAS u32x4*)(KEYS + row * 136 + cc) = *(const u32x4*)(kg + ((size_t)h * 256 + row) * 128 + cc); }
            __syncthreads(); last_h = h; }
        const int grp = ch * 8 + wave;
        if (grp < NG) {
            const int tokb = grp * 16; unsigned L1[16], L2[16];
            route_topk(Q, KEYS, tokb, h, 0, fr, fq, L1); route_topk(Q, KEYS, tokb, h, 1, fr, fq, L2);
            unsigned C[16];
#pragma unroll
            for (int p = 0; p < 16; ++p) C[p] = 0u;
#pragma unroll
            for (int a = 0; a < 16; ++a)
#pragma unroll
                for (int b = 0; b < 16; ++b) if ((a + 1) * (b + 1) <= 16) {
                    const float s = dec_ord(L1[a] & ~127u) + dec_ord(L2[b] & ~127u); ins16(C, (ord_of(s) & ~255u) | (unsigned)(255 - (a * 16 + b))); }
            const float s0 = dec_ord(C[0] & ~255u); float e[16]; float sum = 0.f;
#pragma unroll
            for (int p = 0; p < 16; ++p) { e[p] = __expf(dec_ord(C[p] & ~255u) - s0); sum += e[p]; }
            const float inv = frcp(sum); const size_t ob = (size_t)(tokb + fr) * 128 + h * 16;
#pragma unroll
            for (int p = 0; p < 16; ++p) { LST[(wave * 32 + p) * 64 + lane] = L1[p]; LST[(wave * 32 + 16 + p) * 64 + lane] = L2[p]; }
#pragma unroll
            for (int p = 0; p < 16; ++p) { const int cid = 255 - (int)(C[p] & 255u); const int a = cid >> 4, b = cid & 15;
                const int e1 = 127 - (int)(LST[(wave * 32 + a) * 64 + lane] & 127u), e2 = 127 - (int)(LST[(wave * 32 + 16 + b) * 64 + lane] & 127u);
                if ((p >> 2) == fq) { IDX[ob + p] = e1 * 128 + e2; GT[ob + p] = e[p] * inv; } }
        }
    }
}

__device__ __forceinline__ void phase_gather(ArgP Ap, int l) {
    const int tx = opaque_tid(), lane = tx & 63, wave = tx >> 6, gw = obid() * NWAVES + wave, NGW = ogrid() * NWAVES, rho = lane >> 4;
    float* H = (float*)(A.ws + WS_H); bf16* XB = (bf16*)(A.ws + WS_XB); const int* IDX = (const int*)(A.ws + WS_IDX); const float* GT = (const float*)(A.ws + WS_GT);
    const unsigned char* PU = A.ws + WS_PU; const unsigned char* PV = A.ws + WS_PV; const float* PUS = (const float*)(A.ws + WS_PUS); const float* PVS = (const float*)(A.ws + WS_PVS);
    const float* lgb = A.in[29] + l * D; const float* lbb = A.in[30] + l * D; const int l16 = 16 * lane;
    const int kofs = 2 * (rho & 1) + (rho >> 1);
    for (int tok = gw; tok < T; tok += NGW) {
        const int i0 = IDX[(size_t)tok * 128 + lane], i1 = IDX[(size_t)tok * 128 + 64 + lane];
        float x[16];
#pragma unroll
        for (int q = 0; q < 4; ++q) { const float4 a = *(const float4*)(H + (unsigned)tok * D + l16 + 4 * q); x[4 * q] = a.x; x[4 * q + 1] = a.y; x[4 * q + 2] = a.z; x[4 * q + 3] = a.w; }
        const float su0 = PUS[i0], su1 = PUS[i1];
        const float gv0 = GT[(size_t)tok * 128 + lane] * PVS[i0], gv1 = GT[(size_t)tok * 128 + 64 + lane] * PVS[i1];
        float o[16];
#pragma unroll
        for (int i = 0; i < 16; ++i) o[i] = 0.f;
#pragma unroll 1
        for (int kb = 0; kb < 128; kb += 8) {
            u32x4 uu[8], vv[8];
#pragma unroll
            for (int kk = 0; kk < 8; ++kk) { const int e = __shfl(kb < 64 ? i0 : i1, (kb + kk) & 63);
                const unsigned off = (unsigned)e * D + l16; uu[kk] = *(const u32x4*)(PU + off); vv[kk] = *(const u32x4*)(PV + off); }
            float r[2];
#pragma unroll
            for (int i = 0; i < 2; ++i) { float p[4];
#pragma unroll
                for (int c = 0; c < 4; ++c) { const int kk = 4 * i + c; float f[16]; unpk_fp8x4(uu[kk].x, f); unpk_fp8x4(uu[kk].y, f + 4); unpk_fp8x4(uu[kk].z, f + 8); unpk_fp8x4(uu[kk].w, f + 12); float s = 0.f;
#pragma unroll
                    for (int j = 0; j < 16; ++j) s += f[j] * x[j];
                    p[c] = s; SCHED_FENCE(); }
                float t = row_allsum(swap16_add(swap32_add(p[0], p[1]), swap32_add(p[2], p[3])));
                const int kq = kb + 4 * i + kofs;
                t *= __shfl(kb < 64 ? su0 : su1, kq & 63);
                r[i] = gelu_fast(t) * __shfl(kb < 64 ? gv0 : gv1, kq & 63); SCHED_FENCE(); }
#pragma unroll
            for (int kk = 0; kk < 8; ++kk) { const int c = kk & 3; const float act = RDLANE(r[kk >> 2], 16 * (((c & 1) << 1) | ((c >> 1) & 1)));
                float f[16]; unpk_fp8x4(vv[kk].x, f); unpk_fp8x4(vv[kk].y, f + 4); unpk_fp8x4(vv[kk].z, f + 8); unpk_fp8x4(vv[kk].w, f + 12);
#pragma unroll
                for (int j = 0; j < 16; ++j) o[j] += act * f[j];
                SCHED_FENCE(); }
        }
        float s1 = 0.f;
#pragma unroll
        for (int i = 0; i < 16; ++i) { o[i] += DN_ALPHA_ * x[i]; s1 += o[i]; }
        const float mu = wave_sum64(s1) * (1.0f / D); float s2 = 0.f;
#pragma unroll
        for (int i = 0; i < 16; ++i) { o[i] -= mu; s2 += o[i] * o[i]; }
        const float rstd = frsq(wave_sum64(s2) * (1.0f / D) + EPS_);
#pragma unroll
        for (int i = 0; i < 16; ++i) o[i] = o[i] * rstd * lgb[l16 + i] + lbb[l16 + i];
        float* dst = ((l == 1) ? A.out : H) + (unsigned)tok * D + l16;
#pragma unroll
        for (int q = 0; q < 4; ++q) *(float4*)(dst + 4 * q) = make_float4(o[4 * q], o[4 * q + 1], o[4 * q + 2], o[4 * q + 3]);
        if (l == 0) { float y0[8], y1[8];
#pragma unroll
            for (int i = 0; i < 8; ++i) { y0[i] = o[i]; y1[i] = o[8 + i]; }
            *(u32x4*)(XB + (unsigned)tok * D + l16) = pack8(y0); *(u32x4*)(XB + (unsigned)tok * D + l16 + 8) = pack8(y1); }
    }
}


#ifndef EMU
struct MergeOrder {
    pg8::StaticOrder S;
    __device__ bool next(int i, pg8::Unit& u) const { pg8::Unit t; if (!S.next(i, t)) return false; const int n = t.pm / (T / 256); u.pm = t.pm; u.pn = n * 4 + t.pn; return true; }
    __device__ __forceinline__ void a_ready(const pg8::Unit&) const {}
    __device__ __forceinline__ void done(const pg8::Unit&) const {}
};
struct EpiP {
    static constexpr bool PERM = true, AFTER_DRAIN = false;
    bf16* P;
    __device__ __forceinline__ void operator()(const pg8::f32x4 (&acc)[2][2][4][2], const pg8::Unit& u, int wr, int wc, int fr, int fq) const {
        const int row0 = u.pm * 256 + wr * 64 + fr, col0 = (u.pn & 3) * 256 + wc * 32 + 8 * fq;
#pragma unroll
        for (int ai = 0; ai < 2; ++ai)
#pragma unroll
            for (int m = 0; m < 4; ++m) { bf16* rowp = P + (size_t)(row0 + ai * 128 + m * 16) * D + col0;
#pragma unroll
                for (int bj = 0; bj < 2; ++bj) { const pg8::f32x4 v0 = acc[ai][bj][m][0], v1 = acc[ai][bj][m][1];
                    u32x4 w; w.x = pg8::cvt_pk_bf16(v0[0], v0[1]); w.y = pg8::cvt_pk_bf16(v0[2], v0[3]); w.z = pg8::cvt_pk_bf16(v1[0], v1[1]); w.w = pg8::cvt_pk_bf16(v1[2], v1[3]);
                    *(u32x4*)(rowp + bj * 128) = w; } }
    }
};
__device__ __forceinline__ void phase_merge(ArgP Ap, LAS unsigned char* lds, int l) {
    pg8::Gemm g{(const bf16*)(A.ws + WS_BR), (const bf16*)(A.ws + WS_WB + (size_t)l * WB_BYTES + WB_WBR), 3 * T, 3 * D, 512};
    MergeOrder S; S.S.init(3 * T, D, ogrid(), obid());
    EpiP E{(bf16*)(A.ws + WS_ZM)};
    pg8::gemm_phase<EpiP, MergeOrder>(lds, g, S, E);
}
#endif
__device__ __forceinline__ void phase_combine(ArgP Ap) {
    const size_t gtid = (size_t)obid() * NTHREADS + opaque_tid(), gthreads = (size_t)ogrid() * NTHREADS;
    const bf16* P = (const bf16*)(A.ws + WS_ZM); const bf16* ZG = (const bf16*)(A.ws + WS_ZG); bf16* MIXED = (bf16*)(A.ws + WS_XB);
    for (size_t i = gtid; i < (size_t)T * (D / 8); i += gthreads) { const size_t t = i >> 7, c = (i & 127) * 8; float v[8];
#pragma unroll
        for (int j = 0; j < 8; ++j) v[j] = 0.f;
#pragma unroll
        for (int n = 0; n < 3; ++n) { float p[8], g[8]; unpack8(*(const u32x4*)(P + ((size_t)n * T + t) * D + c), p); unpack8(*(const u32x4*)(ZG + t * NZG + n * D + c), g);
#pragma unroll
            for (int j = 0; j < 8; ++j) v[j] += p[j] * g[j]; }
        *(u32x4*)(MIXED + t * D + c) = pack8(v); }
}
#ifndef EMU
struct EpiF32 {
    static constexpr bool PERM = false, AFTER_DRAIN = false;
    float* C; int ldc;
    __device__ __forceinline__ void operator()(const pg8::f32x4 (&acc)[2][2][4][2], const pg8::Unit& u, int wr, int wc, int fr, int fq) const {
        const int row0 = u.pm * 256 + wr * 64 + fr, col0 = u.pn * 256 + wc * 32 + 4 * fq;
#pragma unroll
        for (int ai = 0; ai < 2; ++ai)
#pragma unroll
            for (int m = 0; m < 4; ++m) { float* rowp = C + (size_t)(row0 + ai * 128 + m * 16) * ldc + col0;
#pragma unroll
                for (int bj = 0; bj < 2; ++bj)
#pragma unroll
                    for (int n = 0; n < 2; ++n) *(pg8::f32x4*)(rowp + bj * 128 + n * 16) = acc[ai][bj][m][n]; }
    }
};
struct EpiB16 {
    static constexpr bool PERM = true, AFTER_DRAIN = false;
    bf16* O; int ldc;
    __device__ __forceinline__ void operator()(const pg8::f32x4 (&acc)[2][2][4][2], const pg8::Unit& u, int wr, int wc, int fr, int fq) const {
        const int row0 = u.pm * 256 + wr * 64 + fr, col0 = u.pn * 256 + wc * 32 + 8 * fq;
#pragma unroll
        for (int ai = 0; ai < 2; ++ai)
#pragma unroll
            for (int m = 0; m < 4; ++m) { bf16* rowp = O + (size_t)(row0 + ai * 128 + m * 16) * ldc + col0;
#pragma unroll
                for (int bj = 0; bj < 2; ++bj) { const pg8::f32x4 v0 = acc[ai][bj][m][0], v1 = acc[ai][bj][m][1];
                    u32x4 w; w.x = pg8::cvt_pk_bf16(v0[0], v0[1]); w.y = pg8::cvt_pk_bf16(v0[2], v0[3]); w.z = pg8::cvt_pk_bf16(v1[0], v1[1]); w.w = pg8::cvt_pk_bf16(v1[2], v1[3]);
                    *(u32x4*)(rowp + bj * 128) = w; } }
    }
};
__device__ __forceinline__ void phase_outproj(ArgP Ap, LAS unsigned char* lds, int l) {
    pg8::Gemm g{(const bf16*)(A.ws + WS_XB), (const bf16*)(A.ws + WS_WB + (size_t)l * WB_BYTES + WB_WO), T, D, D};
    pg8::StaticOrder S; S.init(T, D, ogrid(), obid());
    EpiF32 E{(float*)(A.ws + WS_ZG), D};
    pg8::gemm_phase<EpiF32, pg8::StaticOrder>(lds, g, S, E);
}
__device__ __forceinline__ void phase_qproj(ArgP Ap, LAS unsigned char* lds, int l) {
    pg8::Gemm g{(const bf16*)(A.ws + WS_BR), (const bf16*)(A.ws + WS_WB + (size_t)l * WB_BYTES + WB_WQ), T, 2048, D};
    pg8::StaticOrder S; S.init(T, 2048, ogrid(), obid());
    EpiB16 E{(bf16*)(A.ws + WS_Q), 2048};
    pg8::gemm_phase<EpiB16, pg8::StaticOrder>(lds, g, S, E);
}

__global__ void __launch_bounds__(NTHREADS, 2) mega_fwd(Args kargs) {
    extern __shared__ __attribute__((aligned(16))) unsigned char lds_raw[];
    LAS unsigned char* lds = (LAS unsigned char*)lds_raw;
    volatile LAS unsigned* xst = (volatile LAS unsigned*)(lds + LDS_BYTES - 16);
    unsigned* xbar = (unsigned*)(kargs.ws + WS_CTL);
    if (threadIdx.x < 4) xst[threadIdx.x] = 0u;
    if (blockIdx.x == 0) for (int i = threadIdx.x; i < XCD_BAR_WORDS; i += NTHREADS) xbar[i] = 0u;
#ifdef STAGE_AMP
    if (blockIdx.x == 0 && threadIdx.x < 128) ((unsigned long long*)(kargs.ws + WS_CTL + 40960))[threadIdx.x] = 0ull;
#endif
    __syncthreads();
    XcdBarrier xb; xb.bar = xbar; xb.x = 0; xb.st = xst;
    ArgP Ap = (ArgP)__builtin_amdgcn_kernarg_segment_ptr();
#define RUN(call) do { ArgP Ap_ = Ap; int l_ = l; LAS unsigned char* lds_ = lds; asm volatile("" : "+s"(Ap_), "+s"(l_), "+s"(lds_) :: "memory"); { ArgP Ap = Ap_; const int l = l_; LAS unsigned char* lds = lds_; (void)lds; call; } asm volatile("" ::: "memory"); } while (0)
#ifndef ONLYP
#define ONLYP -1
#endif
#ifndef SKIPP
#define SKIPP -2
#endif
#define PSEL(q) ((ONLYP < 0 || ONLYP == (q)) && SKIPP != (q))
#ifndef REPMASK
#define REPMASK 0
#endif
#define REP(q, l) (((REPMASK >> (q)) & 1) && ((q) != 5 || (l) == 0) && ((q) != 8 || (l) == 1))
#define IN(k) true
#ifdef AMP_PHASE
#define TSTAMP(k) do { if (blockIdx.x == 0 && threadIdx.x == 0) ((unsigned long long*)(kargs.ws + WS_CTL + 32768))[(k)] = __builtin_amdgcn_s_memrealtime(); } while (0)
#else
#define TSTAMP(k) do {} while (0)
#endif
#define SEAM(k) do { if ((k) == 0) { cg::this_grid().sync(); xb = xcd_barrier_post(xbar, xst); } else xcd_barrier(xb); TSTAMP((k) + 1); } while (0)
#pragma unroll 1
    TSTAMP(0);
    {
    { const int l = 0; if (PSEL(0) && IN(0)) { RUN(phase_convert(Ap, lds)); if (REP(0, l)) RUN(phase_convert(Ap, lds)); } (void)l; }
    SEAM(0);
    for (int l = 0; l < 2; ++l) {
        const int p = 1 + 10 * l;
        if (PSEL(1) && IN(p + 0)) { RUN(phase_gemm1(Ap, lds, l)); if (REP(1, l)) RUN(phase_gemm1(Ap, lds, l)); }
        SEAM(p);
        if (PSEL(2) && IN(p + 1)) { RUN(phase_mixers(Ap, lds, l)); if (REP(2, l)) RUN(phase_mixers(Ap, lds, l)); }
        SEAM(p + 1);
#ifdef XBAR_EXTRA
        for (int xe = 0; xe < XBAR_EXTRA; ++xe) xcd_barrier(xb);
#endif
        if (PSEL(9) && IN(p + 2)) RUN(phase_ssdnorm(Ap, l));
        SEAM(p + 2);
        if (PSEL(3) && IN(p + 3)) { RUN(phase_merge(Ap, lds, l)); if (REP(3, l)) RUN(phase_merge(Ap, lds, l)); }
        SEAM(p + 3);
        if (PSEL(10) && IN(p + 4)) RUN(phase_combine(Ap));
        SEAM(p + 4);
        if (PSEL(4) && IN(p + 5)) { RUN(phase_outproj(Ap, lds, l)); if (REP(4, l)) RUN(phase_outproj(Ap, lds, l)); }
        SEAM(p + 5);
        if (PSEL(5) && IN(p + 6)) { RUN(phase_ln1(Ap, l)); if (REP(5, l)) RUN(phase_ln1(Ap, l)); }
        SEAM(p + 6);
        if (PSEL(6) && IN(p + 7)) { RUN(phase_qproj(Ap, lds, l)); if (REP(6, l)) RUN(phase_qproj(Ap, lds, l)); }
        SEAM(p + 7);
        if (PSEL(7) && IN(p + 8)) { RUN(phase_route(Ap, lds, l)); if (REP(7, l)) RUN(phase_route(Ap, lds, l)); }
        SEAM(p + 8);
        if (PSEL(8) && IN(p + 9)) { RUN(phase_gather(Ap, l)); if (REP(8, l)) RUN(phase_gather(Ap, l)); }
        SEAM(p + 9);
    }
    }
#ifdef AMP_PHASE
    if (blockIdx.x == 0 && threadIdx.x == 0) { const unsigned long long* ts = (const unsigned long long*)(kargs.ws + WS_CTL + 32768);
        const unsigned long long dt = (ts[AMP_PHASE + 1] - ts[AMP_PHASE]) * 8ull, t0 = __builtin_amdgcn_s_memrealtime();
        while (__builtin_amdgcn_s_memrealtime() - t0 < dt) __builtin_amdgcn_s_sleep(8); }
#endif
#ifdef STAGE_AMP
    if (blockIdx.x == 0 && threadIdx.x == 0) { const unsigned long long dt = ((const unsigned long long*)(kargs.ws + WS_CTL + 40960))[STAGE_AMP] * 8ull, t0 = __builtin_amdgcn_s_memrealtime();
        while (__builtin_amdgcn_s_memrealtime() - t0 < dt) __builtin_amdgcn_s_sleep(8); }
#endif
#undef IN
#undef RUN
#undef SEAM
}

extern "C" void kernel_launch(void* const* d_in, const int* in_sizes, int n_in, void* d_out, int out_size, void* d_ws, size_t ws_size, hipStream_t stream) {
    static int grid_blocks = 0;
    if (grid_blocks == 0) {
        if (n_in != 31 || (size_t)out_size != O_END || ws_size < WS_END) {
            fprintf(stderr, "kernel_launch: unexpected problem: n_in %d out %d (want %zu) ws %zu (want >= %zu)\n", n_in, out_size, (size_t)O_END, ws_size, (size_t)WS_END); grid_blocks = -1; return; }
        int dev = 0, cus = 0, per_cu = 0;
        (void)hipGetDevice(&dev); (void)hipDeviceGetAttribute(&cus, hipDeviceAttributeMultiprocessorCount, dev);
        if (hipFuncSetAttribute((const void*)mega_fwd, hipFuncAttributeMaxDynamicSharedMemorySize, LDS_BYTES) != hipSuccess) { fprintf(stderr, "kernel_launch: hipFuncSetAttribute failed\n"); grid_blocks = -1; return; }
        if (hipOccupancyMaxActiveBlocksPerMultiprocessor(&per_cu, (const void*)mega_fwd, NTHREADS, LDS_BYTES) != hipSuccess || per_cu < 1) { fprintf(stderr, "kernel_launch: occupancy query failed (%d)\n", per_cu); grid_blocks = -1; return; }
        grid_blocks = cus * per_cu;
        fprintf(stderr, "kernel_launch: %d CUs x %d = %d workgroups\n", cus, per_cu, grid_blocks);
    }
    if (grid_blocks < 0) return;
    Args a{};
    for (int i = 0; i < 31; ++i) a.in[i] = (const float*)d_in[i];
    a.out = (float*)d_out; a.ws = (unsigned char*)d_ws; a.ph_lo = 0; a.ph_hi = 64;
    void* args[] = {&a};
    hipError_t e = hipLaunchCooperativeKernel((const void*)mega_fwd, dim3(grid_blocks), dim3(NTHREADS), args, LDS_BYTES, stream);
    if (e != hipSuccess) fprintf(stderr, "kernel_launch: cooperative launch failed: %s (grid %d)\n", hipGetErrorString(e), grid_blocks);
}
#endif
```

```cpp
#ifndef EMU
#include <hip/hip_runtime.h>
#include <hip/hip_cooperative_groups.h>
#include <cstdio>
#include <cstdint>
namespace cg = cooperative_groups;
namespace pg8 {
#define PG8_LAS __attribute__((address_space(3)))
typedef unsigned short bf16_t;
typedef short bf16x8 __attribute__((ext_vector_type(8)));
typedef float f32x4 __attribute__((ext_vector_type(4)));
typedef unsigned u32x4 __attribute__((ext_vector_type(4)));
constexpr int BM = 256, BK = 64, HALF = 128, HTB = HALF * BK * 2  , STAGE_BYTES = 8 * HTB, NXCD = 8, WGM = 8;

__host__ __device__ __forceinline__ int lds_byte(int r, int c) { const int st = (r >> 4) * 2 + (c >> 5), rr = r & 15, cc = c & 31, ob = rr * 64 + cc * 2; return st * 1024 + (ob ^ (((ob >> 9) & 1) << 5)); }
__host__ __device__ __forceinline__ void stage_rc(int b, int& R, int& C) { const int st = b / 1024, sb = b % 1024, swz = sb ^ (((sb >> 9) & 1) << 5); R = (st >> 1) * 16 + swz / 64; C = (st & 1) * 32 + (swz % 64) / 2; }
__host__ __device__ __forceinline__ int perm32(int rho) { const int n = rho >> 4, i = rho & 15; return 8 * (i >> 2) + 4 * n + (i & 3); }

struct Unit { int pm, pn; };
struct Gemm { const bf16_t* A; const bf16_t* Bt; int M, N, K; };

struct StaticOrder {
    int nM, nN, nwg, G, c;
    __host__ __device__ void init(int M, int N, int G_, int c_) { nM = M / BM; nN = N / BM; nwg = nM * nN; G = G_; c = c_; }
    __host__ __device__ bool next(int i, Unit& u) const {
        const long L = (long)i * G + c; if (L >= nwg) return false;
        int wgid = (int)L; { const int q = nwg / NXCD, r = nwg % NXCD, xcd = wgid % NXCD, off = wgid / NXCD; wgid = (xcd < r ? xcd * (q + 1) : r * (q + 1) + (xcd - r) * q) + off; }
        const int nig = WGM * nN, gid = wgid / nig, fm = gid * WGM, gsz = (nM - fm) < WGM ? (nM - fm) : WGM;
        u.pm = fm + ((wgid % nig) % gsz); u.pn = (wgid % nig) / gsz; return true;
    }
    __device__ __forceinline__ void a_ready(const Unit&) const {}
    __device__ __forceinline__ void done(const Unit&) const {}
};

__device__ __forceinline__ unsigned cvt_pk_bf16(float lo, float hi) { unsigned r; asm volatile("v_cvt_pk_bf16_f32 %0, %1, %2" : "=v"(r) : "v"(lo), "v"(hi)); return r; }
typedef float f32x2 __attribute__((ext_vector_type(2)));
__device__ __forceinline__ f32x2 gelu_pk(f32x2 v) {
    const f32x2 av = __builtin_elementwise_abs(v), d = av * 0.2316418882f + 1.0f;
    f32x2 t; t.x = __builtin_amdgcn_rcpf(d.x); t.y = __builtin_amdgcn_rcpf(d.y);
    f32x2 q = t * 0.5307027145f + (-0.7265760135f); q = q * t + 0.7107068705f; q = q * t + (-0.142248368f); q = q * t + 0.127414796f; q = q * t;
    const f32x2 s = (v * v) * (-0.72134752044f);
    f32x2 e; e.x = __builtin_amdgcn_exp2f(s.x); e.y = __builtin_amdgcn_exp2f(s.y);
    const f32x2 m = v * (q * e), r = v - m;
    f32x2 o; o.x = v.x < 0.f ? m.x : r.x; o.y = v.y < 0.f ? m.y : r.y; return o;
}

template <class Epi, class Sched>
__device__ __forceinline__ void gemm_phase(PG8_LAS unsigned char* lds, const Gemm g, const Sched& S, const Epi& E) {
    int tid_o = threadIdx.x; asm volatile("" : "+v"(tid_o));
    const int tid = tid_o, wid = __builtin_amdgcn_readfirstlane(tid >> 6), lane = tid & 63, wr = wid >> 2, wc = wid & 3, fr = lane & 15, fq = lane >> 4;
    const int K = g.K, nt = K / BK;
    unsigned voffA[2], voffB[2];
#pragma unroll
    for (int i = 0; i < 2; ++i) { int R, C; stage_rc(tid * 16 + i * 8192, R, C); const int Rb = Epi::PERM ? ((R & ~31) + perm32(R & 31)) : R;
        voffA[i] = (unsigned)(R * K + C) * 2u; voffB[i] = (unsigned)(Rb * K + C) * 2u; }
    const size_t kstep = (size_t)(BK * 2);
    const size_t hstep = (size_t)HALF * K * 2;
    const size_t tstep = 2 * hstep;
    const unsigned ldsw = (unsigned)wid * 1024u;
    const int aoff = lds_byte(wr * 64 + fr, fq * 8), boff = lds_byte(wc * 32 + fr, fq * 8);
#define PG8_SA(b, h) (((b) * 2 + (h)) * HTB)
#define PG8_SB(b, h) ((4 + (b) * 2 + (h)) * HTB)
#define PG8_STAGE(bufoff, gbase, voff) do { _Pragma("unroll") for (int _i = 0; _i < 2; ++_i) \
        __builtin_amdgcn_global_load_lds((const unsigned*)((const char*)(gbase) + (voff)[_i]), (PG8_LAS unsigned*)(lds + (bufoff) + ldsw + _i * 8192), 16, 0, 0); } while (0)
#define PG8_LDA(dst, b, h) do { _Pragma("unroll") for (int m = 0; m < 4; ++m) _Pragma("unroll") for (int k = 0; k < 2; ++k) dst[m][k] = *(const PG8_LAS bf16x8*)(lds + PG8_SA(b, h) + aoff + m * 2048 + k * 1024); } while (0)
#define PG8_LDB(dst, b, h) do { _Pragma("unroll") for (int n = 0; n < 2; ++n) _Pragma("unroll") for (int k = 0; k < 2; ++k) dst[n][k] = *(const PG8_LAS bf16x8*)(lds + PG8_SB(b, h) + boff + n * 2048 + k * 1024); } while (0)
#define PG8_MMA(ai, bj, At, Bt) do { __builtin_amdgcn_s_setprio(1); _Pragma("unroll") for (int m = 0; m < 4; ++m) _Pragma("unroll") for (int n = 0; n < 2; ++n) _Pragma("unroll") for (int k = 0; k < 2; ++k) \
        acc[ai][bj][m][n] = __builtin_amdgcn_mfma_f32_16x16x32_bf16(Bt[n][k], At[m][k], acc[ai][bj][m][n], 0, 0, 0); __builtin_amdgcn_s_setprio(0); } while (0)
#define PG8_WAIT_V(n) asm volatile("s_waitcnt vmcnt(" #n ")" ::: "memory")
#define PG8_WAIT_L(n) asm volatile("s_waitcnt lgkmcnt(" #n ")" ::: "memory")
#define PG8_BAR __builtin_amdgcn_s_barrier()
#define PG8_SCHED __builtin_amdgcn_sched_barrier(0)
    Unit cur, nxt; int ui = 0;
    if (!S.next(0, cur)) return;
    f32x4 acc[2][2][4][2];
#pragma unroll
    for (int a = 0; a < 2; ++a)
#pragma unroll
        for (int b = 0; b < 2; ++b)
#pragma unroll
            for (int m = 0; m < 4; ++m)
#pragma unroll
                for (int n = 0; n < 2; ++n) acc[a][b][m][n] = (f32x4){0.f, 0.f, 0.f, 0.f};
    bf16x8 At[4][2], B0[2][2], B1[2][2];
    const char* cA = (const char*)g.A + (size_t)cur.pm * tstep; const char* cB = (const char*)g.Bt + (size_t)cur.pn * tstep;
    S.a_ready(cur);
    PG8_STAGE(PG8_SB(0, 0), cB, voffB); PG8_STAGE(PG8_SA(0, 0), cA, voffA); PG8_STAGE(PG8_SB(0, 1), cB + hstep, voffB); PG8_STAGE(PG8_SA(0, 1), cA + hstep, voffA);
    if (wr == 1) PG8_BAR;
    PG8_WAIT_V(4); PG8_BAR;
    PG8_STAGE(PG8_SB(1, 0), cB + kstep, voffB); PG8_STAGE(PG8_SA(1, 0), cA + kstep, voffA); PG8_STAGE(PG8_SB(1, 1), cB + hstep + kstep, voffB);
    PG8_WAIT_V(6); PG8_BAR;
    for (;;) {
        const bool has_next = S.next(ui + 1, nxt);
        const char* nA = has_next ? (const char*)g.A + (size_t)nxt.pm * tstep : cA; const char* nB = has_next ? (const char*)g.Bt + (size_t)nxt.pn * tstep : cB;
        for (int t = 0; t < nt; t += 2) {
            const bool last = (t == nt - 2);
            const char* a1 = cA + (size_t)(t + 1) * kstep;
            const char* a2 = last ? nA : cA + (size_t)(t + 2) * kstep; const char* b2 = last ? nB : cB + (size_t)(t + 2) * kstep;
            const char* a3 = a2 + kstep; const char* b3 = b2 + kstep;
            if (last && has_next) S.a_ready(nxt);
            PG8_LDB(B0, 0, 0); PG8_SCHED; PG8_LDA(At, 0, 0); PG8_STAGE(PG8_SA(1, 1), a1 + hstep, voffA);
            PG8_WAIT_L(8); PG8_BAR; PG8_WAIT_L(0); PG8_MMA(0, 0, At, B0); PG8_BAR; PG8_SCHED;
            PG8_LDB(B1, 0, 1); PG8_STAGE(PG8_SB(0, 0), b2, voffB);
            PG8_BAR; PG8_WAIT_L(0); PG8_MMA(0, 1, At, B1); PG8_BAR;
            PG8_LDA(At, 0, 1); PG8_STAGE(PG8_SA(0, 0), a2, voffA);
            PG8_BAR; PG8_WAIT_L(0); PG8_MMA(1, 0, At, B0); PG8_BAR; PG8_SCHED;
            PG8_STAGE(PG8_SB(0, 1), b2 + hstep, voffB);
            PG8_WAIT_V(6); PG8_BAR; PG8_MMA(1, 1, At, B1); PG8_BAR;
            PG8_LDB(B0, 1, 0); PG8_SCHED; PG8_LDA(At, 1, 0); PG8_STAGE(PG8_SA(0, 1), a2 + hstep, voffA);
            PG8_WAIT_L(8); PG8_BAR; PG8_WAIT_L(0); PG8_MMA(0, 0, At, B0); PG8_BAR; PG8_SCHED;
            PG8_LDB(B1, 1, 1); PG8_STAGE(PG8_SB(1, 0), b3, voffB);
            PG8_BAR; PG8_WAIT_L(0); PG8_MMA(0, 1, At, B1); PG8_BAR;
            PG8_LDA(At, 1, 1); PG8_STAGE(PG8_SA(1, 0), a3, voffA);
            PG8_BAR; PG8_WAIT_L(0); PG8_MMA(1, 0, At, B0); PG8_BAR; PG8_SCHED;
            PG8_STAGE(PG8_SB(1, 1), b3 + hstep, voffB);
            PG8_WAIT_V(6); PG8_BAR; PG8_MMA(1, 1, At, B1); PG8_BAR;
        }
        if constexpr (!Epi::AFTER_DRAIN) { E(acc, cur, wr, wc, fr, fq); S.done(cur); }
        if (!has_next) break;
#pragma unroll
        for (int a = 0; a < 2; ++a)
#pragma unroll
            for (int b = 0; b < 2; ++b)
#pragma unroll
                for (int m = 0; m < 4; ++m)
#pragma unroll
                    for (int n = 0; n < 2; ++n) acc[a][b][m][n] = (f32x4){0.f, 0.f, 0.f, 0.f};
        cur = nxt; cA = nA; cB = nB; ++ui;
    }
    PG8_WAIT_V(0);
    if (wr == 0) PG8_BAR;
    PG8_BAR;
    if constexpr (Epi::AFTER_DRAIN) { E.fused(acc, cur, wr, wc, fr, fq, lds, wid, lane); S.done(cur); }
#undef PG8_SA
#undef PG8_SB
#undef PG8_STAGE
#undef PG8_LDA
#undef PG8_LDB
#undef PG8_MMA
#undef PG8_WAIT_V
#undef PG8_WAIT_L
#undef PG8_BAR
#undef PG8_SCHED
}
}

#endif

typedef unsigned short bf16;
#ifndef EMU
#define LAS __attribute__((address_space(3)))
#else
#define LAS
#endif
typedef short bf16x8 __attribute__((ext_vector_type(8)));
typedef float f32x4 __attribute__((ext_vector_type(4)));
typedef unsigned u32x4 __attribute__((ext_vector_type(4)));
typedef unsigned u32x2 __attribute__((ext_vector_type(2)));

#ifdef EMU
constexpr int BP = EMU_BP, LP = EMU_LP, BS = EMU_BS;
#else
constexpr int BP = 8, LP = 2048, BS = 128;
#endif
constexpr int D = 1024, LS = 4, TP = BP * LP, TS = BS * LS, T = TP + TS;
constexpr int INW = 7968, NZM = 4864, NZG = 3072, NZ = NZM + NZG, NSM = 32;
constexpr int NEXP = 16384;
constexpr int SPLIT_T = 64 * (((LP / 64) * 5) / 8);
constexpr int NTHREADS = 512, NWAVES = 8;
constexpr int LDS_BYTES = 160 * 1024;

constexpr size_t O_YP = 0, O_YS = O_YP + (size_t)TP * D, O_PC = O_YS + (size_t)TS * D, O_PN = O_PC + 2ull * BP * 4 * 128 * 128, O_PM = O_PN + 2ull * BP * 4 * 128,
    O_PG = O_PM + 2ull * BP * 4, O_PH = O_PG + 2ull * BP * 4 * 64 * 128, O_PV = O_PH + 2ull * BP * 8 * 64 * 64, O_SC = O_PV + 2ull * BP * 3 * 768,
    O_SN = O_SC + 2ull * BS * 4 * 128 * 128, O_SM = O_SN + 2ull * BS * 4 * 128, O_SG = O_SM + 2ull * BS * 4, O_SH = O_SG + 2ull * BS * 4 * 64 * 128,
    O_SV = O_SH + 2ull * BS * 8 * 64 * 64, O_END = O_SV + 2ull * BS * 3 * 768;

constexpr size_t al256(size_t x) { return (x + 255) & ~(size_t)255; }
constexpr size_t WS_CTL = 0, WS_CTL_BYTES = 65536;
constexpr size_t WB_WIN = 0, WB_WS = WB_WIN + (size_t)NZ * D * 2, WB_WBR = WB_WS + (size_t)NSM * D * 2, WB_WO = WB_WBR + 3ull * D * 512 * 2, WB_WQ = WB_WO + (size_t)D * D * 2,
    WB_KEYS = WB_WQ + 2048ull * D * 2, WB_BYTES = WB_KEYS + 16ull * 128 * 128 * 2;
constexpr size_t WS_WB = WS_CTL + WS_CTL_BYTES;
constexpr size_t WS_XB = WS_WB + 2 * WB_BYTES;
constexpr size_t WS_H = WS_XB + (size_t)T * D * 2;
constexpr size_t WS_ZS = WS_H + (size_t)T * D * 4;
constexpr size_t WS_BR = WS_ZS + (size_t)T * NSM * 4;
constexpr size_t WS_ZM = WS_BR + 3ull * T * 512 * 2;
constexpr size_t WS_ZG = WS_ZM + (size_t)T * NZM * 2;
constexpr size_t WS_END0 = WS_ZG + (size_t)T * NZG * 2;
constexpr size_t WS_Q = WS_ZM, WS_IDX = WS_Q + (size_t)T * 2048 * 2, WS_GT = WS_IDX + (size_t)T * 128 * 4;
constexpr size_t WS_PU = WS_END0, WS_PV = WS_PU + (size_t)NEXP * D, WS_PUS = WS_PV + (size_t)NEXP * D, WS_PVS = WS_PUS + (size_t)NEXP * 4, WS_END = WS_PVS + (size_t)NEXP * 4;
#ifndef EMU
__device__ __forceinline__ f32x4 mfma16(bf16x8 a, bf16x8 b, f32x4 c) { return __builtin_amdgcn_mfma_f32_16x16x32_bf16(a, b, c, 0, 0, 0); }
#endif
struct Args { const float* in[31]; float* out; unsigned char* ws; int ph_lo, ph_hi; };
#ifndef EMU
typedef const __attribute__((address_space(4))) Args* ArgP;
#else
typedef const Args* ArgP;
#endif
#define A (*Ap)
#ifdef STAGE_AMP
#define STG_INIT() LAS unsigned long long* stg_acc_ = (LAS unsigned long long*)(lds + LDS_BYTES - 256); if (tid == 0) { for (int i_ = 0; i_ < 16; ++i_) stg_acc_[i_] = 0; stg_acc_[15] = __builtin_amdgcn_s_memrealtime(); stg_acc_[13] = stg_acc_[15]; }
#define STG(k) do { if (tid == 0) { const unsigned long long n_ = __builtin_amdgcn_s_memrealtime(); stg_acc_[k] += n_ - stg_acc_[15]; stg_acc_[15] = n_; } } while (0)
#define STG_TOTAL() do { if (tid == 0) stg_acc_[14] = __builtin_amdgcn_s_memrealtime() - stg_acc_[13]; } while (0)
#define STG_FINI(slot) do { if (tid == 0 && !sample && b == 0 && (slot) >= 0) { unsigned long long* g_ = (unsigned long long*)(A.ws + WS_CTL + 40960) + (slot) * 16; for (int i_ = 0; i_ < 15; ++i_) g_[i_] += stg_acc_[i_]; } } while (0)
#else
#define STG_INIT() do {} while (0)
#define STG(k) do {} while (0)
#define STG_FINI(slot) do {} while (0)
#define STG_TOTAL() do {} while (0)
#endif
#ifndef EMU
#define OPQV(x) asm volatile("" : "+v"(x))
#define OPQS(x) asm volatile("" : "+s"(x))
#define SCHED_FENCE() __builtin_amdgcn_sched_barrier(0)
#define LDS_BARRIER() asm volatile("s_waitcnt lgkmcnt(0)\n\ts_barrier" ::: "memory")
#else
#define OPQV(x) (void)(x)
#define OPQS(x) (void)(x)
#define SCHED_FENCE() do {} while (0)
#define LDS_BARRIER() __syncthreads()
#endif
#ifndef EMU
__device__ __forceinline__ int obid() { int b = blockIdx.x; asm volatile("" : "+s"(b)); return b; }
__device__ __forceinline__ int ogrid() { int g = gridDim.x; asm volatile("" : "+s"(g)); return g; }
__device__ __forceinline__ int opaque_tid() { int t = threadIdx.x; asm volatile("" : "+v"(t)); return t; }
#else
static inline int opaque_tid() { return threadIdx.x; }
static inline int obid() { return blockIdx.x; }
static inline int ogrid() { return gridDim.x; }
#endif

#ifndef EMU
__device__ __forceinline__ unsigned pk_fp8x4(float a, float b, float c, float d) { int w = __builtin_amdgcn_cvt_pk_fp8_f32(a, b, 0, false); w = __builtin_amdgcn_cvt_pk_fp8_f32(c, d, w, true); return (unsigned)w; }
__device__ __forceinline__ void unpk_fp8x4(unsigned w, float* f) { typedef float f32x2_ __attribute__((ext_vector_type(2)));
    const f32x2_ lo = __builtin_amdgcn_cvt_pk_f32_fp8((int)w, false), hi = __builtin_amdgcn_cvt_pk_f32_fp8((int)w, true); f[0] = lo.x; f[1] = lo.y; f[2] = hi.x; f[3] = hi.y; }
#endif
#ifndef EMU
__device__ __forceinline__ float swap32_add(float a, float b) { const auto r = __builtin_amdgcn_permlane32_swap(__float_as_uint(a), __float_as_uint(b), false, false); return __uint_as_float(r[0]) + __uint_as_float(r[1]); }
__device__ __forceinline__ float swap16_add(float a, float b) { const auto r = __builtin_amdgcn_permlane16_swap(__float_as_uint(a), __float_as_uint(b), false, false); return __uint_as_float(r[0]) + __uint_as_float(r[1]); }
__device__ __forceinline__ float row_allsum(float x) {
    x += __uint_as_float(__builtin_amdgcn_update_dpp(0, __float_as_uint(x), 0x128, 0xf, 0xf, false)); x += __uint_as_float(__builtin_amdgcn_update_dpp(0, __float_as_uint(x), 0x124, 0xf, 0xf, false));
    x += __uint_as_float(__builtin_amdgcn_update_dpp(0, __float_as_uint(x), 0x122, 0xf, 0xf, false)); x += __uint_as_float(__builtin_amdgcn_update_dpp(0, __float_as_uint(x), 0x121, 0xf, 0xf, false)); return x; }
#define RDLANE(x, k) __uint_as_float(__builtin_amdgcn_readlane(__float_as_uint(x), (k)))
#endif
#ifndef EMU
__device__ __forceinline__ float frcp(float x) { return __builtin_amdgcn_rcpf(x); }
__device__ __forceinline__ float frsq(float x) { return __builtin_amdgcn_rsqf(x); }
#else
static inline float frcp(float x) { return 1.0f / x; }
static inline float frsq(float x) { return 1.0f / sqrtf(x); }
#endif
__device__ __forceinline__ float gelu_fast(float v) {
    const float av = fabsf(v), t = frcp(av * 0.2316418882f + 1.0f);
    float q = t * 0.5307027145f + (-0.7265760135f); q = q * t + 0.7107068705f; q = q * t + (-0.142248368f); q = q * t + 0.127414796f; q = q * t;
    const float m = v * (q * __expf(v * v * -0.5f));
    return v < 0.f ? m : v - m;
}
__device__ __forceinline__ bf16 f2bf(float f) { unsigned u = __float_as_uint(f); u += 0x7FFFu + ((u >> 16) & 1u); return (bf16)(u >> 16); }
__device__ __forceinline__ float bf2f(bf16 b) { return __uint_as_float(((unsigned)b) << 16); }
__device__ __forceinline__ unsigned pk2(float lo, float hi) { return (unsigned)f2bf(lo) | ((unsigned)f2bf(hi) << 16); }

__device__ __forceinline__ void tconv_tile(const float* __restrict__ src, int ldsrc, int k0, int c0, bf16* __restrict__ dst, int ldd, int n0, LAS float* tile) {
    const int t = opaque_tid(), i = t >> 3, jg = (t & 7) * 8;
    const float4 a = *(const float4*)(src + (size_t)(k0 + i) * ldsrc + c0 + jg), b = *(const float4*)(src + (size_t)(k0 + i) * ldsrc + c0 + jg + 4);
    LAS float* r = tile + i * 65 + jg;
    r[0] = a.x; r[1] = a.y; r[2] = a.z; r[3] = a.w; r[4] = b.x; r[5] = b.y; r[6] = b.z; r[7] = b.w;
    __syncthreads();
    const int j = t >> 3, ig = (t & 7) * 8;
    u32x4 w;
    w.x = pk2(tile[(ig + 0) * 65 + j], tile[(ig + 1) * 65 + j]); w.y = pk2(tile[(ig + 2) * 65 + j], tile[(ig + 3) * 65 + j]);
    w.z = pk2(tile[(ig + 4) * 65 + j], tile[(ig + 5) * 65 + j]); w.w = pk2(tile[(ig + 6) * 65 + j], tile[(ig + 7) * 65 + j]);
    *(u32x4*)(dst + (size_t)(n0 + j) * ldd + k0 + ig) = w;
    __syncthreads();
}
__device__ __forceinline__ int zcol_to_src(int zc) { return zc < 2048 ? zc : (zc < 3584 ? zc + 8 : (zc < 4864 ? zc + 24 : zc + 32)); }
__device__ __forceinline__ int scol_to_src(int sc) { return sc < 8 ? 2048 + sc : (sc < 24 ? 3592 + (sc - 8) : 4888 + (sc - 24)); }

__device__ __forceinline__ void convert_f32_bf16(const float* __restrict__ src, bf16* __restrict__ dst, size_t n, int gtid, int gthreads) {
    for (size_t i = (size_t)gtid * 8; i < n; i += (size_t)gthreads * 8) {
        const float4 a = *(const float4*)(src + i), b = *(const float4*)(src + i + 4);
        u32x4 w; w.x = pk2(a.x, a.y); w.y = pk2(a.z, a.w); w.z = pk2(b.x, b.y); w.w = pk2(b.z, b.w);
        *(u32x4*)(dst + i) = w;
    }
}

__device__ __forceinline__ void convert_weights(ArgP Ap, LAS unsigned char* lds, int l, int part, int nparts) {
    LAS float* tile = (LAS float*)lds;
    constexpr int I_WIN = (NZ / 64) * (D / 64), I_WBR = 3 * (D / 64) * (512 / 64), I_WO = (D / 64) * (D / 64), I_WQ = (2048 / 64) * (D / 64), I_L = I_WIN + I_WBR + I_WO + I_WQ;
    unsigned char* wb = A.ws + WS_WB + (size_t)l * WB_BYTES;
    for (int it = part; it < I_L; it += nparts) {
        int r = it;
        if (r < I_WIN) { const int nt = r / (D / 64), kt = r % (D / 64);
            tconv_tile(A.in[8] + (size_t)l * D * INW, INW, kt * 64, zcol_to_src(nt * 64), (bf16*)(wb + WB_WIN), D, nt * 64, tile); continue; }
        r -= I_WIN;
        if (r < I_WBR) { const int n = r / ((D / 64) * 8), rr = r % ((D / 64) * 8), nt = rr / 8, kt = rr % 8;
            tconv_tile(A.in[21] + ((size_t)l * 3 + n) * 512 * D, D, kt * 64, nt * 64, (bf16*)(wb + WB_WBR) + (size_t)n * D * 512, 512, nt * 64, tile); continue; }
        r -= I_WBR;
        if (r < I_WO) { const int nt = r / (D / 64), kt = r % (D / 64);
            tconv_tile(A.in[22] + (size_t)l * D * D, D, kt * 64, nt * 64, (bf16*)(wb + WB_WO), D, nt * 64, tile); continue; }
        r -= I_WO;
        { const int nt = r / (D / 64), kt = r % (D / 64);
            tconv_tile(A.in[25] + (size_t)l * D * 2048, 2048, kt * 64, nt * 64, (bf16*)(wb + WB_WQ), D, nt * 64, tile); }
    }
    const int gtid = part * NTHREADS + opaque_tid(), gthreads = nparts * NTHREADS;
    for (int e = gtid; e < NSM * D; e += gthreads) { const int n = e / D, k = e % D; ((bf16*)(wb + WB_WS))[e] = f2bf(A.in[8][(size_t)l * D * INW + (size_t)k * INW + scol_to_src(n)]); }
    convert_f32_bf16(A.in[26] + (size_t)l * 16 * 128 * 128, (bf16*)(wb + WB_KEYS), 16 * 128 * 128, gtid, gthreads);
}
__device__ __forceinline__ void convert_tables(ArgP Ap, int l, int part, int nparts) {
    const int tx = opaque_tid(), lane = tx & 63, wave = tx >> 6;
    for (int r2 = part * NWAVES + wave; r2 < 2 * NEXP; r2 += nparts * NWAVES) { const int tab = r2 >= NEXP, row = r2 - tab * NEXP;
        const float* src = A.in[27 + tab] + ((size_t)l * NEXP + row) * D + 16 * lane; float v[16]; float mx = 0.f;
#pragma unroll
        for (int q = 0; q < 4; ++q) { const float4 a = *(const float4*)(src + 4 * q); v[4 * q] = a.x; v[4 * q + 1] = a.y; v[4 * q + 2] = a.z; v[4 * q + 3] = a.w; }
#pragma unroll
        for (int i = 0; i < 16; ++i) mx = fmaxf(mx, fabsf(v[i]));
#pragma unroll
        for (int m = 1; m < 64; m <<= 1) mx = fmaxf(mx, __shfl_xor(mx, m));
        const float sc = (mx > 0.f) ? exp2f(floorf(log2f(224.0f / mx))) : 1.0f;
        u32x4 w; w.x = pk_fp8x4(v[0] * sc, v[1] * sc, v[2] * sc, v[3] * sc); w.y = pk_fp8x4(v[4] * sc, v[5] * sc, v[6] * sc, v[7] * sc);
        w.z = pk_fp8x4(v[8] * sc, v[9] * sc, v[10] * sc, v[11] * sc); w.w = pk_fp8x4(v[12] * sc, v[13] * sc, v[14] * sc, v[15] * sc);
        *(u32x4*)(A.ws + (tab ? WS_PV : WS_PU) + (size_t)row * D + 16 * lane) = w;
        if (lane == 0) ((float*)(A.ws + (tab ? WS_PVS : WS_PUS)))[row] = 1.0f / sc; }
}
__device__ __forceinline__ void phase_convert(ArgP Ap, LAS unsigned char* lds) {
    const int G = ogrid(), bid = obid();
    convert_weights(Ap, lds, 0, bid, G);
    const int gtid = bid * NTHREADS + opaque_tid(), gthreads = G * NTHREADS;
    convert_f32_bf16(A.in[0], (bf16*)(A.ws + WS_XB), (size_t)TP * D, gtid, gthreads);
    convert_f32_bf16(A.in[1], (bf16*)(A.ws + WS_XB) + (size_t)TP * D, (size_t)TS * D, gtid, gthreads);
}

#ifndef EMU
struct EpiZ {
    static constexpr bool PERM = true, AFTER_DRAIN = false;
    bf16* ZM; bf16* ZG;
    __device__ __forceinline__ void operator()(const pg8::f32x4 (&acc)[2][2][4][2], const pg8::Unit& u, int wr, int wc, int fr, int fq) const {
        const int row0 = u.pm * 256 + wr * 64 + fr; const bool gate = u.pn >= 19;
        bf16* base = gate ? ZG : ZM; const int ldc = gate ? NZG : NZM; const int col0 = (gate ? (u.pn - 19) : u.pn) * 256 + wc * 32 + 8 * fq;
#pragma unroll
        for (int ai = 0; ai < 2; ++ai)
#pragma unroll
            for (int m = 0; m < 4; ++m) { bf16* rowp = base + (size_t)(row0 + ai * 128 + m * 16) * ldc + col0;
#pragma unroll
                for (int bj = 0; bj < 2; ++bj) { f32x4 v0 = acc[ai][bj][m][0], v1 = acc[ai][bj][m][1];
                    if (gate) {
#pragma unroll
                        for (int j = 0; j < 4; ++j) { v0[j] = __builtin_amdgcn_rcpf(1.0f + __expf(-v0[j])); v1[j] = __builtin_amdgcn_rcpf(1.0f + __expf(-v1[j])); } }
                    u32x4 w; w.x = pg8::cvt_pk_bf16(v0[0], v0[1]); w.y = pg8::cvt_pk_bf16(v0[2], v0[3]); w.z = pg8::cvt_pk_bf16(v1[0], v1[1]); w.w = pg8::cvt_pk_bf16(v1[2], v1[3]);
                    *(u32x4*)(rowp + bj * 128) = w; } }
    }
};

#endif
__device__ __forceinline__ void small_gemm(const bf16* __restrict__ XB, const bf16* __restrict__ WsT, float* __restrict__ ZS) {
    const int tx = opaque_tid(), lane = tx & 63, wave = tx >> 6, gw = obid() * NWAVES + wave, NGW = ogrid() * NWAVES, fr = lane & 15, fq = lane >> 4;
    for (int rg = gw; rg < T / 16; rg += NGW) {
        f32x4 a0 = {0.f, 0.f, 0.f, 0.f}, a1 = {0.f, 0.f, 0.f, 0.f};
        const bf16* ap = XB + (size_t)(rg * 16 + fr) * D + 8 * fq; const bf16* b0p = WsT + (size_t)fr * D + 8 * fq; const bf16* b1p = WsT + (size_t)(16 + fr) * D + 8 * fq;
#pragma unroll 4
        for (int k0 = 0; k0 < D; k0 += 32) {
            const bf16x8 a = *(const bf16x8*)(ap + k0), b0 = *(const bf16x8*)(b0p + k0), b1 = *(const bf16x8*)(b1p + k0);
            a0 = mfma16(a, b0, a0); a1 = mfma16(a, b1, a1);
        }
#pragma unroll
        for (int r = 0; r < 4; ++r) { float* o = ZS + (size_t)(rg * 16 + fq * 4 + r) * NSM + fr; o[0] = a0[r]; o[16] = a1[r]; }
    }
}

#ifndef EMU
__device__ __forceinline__ void phase_gemm1(ArgP Ap, LAS unsigned char* lds, int l) {
    unsigned char* wb = A.ws + WS_WB + (size_t)l * WB_BYTES;
    pg8::Gemm g{(const bf16*)(A.ws + WS_XB), (const bf16*)(wb + WB_WIN), T, NZ, D};
    pg8::StaticOrder S; S.init(T, NZ, ogrid(), obid());
    EpiZ E{(bf16*)(A.ws + WS_ZM), (bf16*)(A.ws + WS_ZG)};
    pg8::gemm_phase<EpiZ, pg8::StaticOrder>(lds, g, S, E);
    small_gemm((const bf16*)(A.ws + WS_XB), (const bf16*)(wb + WB_WS), (float*)(A.ws + WS_ZS));
}
#endif

#ifndef EMU
#define XB_TMO      128
#define XB_XCNT(j)  (256  + 64 * (j))
#define XB_XSUB(j)  (1280 + 64 * (j))
#define XB_XGEN(j)  (2304 + 64 * (j))
#define XB_TOP      3328
#define XB_TOPGEN   3392
#define XCD_BAR_WORDS 3456
#define XB_SPIN_CAP (1u << 18)

__device__ __forceinline__ unsigned xb_ld(unsigned* p)              { return __hip_atomic_load(p, __ATOMIC_RELAXED, __HIP_MEMORY_SCOPE_AGENT); }
__device__ __forceinline__ unsigned xb_add(unsigned* p, unsigned v) { return __hip_atomic_fetch_add(p, v, __ATOMIC_RELAXED, __HIP_MEMORY_SCOPE_AGENT); }
__device__ __forceinline__ unsigned xb_xcc_id() { return (unsigned)__builtin_amdgcn_s_getreg((3 << 11) | 20) & 0xFu; }
#define XB_SPIN(cond, bar) do { unsigned _sp = 0; while (cond) { __builtin_amdgcn_s_sleep(1); \
    if ((++_sp & 255u) == 0u) { if (xb_ld(&(bar)[XB_TMO])) break; if (_sp > XB_SPIN_CAP) { atomicAdd(&(bar)[XB_TMO], 1u); break; } } } } while (0)

struct XcdBarrier {
    unsigned* bar; unsigned x;
    volatile LAS unsigned* st;
};

__device__ __forceinline__ XcdBarrier xcd_barrier_post(unsigned* bar, volatile LAS unsigned* st) {
    XcdBarrier b; b.bar = bar; b.x = xb_xcc_id(); b.st = st;
    if (threadIdx.x == 0) (void)xb_add(&bar[XB_XCNT(b.x)], 1u);
    return b;
}
__device__ __forceinline__ void xcd_barrier_complete(unsigned* bar, unsigned x, unsigned& nloc, unsigned& nx) {
    const unsigned G = gridDim.x * gridDim.y * gridDim.z;
    unsigned sum, cnt, mine, sp = 0u;
    for (;;) {
        sum = 0u; cnt = 0u; mine = 0u;
#pragma unroll
        for (unsigned j = 0; j < 16; ++j) { const unsigned c = xb_ld(&bar[XB_XCNT(j)]); sum += c; cnt += (c > 0u) ? 1u : 0u; mine = (j == x) ? c : mine; }
        if (sum == G) break;
        __builtin_amdgcn_s_sleep(1);
        if ((++sp & 255u) == 0u) { if (xb_ld(&bar[XB_TMO])) break; if (sp > XB_SPIN_CAP) { atomicAdd(&bar[XB_TMO], 1u); break; } }
    }
    nloc = mine > 0u ? mine : 1u; nx = cnt > 0u ? cnt : 1u;
}

__device__ __forceinline__ void xcd_barrier(const XcdBarrier& b) {
    asm volatile("s_waitcnt vmcnt(0)" ::: "memory");
    __syncthreads();
    if (threadIdx.x == 0) {
        unsigned* bar = b.bar;
        __builtin_amdgcn_s_waitcnt(0);
        unsigned nloc = b.st[0], nx = b.st[1];
        if (nloc == 0u) { xcd_barrier_complete(bar, b.x, nloc, nx); b.st[0] = nloc; b.st[1] = nx; }
        const unsigned old = xb_add(&bar[XB_XSUB(b.x)], 1u);
        const unsigned gen = old / nloc;
        if (old + 1u == (gen + 1u) * nloc) {
            __builtin_amdgcn_fence(__ATOMIC_RELEASE, "agent");
            asm volatile("s_waitcnt vmcnt(0)" ::: "memory");
            const unsigned og = xb_add(&bar[XB_TOP], 1u);
            const unsigned tg = og / nx;
            if (og + 1u == (tg + 1u) * nx) xb_add(&bar[XB_TOPGEN], 1u);
            else XB_SPIN(xb_ld(&bar[XB_TOPGEN]) == tg, bar);
            __builtin_amdgcn_fence(__ATOMIC_ACQUIRE, "agent");
            xb_add(&bar[XB_XGEN(b.x)], 1u);
            asm volatile("s_waitcnt vmcnt(0)" ::: "memory");
        } else {
            XB_SPIN(xb_ld(&bar[XB_XGEN(b.x)]) == gen, bar);
            __builtin_amdgcn_fence(__ATOMIC_ACQUIRE, "agent");
            asm volatile("s_waitcnt vmcnt(0)" ::: "memory");
        }
    }
    __syncthreads();
}

#endif

typedef short s16x4 __attribute__((ext_vector_type(4)));
#ifndef EMU
__device__ __forceinline__ s16x4 tr4(const LAS bf16* p) { return __builtin_amdgcn_ds_read_tr16_b64_v4i16((LAS s16x4*)p); }
#endif
#define FROW(M, ld, rc0, k0) (*(const LAS bf16x8*)((M) + ((rc0) + fr) * (ld) + (k0) + 8 * fq))
__device__ __forceinline__ bf16x8 ftr_(int fr, int fq, const LAS bf16* M, int ld, int k0, int rc0) {
    const LAS bf16* p = M + (k0 + 8 * fq + (fr >> 2)) * ld + rc0 + 4 * (fr & 3);
    const s16x4 lo = tr4(p), hi = tr4(p + 4 * ld);
    return (bf16x8){lo[0], lo[1], lo[2], lo[3], hi[0], hi[1], hi[2], hi[3]};
}
#define FTR(M, ld, k0, rc0) ftr_(fr, fq, M, ld, k0, rc0)
#define MMA_RR(acc, Am, lda, r0, Bm, ldb, c0, K) do { _Pragma("unroll") for (int k0_ = 0; k0_ < (K); k0_ += 32) acc = mfma16(FROW(Am, lda, r0, k0_), FROW(Bm, ldb, c0, k0_), acc); } while (0)
#define MMA_RT(acc, Am, lda, r0, Bk, ldb, c0, K) do { _Pragma("unroll") for (int k0_ = 0; k0_ < (K); k0_ += 32) acc = mfma16(FROW(Am, lda, r0, k0_), FTR(Bk, ldb, k0_, c0), acc); } while (0)
#define MMA_TT(acc, Ak, lda, m0, Bk, ldb, c0, K) do { _Pragma("unroll") for (int k0_ = 0; k0_ < (K); k0_ += 32) acc = mfma16(FTR(Ak, lda, k0_, m0), FTR(Bk, ldb, k0_, c0), acc); } while (0)
#define MMA_RC(acc, Am, lda, r0, cfrag, K) do { _Pragma("unroll") for (int k0_ = 0; k0_ < (K); k0_ += 32) acc = mfma16(FROW(Am, lda, r0, k0_), cfrag, acc); } while (0)
#define MMA_CT(acc, cfrag, Bk, ldb, c0, K) do { _Pragma("unroll") for (int k0_ = 0; k0_ < (K); k0_ += 32) acc = mfma16(cfrag, FTR(Bk, ldb, k0_, c0), acc); } while (0)
__device__ __forceinline__ u32x2 pack4(float a, float b, float c, float d) { u32x2 w; w.x = pk2(a, b); w.y = pk2(c, d); return w; }
constexpr float NEG_INF = -__builtin_huge_valf();
#ifndef EMU
#define DPP_F(old, x, ctrl, rmask, bc) __uint_as_float(__builtin_amdgcn_update_dpp(__float_as_uint(old), __float_as_uint(x), ctrl, rmask, 0xf, bc))
__device__ __forceinline__ float scan_sum64(float v, int) {
    v += DPP_F(0.f, v, 0x111, 0xf, true); v += DPP_F(0.f, v, 0x112, 0xf, true); v += DPP_F(0.f, v, 0x114, 0xf, true); v += DPP_F(0.f, v, 0x118, 0xf, true);
    v += DPP_F(0.f, v, 0x142, 0xa, false); v += DPP_F(0.f, v, 0x143, 0xc, false); return v; }
__device__ __forceinline__ float scan_max64(float v, int) {
    v = fmaxf(v, DPP_F(NEG_INF, v, 0x111, 0xf, false)); v = fmaxf(v, DPP_F(NEG_INF, v, 0x112, 0xf, false)); v = fmaxf(v, DPP_F(NEG_INF, v, 0x114, 0xf, false)); v = fmaxf(v, DPP_F(NEG_INF, v, 0x118, 0xf, false));
    v = fmaxf(v, DPP_F(NEG_INF, v, 0x142, 0xa, false)); v = fmaxf(v, DPP_F(NEG_INF, v, 0x143, 0xc, false)); return v; }
__device__ __forceinline__ float lane63(float v) { return __uint_as_float(__builtin_amdgcn_readlane(__float_as_uint(v), 63)); }
#else
static inline float scan_sum64(float v, int lane) { for (int d = 1; d < 64; d <<= 1) { const float t = __shfl_up(v, d); if (lane >= d) v += t; } return v; }
static inline float scan_max64(float v, int lane) { for (int d = 1; d < 64; d <<= 1) { const float t = __shfl_up(v, d); if (lane >= d) v = fmaxf(v, t); } return v; }
static inline float lane63(float v) { return __shfl(v, 63); }
#endif
__device__ __forceinline__ float wave_max64(float v) { return lane63(scan_max64(v, threadIdx.x & 63)); }
__device__ __forceinline__ float logsig(float x) { return fminf(x, 0.f) - __logf(1.0f + __expf(-fabsf(x))); }
__device__ __forceinline__ float softplusf(float x) { return fmaxf(x, 0.f) + __logf(1.0f + __expf(-fabsf(x))); }
__device__ __forceinline__ float sigmoidf(float x) { return frcp(1.0f + __expf(-x)); }
__device__ __forceinline__ float siluf(float x) { return x * frcp(1.0f + __expf(-x)); }
constexpr float EPS_ = 1e-5f;
__device__ __forceinline__ void unpack8(const u32x4 w, float (&f)[8]) {
    f[0] = __uint_as_float(w.x << 16); f[1] = __uint_as_float(w.x & 0xffff0000u); f[2] = __uint_as_float(w.y << 16); f[3] = __uint_as_float(w.y & 0xffff0000u);
    f[4] = __uint_as_float(w.z << 16); f[5] = __uint_as_float(w.z & 0xffff0000u); f[6] = __uint_as_float(w.w << 16); f[7] = __uint_as_float(w.w & 0xffff0000u);
}
__device__ __forceinline__ u32x4 pack8(const float (&f)[8]) { u32x4 w; w.x = pk2(f[0], f[1]); w.y = pk2(f[2], f[3]); w.z = pk2(f[4], f[5]); w.w = pk2(f[6], f[7]); return w; }

__device__ __forceinline__ void mlstm_item(ArgP Ap, LAS unsigned char* lds, int l, int b, int h, bool sample) {
    int tid_o = threadIdx.x; OPQV(tid_o);
    const int tid = tid_o, lane = tid & 63, wave = tid >> 6, fr = lane & 15, fq = lane >> 4;
    LAS bf16* Qs = (LAS bf16*)(lds); LAS bf16* Ks = (LAS bf16*)(lds + 17408); LAS bf16* Kw = (LAS bf16*)(lds + 34816); LAS bf16* Vs = (LAS bf16*)(lds + 52224);
    LAS bf16* Ss = (LAS bf16*)(lds + 69632); LAS bf16* CbT = (LAS bf16*)(lds + 78848); LAS float* Hs = (LAS float*)(lds + 120320); LAS float* MN = (LAS float*)(lds + 117760); LAS float* gb = (LAS float*)(lds + 118272);
    LAS float* b_ = gb; LAS float* mt_ = gb + 64; LAS float* u_ = gb + 128; LAS float* ein_ = gb + 192; LAS float* wg_ = gb + 256; LAS float* den_ = gb + 320; LAS float* sc_ = gb + 384;
    const int L = sample ? LS : LP, tok0 = sample ? TP + b * LS : b * LP, NB = sample ? BS : BP;
    const bf16* ZM = (const bf16*)(A.ws + WS_ZM); const float* ZS = (const float*)(A.ws + WS_ZS); bf16* BR0 = (bf16*)(A.ws + WS_BR);
    const float ib = A.in[9][l * 4 + h], fb = A.in[10][l * 4 + h];
    f32x4 accC[9];
#pragma unroll
    for (int vi = 0; vi < 9; ++vi) accC[vi] = (f32x4){0.f, 0.f, 0.f, 0.f};
    float m_run = 0.f;
    if (sample) {
        const float* C0 = A.in[2] + ((size_t)(l * BS + b) * 4 + h) * 16384; const float* n0 = A.in[3] + ((size_t)(l * BS + b) * 4 + h) * 128;
        const float* cp = C0 + (4 * fq) * 128 + 16 * wave + fr;
#pragma unroll
        for (int vi = 0; vi < 8; ++vi) {
#pragma unroll
            for (int r = 0; r < 4; ++r) accC[vi][r] = cp[r * 128];
            cp += 2048; OPQV(cp); }
        if (fq == 0) accC[8][0] = n0[16 * wave + fr];
        m_run = A.in[4][(l * BS + b) * 4 + h];
    }
#pragma unroll
    for (int vi = 0; vi < 9; ++vi) *(LAS u32x2*)(CbT + (16 * wave + fr) * 152 + 16 * vi + 4 * fq) = pack4(accC[vi][0], accC[vi][1], accC[vi][2], accC[vi][3]);
    if (tid < 128) MN[tid] = A.in[11][l * 512 + h * 128 + tid];
    u32x4 pq[2], pk[2], pv[2], pm[2]; float pli = NEG_INF, plf = 0.f;
#define MLSTM_PREFETCH_MO(T0N) do { const int nvn_ = (L - (T0N)) < 64 ? (L - (T0N)) : 64; const int t = tid >> 3, part = tid & 7; pm[0] = (u32x4){0u, 0u, 0u, 0u}; pm[1] = pm[0]; \
        if (t < nvn_) { const bf16* mo = ZM + (size_t)(tok0 + (T0N) + t) * NZM + 1536 + h * 128 + 16 * part; pm[0] = *(const u32x4*)mo; pm[1] = *(const u32x4*)(mo + 8); } } while (0)
#define MLSTM_PREFETCH(T0N) do { const int nvn_ = (L - (T0N)) < 64 ? (L - (T0N)) : 64; \
        _Pragma("unroll") for (int i = 0; i < 2; ++i) { const int c = tid + 512 * i, t = c >> 4, cc = (c & 15) * 8; pq[i] = (u32x4){0u, 0u, 0u, 0u}; pk[i] = pq[i]; pv[i] = pq[i]; \
            if (t < nvn_) { const bf16* zp = ZM + (size_t)(tok0 + (T0N) + t) * NZM + h * 128 + cc; pq[i] = *(const u32x4*)zp; pk[i] = *(const u32x4*)(zp + 512); pv[i] = *(const u32x4*)(zp + 1024); } } \
        if (wave == 0) { pli = NEG_INF; plf = 0.f; if (lane < nvn_) { const size_t tok = tok0 + (T0N) + lane; pli = ZS[tok * NSM + h]; plf = ZS[tok * NSM + 4 + h]; } } } while (0)
    MLSTM_PREFETCH(0); MLSTM_PREFETCH_MO(0);
    __syncthreads();
    STG_INIT();
    for (int t0 = 0; t0 < L; t0 += 64) {
        const int nv = (L - t0) < 64 ? (L - t0) : 64, nrt = (nv + 15) >> 4;
        if (wave == 0) {
            const float li = (lane < nv) ? pli + ib : NEG_INF, lf = (lane < nv) ? logsig(plf + fb) : 0.f;
            const float bb = scan_sum64(lf, lane), a = bb + m_run, u = li - bb, M = scan_max64(u, lane), mt = fmaxf(a, bb + M);
            const float blast = lane63(bb), g = blast + u, gmax = wave_max64(g), mnew = fmaxf(blast + m_run, gmax);
            b_[lane] = bb; mt_[lane] = mt; u_[lane] = u; ein_[lane] = __expf(a - mt); wg_[lane] = __expf(g - mnew);
            if (lane == 0) sc_[1] = __expf(blast + m_run - mnew);
            m_run = mnew;
        }
        LDS_BARRIER(); STG(0);
#pragma unroll
        for (int i = 0; i < 2; ++i) { const int c = tid + 512 * i, t = c >> 4, cc = (c & 15) * 8;
            *(LAS u32x4*)(Qs + t * 136 + cc) = pq[i]; *(LAS u32x4*)(Ks + t * 136 + cc) = pk[i]; *(LAS u32x4*)(Vs + t * 136 + cc) = pv[i];
            float f[8]; unpack8(pk[i], f); const float g = wg_[t];
#pragma unroll
            for (int j = 0; j < 8; ++j) f[j] *= g;
            *(LAS u32x4*)(Kw + t * 136 + cc) = pack8(f); }
        MLSTM_PREFETCH(t0 + 64);
        LDS_BARRIER(); STG(1);
#pragma unroll
        for (int j = 0; j < 2; ++j) { const int idx = wave + 8 * j, ti = idx >> 2, si = idx & 3;
            f32x4 acc = {0.f, 0.f, 0.f, 0.f};
            if (ti >= nrt) continue;
            if (si <= ti) MMA_RR(acc, Ks, 136, 16 * si, Qs, 136, 16 * ti, 128);
            const int t = 16 * ti + fr; const float bt = b_[t] - mt_[t]; float v[4];
#pragma unroll
            for (int r = 0; r < 4; ++r) { const int s = 16 * si + 4 * fq + r; v[r] = (s <= t) ? acc[r] * __expf(bt + u_[s]) : 0.f; }
            *(LAS u32x2*)(Ss + t * 72 + 16 * si + 4 * fq) = pack4(v[0], v[1], v[2], v[3]); }
        LDS_BARRIER(); STG(2);
        if (wave < nrt) { const int ti = wave; f32x4 acc = {0.f, 0.f, 0.f, 0.f};
            MMA_RT(acc, Qs, 136, 16 * ti, CbT, 152, 128, 128);
#pragma unroll
            for (int r = 0; r < 4; ++r) acc[r] *= ein_[16 * ti + 4 * fq + r];
            { int fr_ = fr; OPQV(fr_); const short o1 = (fr_ == 0) ? (short)0x3F80 : (short)0; const bf16x8 ones = {o1, o1, o1, o1, o1, o1, o1, o1};
              MMA_RC(acc, Ss, 72, 16 * ti, ones, 64); }
            if (fr == 0) {
#pragma unroll
                for (int r = 0; r < 4; ++r) { const int t = 16 * ti + 4 * fq + r; den_[t] = 0.08838834764831845f * frcp(fmaxf(fabsf(acc[r] * 0.08838834764831845f), __expf(-mt_[t]))); } } }
        LDS_BARRIER(); STG(3);
        { bf16x8 bC[4], bV[2];
#pragma unroll
          for (int kk = 0; kk < 4; ++kk) bC[kk] = FTR(CbT, 152, 32 * kk, 16 * wave);
#pragma unroll
          for (int kk = 0; kk < 2; ++kk) bV[kk] = FTR(Vs, 136, 32 * kk, 16 * wave);
#pragma unroll
          for (int ti = 0; ti < 4; ++ti) { if (ti >= nrt) continue; f32x4 accn = {0.f, 0.f, 0.f, 0.f};
#pragma unroll
            for (int kk = 0; kk < 4; ++kk) accn = mfma16(FROW(Qs, 136, 16 * ti, 32 * kk), bC[kk], accn);
#pragma unroll
            for (int r = 0; r < 4; ++r) accn[r] *= ein_[16 * ti + 4 * fq + r];
#pragma unroll
            for (int kk = 0; kk < 2; ++kk) accn = mfma16(FROW(Ss, 72, 16 * ti, 32 * kk), bV[kk], accn);
#pragma unroll
            for (int r = 0; r < 4; ++r) { const int t = 16 * ti + 4 * fq + r; Hs[t * 132 + 16 * wave + fr] = accn[r] * den_[t]; } } }
        LDS_BARRIER(); STG(4);
        { const int t = tid >> 3, part = tid & 7; float x[16]; float s1 = 0.f;
#pragma unroll
            for (int i = 0; i < 16; ++i) { x[i] = Hs[t * 132 + 16 * part + i]; s1 += x[i]; }
            s1 += __shfl_xor(s1, 1); s1 += __shfl_xor(s1, 2); s1 += __shfl_xor(s1, 4);
            const float mu = s1 * (1.0f / 128.0f); float s2 = 0.f;
#pragma unroll
            for (int i = 0; i < 16; ++i) { x[i] -= mu; s2 += x[i] * x[i]; }
            s2 += __shfl_xor(s2, 1); s2 += __shfl_xor(s2, 2); s2 += __shfl_xor(s2, 4);
            const float rstd = frsq(s2 * (1.0f / 128.0f) + EPS_);
            if (t < nv) { const size_t tok = tok0 + t0 + t;
                float o0[8], o1[8]; unpack8(pm[0], o0); unpack8(pm[1], o1); float y0[8], y1[8];
#pragma unroll
                for (int i = 0; i < 8; ++i) { y0[i] = x[i] * rstd * MN[16 * part + i] * sigmoidf(o0[i]); y1[i] = x[8 + i] * rstd * MN[16 * part + 8 + i] * sigmoidf(o1[i]); }
                bf16* o = BR0 + tok * 512 + h * 128 + 16 * part; *(u32x4*)o = pack8(y0); *(u32x4*)(o + 8) = pack8(y1); } }
        MLSTM_PREFETCH_MO(t0 + 64);
        { const float ec = sc_[1]; bf16x8 bK[2];
#pragma unroll
            for (int kk = 0; kk < 2; ++kk) bK[kk] = FTR(Kw, 136, 32 * kk, 16 * wave);
#pragma unroll
            for (int vi = 0; vi < 9; ++vi) {
#pragma unroll
                for (int r = 0; r < 4; ++r) accC[vi][r] *= ec;
                if (vi < 8) {
#pragma unroll
                    for (int kk = 0; kk < 2; ++kk) accC[vi] = mfma16(FTR(Vs, 136, 32 * kk, 16 * vi), bK[kk], accC[vi]); }
                else { int fr_ = fr; OPQV(fr_); const short o1 = (fr_ == 0) ? (short)0x3F80 : (short)0; const bf16x8 ones = {o1, o1, o1, o1, o1, o1, o1, o1};
#pragma unroll
                    for (int kk = 0; kk < 2; ++kk) accC[vi] = mfma16(ones, bK[kk], accC[vi]); }
                *(LAS u32x2*)(CbT + (16 * wave + fr) * 152 + 16 * vi + 4 * fq) = pack4(accC[vi][0], accC[vi][1], accC[vi][2], accC[vi][3]); } }
        LDS_BARRIER(); STG(5);
    }
#undef MLSTM_PREFETCH
#undef MLSTM_PREFETCH_MO
    float* Co = A.out + (sample ? O_SC : O_PC) + ((size_t)(l * NB + b) * 4 + h) * 16384; float* no = A.out + (sample ? O_SN : O_PN) + ((size_t)(l * NB + b) * 4 + h) * 128;
    { int fq_ = fq, cw_ = 16 * wave + fr; OPQV(fq_); OPQV(cw_);
      float* cp = Co + (4 * fq_) * 128 + cw_;
#pragma unroll
      for (int vi = 0; vi < 8; ++vi) {
#pragma unroll
        for (int r = 0; r < 4; ++r) cp[r * 128] = accC[vi][r];
        cp += 2048; OPQV(cp); }
      if (fq_ == 0) no[cw_] = accC[8][0]; }
    STG_TOTAL(); STG_FINI(h == 0 ? 0 : -1);
    if (tid == 0) A.out[(sample ? O_SM : O_PM) + (size_t)(l * NB + b) * 4 + h] = m_run;
    __syncthreads();
}

__device__ __forceinline__ void gla_item(ArgP Ap, LAS unsigned char* lds, int l, int b, int h, bool sample) {
    int tid_o = threadIdx.x; OPQV(tid_o);
    const int tid = tid_o, lane = tid & 63, wave = tid >> 6, fr = lane & 15, fq = lane >> 4;
    LAS bf16* QE = (LAS bf16*)(lds); LAS bf16* KE = (LAS bf16*)(lds + 9216); LAS bf16* KLs = (LAS bf16*)(lds + 18432); LAS bf16* Vs = (LAS bf16*)(lds + 27648);
    LAS bf16* ATT = (LAS bf16*)(lds + 45056); LAS bf16* STbT = (LAS bf16*)(lds + 54272); LAS float* Os = (LAS float*)(lds + 71680); LAS float* LAM = (LAS float*)(lds + 105472);
    LAS float* GA = (LAS float*)(lds + 122112); LAS float* GUP = (LAS float*)(lds + 126208); LAS float* GBI = (LAS float*)(lds + 130304); LAS float* GN = (LAS float*)(lds + 130560);
    const int L = sample ? LS : LP, tok0 = sample ? TP + b * LS : b * LP, NB = sample ? BS : BP;
    const bf16* ZM = (const bf16*)(A.ws + WS_ZM); const float* ZS = (const float*)(A.ws + WS_ZS); bf16* BR1 = (bf16*)(A.ws + WS_BR) + (size_t)T * 512;
    f32x4 accS[4];
#pragma unroll
    for (int ki = 0; ki < 4; ++ki) accS[ki] = (f32x4){0.f, 0.f, 0.f, 0.f};
    if (sample) { const float* S0 = A.in[5] + ((size_t)(l * BS + b) * 4 + h) * 8192;
        const float* sp = S0 + fr * 128 + 16 * wave + 4 * fq;
#pragma unroll
        for (int ki = 0; ki < 4; ++ki) {
#pragma unroll
            for (int r = 0; r < 4; ++r) accS[ki][r] = sp[r];
            sp += 2048; OPQV(sp); } }
#pragma unroll
    for (int ki = 0; ki < 4; ++ki) *(LAS u32x2*)(STbT + (16 * ki + fr) * 136 + 16 * wave + 4 * fq) = pack4(accS[ki][0], accS[ki][1], accS[ki][2], accS[ki][3]);
    float gup[16];
#pragma unroll
    for (int r = 0; r < 16; ++r) gup[r] = A.in[12][(size_t)l * 16 * 256 + r * 256 + h * 64 + (tid & 63)];
    const float gbi = A.in[13][l * 256 + h * 64 + (tid & 63)];
    if (tid < 128) GN[tid] = A.in[14][l * 512 + h * 128 + tid];
    u32x4 pq, pk, pv[2], pg[2], pgn[2]; float pga[2];
#define GLA_PREFETCH(T0N) do { const int nvn_ = (L - (T0N)) < 64 ? (L - (T0N)) : 64; \
        { const int t = tid >> 3, cc = (tid & 7) * 8; pq = (u32x4){0u, 0u, 0u, 0u}; pk = pq; pgn[0] = pq; pgn[1] = pq; \
            if (t < nvn_) { const bf16* zr = ZM + (size_t)(tok0 + (T0N) + t) * NZM + 2048 + h * 64 + cc; pq = *(const u32x4*)zr; pk = *(const u32x4*)(zr + 256); \
                const bf16* gr = ZM + (size_t)(tok0 + (T0N) + t) * NZM + 3072 + h * 128 + 16 * (tid & 7); pgn[0] = *(const u32x4*)gr; pgn[1] = *(const u32x4*)(gr + 8); } } \
        _Pragma("unroll") for (int i = 0; i < 2; ++i) { const int c = tid + 512 * i, t = c >> 4, cc = (c & 15) * 8; pv[i] = (u32x4){0u, 0u, 0u, 0u}; \
            if (t < nvn_) pv[i] = *(const u32x4*)(ZM + (size_t)(tok0 + (T0N) + t) * NZM + 2560 + h * 128 + cc); \
            const int e = tid + 512 * i, te = e >> 4; pga[i] = (te < nvn_) ? ZS[(size_t)(tok0 + (T0N) + te) * NSM + 8 + (e & 15)] : 0.f; } } while (0)
    GLA_PREFETCH(0);
    __syncthreads();
    STG_INIT();
    for (int t0 = 0; t0 < L; t0 += 64) {
        const int nv = (L - t0) < 64 ? (L - t0) : 64, nrt = (nv + 15) >> 4;
        pg[0] = pgn[0]; pg[1] = pgn[1];
        GA[tid] = pga[0]; GA[tid + 512] = pga[1];
        LDS_BARRIER(); STG(0);
#pragma unroll
        for (int i = 0; i < 8; ++i) { const int t = (tid >> 6) + 8 * i, k = tid & 63; float x = gbi;
#pragma unroll
            for (int q = 0; q < 4; ++q) { const f32x4 ga = *(const LAS f32x4*)(GA + t * 16 + 4 * q); x += ga[0] * gup[4 * q] + ga[1] * gup[4 * q + 1] + ga[2] * gup[4 * q + 2] + ga[3] * gup[4 * q + 3]; }
            LAM[t * 65 + k] = (t < nv) ? logsig(x) * (1.0f / 16.0f) : 0.f; }
        LDS_BARRIER(); STG(1);
#pragma unroll
        for (int c = 0; c < 8; ++c) { const int k = 8 * wave + c; const float v = scan_sum64(LAM[lane * 65 + k], lane); LAM[lane * 65 + k] = v; }
        LDS_BARRIER(); STG(2);
        { const int t = tid >> 3, cc = (tid & 7) * 8; float q[8], k[8], qe[8], ke[8], kl[8]; unpack8(pq, q); unpack8(pk, k);
#pragma unroll
            for (int i = 0; i < 8; ++i) { const float lm = LAM[t * 65 + cc + i], ll = LAM[63 * 65 + cc + i]; qe[i] = q[i] * __expf(lm); ke[i] = k[i] * __expf(-lm); kl[i] = k[i] * __expf(ll - lm); }
            *(LAS u32x4*)(QE + t * 72 + cc) = pack8(qe); *(LAS u32x4*)(KE + t * 72 + cc) = pack8(ke); *(LAS u32x4*)(KLs + t * 72 + cc) = pack8(kl); }
#pragma unroll
        for (int i = 0; i < 2; ++i) { const int c = tid + 512 * i, t = c >> 4, cc = (c & 15) * 8; *(LAS u32x4*)(Vs + t * 136 + cc) = pv[i]; }
        GLA_PREFETCH(t0 + 64);
        LDS_BARRIER(); STG(3);
#pragma unroll
        for (int j = 0; j < 2; ++j) { const int idx = wave + 8 * j, ti = idx >> 2, si = idx & 3; f32x4 acc = {0.f, 0.f, 0.f, 0.f};
            if (ti >= nrt) continue;
            if (si <= ti) MMA_RR(acc, KE, 72, 16 * si, QE, 72, 16 * ti, 64);
            const int t = 16 * ti + fr; float v[4];
#pragma unroll
            for (int r = 0; r < 4; ++r) { const int s = 16 * si + 4 * fq + r; v[r] = (s <= t) ? acc[r] : 0.f; }
            *(LAS u32x2*)(ATT + t * 72 + 16 * si + 4 * fq) = pack4(v[0], v[1], v[2], v[3]); }
        LDS_BARRIER(); STG(4);
        { bf16x8 bS[2], bV[2];
#pragma unroll
          for (int kk = 0; kk < 2; ++kk) { bS[kk] = FTR(STbT, 136, 32 * kk, 16 * wave); bV[kk] = FTR(Vs, 136, 32 * kk, 16 * wave); }
#pragma unroll
          for (int ti = 0; ti < 4; ++ti) { if (ti >= nrt) continue; f32x4 acc = {0.f, 0.f, 0.f, 0.f};
#pragma unroll
            for (int kk = 0; kk < 2; ++kk) acc = mfma16(FROW(QE, 72, 16 * ti, 32 * kk), bS[kk], acc);
#pragma unroll
            for (int kk = 0; kk < 2; ++kk) acc = mfma16(FROW(ATT, 72, 16 * ti, 32 * kk), bV[kk], acc);
#pragma unroll
            for (int r = 0; r < 4; ++r) Os[(16 * ti + 4 * fq + r) * 132 + 16 * wave + fr] = acc[r] * 0.125f; } }
        LDS_BARRIER(); STG(5);
        { const int t = tid >> 3, part = tid & 7; float x[16]; float s2 = 0.f;
#pragma unroll
            for (int i = 0; i < 16; ++i) { x[i] = Os[t * 132 + 16 * part + i]; s2 += x[i] * x[i]; }
            s2 += __shfl_xor(s2, 1); s2 += __shfl_xor(s2, 2); s2 += __shfl_xor(s2, 4);
            const float rstd = frsq(s2 * (1.0f / 128.0f) + EPS_);
            if (t < nv) { const size_t tok = tok0 + t0 + t;
                float g0[8], g1[8]; unpack8(pg[0], g0); unpack8(pg[1], g1); float y0[8], y1[8];
#pragma unroll
                for (int i = 0; i < 8; ++i) { y0[i] = x[i] * rstd * GN[16 * part + i] * siluf(g0[i]); y1[i] = x[8 + i] * rstd * GN[16 * part + 8 + i] * siluf(g1[i]); }
                bf16* o = BR1 + tok * 512 + h * 128 + 16 * part; *(u32x4*)o = pack8(y0); *(u32x4*)(o + 8) = pack8(y1); } }
        { bf16x8 aV[2];
#pragma unroll
          for (int kk = 0; kk < 2; ++kk) aV[kk] = FTR(Vs, 136, 32 * kk, 16 * wave);
#pragma unroll
          for (int ki = 0; ki < 4; ++ki) { const float dec = __expf(LAM[63 * 65 + 16 * ki + fr]);
#pragma unroll
            for (int r = 0; r < 4; ++r) accS[ki][r] *= dec;
#pragma unroll
            for (int kk = 0; kk < 2; ++kk) accS[ki] = mfma16(aV[kk], FTR(KLs, 72, 32 * kk, 16 * ki), accS[ki]);
            *(LAS u32x2*)(STbT + (16 * ki + fr) * 136 + 16 * wave + 4 * fq) = pack4(accS[ki][0], accS[ki][1], accS[ki][2], accS[ki][3]); } }
        LDS_BARRIER(); STG(6);
    }
#undef GLA_PREFETCH
    STG_TOTAL(); STG_FINI(h == 0 ? 1 : -1);
    float* So = A.out + (sample ? O_SG : O_PG) + ((size_t)(l * NB + b) * 4 + h) * 8192;
    { int o_ = fr * 128 + 16 * wave + 4 * fq; OPQV(o_); float* sp = So + o_;
#pragma unroll
      for (int ki = 0; ki < 4; ++ki) {
#pragma unroll
        for (int r = 0; r < 4; ++r) sp[r] = accS[ki][r];
        sp += 2048; OPQV(sp); } }
    __syncthreads();
}

__device__ __forceinline__ int ssd_chmap(int hd, int c) { const int g = hd >> 2; return c < 64 ? hd * 64 + c : (c < 128 ? 512 + g * 64 + (c - 64) : 640 + g * 64 + (c - 128)); }
__device__ __forceinline__ void ssd_item(ArgP Ap, LAS unsigned char* lds, int l, int b, int hd, bool sample) {
    int tid_o = threadIdx.x; OPQV(tid_o);
    const int tid = tid_o, lane = tid & 63, wave = tid >> 6, fr = lane & 15, fq = lane >> 4;
    LAS bf16* RAW = (LAS bf16*)(lds); LAS bf16* Ys = (LAS bf16*)(lds); LAS bf16* W = (LAS bf16*)(lds + 9216); LAS bf16* Bw = (LAS bf16*)(lds + 18432);
    LAS bf16* Xs = (LAS bf16*)(lds + 27648); LAS bf16* Cs = (LAS bf16*)(lds + 36864); LAS bf16* Bs = (LAS bf16*)(lds + 46080); LAS bf16* HbT = (LAS bf16*)(lds + 55296);
    LAS bf16* HIST = (LAS bf16*)(lds + 64512); LAS float* DT = (LAS float*)(lds + 65792); LAS float* LM = (LAS float*)(lds + 66048);
    LAS float* CW = (LAS float*)(lds + 66304); LAS float* CBI = CW + 4 * 192;
    const int L = sample ? LS : LP, tok0 = sample ? TP + b * LS : b * LP, NB = sample ? BS : BP;
    const bf16* ZM = (const bf16*)(A.ws + WS_ZM); const float* ZS = (const float*)(A.ws + WS_ZS); bf16* BR2 = (bf16*)(A.ws + WS_BR) + (size_t)T * 1024;
    const float Dh = A.in[19][l * 8 + hd], dtb = A.in[17][l * 8 + hd], Ah = -__expf(A.in[18][l * 8 + hd]);
    f32x4 accH[2];
#pragma unroll
    for (int j = 0; j < 2; ++j) { const int idx = wave + 8 * j, pi = idx >> 2, ni = idx & 3; accH[j] = (f32x4){0.f, 0.f, 0.f, 0.f};
        if (sample) { const float* h0 = A.in[6] + ((size_t)(l * BS + b) * 8 + hd) * 4096;
            const float* hp = h0 + (16 * pi + 4 * fq) * 64 + 16 * ni + fr; OPQV(hp);
#pragma unroll
            for (int r = 0; r < 4; ++r) accH[j][r] = hp[r * 64]; }
        *(LAS u32x2*)(HbT + (16 * ni + fr) * 72 + 16 * pi + 4 * fq) = pack4(accH[j][0], accH[j][1], accH[j][2], accH[j][3]); }
    for (int e = tid; e < 5 * 192; e += NTHREADS) { const int j = e / 192, c = e % 192, ch = ssd_chmap(hd, c); CW[e] = (j < 4) ? A.in[15][(size_t)l * 4 * 768 + j * 768 + ch] : A.in[16][l * 768 + ch]; }
    for (int e = tid; e < 3 * 200; e += NTHREADS) { const int r = e / 200, c = e % 200; float v = 0.f;
        if (sample && c < 192) v = A.in[7][((size_t)(l * BS + b) * 3 + r) * 768 + ssd_chmap(hd, c)];
        HIST[e] = f2bf(v); }
    u32x4 pr[3], ps; float pdt = 0.f;
#define SSD_PREFETCH(T0N) do { const int nvn_ = (L - (T0N)) < 64 ? (L - (T0N)) : 64; \
        _Pragma("unroll") for (int i = 0; i < 3; ++i) { const int c = tid + 512 * i, t = c / 24, q = c % 24; pr[i] = (u32x4){0u, 0u, 0u, 0u}; \
            if (t < nvn_) pr[i] = *(const u32x4*)(ZM + (size_t)(tok0 + (T0N) + t) * NZM + 4096 + ssd_chmap(hd, 8 * q)); } \
        if (wave == 0) { pdt = 0.f; if (lane < nvn_) pdt = ZS[(size_t)(tok0 + (T0N) + lane) * NSM + 24 + hd]; } } while (0)
#define SSD_PREFETCH_Z(T0N) do { const int nvn_ = (L - (T0N)) < 64 ? (L - (T0N)) : 64; const int t = tid >> 3, part = tid & 7; ps = (u32x4){0u, 0u, 0u, 0u}; \
        if (t < nvn_) ps = *(const u32x4*)(ZM + (size_t)(tok0 + (T0N) + t) * NZM + 3584 + hd * 64 + 8 * part); } while (0)
    SSD_PREFETCH(0); SSD_PREFETCH_Z(0);
    __syncthreads();
    STG_INIT();
    for (int t0 = 0; t0 < L; t0 += 64) {
        const int nv = (L - t0) < 64 ? (L - t0) : 64, nrt = (nv + 15) >> 4;
#pragma unroll
        for (int i = 0; i < 3; ++i) { const int c = tid + 512 * i, t = c / 24, q = c % 24; *(LAS u32x4*)(RAW + (3 + t) * 200 + 8 * q) = pr[i]; }
        if (tid < 3 * 25) { const int r = tid / 25, q = tid % 25; *(LAS u32x4*)(RAW + r * 200 + 8 * q) = *(const LAS u32x4*)(HIST + r * 200 + 8 * q); }
        if (wave == 0) { const float dtv = (lane < nv) ? softplusf(pdt + dtb) : 0.f; const float lam = scan_sum64(dtv * Ah, lane); DT[lane] = dtv; LM[lane] = lam; }
        SSD_PREFETCH(t0 + 64);
        LDS_BARRIER(); STG(0);
#pragma unroll
        for (int i = 0; i < 3; ++i) { const int c = tid + 512 * i, t = c / 24, q = c % 24; float o[8];
            { const f32x4 b0 = *(const LAS f32x4*)(CBI + 8 * q), b1 = *(const LAS f32x4*)(CBI + 8 * q + 4); o[0] = b0[0]; o[1] = b0[1]; o[2] = b0[2]; o[3] = b0[3]; o[4] = b1[0]; o[5] = b1[1]; o[6] = b1[2]; o[7] = b1[3]; }
#pragma unroll
            for (int j = 0; j < 4; ++j) { float x[8]; unpack8(*(const LAS u32x4*)(RAW + (t + j) * 200 + 8 * q), x);
                const f32x4 w0 = *(const LAS f32x4*)(CW + j * 192 + 8 * q), w1 = *(const LAS f32x4*)(CW + j * 192 + 8 * q + 4);
                o[0] += w0[0] * x[0]; o[1] += w0[1] * x[1]; o[2] += w0[2] * x[2]; o[3] += w0[3] * x[3]; o[4] += w1[0] * x[4]; o[5] += w1[1] * x[5]; o[6] += w1[2] * x[6]; o[7] += w1[3] * x[7]; }
#pragma unroll
            for (int e = 0; e < 8; ++e) o[e] = (t < nv) ? siluf(o[e]) : 0.f;
            LAS bf16* dst = (q < 8) ? Xs + t * 72 + q * 8 : (q < 16 ? Bs + t * 72 + (q - 8) * 8 : Cs + t * 72 + (q - 16) * 8);
            *(LAS u32x4*)dst = pack8(o); }
        LDS_BARRIER(); STG(1);
        if (tid < 3 * 25) { const int r = tid / 25, q = tid % 25; *(LAS u32x4*)(HIST + r * 200 + 8 * q) = *(const LAS u32x4*)(RAW + (nv + r) * 200 + 8 * q); }
        f32x4 cbT[2];
#pragma unroll
        for (int j = 0; j < 2; ++j) { const int idx = wave + 8 * j, ti = idx >> 2, si = idx & 3; cbT[j] = (f32x4){0.f, 0.f, 0.f, 0.f};
            if (si <= ti && ti < nrt) MMA_RR(cbT[j], Bs, 72, 16 * si, Cs, 72, 16 * ti, 64); }
        LDS_BARRIER(); STG(2);
#pragma unroll
        for (int j = 0; j < 2; ++j) { const int idx = wave + 8 * j, ti = idx >> 2, si = idx & 3; const int t = 16 * ti + fr; const float lt = LM[t]; float v[4];
#pragma unroll
            for (int r = 0; r < 4; ++r) { const int s = 16 * si + 4 * fq + r; v[r] = (s <= t) ? cbT[j][r] * __expf(lt - LM[s]) * DT[s] : 0.f; }
            *(LAS u32x2*)(W + t * 72 + 16 * si + 4 * fq) = pack4(v[0], v[1], v[2], v[3]); }
        { const int s = tid >> 3, n0 = (tid & 7) * 8; float v[8]; unpack8(*(const LAS u32x4*)(Bs + s * 72 + n0), v); const float ws = __expf(LM[63] - LM[s]) * DT[s];
#pragma unroll
            for (int i = 0; i < 8; ++i) v[i] *= ws;
            *(LAS u32x4*)(Bw + s * 72 + n0) = pack8(v); }
        LDS_BARRIER(); STG(3);
        { const int pi = wave & 3; bf16x8 bH[2], bX[2];
#pragma unroll
          for (int kk = 0; kk < 2; ++kk) { bH[kk] = FTR(HbT, 72, 32 * kk, 16 * pi); bX[kk] = FTR(Xs, 72, 32 * kk, 16 * pi); }
#pragma unroll
          for (int j = 0; j < 2; ++j) { const int ti = (wave >> 2) + 2 * j; if (ti >= nrt) continue; f32x4 acc = {0.f, 0.f, 0.f, 0.f};
#pragma unroll
            for (int kk = 0; kk < 2; ++kk) acc = mfma16(FROW(Cs, 72, 16 * ti, 32 * kk), bH[kk], acc);
#pragma unroll
            for (int r = 0; r < 4; ++r) acc[r] *= __expf(LM[16 * ti + 4 * fq + r]);
#pragma unroll
            for (int kk = 0; kk < 2; ++kk) acc = mfma16(FROW(W, 72, 16 * ti, 32 * kk), bX[kk], acc);
#pragma unroll
            for (int r = 0; r < 4; ++r) { const int t = 16 * ti + 4 * fq + r, p = 16 * pi + fr; Ys[t * 72 + p] = f2bf(acc[r] + Dh * bf2f(Xs[t * 72 + p])); } } }
        { const float dec = __expf(LM[63]); const int ni = wave & 3; bf16x8 bB[2];
#pragma unroll
          for (int kk = 0; kk < 2; ++kk) bB[kk] = FTR(Bw, 72, 32 * kk, 16 * ni);
#pragma unroll
          for (int j = 0; j < 2; ++j) { const int pi = (wave >> 2) + 2 * j;
#pragma unroll
            for (int r = 0; r < 4; ++r) accH[j][r] *= dec;
#pragma unroll
            for (int kk = 0; kk < 2; ++kk) accH[j] = mfma16(FTR(Xs, 72, 32 * kk, 16 * pi), bB[kk], accH[j]); } }
        LDS_BARRIER(); STG(4);
#pragma unroll
        for (int j = 0; j < 2; ++j) { const int idx = wave + 8 * j, pi = idx >> 2, ni = idx & 3;
            *(LAS u32x2*)(HbT + (16 * ni + fr) * 72 + 16 * pi + 4 * fq) = pack4(accH[j][0], accH[j][1], accH[j][2], accH[j][3]); }
        { const int t = tid >> 3, part = tid & 7; float f[8], z[8]; unpack8(*(const LAS u32x4*)(Ys + t * 72 + 8 * part), f); unpack8(ps, z);
#pragma unroll
            for (int i = 0; i < 8; ++i) f[i] *= siluf(z[i]);
            if (t < nv) *(u32x4*)(BR2 + (size_t)(tok0 + t0 + t) * 512 + hd * 64 + 8 * part) = pack8(f); }
        SSD_PREFETCH_Z(t0 + 64);
        LDS_BARRIER(); STG(5);
    }
#undef SSD_PREFETCH_Z
#undef SSD_PREFETCH
    STG_TOTAL(); STG_FINI(hd == 0 ? 2 : -1);
    { float* ho = A.out + (sample ? O_SH : O_PH) + ((size_t)(l * NB + b) * 8 + hd) * 4096;
#pragma unroll
        for (int j = 0; j < 2; ++j) { const int idx = wave + 8 * j, pi = idx >> 2, ni = idx & 3;
            float* hp = ho + (16 * pi + 4 * fq) * 64 + 16 * ni + fr; OPQV(hp);
#pragma unroll
            for (int r = 0; r < 4; ++r) hp[r * 64] = accH[j][r]; } }
    for (int e = tid; e < 3 * 192; e += NTHREADS) { const int r = e / 192, c = e % 192;
        if (c < 64 || (hd & 3) == 0) A.out[(sample ? O_SV : O_PV) + ((size_t)(l * NB + b) * 3 + r) * 768 + ssd_chmap(hd, c)] = bf2f(HIST[r * 200 + c]); }
    __syncthreads();
}

__device__ __forceinline__ void phase_ssdnorm(ArgP Ap, int l) {
    const int tx = opaque_tid(), lane = tx & 63, wave = tx >> 6, gw = obid() * NWAVES + wave, NGW = ogrid() * NWAVES;
    bf16* BR2 = (bf16*)(A.ws + WS_BR) + (size_t)T * 1024; const float* sn = A.in[20] + l * 512 + 8 * lane;
    for (int tok = gw; tok < T; tok += NGW) { float f[8]; unpack8(*(const u32x4*)(BR2 + (size_t)tok * 512 + 8 * lane), f); float s2 = 0.f;
#pragma unroll
        for (int i = 0; i < 8; ++i) s2 += f[i] * f[i];
#pragma unroll
        for (int m = 1; m < 32; m <<= 1) s2 += __shfl_xor(s2, m);
        const float rstd = frsq(s2 * (1.0f / 256.0f) + EPS_);
#pragma unroll
        for (int i = 0; i < 8; ++i) f[i] *= rstd * sn[i];
        *(u32x4*)(BR2 + (size_t)tok * 512 + 8 * lane) = pack8(f); }
}

__device__ __forceinline__ void mixer_item(ArgP Ap, LAS unsigned char* lds, int l, int it) {
    constexpr int NL0 = BP * 4, NL1 = NL0 + BP * 4, NL2 = NL1 + BP * 8, NS0 = NL2 + BS * 4, NS1 = NS0 + BS * 4;
    int kind, r; bool sample;
    if (it < NL0) { kind = 0; r = it; sample = false; } else if (it < NL1) { kind = 1; r = it - NL0; sample = false; } else if (it < NL2) { kind = 2; r = it - NL1; sample = false; }
    else if (it < NS0) { kind = 0; r = it - NL2; sample = true; } else if (it < NS1) { kind = 1; r = it - NS0; sample = true; } else { kind = 2; r = it - NS1; sample = true; }
#ifndef ONLYK
#define ONLYK -1
#endif
#ifndef EMU
#define OPQ() ArgP Ap_ = Ap; int l_ = __builtin_amdgcn_readfirstlane(l), r_ = __builtin_amdgcn_readfirstlane(r); LAS unsigned char* lds_ = lds; asm volatile("" : "+s"(Ap_), "+s"(l_), "+s"(r_), "+s"(lds_) :: "memory")
#else
#define OPQ() ArgP Ap_ = Ap; int l_ = l, r_ = r; LAS unsigned char* lds_ = lds
#endif
    if ((ONLYK < 0 || ONLYK == 0) && kind == 0) { OPQ(); mlstm_item(Ap_, lds_, l_, r_ >> 2, r_ & 3, sample); }
    else if ((ONLYK < 0 || ONLYK == 1) && kind == 1) { OPQ(); gla_item(Ap_, lds_, l_, r_ >> 2, r_ & 3, sample); }
    else if ((ONLYK < 0 || ONLYK == 2) && kind == 2) { OPQ(); ssd_item(Ap_, lds_, l_, r_ >> 3, r_ & 7, sample); }
#undef OPQ
}
__device__ __forceinline__ void phase_mixers(ArgP Ap, LAS unsigned char* lds, int l) {
    constexpr int NLONG = BP * 16, NSHORT = BS * 16; int G = ogrid(), bid = obid(); OPQS(G); OPQS(bid);
#ifdef MIX_NOSPLIT
    const bool split = false;
#else
    const bool split = G > NLONG;
#endif
#ifndef MIX_IDLE
#define MIX_IDLE 0
#endif
    const int step = split ? (bid < NLONG ? (1 << 28) : G - NLONG - MIX_IDLE) : G;
    if (split && MIX_IDLE && bid >= G - MIX_IDLE) return;
#ifndef MIXREP
#define MIXREP 0
#endif
#pragma unroll 1
    for (int it = bid; it < NLONG + NSHORT; it += step) {
        const int reps = ((MIXREP == 1 && it < NLONG) || (MIXREP == 2 && it >= NLONG) || (MIXREP == 3 && it < BP * 4) || (MIXREP == 4 && it >= BP * 4 && it < BP * 8) || (MIXREP == 5 && it >= BP * 8 && it < NLONG)) ? 2 : 1;
#pragma unroll 1
        for (int rp = 0; rp < reps; ++rp) mixer_item(Ap, lds, l, it);
    }
    if (!split || bid >= NLONG) { const int part = split ? bid - NLONG : bid, nparts = split ? G - NLONG : G;
        __syncthreads();
        convert_tables(Ap, l, part, nparts);
        if (l == 0) convert_weights(Ap, lds, 1, part, nparts); }
}

__device__ __forceinline__ float wave_sum64(float v) {
#pragma unroll
    for (int m = 1; m < 64; m <<= 1) v += __shfl_xor(v, m);
    return v;
}
constexpr float DN_ALPHA_ = 1.4142135623730951f;

__device__ __forceinline__ void phase_ln1(ArgP Ap, int l) {
    const int tx = opaque_tid(), lane = tx & 63, wave = tx >> 6, gw = obid() * NWAVES + wave, NGW = ogrid() * NWAVES;
    const float* Y = (const float*)(A.ws + WS_ZG); float* H = (float*)(A.ws + WS_H); bf16* H1B = (bf16*)(A.ws + WS_BR);
    const float* lg = A.in[23] + l * D + 16 * lane; const float* lb = A.in[24] + l * D + 16 * lane;
    for (int tok = gw; tok < T; tok += NGW) {
        const float* xr = (l == 0) ? (tok < TP ? A.in[0] + (size_t)tok * D : A.in[1] + (size_t)(tok - TP) * D) : H + (size_t)tok * D;
        float y[16]; float s1 = 0.f;
#pragma unroll
        for (int q = 0; q < 4; ++q) { const float4 a = *(const float4*)(xr + 16 * lane + 4 * q), b = *(const float4*)(Y + (size_t)tok * D + 16 * lane + 4 * q);
            y[4 * q] = DN_ALPHA_ * a.x + b.x; y[4 * q + 1] = DN_ALPHA_ * a.y + b.y; y[4 * q + 2] = DN_ALPHA_ * a.z + b.z; y[4 * q + 3] = DN_ALPHA_ * a.w + b.w; }
#pragma unroll
        for (int i = 0; i < 16; ++i) s1 += y[i];
        const float mu = wave_sum64(s1) * (1.0f / D); float s2 = 0.f;
#pragma unroll
        for (int i = 0; i < 16; ++i) { y[i] -= mu; s2 += y[i] * y[i]; }
        const float rstd = frsq(wave_sum64(s2) * (1.0f / D) + EPS_);
#pragma unroll
        for (int i = 0; i < 16; ++i) y[i] = y[i] * rstd * lg[i] + lb[i];
#pragma unroll
        for (int q = 0; q < 4; ++q) *(float4*)(H + (size_t)tok * D + 16 * lane + 4 * q) = make_float4(y[4 * q], y[4 * q + 1], y[4 * q + 2], y[4 * q + 3]);
        float y0[8], y1[8];
#pragma unroll
        for (int i = 0; i < 8; ++i) { y0[i] = y[i]; y1[i] = y[8 + i]; }
        *(u32x4*)(H1B + (size_t)tok * D + 16 * lane) = pack8(y0); *(u32x4*)(H1B + (size_t)tok * D + 16 * lane + 8) = pack8(y1);
    }
}

__device__ __forceinline__ unsigned ord_of(float f) { const unsigned u = __float_as_uint(f); return (u & 0x80000000u) ? ~u : (u | 0x80000000u); }
__device__ __forceinline__ float dec_ord(unsigned o) { const unsigned u = (o & 0x80000000u) ? (o & 0x7fffffffu) : ~o; return __uint_as_float(u); }
__device__ __forceinline__ unsigned umax_(unsigned a, unsigned b) { return a > b ? a : b; }
__device__ __forceinline__ unsigned umin_(unsigned a, unsigned b) { return a < b ? a : b; }
__device__ __forceinline__ void ins16(unsigned (&L)[16], unsigned x) {
#pragma unroll
    for (int p = 0; p < 16; ++p) { const unsigned hi = umax_(L[p], x); x = umin_(L[p], x); L[p] = hi; }
}
__device__ __forceinline__ unsigned sel16(const unsigned (&L)[16], int a) { unsigned r = L[0];
#pragma unroll
    for (int p = 1; p < 16; ++p) r = (a == p) ? L[p] : r;
    return r; }

#define CE_DESC(a, b) do { const unsigned hi_ = umax_(a, b), lo_ = umin_(a, b); a = hi_; b = lo_; } while (0)
__device__ __forceinline__ void bitonic_sort16_desc(unsigned (&a)[16]) {
#pragma unroll
    for (int k = 2; k <= 16; k <<= 1)
#pragma unroll
        for (int j = k >> 1; j > 0; j >>= 1)
#pragma unroll
            for (int i = 0; i < 16; ++i) { const int l2 = i ^ j; if (l2 > i) { if ((i & k) == 0) CE_DESC(a[i], a[l2]); else CE_DESC(a[l2], a[i]); } }
}
__device__ __forceinline__ void bitonic_merge16_desc(unsigned (&a)[16]) {
#pragma unroll
    for (int j = 8; j > 0; j >>= 1)
#pragma unroll
        for (int i = 0; i < 16; ++i) { const int l2 = i ^ j; if (l2 > i) CE_DESC(a[i], a[l2]); }
}
__device__ __forceinline__ void merge_top16(unsigned (&a)[16], const unsigned (&b)[16]) {
#pragma unroll
    for (int i = 0; i < 16; ++i) a[i] = umax_(a[i], b[15 - i]);
    bitonic_merge16_desc(a);
}
__device__ __forceinline__ void route_topk(const bf16* __restrict__ Q, const LAS bf16* KEYS, int tokb, int h, int j, int fr, int fq, unsigned (&Lt)[16]) {
    f32x4 acc[8];
#pragma unroll
    for (int ki = 0; ki < 8; ++ki) acc[ki] = (f32x4){0.f, 0.f, 0.f, 0.f};
#pragma unroll
    for (int kk = 0; kk < 4; ++kk) { const bf16x8 bq = *(const bf16x8*)(Q + (size_t)(tokb + fr) * 2048 + h * 256 + j * 128 + 32 * kk + 8 * fq);
#pragma unroll
        for (int ki = 0; ki < 8; ++ki) { const bf16x8 ak = *(const LAS bf16x8*)(KEYS + (j * 128 + 16 * ki + fr) * 136 + 32 * kk + 8 * fq); acc[ki] = mfma16(ak, bq, acc[ki]); } }
    unsigned Lb[16];
#pragma unroll
    for (int ki = 0; ki < 4; ++ki)
#pragma unroll
        for (int r = 0; r < 4; ++r) { Lt[4 * ki + r] = (ord_of(acc[ki][r]) & ~127u) | (unsigned)(127 - (16 * ki + 4 * fq + r)); Lb[4 * ki + r] = (ord_of(acc[4 + ki][r]) & ~127u) | (unsigned)(127 - (16 * (4 + ki) + 4 * fq + r)); }
    bitonic_sort16_desc(Lt); bitonic_sort16_desc(Lb); merge_top16(Lt, Lb);
#pragma unroll
    for (int m = 16; m < 64; m <<= 1) { unsigned R[16];
#pragma unroll
        for (int p = 0; p < 16; ++p) R[p] = __shfl_xor(Lt[p], m);
        merge_top16(Lt, R); }
}

__device__ __forceinline__ void phase_route(ArgP Ap, LAS unsigned char* lds, int l) {
    const int tid = opaque_tid(), lane = tid & 63, wave = tid >> 6, fr = lane & 15, fq = lane >> 4;
    LAS bf16* KEYS = (LAS bf16*)lds;
    LAS unsigned* LST = (LAS unsigned*)(lds + 69632);
    const bf16* Q = (const bf16*)(A.ws + WS_Q); int* IDX = (int*)(A.ws + WS_IDX); float* GT = (float*)(A.ws + WS_GT);
    const bf16* kg = (const bf16*)(A.ws + WS_WB + (size_t)l * WB_BYTES + WB_KEYS);
    constexpr int NG = T / 16, NCH = (NG + 7) / 8, NITEMS = NCH * 8;
    int last_h = -1;
    for (int it = obid(); it < NITEMS; it += ogrid()) {
        const int h = it & 7, ch = it >> 3;
        if (h != last_h) { __syncthreads();
            for (int c = tid; c < 2 * 128 * 16; c += NTHREADS) { const int row = c >> 4, cc = (c & 15) * 8; *(LAS u32x4*)(KEYS + row * 136 + cc) = *(const u32x4*)(kg + ((size_t)h * 256 + row) * 128 + cc); }
            __syncthreads(); last_h = h; }
        const int grp = ch * 8 + wave;
        if (grp < NG) {
            const int tokb = grp * 16; unsigned L1[16], L2[16];
            route_topk(Q, KEYS, tokb, h, 0, fr, fq, L1); route_topk(Q, KEYS, tokb, h, 1, fr, fq, L2);
#define CAND(a, b) ((ord_of(dec_ord(L1[a] & ~127u) + dec_ord(L2[b] & ~127u)) & ~255u) | (unsigned)(255 - ((a) * 16 + (b))))
            unsigned C[16], X[16];
#pragma unroll
            for (int b2 = 0; b2 < 16; ++b2) C[b2] = CAND(0, b2);
#pragma unroll
            for (int b2 = 0; b2 < 8; ++b2) { X[b2] = CAND(1, b2); X[15 - b2] = CAND(8 + b2, 0); }
            bitonic_merge16_desc(X); merge_top16(C, X);
#pragma unroll
            for (int a = 2; a < 8; ++a)
#pragma unroll
                for (int b2 = 0; b2 < 16; ++b2) if ((a + 1) * (b2 + 1) <= 16) ins16(C, CAND(a, b2));
#undef CAND
            const float s0 = dec_ord(C[0] & ~255u); float e[16]; float sum = 0.f;
#pragma unroll
            for (int p = 0; p < 16; ++p) { e[p] = __expf(dec_ord(C[p] & ~255u) - s0); sum += e[p]; }
            const float inv = frcp(sum); const size_t ob = (size_t)(tokb + fr) * 128 + h * 16;
#pragma unroll
            for (int p = 0; p < 16; ++p) { LST[(wave * 32 + p) * 64 + lane] = L1[p]; LST[(wave * 32 + 16 + p) * 64 + lane] = L2[p]; }
#pragma unroll
            for (int p = 0; p < 16; ++p) { const int cid = 255 - (int)(C[p] & 255u); const int a = cid >> 4, b = cid & 15;
                const int e1 = 127 - (int)(LST[(wave * 32 + a) * 64 + lane] & 127u), e2 = 127 - (int)(LST[(wave * 32 + 16 + b) * 64 + lane] & 127u);
                if ((p >> 2) == fq) { IDX[ob + p] = e1 * 128 + e2; GT[ob + p] = e[p] * inv; } }
        }
    }
}

__device__ __forceinline__ void phase_gather(ArgP Ap, int l) {
    const int tx = opaque_tid(), lane = tx & 63, wave = tx >> 6, gw = obid() * NWAVES + wave, NGW = ogrid() * NWAVES, rho = lane >> 4;
    float* H = (float*)(A.ws + WS_H); bf16* XB = (bf16*)(A.ws + WS_XB); const int* IDX = (const int*)(A.ws + WS_IDX); const float* GT = (const float*)(A.ws + WS_GT);
    const unsigned char* PU = A.ws + WS_PU; const unsigned char* PV = A.ws + WS_PV; const float* PUS = (const float*)(A.ws + WS_PUS); const float* PVS = (const float*)(A.ws + WS_PVS);
    const float* lgb = A.in[29] + l * D; const float* lbb = A.in[30] + l * D; const int l16 = 16 * lane;
    const int kofs = 2 * (rho & 1) + (rho >> 1);
    for (int tok = gw; tok < T; tok += NGW) {
        const int i0 = IDX[(size_t)tok * 128 + lane], i1 = IDX[(size_t)tok * 128 + 64 + lane];
        float x[16];
#pragma unroll
        for (int q = 0; q < 4; ++q) { const float4 a = *(const float4*)(H + (unsigned)tok * D + l16 + 4 * q); x[4 * q] = a.x; x[4 * q + 1] = a.y; x[4 * q + 2] = a.z; x[4 * q + 3] = a.w; }
        const float su0 = PUS[i0], su1 = PUS[i1];
        const float gv0 = GT[(size_t)tok * 128 + lane] * PVS[i0], gv1 = GT[(size_t)tok * 128 + 64 + lane] * PVS[i1];
        float o[16];
#pragma unroll
        for (int i = 0; i < 16; ++i) o[i] = 0.f;
#pragma unroll 1
        for (int kb = 0; kb < 128; kb += 8) {
            u32x4 uu[8], vv[8];
#pragma unroll
            for (int kk = 0; kk < 8; ++kk) { const int e = __shfl(kb < 64 ? i0 : i1, (kb + kk) & 63);
                const unsigned off = (unsigned)e * D + l16; uu[kk] = *(const u32x4*)(PU + off); vv[kk] = *(const u32x4*)(PV + off); }
            float r[2];
#pragma unroll
            for (int i = 0; i < 2; ++i) { float p[4];
#pragma unroll
                for (int c = 0; c < 4; ++c) { const int kk = 4 * i + c; float f[16]; unpk_fp8x4(uu[kk].x, f); unpk_fp8x4(uu[kk].y, f + 4); unpk_fp8x4(uu[kk].z, f + 8); unpk_fp8x4(uu[kk].w, f + 12); float s = 0.f;
#pragma unroll
                    for (int j = 0; j < 16; ++j) s += f[j] * x[j];
                    p[c] = s; SCHED_FENCE(); }
                float t = row_allsum(swap16_add(swap32_add(p[0], p[1]), swap32_add(p[2], p[3])));
                const int kq = kb + 4 * i + kofs;
                t *= __shfl(kb < 64 ? su0 : su1, kq & 63);
                r[i] = gelu_fast(t) * __shfl(kb < 64 ? gv0 : gv1, kq & 63); SCHED_FENCE(); }
#pragma unroll
            for (int kk = 0; kk < 8; ++kk) { const int c = kk & 3; const float act = RDLANE(r[kk >> 2], 16 * (((c & 1) << 1) | ((c >> 1) & 1)));
                float f[16]; unpk_fp8x4(vv[kk].x, f); unpk_fp8x4(vv[kk].y, f + 4); unpk_fp8x4(vv[kk].z, f + 8); unpk_fp8x4(vv[kk].w, f + 12);
#pragma unroll
                for (int j = 0; j < 16; ++j) o[j] += act * f[j];
                SCHED_FENCE(); }
        }
        float s1 = 0.f;
#pragma unroll
        for (int i = 0; i < 16; ++i) { o[i] += DN_ALPHA_ * x[i]; s1 += o[i]; }
        const float mu = wave_sum64(s1) * (1.0f / D); float s2 = 0.f;
#pragma unroll
        for (int i = 0; i < 16; ++i) { o[i] -= mu; s2 += o[i] * o[i]; }
        const float rstd = frsq(wave_sum64(s2) * (1.0f / D) + EPS_);
#pragma unroll
        for (int i = 0; i < 16; ++i) o[i] = o[i] * rstd * lgb[l16 + i] + lbb[l16 + i];
        float* dst = ((l == 1) ? A.out : H) + (unsigned)tok * D + l16;
#pragma unroll
        for (int q = 0; q < 4; ++q) *(float4*)(dst + 4 * q) = make_float4(o[4 * q], o[4 * q + 1], o[4 * q + 2], o[4 * q + 3]);
        if (l == 0) { float y0[8], y1[8];
#pragma unroll
            for (int i = 0; i < 8; ++i) { y0[i] = o[i]; y1[i] = o[8 + i]; }
            *(u32x4*)(XB + (unsigned)tok * D + l16) = pack8(y0); *(u32x4*)(XB + (unsigned)tok * D + l16 + 8) = pack8(y1); }
    }
}


#ifndef EMU
struct MergeOrder {
    pg8::StaticOrder S;
    __device__ bool next(int i, pg8::Unit& u) const { pg8::Unit t; if (!S.next(i, t)) return false; const int n = t.pm / (T / 256); u.pm = t.pm; u.pn = n * 4 + t.pn; return true; }
    __device__ __forceinline__ void a_ready(const pg8::Unit&) const {}
    __device__ __forceinline__ void done(const pg8::Unit&) const {}
};
struct EpiP {
    static constexpr bool PERM = true, AFTER_DRAIN = false;
    bf16* P;
    __device__ __forceinline__ void operator()(const pg8::f32x4 (&acc)[2][2][4][2], const pg8::Unit& u, int wr, int wc, int fr, int fq) const {
        const int row0 = u.pm * 256 + wr * 64 + fr, col0 = (u.pn & 3) * 256 + wc * 32 + 8 * fq;
#pragma unroll
        for (int ai = 0; ai < 2; ++ai)
#pragma unroll
            for (int m = 0; m < 4; ++m) { bf16* rowp = P + (size_t)(row0 + ai * 128 + m * 16) * D + col0;
#pragma unroll
                for (int bj = 0; bj < 2; ++bj) { const pg8::f32x4 v0 = acc[ai][bj][m][0], v1 = acc[ai][bj][m][1];
                    u32x4 w; w.x = pg8::cvt_pk_bf16(v0[0], v0[1]); w.y = pg8::cvt_pk_bf16(v0[2], v0[3]); w.z = pg8::cvt_pk_bf16(v1[0], v1[1]); w.w = pg8::cvt_pk_bf16(v1[2], v1[3]);
                    *(u32x4*)(rowp + bj * 128) = w; } }
    }
};
__device__ __forceinline__ void phase_merge(ArgP Ap, LAS unsigned char* lds, int l) {
    pg8::Gemm g{(const bf16*)(A.ws + WS_BR), (const bf16*)(A.ws + WS_WB + (size_t)l * WB_BYTES + WB_WBR), 3 * T, 3 * D, 512};
    MergeOrder S; S.S.init(3 * T, D, ogrid(), obid());
    EpiP E{(bf16*)(A.ws + WS_ZM)};
    pg8::gemm_phase<EpiP, MergeOrder>(lds, g, S, E);
}
#endif
__device__ __forceinline__ void phase_combine(ArgP Ap) {
    const size_t gtid = (size_t)obid() * NTHREADS + opaque_tid(), gthreads = (size_t)ogrid() * NTHREADS;
    const bf16* P = (const bf16*)(A.ws + WS_ZM); const bf16* ZG = (const bf16*)(A.ws + WS_ZG); bf16* MIXED = (bf16*)(A.ws + WS_XB);
    for (size_t i = gtid; i < (size_t)T * (D / 8); i += gthreads) { const size_t t = i >> 7, c = (i & 127) * 8; float v[8];
#pragma unroll
        for (int j = 0; j < 8; ++j) v[j] = 0.f;
#pragma unroll
        for (int n = 0; n < 3; ++n) { float p[8], g[8]; unpack8(*(const u32x4*)(P + ((size_t)n * T + t) * D + c), p); unpack8(*(const u32x4*)(ZG + t * NZG + n * D + c), g);
#pragma unroll
            for (int j = 0; j < 8; ++j) v[j] += p[j] * g[j]; }
        *(u32x4*)(MIXED + t * D + c) = pack8(v); }
}
#ifndef EMU
struct EpiF32 {
    static constexpr bool PERM = false, AFTER_DRAIN = false;
    float* C; int ldc;
    __device__ __forceinline__ void operator()(const pg8::f32x4 (&acc)[2][2][4][2], const pg8::Unit& u, int wr, int wc, int fr, int fq) const {
        const int row0 = u.pm * 256 + wr * 64 + fr, col0 = u.pn * 256 + wc * 32 + 4 * fq;
#pragma unroll
        for (int ai = 0; ai < 2; ++ai)
#pragma unroll
            for (int m = 0; m < 4; ++m) { float* rowp = C + (size_t)(row0 + ai * 128 + m * 16) * ldc + col0;
#pragma unroll
                for (int bj = 0; bj < 2; ++bj)
#pragma unroll
                    for (int n = 0; n < 2; ++n) *(pg8::f32x4*)(rowp + bj * 128 + n * 16) = acc[ai][bj][m][n]; }
    }
};
struct EpiB16 {
    static constexpr bool PERM = true, AFTER_DRAIN = false;
    bf16* O; int ldc;
    __device__ __forceinline__ void operator()(const pg8::f32x4 (&acc)[2][2][4][2], const pg8::Unit& u, int wr, int wc, int fr, int fq) const {
        const int row0 = u.pm * 256 + wr * 64 + fr, col0 = u.pn * 256 + wc * 32 + 8 * fq;
#pragma unroll
        for (int ai = 0; ai < 2; ++ai)
#pragma unroll
            for (int m = 0; m < 4; ++m) { bf16* rowp = O + (size_t)(row0 + ai * 128 + m * 16) * ldc + col0;
#pragma unroll
                for (int bj = 0; bj < 2; ++bj) { const pg8::f32x4 v0 = acc[ai][bj][m][0], v1 = acc[ai][bj][m][1];
                    u32x4 w; w.x = pg8::cvt_pk_bf16(v0[0], v0[1]); w.y = pg8::cvt_pk_bf16(v0[2], v0[3]); w.z = pg8::cvt_pk_bf16(v1[0], v1[1]); w.w = pg8::cvt_pk_bf16(v1[2], v1[3]);
                    *(u32x4*)(rowp + bj * 128) = w; } }
    }
};
__device__ __forceinline__ void phase_outproj(ArgP Ap, LAS unsigned char* lds, int l) {
    pg8::Gemm g{(const bf16*)(A.ws + WS_XB), (const bf16*)(A.ws + WS_WB + (size_t)l * WB_BYTES + WB_WO), T, D, D};
    pg8::StaticOrder S; S.init(T, D, ogrid(), obid());
    EpiF32 E{(float*)(A.ws + WS_ZG), D};
    pg8::gemm_phase<EpiF32, pg8::StaticOrder>(lds, g, S, E);
}
__device__ __forceinline__ void phase_qproj(ArgP Ap, LAS unsigned char* lds, int l) {
    pg8::Gemm g{(const bf16*)(A.ws + WS_BR), (const bf16*)(A.ws + WS_WB + (size_t)l * WB_BYTES + WB_WQ), T, 2048, D};
    pg8::StaticOrder S; S.init(T, 2048, ogrid(), obid());
    EpiB16 E{(bf16*)(A.ws + WS_Q), 2048};
    pg8::gemm_phase<EpiB16, pg8::StaticOrder>(lds, g, S, E);
}

__global__ void __launch_bounds__(NTHREADS, 2) mega_fwd(Args kargs) {
    extern __shared__ __attribute__((aligned(16))) unsigned char lds_raw[];
    LAS unsigned char* lds = (LAS unsigned char*)lds_raw;
    volatile LAS unsigned* xst = (volatile LAS unsigned*)(lds + LDS_BYTES - 16);
    unsigned* xbar = (unsigned*)(kargs.ws + WS_CTL);
    if (threadIdx.x < 4) xst[threadIdx.x] = 0u;
    if (blockIdx.x == 0) for (int i = threadIdx.x; i < XCD_BAR_WORDS; i += NTHREADS) xbar[i] = 0u;
#ifdef STAGE_AMP
    if (blockIdx.x == 0 && threadIdx.x < 128) ((unsigned long long*)(kargs.ws + WS_CTL + 40960))[threadIdx.x] = 0ull;
#endif
    __syncthreads();
    XcdBarrier xb; xb.bar = xbar; xb.x = 0; xb.st = xst;
    ArgP Ap = (ArgP)__builtin_amdgcn_kernarg_segment_ptr();
#define RUN(call) do { ArgP Ap_ = Ap; int l_ = l; LAS unsigned char* lds_ = lds; asm volatile("" : "+s"(Ap_), "+s"(l_), "+s"(lds_) :: "memory"); { ArgP Ap = Ap_; const int l = l_; LAS unsigned char* lds = lds_; (void)lds; call; } asm volatile("" ::: "memory"); } while (0)
#ifndef ONLYP
#define ONLYP -1
#endif
#ifndef SKIPP
#define SKIPP -2
#endif
#define PSEL(q) ((ONLYP < 0 || ONLYP == (q)) && SKIPP != (q))
#ifndef REPMASK
#define REPMASK 0
#endif
#define REP(q, l) (((REPMASK >> (q)) & 1) && ((q) != 5 || (l) == 0) && ((q) != 8 || (l) == 1))
#define IN(k) true
#ifdef AMP_PHASE
#define TSTAMP(k) do { if (blockIdx.x == 0 && threadIdx.x == 0) ((unsigned long long*)(kargs.ws + WS_CTL + 32768))[(k)] = __builtin_amdgcn_s_memrealtime(); } while (0)
#else
#define TSTAMP(k) do {} while (0)
#endif
#define SEAM(k) do { if ((k) == 0) { cg::this_grid().sync(); xb = xcd_barrier_post(xbar, xst); } else xcd_barrier(xb); TSTAMP((k) + 1); } while (0)
#pragma unroll 1
    TSTAMP(0);
    {
    { const int l = 0; if (PSEL(0) && IN(0)) { RUN(phase_convert(Ap, lds)); if (REP(0, l)) RUN(phase_convert(Ap, lds)); } (void)l; }
    SEAM(0);
    for (int l = 0; l < 2; ++l) {
        const int p = 1 + 10 * l;
        if (PSEL(1) && IN(p + 0)) { RUN(phase_gemm1(Ap, lds, l)); if (REP(1, l)) RUN(phase_gemm1(Ap, lds, l)); }
        SEAM(p);
        if (PSEL(2) && IN(p + 1)) { RUN(phase_mixers(Ap, lds, l)); if (REP(2, l)) RUN(phase_mixers(Ap, lds, l)); }
        SEAM(p + 1);
#ifdef XBAR_EXTRA
        for (int xe = 0; xe < XBAR_EXTRA; ++xe) xcd_barrier(xb);
#endif
        if (PSEL(9) && IN(p + 2)) RUN(phase_ssdnorm(Ap, l));
        SEAM(p + 2);
        if (PSEL(3) && IN(p + 3)) { RUN(phase_merge(Ap, lds, l)); if (REP(3, l)) RUN(phase_merge(Ap, lds, l)); }
        SEAM(p + 3);
        if (PSEL(10) && IN(p + 4)) RUN(phase_combine(Ap));
        SEAM(p + 4);
        if (PSEL(4) && IN(p + 5)) { RUN(phase_outproj(Ap, lds, l)); if (REP(4, l)) RUN(phase_outproj(Ap, lds, l)); }
        SEAM(p + 5);
        if (PSEL(5) && IN(p + 6)) { RUN(phase_ln1(Ap, l)); if (REP(5, l)) RUN(phase_ln1(Ap, l)); }
        SEAM(p + 6);
        if (PSEL(6) && IN(p + 7)) { RUN(phase_qproj(Ap, lds, l)); if (REP(6, l)) RUN(phase_qproj(Ap, lds, l)); }
        SEAM(p + 7);
        if (PSEL(7) && IN(p + 8)) { RUN(phase_route(Ap, lds, l)); if (REP(7, l)) RUN(phase_route(Ap, lds, l)); }
        SEAM(p + 8);
        if (PSEL(8) && IN(p + 9)) { RUN(phase_gather(Ap, l)); if (REP(8, l)) RUN(phase_gather(Ap, l)); }
        SEAM(p + 9);
    }
    }
#ifdef AMP_PHASE
    if (blockIdx.x == 0 && threadIdx.x == 0) { const unsigned long long* ts = (const unsigned long long*)(kargs.ws + WS_CTL + 32768);
        const unsigned long long dt = (ts[AMP_PHASE + 1] - ts[AMP_PHASE]) * 8ull, t0 = __builtin_amdgcn_s_memrealtime();
        while (__builtin_amdgcn_s_memrealtime() - t0 < dt) __builtin_amdgcn_s_sleep(8); }
#endif
#ifdef STAGE_AMP
    if (blockIdx.x == 0 && threadIdx.x == 0) { const unsigned long long dt = ((const unsigned long long*)(kargs.ws + WS_CTL + 40960))[STAGE_AMP] * 8ull, t0 = __builtin_amdgcn_s_memrealtime();
        while (__builtin_amdgcn_s_memrealtime() - t0 < dt) __builtin_amdgcn_s_sleep(8); }
#endif
#undef IN
#undef RUN
#undef SEAM
}

extern "C" void kernel_launch(void* const* d_in, const int* in_sizes, int n_in, void* d_out, int out_size, void* d_ws, size_t ws_size, hipStream_t stream) {
    static int grid_blocks = 0;
    if (grid_blocks == 0) {
        if (n_in != 31 || (size_t)out_size != O_END || ws_size < WS_END) {
            fprintf(stderr, "kernel_launch: unexpected problem: n_in %d out %d (want %zu) ws %zu (want >= %zu)\n", n_in, out_size, (size_t)O_END, ws_size, (size_t)WS_END); grid_blocks = -1; return; }
        int dev = 0, cus = 0, per_cu = 0;
        (void)hipGetDevice(&dev); (void)hipDeviceGetAttribute(&cus, hipDeviceAttributeMultiprocessorCount, dev);
        if (hipFuncSetAttribute((const void*)mega_fwd, hipFuncAttributeMaxDynamicSharedMemorySize, LDS_BYTES) != hipSuccess) { fprintf(stderr, "kernel_launch: hipFuncSetAttribute failed\n"); grid_blocks = -1; return; }
        if (hipOccupancyMaxActiveBlocksPerMultiprocessor(&per_cu, (const void*)mega_fwd, NTHREADS, LDS_BYTES) != hipSuccess || per_cu < 1) { fprintf(stderr, "kernel_launch: occupancy query failed (%d)\n", per_cu); grid_blocks = -1; return; }
        grid_blocks = cus * per_cu;
        fprintf(stderr, "kernel_launch: %d CUs x %d = %d workgroups\n", cus, per_cu, grid_blocks);
    }
    if (grid_blocks < 0) return;
    Args a{};
    for (int i = 0; i < 31; ++i) a.in[i] = (const float*)d_in[i];
    a.out = (float*)d_out; a.ws = (unsigned char*)d_ws; a.ph_lo = 0; a.ph_hi = 64;
    void* args[] = {&a};
    hipError_t e = hipLaunchCooperativeKernel((const void*)mega_fwd, dim3(grid_blocks), dim3(NTHREADS), args, LDS_BYTES, stream);
    if (e != hipSuccess) fprintf(stderr, "kernel_launch: cooperative launch failed: %s (grid %d)\n", hipGetErrorString(e), grid_blocks);
}
#endif
```
